# Optimizing an MI355X kernel written in HIP

```python
import math
import jax, jax.numpy as jnp
from jax import lax
import numpy as np

D_MODEL = 1024
BATCH = 8
SEQ = 4096
DEPTH = 2
DEC_BATCH = 128
DEC_SEQ = 4
PAST_LEN = 16384
PAGE_SIZE = 128

N_MIXERS = 2
HEAD_DIM = 64
A_HEADS = 12
A_KV_HEADS = 4
A_GROUP = A_HEADS // A_KV_HEADS
WINDOW = 128
BLOCK = 128
W_BUF = min(WINDOW, PAST_LEN)
B_WIDTH = 768
B_GROUPS = 4
B_GROUP_DIM = B_WIDTH // B_GROUPS
CHUNK = 128
X_HEADS = 4
X_WIDTH = X_HEADS * HEAD_DIM
N_MEM = 256
D_FF = 2816
CONV_W = 3
N_A = (DEPTH + 1) // 2
N_B = DEPTH // 2
A_Q = A_HEADS * HEAD_DIM
A_KV = A_KV_HEADS * HEAD_DIM
A_IN = A_Q + 2 * A_KV + X_WIDTH
A_OUT = A_Q + X_WIDTH
B_IN = 2 * B_WIDTH + X_WIDTH
B_OUT = B_WIDTH + X_WIDTH
EPS = 1e-6
NEG = -1e30

kernel_name = 'swa_sink_gmlp_chunk_memattn_convffn_step'


def rms_norm(x, g):
    xf = x.astype(jnp.float32)
    y = xf * lax.rsqrt(jnp.mean(xf * xf, axis=-1, keepdims=True) + EPS)
    return (y * g.astype(jnp.float32)).astype(x.dtype)


def alibi_slopes(n):
    def pow2(m):
        start = 2.0 ** (-8.0 / m)
        return [start ** (i + 1) for i in range(m)]
    p = 2 ** int(math.floor(math.log2(n)))
    s = pow2(p)
    if p < n:
        s = s + pow2(2 * p)[0::2][: n - p]
    return jnp.asarray(s, jnp.float32)


def sink_gqa_attention(q, k, v, dist, valid, slopes, sinks):
    *lead, nq, _, hd = q.shape
    qg = q.reshape(*lead, nq, A_KV_HEADS, A_GROUP, hd)
    s = jnp.einsum('...qhgd,...khd->...hgqk', qg, k).astype(jnp.float32) * (hd ** -0.5)
    s = s - slopes.reshape(A_KV_HEADS, A_GROUP, 1, 1) * dist[..., None, None, :, :]
    s = jnp.where(valid[..., None, None, :, :], s, NEG)
    sink = sinks.astype(jnp.float32).reshape(A_KV_HEADS, A_GROUP, 1, 1)
    m = jnp.maximum(jnp.max(s, axis=-1, keepdims=True), sink)
    e = jnp.exp(s - m)
    p = e / (jnp.sum(e, axis=-1, keepdims=True) + jnp.exp(sink - m))
    o = jnp.einsum('...hgqk,...khd->...qhgd', p.astype(v.dtype), v)
    return o.reshape(*lead, nq, A_HEADS * hd)


def swa_prompt(q, k, v, slopes, sinks):
    n, t = q.shape[:2]
    nb = t // BLOCK
    qb = q.reshape(n, nb, BLOCK, A_HEADS, HEAD_DIM)

    def band(x):
        xb = x.reshape(n, nb, BLOCK, A_KV_HEADS, HEAD_DIM)
        prev = jnp.pad(xb[:, :-1], ((0, 0), (1, 0), (0, 0), (0, 0), (0, 0)))
        return jnp.concatenate([prev, xb], axis=2)

    i = jnp.arange(BLOCK)[:, None]
    j = jnp.arange(2 * BLOCK)[None, :]
    d = i + BLOCK - j
    kpos = jnp.arange(nb)[:, None, None] * BLOCK - BLOCK + j[None]
    valid = (d >= 0) & (d < WINDOW) & (kpos >= 0)
    dist = jnp.broadcast_to(d.astype(jnp.float32), valid.shape)
    o = sink_gqa_attention(qb, band(k), band(v), dist[None], valid[None], slopes, sinks)
    return o.reshape(n, t, A_Q)


def swa_sample(q, k_new, v_new, k_buf, v_buf, slopes, sinks):
    s = q.shape[1]
    k = jnp.concatenate([k_buf, k_new], axis=1)
    v = jnp.concatenate([v_buf, v_new], axis=1)
    i = jnp.arange(s)[:, None]
    j = jnp.arange(W_BUF + s)[None, :]
    d = i + W_BUF - j
    valid = (d >= 0) & (d < WINDOW)
    o = sink_gqa_attention(q, k, v, d.astype(jnp.float32)[None], valid[None], slopes, sinks)
    return o, k[:, -W_BUF:], v[:, -W_BUF:]


def chunk_spatial_gate(u, vn, w_s, b_s):
    n, t, _ = vn.shape
    L = min(t, CHUNK)
    vc = vn.reshape(n, t // L, L, B_GROUPS, B_GROUP_DIM)
    w = jnp.tril(w_s[:, :L, :L])
    mixed = jnp.einsum('gij,ncjgd->ncigd', w, vc) + b_s[:, :L].T[None, None, :, :, None]
    return u * mixed.reshape(n, t, B_WIDTH)


def memory_kv(mem, g, w, kg):
    n, m, _ = mem.shape
    kv = rms_norm(mem, g) @ w
    mk, mv = jnp.split(kv, 2, axis=-1)
    mk = rms_norm(mk.reshape(n, m, X_HEADS, HEAD_DIM), kg)
    return mk, mv.reshape(n, m, X_HEADS, HEAD_DIM)


def memory_attention(q, mk, mv):
    n, t = q.shape[:2]
    s = jnp.einsum('nthd,nmhd->nhtm', q, mk).astype(jnp.float32) * (HEAD_DIM ** -0.5)
    p = jax.nn.softmax(s, axis=-1)
    o = jnp.einsum('nhtm,nmhd->nthd', p.astype(mv.dtype), mv)
    return o.reshape(n, t, X_WIDTH)


def conv_ffn(x, g, w_in, conv_w, conv_b, w_down, prefix):
    t = x.shape[1]
    gu = rms_norm(x, g) @ w_in
    a, up = jnp.split(gu, 2, axis=-1)
    full = jnp.concatenate([prefix, a], axis=1)
    c = conv_b + sum(conv_w[r] * full[:, r:r + t] for r in range(CONV_W))
    y = (jax.nn.silu(c) * up) @ w_down
    return y, full[:, -(CONV_W - 1):]


def run_group(x, p, is_prompt, mem=None, mem_k_in=None, mem_v_in=None,
              win_k_in=None, win_v_in=None, conv_in=None):
    n, t, _ = x.shape
    slopes = alibi_slopes(A_HEADS)
    win_k, win_v, chunk_v, mem_ks, mem_vs, convs = [], [], [], [], [], []
    for i in range(DEPTH):
        if is_prompt:
            mk, mv = memory_kv(mem, p['mem_norm_g'][i], p['w_mem_kv'][i], p['xk_norm'][i])
            mem_ks.append(mk)
            mem_vs.append(mv)
        else:
            mk, mv = mem_k_in[i], mem_v_in[i]
        h = rms_norm(x, p['norm1_g'][i])
        if i % N_MIXERS == 0:
            a = i // N_MIXERS
            z = h @ p['w_in_a'][a]
            q, k, v, xq = jnp.split(z, [A_Q, A_Q + A_KV, A_Q + 2 * A_KV], axis=-1)
            q = rms_norm(q.reshape(n, t, A_HEADS, HEAD_DIM), p['q_norm_a'][a])
            k = rms_norm(k.reshape(n, t, A_KV_HEADS, HEAD_DIM), p['k_norm_a'][a])
            v = v.reshape(n, t, A_KV_HEADS, HEAD_DIM)
            if is_prompt:
                o = swa_prompt(q, k, v, slopes, p['sinks_a'][a])
                nk, nv = k[:, t - W_BUF:], v[:, t - W_BUF:]
            else:
                o, nk, nv = swa_sample(q, k, v, win_k_in[a], win_v_in[a], slopes, p['sinks_a'][a])
            win_k.append(nk)
            win_v.append(nv)
            w_out = p['w_out_a'][a]
        else:
            b = i // N_MIXERS
            z = h @ p['w_in_b'][b]
            uv, xq = z[..., :2 * B_WIDTH], z[..., 2 * B_WIDTH:]
            u, v = jnp.split(jax.nn.gelu(uv, approximate=False), 2, axis=-1)
            vn = rms_norm(v, p['v_norm_b'][b])
            o = chunk_spatial_gate(u, vn, p['w_s_b'][b], p['b_s_b'][b])
            chunk_v.append(vn[:, ((t - 1) // CHUNK) * CHUNK:])
            w_out = p['w_out_b'][b]
        xq = rms_norm(xq.reshape(n, t, X_HEADS, HEAD_DIM), p['xq_norm'][i])
        xo = memory_attention(xq, mk, mv)
        x = x + jnp.concatenate([o, xo], axis=-1) @ w_out
        prefix = jnp.zeros((n, CONV_W - 1, D_FF), x.dtype) if is_prompt else conv_in[i]
        yf, cst = conv_ffn(x, p['norm2_g'][i], p['w_ffn_in'][i], p['conv_w'][i],
                           p['conv_b'][i], p['w_down'][i], prefix)
        convs.append(cst)
        x = x + yf
    return (x, jnp.stack(win_k), jnp.stack(win_v), jnp.stack(chunk_v),
            mem_ks, mem_vs, jnp.stack(convs))


def setup_inputs(seed: int = 0) -> dict:
    key = jax.random.key(seed)
    ks = jax.random.split(key, 32)
    f32 = jnp.float32
    res = (2 * DEPTH) ** -0.5

    def nrm(k, shape, scale):
        return jax.random.normal(k, shape, f32) * scale

    def gain(k, shape):
        return 1.0 + 0.02 * jax.random.normal(k, shape, f32)

    return {
        'x_prompt': nrm(ks[0], (BATCH, SEQ, D_MODEL), 1.0),
        'x_sample': nrm(ks[1], (DEC_BATCH, DEC_SEQ, D_MODEL), 1.0),
        'cache_win_k': nrm(ks[2], (N_A, DEC_BATCH, W_BUF, A_KV_HEADS, HEAD_DIM), 1.0),
        'cache_win_v': nrm(ks[3], (N_A, DEC_BATCH, W_BUF, A_KV_HEADS, HEAD_DIM), 1.0),
        'cache_mem_k': nrm(ks[4], (DEPTH, DEC_BATCH, N_MEM, X_HEADS, HEAD_DIM), 1.0),
        'cache_mem_v': nrm(ks[5], (DEPTH, DEC_BATCH, N_MEM, X_HEADS, HEAD_DIM), 1.0),
        'state_conv': nrm(ks[6], (DEPTH, DEC_BATCH, CONV_W - 1, D_FF), 1.0),
        'mem_prompt': nrm(ks[7], (BATCH, N_MEM, D_MODEL), 1.0),
        'norm1_g': gain(ks[8], (DEPTH, D_MODEL)),
        'norm2_g': gain(ks[9], (DEPTH, D_MODEL)),
        'mem_norm_g': gain(ks[10], (DEPTH, D_MODEL)),
        'w_in_a': nrm(ks[11], (N_A, D_MODEL, A_IN), D_MODEL ** -0.5),
        'q_norm_a': gain(ks[12], (N_A, HEAD_DIM)),
        'k_norm_a': gain(ks[13], (N_A, HEAD_DIM)),
        'sinks_a': nrm(ks[14], (N_A, A_HEADS), 0.5),
        'w_out_a': nrm(ks[15], (N_A, A_OUT, D_MODEL), A_OUT ** -0.5 * res),
        'w_in_b': nrm(ks[16], (N_B, D_MODEL, B_IN), D_MODEL ** -0.5),
        'v_norm_b': gain(ks[17], (N_B, B_WIDTH)),
        'w_s_b': nrm(ks[18], (N_B, B_GROUPS, CHUNK, CHUNK), CHUNK ** -0.5),
        'b_s_b': gain(ks[19], (N_B, B_GROUPS, CHUNK)),
        'w_out_b': nrm(ks[20], (N_B, B_OUT, D_MODEL), B_OUT ** -0.5 * res),
        'w_mem_kv': nrm(ks[21], (DEPTH, D_MODEL, 2 * X_WIDTH), D_MODEL ** -0.5),
        'xq_norm': gain(ks[22], (DEPTH, HEAD_DIM)),
        'xk_norm': gain(ks[23], (DEPTH, HEAD_DIM)),
        'w_ffn_in': nrm(ks[24], (DEPTH, D_MODEL, 2 * D_FF), D_MODEL ** -0.5),
        'conv_w': nrm(ks[25], (DEPTH, CONV_W, D_FF), CONV_W ** -0.5),
        'conv_b': nrm(ks[26], (DEPTH, D_FF), 0.02),
        'w_down': nrm(ks[27], (DEPTH, D_FF, D_MODEL), D_FF ** -0.5 * res),
    }


def reference(x_prompt, x_sample, cache_win_k, cache_win_v, cache_mem_k, cache_mem_v,
              state_conv, mem_prompt, norm1_g, norm2_g, mem_norm_g, w_in_a, q_norm_a,
              k_norm_a, sinks_a, w_out_a, w_in_b, v_norm_b, w_s_b, b_s_b, w_out_b,
              w_mem_kv, xq_norm, xk_norm, w_ffn_in, conv_w, conv_b, w_down):
    p = dict(norm1_g=norm1_g, norm2_g=norm2_g, mem_norm_g=mem_norm_g, w_in_a=w_in_a,
             q_norm_a=q_norm_a, k_norm_a=k_norm_a, sinks_a=sinks_a, w_out_a=w_out_a,
             w_in_b=w_in_b, v_norm_b=v_norm_b, w_s_b=w_s_b, b_s_b=b_s_b, w_out_b=w_out_b,
             w_mem_kv=w_mem_kv, xq_norm=xq_norm, xk_norm=xk_norm, w_ffn_in=w_ffn_in,
             conv_w=conv_w, conv_b=conv_b, w_down=w_down)
    (y_prompt, win_k_prompt, win_v_prompt, chunk_v_prompt, mem_ks, mem_vs,
     conv_prompt) = run_group(x_prompt, p, True, mem=mem_prompt)
    mem_k_prompt = jnp.stack(mem_ks)
    mem_v_prompt = jnp.stack(mem_vs)
    (y_sample, win_k_sample, win_v_sample, chunk_v_sample, _, _,
     conv_sample) = run_group(x_sample, p, False, mem_k_in=cache_mem_k, mem_v_in=cache_mem_v,
                              win_k_in=cache_win_k, win_v_in=cache_win_v, conv_in=state_conv)
    return (y_prompt, y_sample, win_k_prompt, win_v_prompt, chunk_v_prompt, mem_k_prompt,
            mem_v_prompt, conv_prompt, win_k_sample, win_v_sample, chunk_v_sample, conv_sample)
```

```cpp
#include <hip/hip_runtime.h>
#include <hip/hip_cooperative_groups.h>
#include <cstdio>
#include <cstdint>
namespace cg = cooperative_groups;

#ifndef MK_N_LAUNCHES
#define MK_N_LAUNCHES 1
#endif

#define LAS __attribute__((address_space(3)))
typedef unsigned short bf16_t;
typedef short bf16x8 __attribute__((ext_vector_type(8)));
typedef short s16x4 __attribute__((ext_vector_type(4)));
typedef float f32x4 __attribute__((ext_vector_type(4)));
typedef float f32x2 __attribute__((ext_vector_type(2)));
typedef float f32x16 __attribute__((ext_vector_type(16)));
typedef unsigned u32x4 __attribute__((ext_vector_type(4)));
typedef unsigned u32x2 __attribute__((ext_vector_type(2)));
typedef __bf16 bf16x2_t __attribute__((ext_vector_type(2)));

constexpr int DM = 1024, NBATCH = 8, SEQ = 4096, MP = NBATCH * SEQ, NDEC = 128, DSEQ = 4, MS = NDEC * DSEQ, M = MP + MS;
constexpr int NMEM = 256, MMEM = NBATCH * NMEM;
constexpr int DFF = 2816, NFF = 2 * DFF;
constexpr int NINA = 1536, NINB = 1792;
constexpr float EPS = 1e-6f;
constexpr float LOG2E = 1.4426950408889634f;
constexpr int NPHASE = 13;

constexpr size_t O_Y = 0, O_WKP = 34078720, O_WVP = 34340864, O_CVP = 34603008, O_MKP = 35389440, O_MVP = 36438016, O_CONVP = 37486592,
                 O_WKS = 37576704, O_WVS = 41771008, O_CVS = 45965312, O_CONVS = 46358528, O_END = 47800320;

constexpr size_t MiB = 1u << 20;
constexpr size_t WS_SSQ = 0, WS_GT = 1 * MiB;
constexpr size_t WS_WINA = 2 * MiB, WS_WOUTA = 5 * MiB, WS_WINB = 7 * MiB, WS_WOUTB = 11 * MiB, WS_WMKV = 13 * MiB, WS_WFFN = 15 * MiB,
                 WS_WDOWN = 37 * MiB, WS_WST = 48 * MiB;
constexpr size_t WS_MEMB = 50 * MiB, WS_MK = 54 * MiB, WS_MV = 56 * MiB;
constexpr size_t WS_XB = 58 * MiB;
constexpr size_t WS_AU = 124 * MiB;
constexpr size_t WS_Q = WS_AU, WS_K = WS_Q + (size_t)M * 768 * 2, WS_V = WS_K + (size_t)M * 256 * 2, WS_XQ = WS_V + (size_t)M * 256 * 2,
                 WS_O = WS_XQ + (size_t)M * 256 * 2, WS_U = WS_O + (size_t)M * 1024 * 2, WS_GV = WS_U + (size_t)M * 768 * 2;
constexpr size_t WS_END = WS_AU + (size_t)M * NFF * 2;
static_assert(WS_GV + (size_t)M * 768 * 2 <= WS_END, "mixer buffers inside AU");
static_assert(WS_END <= 512 * MiB, "ws");

namespace pg8 {
constexpr int BM = 256, BK = 64, HALF = 128, HTB = HALF * BK * 2, STAGE_BYTES = 8 * HTB, NXCD = 8, WGM = 8;
__host__ __device__ __forceinline__ int lds_byte(int r, int c) { const int st = (r >> 4) * 2 + (c >> 5), rr = r & 15, cc = c & 31, ob = rr * 64 + cc * 2; return st * 1024 + (ob ^ (((ob >> 9) & 1) << 5)); }
__host__ __device__ __forceinline__ void stage_rc(int b, int& R, int& C) { const int st = b / 1024, sb = b % 1024, swz = sb ^ (((sb >> 9) & 1) << 5); R = (st >> 1) * 16 + swz / 64; C = (st & 1) * 32 + (swz % 64) / 2; }
__host__ __device__ __forceinline__ int perm32(int rho) { const int n = rho >> 4, i = rho & 15; return 8 * (i >> 2) + 4 * n + (i & 3); }

struct Unit { int pm, pn; };
struct Gemm { const bf16_t* A; const bf16_t* Bt; int lda, K; };

struct StaticOrder {
    int nM, nN, nwg, G, c;
    __device__ void init(int Mr, int N, int G_, int c_) { nM = Mr / BM; nN = N / BM; nwg = nM * nN; G = G_; c = c_; }
    __device__ bool next(int i, Unit& u) const {
        const long L = (long)i * G + c; if (L >= nwg) return false;
        int wgid = (int)L; { const int q = nwg / NXCD, r = nwg % NXCD, xcd = wgid % NXCD, off = wgid / NXCD; wgid = (xcd < r ? xcd * (q + 1) : r * (q + 1) + (xcd - r) * q) + off; }
        const int nig = WGM * nN, gid = wgid / nig, fm = gid * WGM, gsz = (nM - fm) < WGM ? (nM - fm) : WGM;
        u.pm = fm + ((wgid % nig) % gsz); u.pn = (wgid % nig) / gsz; return true;
    }
};

template <class Epi, bool ALIGN_EPI, bool SP2>
__device__ __forceinline__ void gemm_phase(LAS unsigned char* lds, const Gemm g, const StaticOrder& S, const Epi& E) {
    const int tid = threadIdx.x, wid = __builtin_amdgcn_readfirstlane(tid >> 6), lane = tid & 63, wr = wid >> 2, wc = wid & 3, fr = lane & 15, fq = lane >> 4;
    const int K = g.K, nt = K / BK, lda = g.lda;
    unsigned voffA[2], voffB[2];
#pragma unroll
    for (int i = 0; i < 2; ++i) { int R, C; stage_rc(tid * 16 + i * 8192, R, C); const int Rb = (R & ~31) + perm32(R & 31);
        voffA[i] = (unsigned)(R * lda + C) * 2u; voffB[i] = (unsigned)(Rb * K + C) * 2u; }
    const size_t kstep = (size_t)(BK * 2);
    const size_t hstepA = (size_t)HALF * lda * 2, hstepB = (size_t)HALF * K * 2;
    const size_t tstepA = 2 * hstepA, tstepB = 2 * hstepB;
    const unsigned ldsw = (unsigned)wid * 1024u;
    const int aoff = lds_byte(wr * 64 + fr, fq * 8), boff = lds_byte(wc * 32 + fr, fq * 8);
#define PG8_SA(b, h) (((b) * 2 + (h)) * HTB)
#define PG8_SB(b, h) ((4 + (b) * 2 + (h)) * HTB)
#define PG8_STAGE(bufoff, gbase, voff) do { _Pragma("unroll") for (int _i = 0; _i < 2; ++_i) \
        __builtin_amdgcn_global_load_lds((const unsigned*)((const char*)(gbase) + (voff)[_i]), (LAS unsigned*)(lds + (bufoff) + ldsw + _i * 8192), 16, 0, 0); } while (0)
#define PG8_LDA(dst, b, h) do { _Pragma("unroll") for (int m = 0; m < 4; ++m) _Pragma("unroll") for (int k = 0; k < 2; ++k) dst[m][k] = *(const LAS bf16x8*)(lds + PG8_SA(b, h) + aoff + m * 2048 + k * 1024); } while (0)
#define PG8_LDB(dst, b, h) do { _Pragma("unroll") for (int n = 0; n < 2; ++n) _Pragma("unroll") for (int k = 0; k < 2; ++k) dst[n][k] = *(const LAS bf16x8*)(lds + PG8_SB(b, h) + boff + n * 2048 + k * 1024); } while (0)
#define PG8_MMA(ai, bj, At, Bt) do { __builtin_amdgcn_s_setprio(1); _Pragma("unroll") for (int m = 0; m < 4; ++m) _Pragma("unroll") for (int n = 0; n < 2; ++n) _Pragma("unroll") for (int k = 0; k < 2; ++k) \
        acc[ai][bj][m][n] = __builtin_amdgcn_mfma_f32_16x16x32_bf16(Bt[n][k], At[m][k], acc[ai][bj][m][n], 0, 0, 0); __builtin_amdgcn_s_setprio(0); } while (0)
#define PG8_WAIT_V(n) asm volatile("s_waitcnt vmcnt(" #n ")" ::: "memory")
#define PG8_WAIT_L(n) asm volatile("s_waitcnt lgkmcnt(" #n ")" ::: "memory")
#define PG8_BAR __builtin_amdgcn_s_barrier()
#define PG8_SCHED __builtin_amdgcn_sched_barrier(0)
    Unit cur, nxt; int ui = 0;
    if (!S.next(0, cur)) return;
    f32x4 acc[2][2][4][2];
#pragma unroll
    for (int a = 0; a < 2; ++a)
#pragma unroll
        for (int b = 0; b < 2; ++b)
#pragma unroll
            for (int m = 0; m < 4; ++m)
#pragma unroll
                for (int n = 0; n < 2; ++n) acc[a][b][m][n] = (f32x4){0.f, 0.f, 0.f, 0.f};
    bf16x8 At[4][2], B0[2][2], B1[2][2];
    const char* cA = (const char*)g.A + (size_t)cur.pm * tstepA; const char* cB = (const char*)g.Bt + (size_t)cur.pn * tstepB;
    if constexpr (SP2) {
        PG8_STAGE(PG8_SB(0, 0), cB, voffB); PG8_STAGE(PG8_SB(0, 1), cB + hstepB, voffB); PG8_STAGE(PG8_SA(0, 0), cA, voffA); PG8_STAGE(PG8_SA(0, 1), cA + hstepA, voffA);
        if (wr == 1) PG8_BAR;
        PG8_WAIT_V(2); PG8_BAR;
        PG8_STAGE(PG8_SB(1, 0), cB + kstep, voffB); PG8_STAGE(PG8_SA(1, 0), cA + kstep, voffA); PG8_STAGE(PG8_SB(1, 1), cB + hstepB + kstep, voffB);
        PG8_WAIT_V(6); PG8_BAR;
    } else {
        PG8_STAGE(PG8_SB(0, 0), cB, voffB); PG8_STAGE(PG8_SA(0, 0), cA, voffA); PG8_STAGE(PG8_SB(0, 1), cB + hstepB, voffB); PG8_STAGE(PG8_SA(0, 1), cA + hstepA, voffA);
        if (wr == 1) PG8_BAR;
        PG8_WAIT_V(4); PG8_BAR;
        PG8_STAGE(PG8_SB(1, 0), cB + kstep, voffB); PG8_STAGE(PG8_SA(1, 0), cA + kstep, voffA); PG8_STAGE(PG8_SB(1, 1), cB + hstepB + kstep, voffB);
        PG8_WAIT_V(6); PG8_BAR;
    }
    for (;;) {
        const bool has_next = S.next(ui + 1, nxt);
        const char* nA = has_next ? (const char*)g.A + (size_t)nxt.pm * tstepA : cA; const char* nB = has_next ? (const char*)g.Bt + (size_t)nxt.pn * tstepB : cB;
        for (int t = 0; t < nt; t += 2) {
            const bool last = (t == nt - 2);
            const char* a1 = cA + (size_t)(t + 1) * kstep;
            const char* a2 = last ? nA : cA + (size_t)(t + 2) * kstep; const char* b2 = last ? nB : cB + (size_t)(t + 2) * kstep;
            const char* a3 = a2 + kstep; const char* b3 = b2 + kstep;
            if constexpr (SP2) {
            PG8_LDB(B0, 0, 0); PG8_LDB(B1, 0, 1); PG8_SCHED; PG8_LDA(At, 0, 0); PG8_STAGE(PG8_SA(1, 1), a1 + hstepA, voffA);
            PG8_WAIT_V(8); PG8_WAIT_L(0); PG8_BAR; PG8_MMA(0, 0, At, B0); PG8_MMA(0, 1, At, B1); PG8_BAR; PG8_SCHED;
            PG8_LDA(At, 0, 1); PG8_STAGE(PG8_SB(0, 0), b2, voffB); PG8_STAGE(PG8_SB(0, 1), b2 + hstepB, voffB); PG8_STAGE(PG8_SA(0, 0), a2, voffA);
            PG8_WAIT_V(8); PG8_WAIT_L(0); PG8_BAR; PG8_MMA(1, 0, At, B0); PG8_MMA(1, 1, At, B1); PG8_BAR; PG8_SCHED;
            PG8_LDB(B0, 1, 0); PG8_LDB(B1, 1, 1); PG8_SCHED; PG8_LDA(At, 1, 0); PG8_STAGE(PG8_SA(0, 1), a2 + hstepA, voffA);
            PG8_WAIT_V(8); PG8_WAIT_L(0); PG8_BAR; PG8_MMA(0, 0, At, B0); PG8_MMA(0, 1, At, B1); PG8_BAR; PG8_SCHED;
            PG8_LDA(At, 1, 1); PG8_STAGE(PG8_SB(1, 0), b3, voffB); PG8_STAGE(PG8_SB(1, 1), b3 + hstepB, voffB); PG8_STAGE(PG8_SA(1, 0), a3, voffA);
            PG8_WAIT_V(8); PG8_WAIT_L(0); PG8_BAR; PG8_MMA(1, 0, At, B0); PG8_MMA(1, 1, At, B1); PG8_BAR; PG8_SCHED;
            } else {
            PG8_LDB(B0, 0, 0); PG8_SCHED; PG8_LDA(At, 0, 0); PG8_STAGE(PG8_SA(1, 1), a1 + hstepA, voffA);
            PG8_WAIT_L(8); PG8_BAR; PG8_WAIT_L(0); PG8_MMA(0, 0, At, B0); PG8_BAR; PG8_SCHED;
            PG8_LDB(B1, 0, 1); PG8_STAGE(PG8_SB(0, 0), b2, voffB);
            PG8_BAR; PG8_WAIT_L(0); PG8_MMA(0, 1, At, B1); PG8_BAR;
            PG8_LDA(At, 0, 1); PG8_STAGE(PG8_SA(0, 0), a2, voffA);
            PG8_BAR; PG8_WAIT_L(0); PG8_MMA(1, 0, At, B0); PG8_BAR; PG8_SCHED;
            PG8_STAGE(PG8_SB(0, 1), b2 + hstepB, voffB);
            PG8_WAIT_V(6); PG8_BAR; PG8_MMA(1, 1, At, B1); PG8_BAR;
            PG8_LDB(B0, 1, 0); PG8_SCHED; PG8_LDA(At, 1, 0); PG8_STAGE(PG8_SA(0, 1), a2 + hstepA, voffA);
            PG8_WAIT_L(8); PG8_BAR; PG8_WAIT_L(0); PG8_MMA(0, 0, At, B0); PG8_BAR; PG8_SCHED;
            PG8_LDB(B1, 1, 1); PG8_STAGE(PG8_SB(1, 0), b3, voffB);
            PG8_BAR; PG8_WAIT_L(0); PG8_MMA(0, 1, At, B1); PG8_BAR;
            PG8_LDA(At, 1, 1); PG8_STAGE(PG8_SA(1, 0), a3, voffA);
            PG8_BAR; PG8_WAIT_L(0); PG8_MMA(1, 0, At, B0); PG8_BAR; PG8_SCHED;
            PG8_STAGE(PG8_SB(1, 1), b3 + hstepB, voffB);
            PG8_WAIT_V(6); PG8_BAR; PG8_MMA(1, 1, At, B1); PG8_BAR;
            }
        }
        if constexpr (ALIGN_EPI) { if (wr == 0) PG8_BAR; }
        E(acc, cur, wr, wc, fr, fq);
        if (!has_next) break;
#pragma unroll
        for (int a = 0; a < 2; ++a)
#pragma unroll
            for (int b = 0; b < 2; ++b)
#pragma unroll
                for (int m = 0; m < 4; ++m)
#pragma unroll
                    for (int n = 0; n < 2; ++n) acc[a][b][m][n] = (f32x4){0.f, 0.f, 0.f, 0.f};
        cur = nxt; cA = nA; cB = nB; ++ui;
        if constexpr (ALIGN_EPI) { if (wr == 1) PG8_BAR; }
    }
    PG8_WAIT_V(0);
    if constexpr (!ALIGN_EPI) { if (wr == 0) PG8_BAR; }
    PG8_BAR;
#undef PG8_SA
#undef PG8_SB
#undef PG8_STAGE
#undef PG8_LDA
#undef PG8_LDB
#undef PG8_MMA
#undef PG8_WAIT_V
#undef PG8_WAIT_L
#undef PG8_BAR
#undef PG8_SCHED
}
}
using pg8::Unit;

constexpr int RING_BYTES = 131072, WSF_OFF = RING_BYTES, OSTG2_OFF = RING_BYTES + 4096, LDS_BYTES = 147456;
__device__ __forceinline__ unsigned cvtpk(float lo, float hi) { f32x2 v = {lo, hi}; bf16x2_t b = __builtin_convertvector(v, bf16x2_t); return __builtin_bit_cast(unsigned, b); }
__device__ __forceinline__ u32x4 pack8(const f32x4 a, const f32x4 b) { u32x4 w; w.x = cvtpk(a[0], a[1]); w.y = cvtpk(a[2], a[3]); w.z = cvtpk(b[0], b[1]); w.w = cvtpk(b[2], b[3]); return w; }
__device__ __forceinline__ float bf2f(unsigned short h) { return __uint_as_float((unsigned)h << 16); }
__device__ __forceinline__ float bflo(unsigned w) { return __uint_as_float(w << 16); }
__device__ __forceinline__ float bfhi(unsigned w) { return __uint_as_float(w & 0xffff0000u); }
__device__ __forceinline__ float wave_sum(float v) {
#pragma unroll
    for (int o = 1; o < 64; o <<= 1) v += __shfl_xor(v, o);
    return v;
}
__device__ __forceinline__ f32x2 gelu_pk(f32x2 v) {
    const f32x2 av = __builtin_elementwise_abs(v), d = av * 0.2316418882f + 1.0f;
    f32x2 t; t.x = __builtin_amdgcn_rcpf(d.x); t.y = __builtin_amdgcn_rcpf(d.y);
    f32x2 q = t * 0.5307027145f + (-0.7265760135f); q = q * t + 0.7107068705f; q = q * t + (-0.142248368f); q = q * t + 0.127414796f; q = q * t;
    const f32x2 s = (v * v) * (-0.72134752044f);
    f32x2 e; e.x = __builtin_amdgcn_exp2f(s.x); e.y = __builtin_amdgcn_exp2f(s.y);
    const f32x2 m = v * (q * e), r = v - m;
    f32x2 o; o.x = v.x < 0.f ? m.x : r.x; o.y = v.y < 0.f ? m.y : r.y; return o;
}
__device__ __forceinline__ f32x4 gelu4(f32x4 v) { const f32x2 a = gelu_pk((f32x2){v[0], v[1]}), b = gelu_pk((f32x2){v[2], v[3]}); return (f32x4){a.x, a.y, b.x, b.y}; }
__device__ __forceinline__ float dot4(f32x4 v) { return (v[0] * v[0] + v[1] * v[1]) + (v[2] * v[2] + v[3] * v[3]); }
__device__ __forceinline__ unsigned short f2bf_s(float f) { return (unsigned short)(cvtpk(f, 0.f) & 0xffffu); }
__device__ __forceinline__ float alibi_slope(int h) { return h < 8 ? exp2f(-(float)(h + 1)) : exp2f(-0.5f - (float)(h - 8)); }

struct Params {
    const float* in[28];
    float* out;
    unsigned char* ws;
    int ph_lo, ph_hi;
};

#define EPI_ARGS const f32x4 (&acc)[2][2][4][2], const Unit& u, int wr, int wc, int fr, int fq
#define FOR_AI_M _Pragma("unroll") for (int ai = 0; ai < 2; ++ai) _Pragma("unroll") for (int m = 0; m < 4; ++m)

__device__ __forceinline__ void head_norm(f32x4 (&v)[2][2], const float (&g)[2][8]) {
    float ss = (dot4(v[0][0]) + dot4(v[0][1])) + (dot4(v[1][0]) + dot4(v[1][1]));
    ss += __shfl_xor(ss, 16); ss += __shfl_xor(ss, 32);
    const float inv = rsqrtf(ss * (1.f / 64.f) + EPS);
#pragma unroll
    for (int bj = 0; bj < 2; ++bj)
#pragma unroll
        for (int n = 0; n < 2; ++n)
#pragma unroll
            for (int e = 0; e < 4; ++e) v[bj][n][e] *= inv * g[bj][4 * n + e];
}

struct EpiInA {
    const float* ssq; bf16_t* Qb; const float* gt; float* out;
    __device__ __forceinline__ void operator()(EPI_ARGS) const {
        const int pn = u.pn, typ = pn < 3 ? 0 : pn - 2;
        const float* gp = gt + typ * 64;
        float g[2][8];
#pragma unroll
        for (int bj = 0; bj < 2; ++bj)
#pragma unroll
            for (int e = 0; e < 8; ++e) g[bj][e] = gp[32 * bj + 8 * fq + e];
        const size_t doff = typ == 0 ? 0 : (size_t)M * 768 + (size_t)(typ - 1) * M * 256;
        const int ld = typ == 0 ? 768 : 256, cb = typ == 0 ? (pn * 4 + wc) * 64 : wc * 64;
        bf16_t* dst = Qb + doff;
        const int row0 = u.pm * 256 + wr * 64 + fr; const bool sample = u.pm >= 128;
        FOR_AI_M {
            const int row = row0 + ai * 128 + m * 16;
            const float rs = rsqrtf(ssq[row] * (1.f / 1024.f) + EPS);
            f32x4 v[2][2];
#pragma unroll
            for (int bj = 0; bj < 2; ++bj)
#pragma unroll
                for (int n = 0; n < 2; ++n) v[bj][n] = acc[ai][bj][m][n] * rs;
            if (typ != 2) head_norm(v, g);
#pragma unroll
            for (int bj = 0; bj < 2; ++bj) *(u32x4*)(dst + (size_t)row * ld + cb + 32 * bj + 8 * fq) = pack8(v[bj][0], v[bj][1]);
            if (typ == 1 || typ == 2) {
                long wo = -1;
                if (sample) { const int ns = row - MP; wo = (long)O_WKS + (long)(typ - 1) * (long)(O_WVS - O_WKS) + (long)((ns >> 2) * 128 + 124 + (ns & 3)) * 256; }
                else if ((u.pm & 15) == 15 && ai == 1) { const int b = row >> 12, t = row & 4095; wo = (long)O_WKP + (long)(typ - 1) * (long)(O_WVP - O_WKP) + (long)(b * 128 + t - 3968) * 256; }
                if (wo >= 0) { float* wout = out + wo;
#pragma unroll
                    for (int bj = 0; bj < 2; ++bj)
#pragma unroll
                        for (int n = 0; n < 2; ++n) *(f32x4*)(wout + wc * 64 + 32 * bj + 8 * fq + 4 * n) = v[bj][n];
                }
            }
        }
    }
};

struct EpiMemKV {
    const float* ssq; const float* xk; float *outk, *outv; bf16_t *MK, *MV;
    __device__ __forceinline__ void operator()(EPI_ARGS) const {
        const int layer = u.pn >> 1; const bool isv = u.pn & 1;
        float g[2][8];
#pragma unroll
        for (int bj = 0; bj < 2; ++bj)
#pragma unroll
            for (int e = 0; e < 8; ++e) g[bj][e] = isv ? 1.f : xk[layer * 64 + 32 * bj + 8 * fq + e];
        float* of = (isv ? outv : outk) + (size_t)layer * MMEM * 256; bf16_t* ob = (isv ? MV : MK) + (size_t)layer * MMEM * 256;
        const int row0 = u.pm * 256 + wr * 64 + fr;
        FOR_AI_M {
            const int row = row0 + ai * 128 + m * 16;
            const float rs = rsqrtf(ssq[row] * (1.f / 1024.f) + EPS);
            f32x4 v[2][2];
#pragma unroll
            for (int bj = 0; bj < 2; ++bj)
#pragma unroll
                for (int n = 0; n < 2; ++n) v[bj][n] = acc[ai][bj][m][n] * rs;
            if (!isv) head_norm(v, g);
#pragma unroll
            for (int bj = 0; bj < 2; ++bj) {
                const size_t o = (size_t)row * 256 + wc * 64 + 32 * bj + 8 * fq;
                *(u32x4*)(ob + o) = pack8(v[bj][0], v[bj][1]);
                *(f32x4*)(of + o) = v[bj][0]; *(f32x4*)(of + o + 4) = v[bj][1];
            }
        }
    }
};

struct EpiRes {
    const float* xin_p; const float* xin_s; float* xout; bf16_t* xb; float* ssq;
    __device__ __forceinline__ void operator()(EPI_ARGS) const {
        const int row0 = u.pm * 256 + wr * 64 + fr, col0 = u.pn * 256 + wc * 32 + 8 * fq;
        FOR_AI_M {
            const int row = row0 + ai * 128 + m * 16;
            const float* src = (row < MP ? xin_p + (size_t)row * DM : xin_s + (size_t)(row - MP) * DM) + col0;
            float ss = 0.f;
#pragma unroll
            for (int bj = 0; bj < 2; ++bj) {
                const f32x4 x0 = *(const f32x4*)(src + 128 * bj) + acc[ai][bj][m][0], x1 = *(const f32x4*)(src + 128 * bj + 4) + acc[ai][bj][m][1];
                float* o = xout + (size_t)row * DM + col0 + 128 * bj;
                *(f32x4*)o = x0; *(f32x4*)(o + 4) = x1;
                if (xb) *(u32x4*)(xb + (size_t)row * DM + col0 + 128 * bj) = pack8(x0, x1);
                ss += dot4(x0) + dot4(x1);
            }
            if (ssq) { ss += __shfl_xor(ss, 16); ss += __shfl_xor(ss, 32); if (fq == 0) atomicAdd(ssq + row, ss); }
        }
    }
};

struct EpiFfn {
    const float* ssq; bf16_t* AU;
    __device__ __forceinline__ void operator()(EPI_ARGS) const {
        const int row0 = u.pm * 256 + wr * 64 + fr, col0 = u.pn * 128 + wc * 32 + 8 * fq;
        FOR_AI_M {
            const int row = row0 + ai * 128 + m * 16;
            const float rs = rsqrtf(ssq[row] * (1.f / 1024.f) + EPS);
#pragma unroll
            for (int bj = 0; bj < 2; ++bj) *(u32x4*)(AU + (size_t)row * NFF + bj * DFF + col0) = pack8(acc[ai][bj][m][0] * rs, acc[ai][bj][m][1] * rs);
        }
    }
};

struct EpiInB {
    const float* ssq; bf16_t *U, *GV, *XQ; const float* xg; float* ssqv;
    __device__ __forceinline__ void operator()(EPI_ARGS) const {
        const int pn = u.pn, row0 = u.pm * 256 + wr * 64 + fr;
        if (pn < 6) {
            bf16_t* dst = pn < 3 ? U : GV; const int col0 = (pn % 3) * 256 + wc * 32 + 8 * fq;
            FOR_AI_M {
                const int row = row0 + ai * 128 + m * 16;
                const float rs = rsqrtf(ssq[row] * (1.f / 1024.f) + EPS);
                float ss = 0.f;
#pragma unroll
                for (int bj = 0; bj < 2; ++bj) {
                    const f32x4 v0 = gelu4(acc[ai][bj][m][0] * rs), v1 = gelu4(acc[ai][bj][m][1] * rs);
                    *(u32x4*)(dst + (size_t)row * 768 + col0 + 128 * bj) = pack8(v0, v1);
                    ss += dot4(v0) + dot4(v1);
                }
                if (pn >= 3) { ss += __shfl_xor(ss, 16); ss += __shfl_xor(ss, 32); if (fq == 0) atomicAdd(ssqv + row, ss); }
            }
        } else {
            float g[2][8];
#pragma unroll
            for (int bj = 0; bj < 2; ++bj)
#pragma unroll
                for (int e = 0; e < 8; ++e) g[bj][e] = xg[32 * bj + 8 * fq + e];
            FOR_AI_M {
                const int row = row0 + ai * 128 + m * 16;
                const float rs = rsqrtf(ssq[row] * (1.f / 1024.f) + EPS);
                f32x4 v[2][2];
#pragma unroll
                for (int bj = 0; bj < 2; ++bj)
#pragma unroll
                    for (int n = 0; n < 2; ++n) v[bj][n] = acc[ai][bj][m][n] * rs;
                head_norm(v, g);
#pragma unroll
                for (int bj = 0; bj < 2; ++bj) *(u32x4*)(XQ + (size_t)row * 256 + wc * 64 + 32 * bj + 8 * fq) = pack8(v[bj][0], v[bj][1]);
            }
        }
    }
};

__device__ __forceinline__ void p0_transpose_item(const float* W, int K, int N, const float* gain, bf16_t* WT, int kb, int n0, int drow0, LAS float* scr, int lane) {
    const int k0 = 64 * kb;
#pragma unroll 8
    for (int i = 0; i < 32; ++i) { const int kk = 2 * i + (lane >> 5); float w = W[(size_t)(k0 + kk) * N + n0 + (lane & 31)]; if (gain) w *= gain[k0 + kk]; scr[kk * 33 + (lane & 31)] = w; }
    asm volatile("s_waitcnt lgkmcnt(0)" ::: "memory");
    const int c = lane & 7;
#pragma unroll
    for (int j = 0; j < 4; ++j) { const int n = (lane >> 3) + 8 * j; const LAS float* s = scr + (8 * c) * 33 + n;
        u32x4 o; o.x = cvtpk(s[0 * 33], s[1 * 33]); o.y = cvtpk(s[2 * 33], s[3 * 33]); o.z = cvtpk(s[4 * 33], s[5 * 33]); o.w = cvtpk(s[6 * 33], s[7 * 33]);
        *(u32x4*)(WT + (size_t)(drow0 + n) * K + k0 + 8 * c) = o; }
    asm volatile("s_waitcnt lgkmcnt(0)" ::: "memory");
}
__device__ __forceinline__ int map_headperm(int nb) { const int p = (nb * 32) & 255, bj = p >> 7, wc = (p >> 5) & 3; return ((nb * 32) & ~255) + 64 * wc + 32 * bj; }
__device__ __forceinline__ int map_ffn(int nb) { const int tile = nb >> 3, p = (nb & 7) * 32; return p < 128 ? 128 * tile + p : DFF + 128 * tile + (p - 128); }

__device__ __forceinline__ void row_to_bf16(const float* xrow, bf16_t* orow, float* ssq, int lane) {
    const f32x4* xr = (const f32x4*)xrow + lane; f32x4 v[4]; float s = 0.f;
#pragma unroll
    for (int j = 0; j < 4; ++j) { v[j] = xr[64 * j]; s += dot4(v[j]); }
    s = wave_sum(s);
    u32x2* o8 = (u32x2*)orow + lane;
#pragma unroll
    for (int j = 0; j < 4; ++j) { u32x2 w; w.x = cvtpk(v[j][0], v[j][1]); w.y = cvtpk(v[j][2], v[j][3]); o8[64 * j] = w; }
    if (lane == 0) *ssq = s;
}

__device__ __forceinline__ void p0_prologue(const Params& P, LAS unsigned char* lds, int G, int bid) {
    const int tid = threadIdx.x, lane = tid & 63, wave = __builtin_amdgcn_readfirstlane(tid >> 6);
    LAS float* scr = (LAS float*)(lds + wave * 16384);
    const int gw = bid * 8 + wave, NGW = G * 8;
    unsigned char* ws = P.ws;
    float* ssq = (float*)(ws + WS_SSQ);
    constexpr int I0 = 16 * 48, I1 = 16 * 32, I2 = 16 * 56, I3 = 16 * 32, I4 = 16 * 16, I6 = 16 * 176, I8 = 44 * 32;
    constexpr int NITEMS = I0 + I1 + I2 + I3 + 2 * I4 + 2 * I6 + 2 * I8;
    for (int it = gw; it < NITEMS; it += NGW) {
        int r = it;
        if (r < I0) { const int nb = r % 48, kb = r / 48; p0_transpose_item(P.in[11], 1024, NINA, P.in[8], (bf16_t*)(ws + WS_WINA), kb, map_headperm(nb), 32 * nb, scr, lane); continue; } r -= I0;
        if (r < I1) { const int nb = r % 32, kb = r / 32; p0_transpose_item(P.in[15], 1024, 1024, nullptr, (bf16_t*)(ws + WS_WOUTA), kb, 32 * nb, 32 * nb, scr, lane); continue; } r -= I1;
        if (r < I2) { const int nb = r % 56, kb = r / 56; p0_transpose_item(P.in[16], 1024, NINB, P.in[8] + 1024, (bf16_t*)(ws + WS_WINB), kb, nb < 48 ? 32 * nb : map_headperm(nb), 32 * nb, scr, lane); continue; } r -= I2;
        if (r < I3) { const int nb = r % 32, kb = r / 32; p0_transpose_item(P.in[20], 1024, 1024, nullptr, (bf16_t*)(ws + WS_WOUTB), kb, 32 * nb, 32 * nb, scr, lane); continue; } r -= I3;
        if (r < 2 * I4) { const int l = r / I4; r -= l * I4; const int nb = r % 16, kb = r / 16;
            p0_transpose_item(P.in[21] + (size_t)l * 1024 * 512, 1024, 512, P.in[10] + l * 1024, (bf16_t*)(ws + WS_WMKV) + (size_t)l * 512 * 1024, kb, map_headperm(nb), 32 * nb, scr, lane); continue; } r -= 2 * I4;
        if (r < 2 * I6) { const int l = r / I6; r -= l * I6; const int nb = r % 176, kb = r / 176;
            p0_transpose_item(P.in[24] + (size_t)l * 1024 * NFF, 1024, NFF, P.in[9] + l * 1024, (bf16_t*)(ws + WS_WFFN) + (size_t)l * NFF * 1024, kb, map_ffn(nb), 32 * nb, scr, lane); continue; } r -= 2 * I6;
        { const int l = r / I8; r -= l * I8; const int nb = r % 32, kb = r / 32;
            p0_transpose_item(P.in[27] + (size_t)l * DFF * 1024, DFF, 1024, nullptr, (bf16_t*)(ws + WS_WDOWN) + (size_t)l * 1024 * DFF, kb, 32 * nb, 32 * nb, scr, lane); }
    }
    bf16_t* XB = (bf16_t*)(ws + WS_XB); bf16_t* MEMB = (bf16_t*)(ws + WS_MEMB);
    for (int r = gw; r < M + MMEM; r += NGW) {
        if (r < MP) row_to_bf16(P.in[0] + (size_t)r * DM, XB + (size_t)r * DM, ssq + r, lane);
        else if (r < M) row_to_bf16(P.in[1] + (size_t)(r - MP) * DM, XB + (size_t)r * DM, ssq + r, lane);
        else row_to_bf16(P.in[7] + (size_t)(r - M) * DM, MEMB + (size_t)(r - M) * DM, ssq + 5 * M + (r - M), lane);
    }
    const int gt = bid * 512 + tid, NGT = G * 512;
    for (int i = gt; i < 4 * M; i += NGT) ssq[M + i] = 0.f;
    if (gt < 256) { float* GT = (float*)(ws + WS_GT); const int t4 = gt >> 6, d = gt & 63; GT[gt] = t4 == 0 ? P.in[12][d] : t4 == 1 ? P.in[13][d] : t4 == 2 ? 1.f : P.in[22][d]; }
    { bf16_t* WST = (bf16_t*)(ws + WS_WST); const float* wsb = P.in[18];
      for (int i = gt; i < 4 * 128 * 128; i += NGT) { const int ii = (i >> 7) & 127, jj = i & 127; const float w = jj <= ii ? wsb[i] : 0.f; WST[i] = (bf16_t)(cvtpk(w, 0.f) & 0xffffu); } }
    { const f32x4* ck = (const f32x4*)P.in[2]; const f32x4* cv = (const f32x4*)P.in[3]; f32x4* ok = (f32x4*)(P.out + O_WKS); f32x4* ov = (f32x4*)(P.out + O_WVS);
      for (int i = gt; i < NDEC * 124 * 64; i += NGT) { const int n = i / (124 * 64), r = i % (124 * 64); const size_t s = (size_t)n * 128 * 64 + 4 * 64 + r, d = (size_t)n * 128 * 64 + r; ok[d] = ck[s]; ov[d] = cv[s]; } }
}

__device__ __forceinline__ int crow(int r, int hi) { return (r & 3) + 8 * (r >> 2) + 4 * hi; }
__device__ __forceinline__ int kv_off(int row, int chunk) { return row * 128 + ((chunk ^ (row & 7)) << 4); }
__device__ __forceinline__ s16x4 vtr(const LAS unsigned char* p) { return __builtin_bit_cast(s16x4, __builtin_amdgcn_ds_read_tr16_b64_v4i16((LAS s16x4*)p)); }

struct AttnOfs { int k[4]; int v[2]; };
__device__ __forceinline__ AttnOfs attn_ofs() {
    const int lane = threadIdx.x & 63, r32 = lane & 31, hi = lane >> 5; AttnOfs a;
#pragma unroll
    for (int ks = 0; ks < 4; ++ks) a.k[ks] = r32 * 128 + (((2 * ks + hi) ^ (r32 & 7)) << 4);
    const int vkey = 4 * hi + ((lane & 15) >> 2), vcol = 16 * ((lane >> 4) & 1) + 4 * (lane & 3);
#pragma unroll
    for (int d0 = 0; d0 < 2; ++d0) a.v[d0] = vkey * 128 + (((4 * d0 + (vcol >> 3)) ^ vkey) << 4) + (vcol & 7) * 2;
    return a;
}
template <int CT, bool MASK, bool FIRST>
__device__ __forceinline__ void attn_chunk(const bf16x8 (&qf)[4], const AttnOfs& ao, const LAS unsigned char* Kb, const LAS unsigned char* Vb, int qpos, int kpos0, float slope2, LAS float* wsf, float& m, float& l, f32x16 (&o)[2]) {
    const int lane = threadIdx.x & 63, r32 = lane & 31, hi = lane >> 5;
    f32x16 s[CT];
#pragma unroll
    for (int t = 0; t < CT; ++t) {
#pragma unroll
        for (int r = 0; r < 16; ++r) s[t][r] = 0.f;
#pragma unroll
        for (int ks = 0; ks < 4; ++ks) { const bf16x8 kf = *(const LAS bf16x8*)(Kb + ao.k[ks] + t * 4096); s[t] = __builtin_amdgcn_mfma_f32_32x32x16_bf16(kf, qf[ks], s[t], 0, 0, 0); }
    }
    const float C2 = 0.125f * LOG2E;
    float mx = -1e30f;
    if (MASK) {
        int dbase = qpos - kpos0 - 4 * hi; asm volatile("" : "+v"(dbase));
        const float fdb = (float)dbase, lim = (float)(qpos < 127 ? qpos : 127), ns = -slope2;
#pragma unroll
        for (int t = 0; t < CT; ++t)
#pragma unroll
            for (int r = 0; r < 16; ++r) {
                const float fd = fdb - (float)(32 * t + (r & 3) + 8 * (r >> 2));
                float v = __builtin_fmaf(ns, fd, s[t][r] * C2);
                v = (fd >= 0.f && fd <= lim) ? v : -1e30f;
                s[t][r] = v; mx = fmaxf(mx, v);
            }
    } else {
#pragma unroll
        for (int t = 0; t < CT; ++t)
#pragma unroll
            for (int r = 0; r < 16; ++r) { const float v = s[t][r] * C2; s[t][r] = v; mx = fmaxf(mx, v); }
    }
    mx = fmaxf(mx, __shfl_xor(mx, 32));
    const float mn = fmaxf(m, mx), alpha = __builtin_amdgcn_exp2f(m - mn);
    m = mn;
    float sum = 0.f;
#pragma unroll
    for (int t = 0; t < CT; ++t)
#pragma unroll
        for (int r = 0; r < 16; ++r) { const float e = __builtin_amdgcn_exp2f(s[t][r] - mn); s[t][r] = e; sum += e; }
    l = l * alpha + sum;
    if (!FIRST) {
        if (hi == 0) wsf[r32] = alpha;
        asm volatile("s_waitcnt lgkmcnt(0)" ::: "memory");
#pragma unroll
        for (int r = 0; r < 16; ++r) { const float a = wsf[crow(r, hi)]; o[0][r] *= a; o[1][r] *= a; }
        asm volatile("s_waitcnt lgkmcnt(0)" ::: "memory");
    }
#pragma unroll
    for (int t = 0; t < CT; ++t)
#pragma unroll
        for (int k2 = 0; k2 < 2; ++k2) {
            u32x4 pw; pw.x = cvtpk(s[t][8 * k2 + 0], s[t][8 * k2 + 1]); pw.y = cvtpk(s[t][8 * k2 + 2], s[t][8 * k2 + 3]); pw.z = cvtpk(s[t][8 * k2 + 4], s[t][8 * k2 + 5]); pw.w = cvtpk(s[t][8 * k2 + 6], s[t][8 * k2 + 7]);
            const bf16x8 pa = __builtin_bit_cast(bf16x8, pw);
#pragma unroll
            for (int d0 = 0; d0 < 2; ++d0) {
                const LAS unsigned char* vp = Vb + ao.v[d0] + (32 * t + 16 * k2) * 128;
                const s16x4 lo = vtr(vp), hh = vtr(vp + 1024);
                const bf16x8 vf = (bf16x8){lo[0], lo[1], lo[2], lo[3], hh[0], hh[1], hh[2], hh[3]};
                o[d0] = __builtin_amdgcn_mfma_f32_32x32x16_bf16(pa, vf, o[d0], 0, 0, 0);
            }
        }
}
__device__ __forceinline__ void attn_init(bool mask, float sink2, float& m, float& l, f32x16 (&o)[2]) {
    const int hi = (threadIdx.x & 63) >> 5;
    m = mask ? sink2 : -1e30f; l = (mask && hi == 0) ? 1.f : 0.f;
#pragma unroll
    for (int r = 0; r < 16; ++r) { o[0][r] = 0.f; o[1][r] = 0.f; }
}
__device__ __forceinline__ void attn_finish(float l, LAS float* wsf, f32x16 (&o)[2], LAS unsigned short* stg) {
    const int lane = threadIdx.x & 63, r32 = lane & 31, hi = lane >> 5;
    l += __shfl_xor(l, 32);
    if (hi == 0) wsf[r32] = 1.0f / l;
    asm volatile("s_waitcnt lgkmcnt(0)" ::: "memory");
#pragma unroll
    for (int r = 0; r < 16; ++r) { const float li = wsf[crow(r, hi)]; const int q = crow(r, hi);
        stg[q * 64 + r32] = (unsigned short)(cvtpk(o[0][r] * li, 0.f) & 0xffffu); stg[q * 64 + 32 + r32] = (unsigned short)(cvtpk(o[1][r] * li, 0.f) & 0xffffu); }
    asm volatile("s_waitcnt lgkmcnt(0)" ::: "memory");
}
__device__ __forceinline__ void attn_swa(const bf16x8 (&qf)[4], const AttnOfs& ao, const LAS unsigned char* Kb, const LAS unsigned char* Vb, int qpos, int kpos0, float slope2, float sink2, LAS float* wsf, LAS unsigned short* stg) {
    float m, l; f32x16 o[2]; attn_init(true, sink2, m, l, o);
    attn_chunk<3, true, true>(qf, ao, Kb, Vb, qpos, kpos0, slope2, wsf, m, l, o);
    attn_chunk<2, true, false>(qf, ao, Kb + 96 * 128, Vb + 96 * 128, qpos, kpos0 + 96, slope2, wsf, m, l, o);
    attn_finish(l, wsf, o, stg);
}
__device__ __forceinline__ void attn_mem(const bf16x8 (&qf)[4], const AttnOfs& ao, const LAS unsigned char* Kb, const LAS unsigned char* Vb, LAS float* wsf, LAS unsigned short* stg) {
    float m, l; f32x16 o[2]; attn_init(false, 0.f, m, l, o);
    attn_chunk<2, false, true>(qf, ao, Kb, Vb, 0, 0, 0.f, wsf, m, l, o);
#pragma unroll 1
    for (int c = 1; c < 4; ++c) attn_chunk<2, false, false>(qf, ao, Kb + c * 64 * 128, Vb + c * 64 * 128, 0, 0, 0.f, wsf, m, l, o);
    attn_finish(l, wsf, o, stg);
}
__device__ __forceinline__ void stage_out(const LAS unsigned short* stg, bf16_t* gdst, size_t ld) {
    const int lane = threadIdx.x & 63;
#pragma unroll
    for (int i = 0; i < 4; ++i) { const int row = i * 8 + (lane >> 3), ch = lane & 7; *(u32x4*)(gdst + (size_t)row * ld + ch * 8) = *(const LAS u32x4*)(stg + row * 64 + ch * 8); }
    asm volatile("s_waitcnt lgkmcnt(0)" ::: "memory");
}

__device__ __forceinline__ void unit_swa_prompt(const Params& P, LAS unsigned char* lds, LAS float* wsf, int b, int qb, int g) {
    const int tid = threadIdx.x, lane = tid & 63, wave = __builtin_amdgcn_readfirstlane(tid >> 6), r32 = lane & 31, hi = lane >> 5;
    const bf16_t* Qg = (const bf16_t*)(P.ws + WS_Q); const bf16_t* Kg = (const bf16_t*)(P.ws + WS_K); const bf16_t* Vg = (const bf16_t*)(P.ws + WS_V); bf16_t* Og = (bf16_t*)(P.ws + WS_O);
    LAS unsigned char* Kl = lds; LAS unsigned char* Vl = lds + 49152; LAS unsigned short* stg = (LAS unsigned short*)(lds + 98304 + wave * 4096);
#pragma unroll 2
    for (int idx = tid; idx < 384 * 8; idx += 512) {
        const int row = idx >> 3, ch = idx & 7, t = 256 * qb - 128 + row;
        u32x4 kv = (u32x4){0u, 0u, 0u, 0u}, vv = kv;
        if (t >= 0) { const size_t o = (size_t)(b * SEQ + t) * 256 + g * 64 + ch * 8; kv = *(const u32x4*)(Kg + o); vv = *(const u32x4*)(Vg + o); }
        *(LAS u32x4*)(Kl + kv_off(row, ch)) = kv; *(LAS u32x4*)(Vl + kv_off(row, ch)) = vv;
    }
    __syncthreads();
    const AttnOfs ao = attn_ofs();
    const int t0 = 256 * qb + 32 * wave;
#pragma unroll 1
    for (int hh = 0; hh < 3; ++hh) {
        const int head = 3 * g + hh;
        bf16x8 qf[4];
#pragma unroll
        for (int ks = 0; ks < 4; ++ks) qf[ks] = *(const bf16x8*)(Qg + (size_t)(b * SEQ + t0 + r32) * 768 + head * 64 + 16 * ks + 8 * hi);
        attn_swa(qf, ao, Kl + 32 * wave * 128, Vl + 32 * wave * 128, t0 + r32, t0 - 128, alibi_slope(head) * LOG2E, P.in[14][head] * LOG2E, wsf, stg);
        stage_out(stg, Og + (size_t)(b * SEQ + t0) * DM + head * 64, DM);
    }
    __syncthreads();
}

__device__ __forceinline__ void unit_mem_prompt(const Params& P, LAS unsigned char* lds, LAS float* wsf, int layer, int b, int qb, int h) {
    const int tid = threadIdx.x, lane = tid & 63, wave = __builtin_amdgcn_readfirstlane(tid >> 6), r32 = lane & 31, hi = lane >> 5;
    const bf16_t* XQ = (const bf16_t*)(P.ws + WS_XQ); bf16_t* Og = (bf16_t*)(P.ws + WS_O);
    const bf16_t* MK = (const bf16_t*)(P.ws + WS_MK) + (size_t)layer * MMEM * 256; const bf16_t* MV = (const bf16_t*)(P.ws + WS_MV) + (size_t)layer * MMEM * 256;
    LAS unsigned char* Kl = lds; LAS unsigned char* Vl = lds + 32768; LAS unsigned short* stg = (LAS unsigned short*)(lds + 98304 + wave * 4096);
#pragma unroll 2
    for (int idx = tid; idx < 256 * 8; idx += 512) {
        const int row = idx >> 3, ch = idx & 7; const size_t o = (size_t)(b * NMEM + row) * 256 + h * 64 + ch * 8;
        *(LAS u32x4*)(Kl + kv_off(row, ch)) = *(const u32x4*)(MK + o); *(LAS u32x4*)(Vl + kv_off(row, ch)) = *(const u32x4*)(MV + o);
    }
    __syncthreads();
    const AttnOfs ao = attn_ofs();
    const int t0 = 256 * qb + 32 * wave;
    bf16x8 qf[4];
#pragma unroll
    for (int ks = 0; ks < 4; ++ks) qf[ks] = *(const bf16x8*)(XQ + (size_t)(b * SEQ + t0 + r32) * 256 + h * 64 + 16 * ks + 8 * hi);
    attn_mem(qf, ao, Kl, Vl, wsf, stg);
    stage_out(stg, Og + (size_t)(b * SEQ + t0) * DM + 768 + h * 64, DM);
    __syncthreads();
}

__device__ __forceinline__ u32x4 ld8f_pack(const float* p) { const f32x4 a = *(const f32x4*)p, b = *(const f32x4*)(p + 4); return pack8(a, b); }

__device__ __forceinline__ void unit_swa_sample(const Params& P, LAS unsigned char* lds, LAS float* wsf, int n, int gp) {
    const int tid = threadIdx.x, lane = tid & 63, wave = __builtin_amdgcn_readfirstlane(tid >> 6), r32 = lane & 31, hi = lane >> 5;
    const bf16_t* Qg = (const bf16_t*)(P.ws + WS_Q); const bf16_t* Kg = (const bf16_t*)(P.ws + WS_K); const bf16_t* Vg = (const bf16_t*)(P.ws + WS_V); bf16_t* Og = (bf16_t*)(P.ws + WS_O);
#pragma unroll 1
    for (int idx = tid; idx < 2 * 160 * 8; idx += 512) {
        const int gi = idx / 1280, rem = idx % 1280, row = rem >> 3, ch = rem & 7, g = 2 * gp + gi;
        LAS unsigned char* Kl = lds + gi * 40960; LAS unsigned char* Vl = Kl + 20480;
        u32x4 kv = (u32x4){0u, 0u, 0u, 0u}, vv = kv;
        if (row < 128) { const size_t o = ((size_t)(n * 128 + row) * 4 + g) * 64 + ch * 8; kv = ld8f_pack(P.in[2] + o); vv = ld8f_pack(P.in[3] + o); }
        else if (row < 132) { const size_t o = (size_t)(MP + 4 * n + row - 128) * 256 + g * 64 + ch * 8; kv = *(const u32x4*)(Kg + o); vv = *(const u32x4*)(Vg + o); }
        *(LAS u32x4*)(Kl + kv_off(row, ch)) = kv; *(LAS u32x4*)(Vl + kv_off(row, ch)) = vv;
    }
    __syncthreads();
    if (wave < 2) {
        LAS unsigned short* stg = (LAS unsigned short*)(lds + 98304 + wave * 4096);
        const AttnOfs ao = attn_ofs();
        const int g = 2 * gp + wave; const bool qv = r32 < 12; const int hh = qv ? (r32 >> 2) : 0, sidx = r32 & 3, head = 3 * g + hh;
        bf16x8 qf[4];
#pragma unroll
        for (int ks = 0; ks < 4; ++ks) { qf[ks] = *(const bf16x8*)(Qg + (size_t)(MP + 4 * n + sidx) * 768 + head * 64 + 16 * ks + 8 * hi); if (!qv) qf[ks] = (bf16x8){0, 0, 0, 0, 0, 0, 0, 0}; }
        const LAS unsigned char* Kl = lds + wave * 40960;
        attn_swa(qf, ao, Kl, Kl + 20480, 128 + sidx, 0, alibi_slope(head) * LOG2E, P.in[14][head] * LOG2E, wsf, stg);
        for (int i = lane; i < 96; i += 64) { const int q = i >> 3, ch = i & 7;
            *(u32x4*)(Og + (size_t)(MP + 4 * n + (q & 3)) * DM + (3 * g + (q >> 2)) * 64 + ch * 8) = *(const LAS u32x4*)(stg + q * 64 + ch * 8); }
        asm volatile("s_waitcnt lgkmcnt(0)" ::: "memory");
    }
    __syncthreads();
}

__device__ __forceinline__ void unit_mem_sample(const Params& P, LAS unsigned char* lds, LAS float* wsf, int layer, int n, int hp) {
    const int tid = threadIdx.x, lane = tid & 63, wave = __builtin_amdgcn_readfirstlane(tid >> 6), r32 = lane & 31, hi = lane >> 5;
    const bf16_t* XQ = (const bf16_t*)(P.ws + WS_XQ); bf16_t* Og = (bf16_t*)(P.ws + WS_O);
    const float* ck = P.in[4] + (size_t)(layer * NDEC + n) * NMEM * 256; const float* cv = P.in[5] + (size_t)(layer * NDEC + n) * NMEM * 256;
#pragma unroll 2
    for (int idx = tid; idx < 256 * 16; idx += 512) {
        const int row = idx >> 4, hsel = (idx >> 3) & 1, ch = idx & 7; const size_t o = (size_t)row * 256 + (2 * hp + hsel) * 64 + ch * 8;
        LAS unsigned char* Kl = lds + hsel * 65536;
        *(LAS u32x4*)(Kl + kv_off(row, ch)) = ld8f_pack(ck + o); *(LAS u32x4*)(Kl + 32768 + kv_off(row, ch)) = ld8f_pack(cv + o);
    }
    __syncthreads();
    if (wave < 2) {
        LAS unsigned short* stg = (LAS unsigned short*)(lds + OSTG2_OFF + wave * 4096);
        const AttnOfs ao = attn_ofs();
        const int h = 2 * hp + wave; const bool qv = r32 < 4;
        bf16x8 qf[4];
#pragma unroll
        for (int ks = 0; ks < 4; ++ks) { qf[ks] = *(const bf16x8*)(XQ + (size_t)(MP + 4 * n + (r32 & 3)) * 256 + h * 64 + 16 * ks + 8 * hi); if (!qv) qf[ks] = (bf16x8){0, 0, 0, 0, 0, 0, 0, 0}; }
        const LAS unsigned char* Kl = lds + wave * 65536;
        attn_mem(qf, ao, Kl, Kl + 32768, wsf, stg);
        if (lane < 32) { const int q = lane >> 3, ch = lane & 7;
            *(u32x4*)(Og + (size_t)(MP + 4 * n + q) * DM + 768 + h * 64 + ch * 8) = *(const LAS u32x4*)(stg + q * 64 + ch * 8); }
        asm volatile("s_waitcnt lgkmcnt(0)" ::: "memory");
    }
    __syncthreads();
}

__device__ __forceinline__ void unit_gmlp_prompt(const Params& P, LAS unsigned char* lds, int b, int c) {
    const int tid = threadIdx.x, lane = tid & 63, wave = __builtin_amdgcn_readfirstlane(tid >> 6), r32 = lane & 31, hi = lane >> 5;
    const bf16_t* U = (const bf16_t*)(P.ws + WS_U); const bf16_t* GV = (const bf16_t*)(P.ws + WS_GV); bf16_t* Og = (bf16_t*)(P.ws + WS_O);
    const bf16_t* WST = (const bf16_t*)(P.ws + WS_WST); const float* ssqv = (const float*)(P.ws + WS_SSQ) + 4 * M;
    const float* vg = P.in[17]; const float* bs = P.in[19]; float* cvp = P.out + O_CVP;
    const int rowb = b * SEQ + c * 128;
    const int ib = wave & 3, cb0 = 3 * (wave >> 2);
#pragma unroll 1
    for (int g = 0; g < 4; ++g) {
        for (int idx = tid; idx < 128 * 24; idx += 512) {
            const int j = idx / 24, ch = idx % 24; const int row = rowb + j, col = g * 192 + ch * 8;
            const float rv = rsqrtf(ssqv[row] * (1.f / 768.f) + EPS);
            const u32x4 w = *(const u32x4*)(GV + (size_t)row * 768 + col);
            const f32x4 g0 = *(const f32x4*)(vg + col), g1 = *(const f32x4*)(vg + col + 4);
            f32x4 v0 = (f32x4){bflo(w.x), bfhi(w.x), bflo(w.y), bfhi(w.y)}, v1 = (f32x4){bflo(w.z), bfhi(w.z), bflo(w.w), bfhi(w.w)};
            v0 = v0 * rv * g0; v1 = v1 * rv * g1;
            *(LAS u32x4*)(lds + j * 384 + ch * 16) = pack8(v0, v1);
            if (c == 31) { float* o = cvp + (size_t)(b * 128 + j) * 768 + col; *(f32x4*)o = v0; *(f32x4*)(o + 4) = v1; }
        }
        __syncthreads();
        f32x16 acc[3];
#pragma unroll
        for (int i = 0; i < 3; ++i)
#pragma unroll
            for (int r = 0; r < 16; ++r) acc[i][r] = 0.f;
        const int nks = 2 * (ib + 1);
#pragma unroll 1
        for (int ks = 0; ks < nks; ++ks) {
            const bf16x8 af = *(const bf16x8*)(WST + (size_t)(g * 128 + 32 * ib + r32) * 128 + 16 * ks + 8 * hi);
            const int j0 = 16 * ks + 8 * hi + ((lane & 15) >> 2);
#pragma unroll
            for (int i = 0; i < 3; ++i) {
                const int col = 32 * (cb0 + i) + 16 * ((lane >> 4) & 1) + 4 * (lane & 3);
                const s16x4 lo = vtr(lds + j0 * 384 + col * 2), hh = vtr(lds + (j0 + 4) * 384 + col * 2);
                const bf16x8 vf = (bf16x8){lo[0], lo[1], lo[2], lo[3], hh[0], hh[1], hh[2], hh[3]};
                acc[i] = __builtin_amdgcn_mfma_f32_32x32x16_bf16(af, vf, acc[i], 0, 0, 0);
            }
        }
        LAS float* stg = (LAS float*)(lds + 49152 + wave * 4096);
#pragma unroll 1
        for (int i = 0; i < 3; ++i) {
            const f32x16 a = i == 0 ? acc[0] : i == 1 ? acc[1] : acc[2];
#pragma unroll
            for (int r = 0; r < 16; ++r) { const int q = crow(r, hi); stg[q * 32 + r32] = a[r] + bs[g * 128 + 32 * ib + q]; }
            asm volatile("s_waitcnt lgkmcnt(0)" ::: "memory");
            const int q = lane >> 1, hf = lane & 1; const size_t ro = (size_t)(rowb + 32 * ib + q); const int col = g * 192 + 32 * (cb0 + i) + 16 * hf;
            const u32x4 u0 = *(const u32x4*)(U + ro * 768 + col), u1 = *(const u32x4*)(U + ro * 768 + col + 8);
            const LAS f32x4* sp = (const LAS f32x4*)(stg + q * 32 + 16 * hf);
            const f32x4 m0 = sp[0], m1 = sp[1], m2 = sp[2], m3 = sp[3];
            u32x4 o0, o1;
            o0.x = cvtpk(bflo(u0.x) * m0[0], bfhi(u0.x) * m0[1]); o0.y = cvtpk(bflo(u0.y) * m0[2], bfhi(u0.y) * m0[3]); o0.z = cvtpk(bflo(u0.z) * m1[0], bfhi(u0.z) * m1[1]); o0.w = cvtpk(bflo(u0.w) * m1[2], bfhi(u0.w) * m1[3]);
            o1.x = cvtpk(bflo(u1.x) * m2[0], bfhi(u1.x) * m2[1]); o1.y = cvtpk(bflo(u1.y) * m2[2], bfhi(u1.y) * m2[3]); o1.z = cvtpk(bflo(u1.z) * m3[0], bfhi(u1.z) * m3[1]); o1.w = cvtpk(bflo(u1.w) * m3[2], bfhi(u1.w) * m3[3]);
            *(u32x4*)(Og + ro * DM + col) = o0; *(u32x4*)(Og + ro * DM + col + 8) = o1;
            asm volatile("s_waitcnt lgkmcnt(0)" ::: "memory");
        }
        __syncthreads();
    }
}

__device__ __forceinline__ void gmlp_sample(const Params& P, int G, int bid) {
    const bf16_t* U = (const bf16_t*)(P.ws + WS_U); const bf16_t* GV = (const bf16_t*)(P.ws + WS_GV); bf16_t* Og = (bf16_t*)(P.ws + WS_O);
    const float* ssqv = (const float*)(P.ws + WS_SSQ) + 4 * M; const float* vg = P.in[17]; const float* wsb = P.in[18]; const float* bs = P.in[19]; float* cvs = P.out + O_CVS;
    for (int i = bid * 512 + threadIdx.x; i < NDEC * 768; i += G * 512) {
        const int n = i / 768, col = i % 768, g = col / 192; float vn[4];
#pragma unroll
        for (int s = 0; s < 4; ++s) { const int row = MP + 4 * n + s; vn[s] = bf2f(GV[(size_t)row * 768 + col]) * rsqrtf(ssqv[row] * (1.f / 768.f) + EPS) * vg[col]; cvs[(size_t)(4 * n + s) * 768 + col] = vn[s]; }
#pragma unroll
        for (int s = 0; s < 4; ++s) { float mx = bs[g * 128 + s];
#pragma unroll
            for (int j = 0; j < 4; ++j) if (j <= s) mx += wsb[(size_t)(g * 128 + s) * 128 + j] * vn[j];
            const int row = MP + 4 * n + s; Og[(size_t)row * DM + col] = f2bf_s(bf2f(U[(size_t)row * 768 + col]) * mx); }
    }
}

__device__ __forceinline__ void unpack8(const u32x4 w, float (&f)[8]) { f[0] = bflo(w.x); f[1] = bfhi(w.x); f[2] = bflo(w.y); f[3] = bfhi(w.y); f[4] = bflo(w.z); f[5] = bfhi(w.z); f[6] = bflo(w.w); f[7] = bfhi(w.w); }
__device__ __forceinline__ void conv_pass(const Params& P, int layer, int G, int bid) {
    bf16_t* AU = (bf16_t*)(P.ws + WS_AU);
    const float* cw = P.in[25] + (size_t)layer * 3 * DFF; const float* cbp = P.in[26] + (size_t)layer * DFF; const float* st = P.in[6] + (size_t)layer * NDEC * 2 * DFF;
    float* convp = P.out + O_CONVP + (size_t)layer * NBATCH * 2 * DFF; float* convs = P.out + O_CONVS + (size_t)layer * NDEC * 2 * DFF;
    constexpr int NCV = DFF / 8, RUN = 16, NRUNP = MP / RUN, NITP = NRUNP * NCV, NITS = NDEC * NCV;
    for (int it = bid * 512 + threadIdx.x; it < NITP + NITS; it += G * 512) {
        const bool smp = it >= NITP; const int jt = smp ? it - NITP : it; const int rr = jt / NCV, cv = jt % NCV, col = cv * 8;
        float w0[8], w1[8], w2[8], cb[8];
#pragma unroll
        for (int e = 0; e < 8; ++e) { w0[e] = cw[col + e]; w1[e] = cw[DFF + col + e]; w2[e] = cw[2 * DFF + col + e]; cb[e] = cbp[col + e]; }
        float am2[8], am1[8];
        int r0, nr;
        if (!smp) { r0 = rr * RUN; nr = RUN;
            if ((r0 & (SEQ - 1)) == 0) {
#pragma unroll
                for (int e = 0; e < 8; ++e) { am2[e] = 0.f; am1[e] = 0.f; } }
            else { unpack8(*(const u32x4*)(AU + (size_t)(r0 - 2) * NFF + col), am2); unpack8(*(const u32x4*)(AU + (size_t)(r0 - 1) * NFF + col), am1); }
        } else { r0 = MP + 4 * rr; nr = 4;
#pragma unroll
            for (int e = 0; e < 8; ++e) { am2[e] = st[(size_t)(rr * 2 + 0) * DFF + col + e]; am1[e] = st[(size_t)(rr * 2 + 1) * DFF + col + e]; } }
        for (int i = 0; i < nr; ++i) {
            const size_t ro = (size_t)(r0 + i) * NFF + col;
            float a[8], up[8]; unpack8(*(const u32x4*)(AU + ro), a); unpack8(*(const u32x4*)(AU + ro + DFF), up);
            float h[8];
#pragma unroll
            for (int e = 0; e < 8; ++e) { const float c = cb[e] + w0[e] * am2[e] + w1[e] * am1[e] + w2[e] * a[e]; const float sg = c * __builtin_amdgcn_rcpf(1.f + __builtin_amdgcn_exp2f(-c * LOG2E)); h[e] = sg * up[e]; am2[e] = am1[e]; am1[e] = a[e]; }
            u32x4 w; w.x = cvtpk(h[0], h[1]); w.y = cvtpk(h[2], h[3]); w.z = cvtpk(h[4], h[5]); w.w = cvtpk(h[6], h[7]);
            *(u32x4*)(AU + ro + DFF) = w;
        }
        if (!smp) { if (((r0 + RUN) & (SEQ - 1)) == 0) { const int b = r0 >> 12;
#pragma unroll
                for (int e = 0; e < 8; ++e) { convp[(size_t)(b * 2 + 0) * DFF + col + e] = am2[e]; convp[(size_t)(b * 2 + 1) * DFF + col + e] = am1[e]; } } }
        else {
#pragma unroll
            for (int e = 0; e < 8; ++e) { convs[(size_t)(rr * 2 + 0) * DFF + col + e] = am2[e]; convs[(size_t)(rr * 2 + 1) * DFF + col + e] = am1[e]; } }
    }
}


__global__ void __launch_bounds__(512, 2) mk_fwd(Params P) {
    extern __shared__ __attribute__((aligned(16))) unsigned char lds_raw[];
    LAS unsigned char* lds = (LAS unsigned char*)lds_raw;
    const int tid = threadIdx.x, wave = __builtin_amdgcn_readfirstlane(tid >> 6);
    const int G = gridDim.x, bid = blockIdx.x;
    LAS float* wsf = (LAS float*)(lds + WSF_OFF) + wave * 64;
    unsigned char* ws = P.ws;
    float* ssq = (float*)(ws + WS_SSQ);
    bf16_t* XB = (bf16_t*)(ws + WS_XB);
    cg::grid_group grid = cg::this_grid();
    const int lo = P.ph_lo, hi = P.ph_hi;
#ifndef PH_MASK
#define PH_MASK 0x1fff
#endif
#define IN(k) (((PH_MASK >> (k)) & 1) && lo <= (k) && (k) < hi)
#define SEAM(k) do { if (IN(k) && IN((k) + 1)) grid.sync(); } while (0)

    if (IN(0)) { p0_prologue(P, lds, G, bid); }
    SEAM(0);
    if (IN(1)) {
        { pg8::Gemm g{XB, (const bf16_t*)(ws + WS_WINA), DM, DM}; pg8::StaticOrder S; S.init(M, NINA, G, bid);
          EpiInA E{ssq, (bf16_t*)(ws + WS_Q), (const float*)(ws + WS_GT), P.out};
          pg8::gemm_phase<EpiInA, true, true>(lds, g, S, E); }
        { pg8::Gemm g{(const bf16_t*)(ws + WS_MEMB), (const bf16_t*)(ws + WS_WMKV), DM, DM}; pg8::StaticOrder S; S.init(MMEM, 1024, G, (bid + G - 12) % G);
          EpiMemKV E{ssq + 5 * M, P.in[23], P.out + O_MKP, P.out + O_MVP, (bf16_t*)(ws + WS_MK), (bf16_t*)(ws + WS_MV)};
          pg8::gemm_phase<EpiMemKV, true, true>(lds, g, S, E); }
    }
    SEAM(1);
    if (IN(2)) {
        for (int uidx = bid; uidx < 1536; uidx += G) {
#ifndef UM
#define UM 15
#endif
            if (uidx < 512) { if (UM & 1) unit_swa_prompt(P, lds, wsf, uidx >> 6, (uidx >> 2) & 15, uidx & 3); }
            else if (uidx < 1024) { const int v = uidx - 512; if (UM & 2) unit_mem_prompt(P, lds, wsf, 0, v >> 6, (v >> 2) & 15, v & 3); }
            else if (uidx < 1280) { const int v = uidx - 1024; if (UM & 4) unit_mem_sample(P, lds, wsf, 0, v >> 1, v & 1); }
            else { const int v = uidx - 1280; if (UM & 8) unit_swa_sample(P, lds, wsf, v >> 1, v & 1); }
        }
    }
    SEAM(2);
    if (IN(3)) {
        pg8::Gemm g{(const bf16_t*)(ws + WS_O), (const bf16_t*)(ws + WS_WOUTA), DM, DM}; pg8::StaticOrder S; S.init(M, DM, G, bid);
        EpiRes E{P.in[0], P.in[1], P.out + O_Y, XB, ssq + M};
        pg8::gemm_phase<EpiRes, true, true>(lds, g, S, E);
    }
    SEAM(3);
    if (IN(4)) {
        pg8::Gemm g{XB, (const bf16_t*)(ws + WS_WFFN), DM, DM}; pg8::StaticOrder S; S.init(M, NFF, G, bid);
        EpiFfn E{ssq + M, (bf16_t*)(ws + WS_AU)};
        pg8::gemm_phase<EpiFfn, true, true>(lds, g, S, E);
    }
    SEAM(4);
    if (IN(5)) conv_pass(P, 0, G, bid);
    SEAM(5);
    if (IN(6)) {
        pg8::Gemm g{(const bf16_t*)(ws + WS_AU) + DFF, (const bf16_t*)(ws + WS_WDOWN), NFF, DFF}; pg8::StaticOrder S; S.init(M, DM, G, bid);
        EpiRes E{P.out + O_Y, P.out + O_Y + (size_t)MP * DM, P.out + O_Y, XB, ssq + 2 * M};
        pg8::gemm_phase<EpiRes, true, true>(lds, g, S, E);
    }
    SEAM(6);
    if (IN(7)) {
        pg8::Gemm g{XB, (const bf16_t*)(ws + WS_WINB), DM, DM}; pg8::StaticOrder S; S.init(M, NINB, G, bid);
        EpiInB E{ssq + 2 * M, (bf16_t*)(ws + WS_U), (bf16_t*)(ws + WS_GV), (bf16_t*)(ws + WS_XQ), P.in[22] + 64, ssq + 4 * M};
        pg8::gemm_phase<EpiInB, true, true>(lds, g, S, E);
    }
    SEAM(7);
    if (IN(8)) {
        for (int uidx = bid; uidx < 1024; uidx += G) {
            if (uidx < 256) unit_gmlp_prompt(P, lds, uidx >> 5, uidx & 31);
            else if (uidx < 768) { const int v = uidx - 256; unit_mem_prompt(P, lds, wsf, 1, v >> 6, (v >> 2) & 15, v & 3); }
            else { const int v = uidx - 768; unit_mem_sample(P, lds, wsf, 1, v >> 1, v & 1); }
        }
        gmlp_sample(P, G, bid);
    }
    SEAM(8);
    if (IN(9)) {
        pg8::Gemm g{(const bf16_t*)(ws + WS_O), (const bf16_t*)(ws + WS_WOUTB), DM, DM}; pg8::StaticOrder S; S.init(M, DM, G, bid);
        EpiRes E{P.out + O_Y, P.out + O_Y + (size_t)MP * DM, P.out + O_Y, XB, ssq + 3 * M};
        pg8::gemm_phase<EpiRes, true, true>(lds, g, S, E);
    }
    SEAM(9);
    if (IN(10)) {
        pg8::Gemm g{XB, (const bf16_t*)(ws + WS_WFFN) + (size_t)NFF * DM, DM, DM}; pg8::StaticOrder S; S.init(M, NFF, G, bid);
        EpiFfn E{ssq + 3 * M, (bf16_t*)(ws + WS_AU)};
        pg8::gemm_phase<EpiFfn, true, true>(lds, g, S, E);
    }
    SEAM(10);
    if (IN(11)) conv_pass(P, 1, G, bid);
    SEAM(11);
    if (IN(12)) {
        pg8::Gemm g{(const bf16_t*)(ws + WS_AU) + DFF, (const bf16_t*)(ws + WS_WDOWN) + (size_t)DM * DFF, NFF, DFF}; pg8::StaticOrder S; S.init(M, DM, G, bid);
        EpiRes E{P.out + O_Y, P.out + O_Y + (size_t)MP * DM, P.out + O_Y, nullptr, nullptr};
        pg8::gemm_phase<EpiRes, true, true>(lds, g, S, E);
    }
#undef IN
#undef SEAM
}

extern "C" void kernel_launch(void* const* d_in, const int* in_sizes, int n_in, void* d_out, int out_size, void* d_ws, size_t ws_size, hipStream_t stream) {
    static int grid = 0;
    if (grid == 0) {
        if (n_in != 28 || (size_t)out_size != O_END || ws_size < WS_END) { fprintf(stderr, "kernel_launch: unexpected shapes: n_in %d out %d ws %zu (need %zu)\n", n_in, out_size, ws_size, (size_t)WS_END); grid = -1; return; }
        int dev = 0, cus = 0, per_cu = 0;
        hipGetDevice(&dev); hipDeviceGetAttribute(&cus, hipDeviceAttributeMultiprocessorCount, dev);
        if (hipFuncSetAttribute((const void*)mk_fwd, hipFuncAttributeMaxDynamicSharedMemorySize, LDS_BYTES) != hipSuccess) { fprintf(stderr, "kernel_launch: hipFuncSetAttribute failed\n"); grid = -1; return; }
        hipOccupancyMaxActiveBlocksPerMultiprocessor(&per_cu, (const void*)mk_fwd, 512, LDS_BYTES);
        (void)hipGetLastError();
        if (per_cu < 1) { fprintf(stderr, "kernel_launch: occupancy query says %d blocks per CU\n", per_cu); per_cu = 1; }
        grid = cus;
    }
    if (grid < 0) return;
    Params p{};
    for (int i = 0; i < 28; ++i) p.in[i] = (const float*)d_in[i];
    p.out = (float*)d_out; p.ws = (unsigned char*)d_ws;
#if MK_N_LAUNCHES == 1
    p.ph_lo = 0; p.ph_hi = NPHASE;
    void* args[] = {&p};
    hipError_t e = hipLaunchCooperativeKernel((const void*)mk_fwd, dim3(grid), dim3(512), args, LDS_BYTES, stream);
    if (e != hipSuccess) fprintf(stderr, "cooperative launch failed: %s (grid %d)\n", hipGetErrorString(e), grid);
#else
    for (int ph = 0; ph < NPHASE; ++ph) {
        p.ph_lo = ph; p.ph_hi = ph + 1;
        hipLaunchKernelGGL(mk_fwd, dim3(grid), dim3(512), LDS_BYTES, stream, p);
    }
#endif
}
```

```cpp
#include <hip/hip_runtime.h>
#include <hip/hip_cooperative_groups.h>
#include <cstdio>
#include <cstdint>
namespace cg = cooperative_groups;

#ifndef MK_N_LAUNCHES
#define MK_N_LAUNCHES 1
#endif

#ifndef DUP
#define DUP -1
#endif
#define LAS __attribute__((address_space(3)))
typedef unsigned short bf16_t;
typedef short bf16x8 __attribute__((ext_vector_type(8)));
typedef short s16x4 __attribute__((ext_vector_type(4)));
typedef float f32x4 __attribute__((ext_vector_type(4)));
typedef float f32x2 __attribute__((ext_vector_type(2)));
typedef float f32x16 __attribute__((ext_vector_type(16)));
typedef unsigned u32x4 __attribute__((ext_vector_type(4)));
typedef unsigned u32x2 __attribute__((ext_vector_type(2)));
typedef __bf16 bf16x2_t __attribute__((ext_vector_type(2)));

constexpr int DM = 1024, NBATCH = 8, SEQ = 4096, MP = NBATCH * SEQ, NDEC = 128, DSEQ = 4, MS = NDEC * DSEQ, M = MP + MS;
constexpr int NMEM = 256, MMEM = NBATCH * NMEM;
constexpr int DFF = 2816, NFF = 2 * DFF;
constexpr int NINA = 1536, NINB = 1792;
constexpr float EPS = 1e-6f;
constexpr float LOG2E = 1.4426950408889634f;
constexpr int NPHASE = 13;

constexpr size_t O_Y = 0, O_WKP = 34078720, O_WVP = 34340864, O_CVP = 34603008, O_MKP = 35389440, O_MVP = 36438016, O_CONVP = 37486592,
                 O_WKS = 37576704, O_WVS = 41771008, O_CVS = 45965312, O_CONVS = 46358528, O_END = 47800320;

constexpr size_t MiB = 1u << 20;
constexpr size_t WS_SSQ = 0, WS_GT = 1 * MiB;
constexpr size_t WS_WINA = 2 * MiB, WS_WOUTA = 5 * MiB, WS_WINB = 7 * MiB, WS_WOUTB = 11 * MiB, WS_WMKV = 13 * MiB, WS_WFFN = 15 * MiB,
                 WS_WDOWN = 37 * MiB, WS_WST = 48 * MiB;
constexpr size_t WS_MEMB = 50 * MiB, WS_MK = 54 * MiB, WS_MV = 56 * MiB;
constexpr size_t WS_XB = 58 * MiB;
constexpr size_t WS_AU = 124 * MiB;
constexpr size_t WS_Q = WS_AU, WS_K = WS_Q + (size_t)M * 768 * 2, WS_V = WS_K + (size_t)M * 256 * 2, WS_XQ = WS_V + (size_t)M * 256 * 2,
                 WS_O = WS_XQ + (size_t)M * 256 * 2, WS_U = WS_O + (size_t)M * 1024 * 2, WS_GV = WS_U + (size_t)M * 768 * 2;
constexpr size_t WS_END = WS_AU + (size_t)M * NFF * 2;
static_assert(WS_GV + (size_t)M * 768 * 2 <= WS_END, "mixer buffers inside AU");
static_assert(WS_END <= 512 * MiB, "ws");

namespace pg8 {
constexpr int BM = 256, BK = 64, HALF = 128, HTB = HALF * BK * 2, STAGE_BYTES = 8 * HTB, NXCD = 8, WGM = 8;
__host__ __device__ __forceinline__ int lds_byte(int r, int c) { const int st = (r >> 4) * 2 + (c >> 5), rr = r & 15, cc = c & 31, ob = rr * 64 + cc * 2; return st * 1024 + (ob ^ (((ob >> 9) & 1) << 5)); }
__host__ __device__ __forceinline__ void stage_rc(int b, int& R, int& C) { const int st = b / 1024, sb = b % 1024, swz = sb ^ (((sb >> 9) & 1) << 5); R = (st >> 1) * 16 + swz / 64; C = (st & 1) * 32 + (swz % 64) / 2; }
__host__ __device__ __forceinline__ int perm32(int rho) { const int n = rho >> 4, i = rho & 15; return 8 * (i >> 2) + 4 * n + (i & 3); }

struct Unit { int pm, pn; };
struct Gemm { const bf16_t* A; const bf16_t* Bt; int lda, K; };

struct StaticOrder {
    int nM, nN, nwg, G, c;
    __device__ void init(int Mr, int N, int G_, int c_) { nM = Mr / BM; nN = N / BM; nwg = nM * nN; G = G_; c = c_; }
    __device__ bool next(int i, Unit& u) const {
        const long L = (long)i * G + c; if (L >= nwg) return false;
        int wgid = (int)L; { const int q = nwg / NXCD, r = nwg % NXCD, xcd = wgid % NXCD, off = wgid / NXCD; wgid = (xcd < r ? xcd * (q + 1) : r * (q + 1) + (xcd - r) * q) + off; }
        const int nig = WGM * nN, gid = wgid / nig, fm = gid * WGM, gsz = (nM - fm) < WGM ? (nM - fm) : WGM;
        u.pm = fm + ((wgid % nig) % gsz); u.pn = (wgid % nig) / gsz; return true;
    }
};

template <class Epi, bool ALIGN_EPI, bool SP2>
__device__ __forceinline__ void gemm_phase(LAS unsigned char* lds, const Gemm g, const StaticOrder& S, const Epi& E) {
    const int tid = threadIdx.x, wid = __builtin_amdgcn_readfirstlane(tid >> 6), lane = tid & 63, wr = wid >> 2, wc = wid & 3, fr = lane & 15, fq = lane >> 4;
    const int K = g.K, nt = K / BK, lda = g.lda;
    unsigned voffA[2], voffB[2];
#pragma unroll
    for (int i = 0; i < 2; ++i) { int R, C; stage_rc(tid * 16 + i * 8192, R, C); const int Rb = (R & ~31) + perm32(R & 31);
        voffA[i] = (unsigned)(R * lda + C) * 2u; voffB[i] = (unsigned)(Rb * K + C) * 2u; }
    const size_t kstep = (size_t)(BK * 2);
    const size_t hstepA = (size_t)HALF * lda * 2, hstepB = (size_t)HALF * K * 2;
    const size_t tstepA = 2 * hstepA, tstepB = 2 * hstepB;
    const unsigned ldsw = (unsigned)wid * 1024u;
    const int aoff = lds_byte(wr * 64 + fr, fq * 8), boff = lds_byte(wc * 32 + fr, fq * 8);
#define PG8_SA(b, h) (((b) * 2 + (h)) * HTB)
#define PG8_SB(b, h) ((4 + (b) * 2 + (h)) * HTB)
#define PG8_STAGE(bufoff, gbase, voff) do { _Pragma("unroll") for (int _i = 0; _i < 2; ++_i) \
        __builtin_amdgcn_global_load_lds((const unsigned*)((const char*)(gbase) + (voff)[_i]), (LAS unsigned*)(lds + (bufoff) + ldsw + _i * 8192), 16, 0, 0); } while (0)
#define PG8_LDA(dst, b, h) do { _Pragma("unroll") for (int m = 0; m < 4; ++m) _Pragma("unroll") for (int k = 0; k < 2; ++k) dst[m][k] = *(const LAS bf16x8*)(lds + PG8_SA(b, h) + aoff + m * 2048 + k * 1024); } while (0)
#define PG8_LDB(dst, b, h) do { _Pragma("unroll") for (int n = 0; n < 2; ++n) _Pragma("unroll") for (int k = 0; k < 2; ++k) dst[n][k] = *(const LAS bf16x8*)(lds + PG8_SB(b, h) + boff + n * 2048 + k * 1024); } while (0)
#define PG8_MMA(ai, bj, At, Bt) do { __builtin_amdgcn_s_setprio(1); _Pragma("unroll") for (int m = 0; m < 4; ++m) _Pragma("unroll") for (int n = 0; n < 2; ++n) _Pragma("unroll") for (int k = 0; k < 2; ++k) \
        acc[ai][bj][m][n] = __builtin_amdgcn_mfma_f32_16x16x32_bf16(Bt[n][k], At[m][k], acc[ai][bj][m][n], 0, 0, 0); __builtin_amdgcn_s_setprio(0); } while (0)
#define PG8_WAIT_V(n) asm volatile("s_waitcnt vmcnt(" #n ")" ::: "memory")
#define PG8_WAIT_L(n) asm volatile("s_waitcnt lgkmcnt(" #n ")" ::: "memory")
#define PG8_BAR __builtin_amdgcn_s_barrier()
#define PG8_SCHED __builtin_amdgcn_sched_barrier(0)
    Unit cur, nxt; int ui = 0;
    if (!S.next(0, cur)) return;
    f32x4 acc[2][2][4][2];
#pragma unroll
    for (int a = 0; a < 2; ++a)
#pragma unroll
        for (int b = 0; b < 2; ++b)
#pragma unroll
            for (int m = 0; m < 4; ++m)
#pragma unroll
                for (int n = 0; n < 2; ++n) acc[a][b][m][n] = (f32x4){0.f, 0.f, 0.f, 0.f};
    bf16x8 At[4][2], B0[2][2], B1[2][2];
    const char* cA = (const char*)g.A + (size_t)cur.pm * tstepA; const char* cB = (const char*)g.Bt + (size_t)cur.pn * tstepB;
    if constexpr (SP2) {
        PG8_STAGE(PG8_SB(0, 0), cB, voffB); PG8_STAGE(PG8_SB(0, 1), cB + hstepB, voffB); PG8_STAGE(PG8_SA(0, 0), cA, voffA); PG8_STAGE(PG8_SA(0, 1), cA + hstepA, voffA);
        if (wr == 1) PG8_BAR;
        PG8_WAIT_V(2); PG8_BAR;
        PG8_STAGE(PG8_SB(1, 0), cB + kstep, voffB); PG8_STAGE(PG8_SA(1, 0), cA + kstep, voffA); PG8_STAGE(PG8_SB(1, 1), cB + hstepB + kstep, voffB);
        PG8_WAIT_V(6); PG8_BAR;
    } else {
        PG8_STAGE(PG8_SB(0, 0), cB, voffB); PG8_STAGE(PG8_SA(0, 0), cA, voffA); PG8_STAGE(PG8_SB(0, 1), cB + hstepB, voffB); PG8_STAGE(PG8_SA(0, 1), cA + hstepA, voffA);
        if (wr == 1) PG8_BAR;
        PG8_WAIT_V(4); PG8_BAR;
        PG8_STAGE(PG8_SB(1, 0), cB + kstep, voffB); PG8_STAGE(PG8_SA(1, 0), cA + kstep, voffA); PG8_STAGE(PG8_SB(1, 1), cB + hstepB + kstep, voffB);
        PG8_WAIT_V(6); PG8_BAR;
    }
    for (;;) {
        const bool has_next = S.next(ui + 1, nxt);
        const char* nA = has_next ? (const char*)g.A + (size_t)nxt.pm * tstepA : cA; const char* nB = has_next ? (const char*)g.Bt + (size_t)nxt.pn * tstepB : cB;
        for (int t = 0; t < nt; t += 2) {
            const bool last = (t == nt - 2);
            const char* a1 = cA + (size_t)(t + 1) * kstep;
            const char* a2 = last ? nA : cA + (size_t)(t + 2) * kstep; const char* b2 = last ? nB : cB + (size_t)(t + 2) * kstep;
            const char* a3 = a2 + kstep; const char* b3 = b2 + kstep;
            if constexpr (SP2) {
            PG8_LDB(B0, 0, 0); PG8_LDB(B1, 0, 1); PG8_SCHED; PG8_LDA(At, 0, 0); PG8_STAGE(PG8_SA(1, 1), a1 + hstepA, voffA);
            PG8_WAIT_V(8); PG8_WAIT_L(0); PG8_BAR; PG8_MMA(0, 0, At, B0); PG8_MMA(0, 1, At, B1); PG8_BAR; PG8_SCHED;
            PG8_LDA(At, 0, 1); PG8_STAGE(PG8_SB(0, 0), b2, voffB); PG8_STAGE(PG8_SB(0, 1), b2 + hstepB, voffB); PG8_STAGE(PG8_SA(0, 0), a2, voffA);
            PG8_WAIT_V(8); PG8_WAIT_L(0); PG8_BAR; PG8_MMA(1, 0, At, B0); PG8_MMA(1, 1, At, B1); PG8_BAR; PG8_SCHED;
            PG8_LDB(B0, 1, 0); PG8_LDB(B1, 1, 1); PG8_SCHED; PG8_LDA(At, 1, 0); PG8_STAGE(PG8_SA(0, 1), a2 + hstepA, voffA);
            PG8_WAIT_V(8); PG8_WAIT_L(0); PG8_BAR; PG8_MMA(0, 0, At, B0); PG8_MMA(0, 1, At, B1); PG8_BAR; PG8_SCHED;
            PG8_LDA(At, 1, 1); PG8_STAGE(PG8_SB(1, 0), b3, voffB); PG8_STAGE(PG8_SB(1, 1), b3 + hstepB, voffB); PG8_STAGE(PG8_SA(1, 0), a3, voffA);
            PG8_WAIT_V(8); PG8_WAIT_L(0); PG8_BAR; PG8_MMA(1, 0, At, B0); PG8_MMA(1, 1, At, B1); PG8_BAR; PG8_SCHED;
            } else {
            PG8_LDB(B0, 0, 0); PG8_SCHED; PG8_LDA(At, 0, 0); PG8_STAGE(PG8_SA(1, 1), a1 + hstepA, voffA);
            PG8_WAIT_L(8); PG8_BAR; PG8_WAIT_L(0); PG8_MMA(0, 0, At, B0); PG8_BAR; PG8_SCHED;
            PG8_LDB(B1, 0, 1); PG8_STAGE(PG8_SB(0, 0), b2, voffB);
            PG8_BAR; PG8_WAIT_L(0); PG8_MMA(0, 1, At, B1); PG8_BAR;
            PG8_LDA(At, 0, 1); PG8_STAGE(PG8_SA(0, 0), a2, voffA);
            PG8_BAR; PG8_WAIT_L(0); PG8_MMA(1, 0, At, B0); PG8_BAR; PG8_SCHED;
            PG8_STAGE(PG8_SB(0, 1), b2 + hstepB, voffB);
            PG8_WAIT_V(6); PG8_BAR; PG8_MMA(1, 1, At, B1); PG8_BAR;
            PG8_LDB(B0, 1, 0); PG8_SCHED; PG8_LDA(At, 1, 0); PG8_STAGE(PG8_SA(0, 1), a2 + hstepA, voffA);
            PG8_WAIT_L(8); PG8_BAR; PG8_WAIT_L(0); PG8_MMA(0, 0, At, B0); PG8_BAR; PG8_SCHED;
            PG8_LDB(B1, 1, 1); PG8_STAGE(PG8_SB(1, 0), b3, voffB);
            PG8_BAR; PG8_WAIT_L(0); PG8_MMA(0, 1, At, B1); PG8_BAR;
            PG8_LDA(At, 1, 1); PG8_STAGE(PG8_SA(1, 0), a3, voffA);
            PG8_BAR; PG8_WAIT_L(0); PG8_MMA(1, 0, At, B0); PG8_BAR; PG8_SCHED;
            PG8_STAGE(PG8_SB(1, 1), b3 + hstepB, voffB);
            PG8_WAIT_V(6); PG8_BAR; PG8_MMA(1, 1, At, B1); PG8_BAR;
            }
        }
        if constexpr (ALIGN_EPI) { if (wr == 0) PG8_BAR; }
        E(acc, cur, wr, wc, fr, fq);
        if (!has_next) break;
#pragma unroll
        for (int a = 0; a < 2; ++a)
#pragma unroll
            for (int b = 0; b < 2; ++b)
#pragma unroll
                for (int m = 0; m < 4; ++m)
#pragma unroll
                    for (int n = 0; n < 2; ++n) acc[a][b][m][n] = (f32x4){0.f, 0.f, 0.f, 0.f};
        cur = nxt; cA = nA; cB = nB; ++ui;
        if constexpr (ALIGN_EPI) { if (wr == 1) PG8_BAR; }
    }
    PG8_WAIT_V(0);
    if constexpr (!ALIGN_EPI) { if (wr == 0) PG8_BAR; }
    PG8_BAR;
#undef PG8_SA
#undef PG8_SB
#undef PG8_STAGE
#undef PG8_LDA
#undef PG8_LDB
#undef PG8_MMA
#undef PG8_WAIT_V
#undef PG8_WAIT_L
#undef PG8_BAR
#undef PG8_SCHED
}
}
using pg8::Unit;

constexpr int RING_BYTES = 131072, WSF_OFF = RING_BYTES, OSTG2_OFF = RING_BYTES + 4096, LDS_BYTES = 147456;
__device__ __forceinline__ unsigned cvtpk(float lo, float hi) { f32x2 v = {lo, hi}; bf16x2_t b = __builtin_convertvector(v, bf16x2_t); return __builtin_bit_cast(unsigned, b); }
__device__ __forceinline__ u32x4 pack8(const f32x4 a, const f32x4 b) { u32x4 w; w.x = cvtpk(a[0], a[1]); w.y = cvtpk(a[2], a[3]); w.z = cvtpk(b[0], b[1]); w.w = cvtpk(b[2], b[3]); return w; }
__device__ __forceinline__ float bf2f(unsigned short h) { return __uint_as_float((unsigned)h << 16); }
__device__ __forceinline__ float bflo(unsigned w) { return __uint_as_float(w << 16); }
__device__ __forceinline__ float bfhi(unsigned w) { return __uint_as_float(w & 0xffff0000u); }
__device__ __forceinline__ float wave_sum(float v) {
#pragma unroll
    for (int o = 1; o < 64; o <<= 1) v += __shfl_xor(v, o);
    return v;
}
__device__ __forceinline__ f32x2 gelu_pk(f32x2 v) {
    const f32x2 av = __builtin_elementwise_abs(v), d = av * 0.2316418882f + 1.0f;
    f32x2 t; t.x = __builtin_amdgcn_rcpf(d.x); t.y = __builtin_amdgcn_rcpf(d.y);
    f32x2 q = t * 0.5307027145f + (-0.7265760135f); q = q * t + 0.7107068705f; q = q * t + (-0.142248368f); q = q * t + 0.127414796f; q = q * t;
    const f32x2 s = (v * v) * (-0.72134752044f);
    f32x2 e; e.x = __builtin_amdgcn_exp2f(s.x); e.y = __builtin_amdgcn_exp2f(s.y);
    const f32x2 m = v * (q * e), r = v - m;
    f32x2 o; o.x = v.x < 0.f ? m.x : r.x; o.y = v.y < 0.f ? m.y : r.y; return o;
}
__device__ __forceinline__ f32x4 gelu4(f32x4 v) { const f32x2 a = gelu_pk((f32x2){v[0], v[1]}), b = gelu_pk((f32x2){v[2], v[3]}); return (f32x4){a.x, a.y, b.x, b.y}; }
__device__ __forceinline__ float dot4(f32x4 v) { return (v[0] * v[0] + v[1] * v[1]) + (v[2] * v[2] + v[3] * v[3]); }
__device__ __forceinline__ unsigned short f2bf_s(float f) { return (unsigned short)(cvtpk(f, 0.f) & 0xffffu); }
__device__ __forceinline__ float alibi_slope(int h) { return h < 8 ? exp2f(-(float)(h + 1)) : exp2f(-0.5f - (float)(h - 8)); }

struct Params {
    const float* in[28];
    float* out;
    unsigned char* ws;
    int ph_lo, ph_hi;
};

#define EPI_ARGS const f32x4 (&acc)[2][2][4][2], const Unit& u, int wr, int wc, int fr, int fq
#define FOR_AI_M _Pragma("unroll") for (int ai = 0; ai < 2; ++ai) _Pragma("unroll") for (int m = 0; m < 4; ++m)
#define BIG_ROWS(E) do { const int row0_ = u.pm * 256 + wr * 64 + fr; FOR_AI_M { f32x4 v_[2][2]; \
    _Pragma("unroll") for (int bj = 0; bj < 2; ++bj) _Pragma("unroll") for (int n = 0; n < 2; ++n) v_[bj][n] = acc[ai][bj][m][n]; \
    (E).row(v_, row0_ + ai * 128 + m * 16, u.pn, wc, fq); } } while (0)

__device__ __forceinline__ void head_norm(f32x4 (&v)[2][2], const float* gp, int fq) {
    float ss = (dot4(v[0][0]) + dot4(v[0][1])) + (dot4(v[1][0]) + dot4(v[1][1]));
    ss += __shfl_xor(ss, 16); ss += __shfl_xor(ss, 32);
    const float inv = rsqrtf(ss * (1.f / 64.f) + EPS);
#pragma unroll
    for (int bj = 0; bj < 2; ++bj)
#pragma unroll
        for (int n = 0; n < 2; ++n) { const f32x4 g = *(const f32x4*)(gp + 32 * bj + 8 * fq + 4 * n); v[bj][n] = v[bj][n] * inv * g; }
}

struct EpiInA {
    const float* ssq; bf16_t* Qb; const float* gt; float* out;
    __device__ __forceinline__ void row(f32x4 (&v)[2][2], int row, int pn, int wc, int fq) const {
        const int typ = pn < 3 ? 0 : pn - 2;
        const size_t doff = typ == 0 ? 0 : (size_t)M * 768 + (size_t)(typ - 1) * M * 256;
        const int ld = typ == 0 ? 768 : 256, cb = typ == 0 ? (pn * 4 + wc) * 64 : wc * 64;
        const float rs = rsqrtf(ssq[row] * (1.f / 1024.f) + EPS);
#pragma unroll
        for (int bj = 0; bj < 2; ++bj)
#pragma unroll
            for (int n = 0; n < 2; ++n) v[bj][n] = v[bj][n] * rs;
        if (typ != 2) head_norm(v, gt + typ * 64, fq);
#pragma unroll
        for (int bj = 0; bj < 2; ++bj) *(u32x4*)(Qb + doff + (size_t)row * ld + cb + 32 * bj + 8 * fq) = pack8(v[bj][0], v[bj][1]);
        if (typ == 1 || typ == 2) {
            long wo = -1;
            if (row >= MP) { const int ns = row - MP; wo = (long)O_WKS + (long)(typ - 1) * (long)(O_WVS - O_WKS) + (long)((ns >> 2) * 128 + 124 + (ns & 3)) * 256; }
            else if ((row & 4095) >= 3968) { const int b = row >> 12, t = row & 4095; wo = (long)O_WKP + (long)(typ - 1) * (long)(O_WVP - O_WKP) + (long)(b * 128 + t - 3968) * 256; }
            if (wo >= 0) { float* wout = out + wo;
#pragma unroll
                for (int bj = 0; bj < 2; ++bj)
#pragma unroll
                    for (int n = 0; n < 2; ++n) *(f32x4*)(wout + wc * 64 + 32 * bj + 8 * fq + 4 * n) = v[bj][n];
            }
        }
    }
    __device__ __forceinline__ void operator()(EPI_ARGS) const { BIG_ROWS(*this); }
};

struct EpiMemKV {
    const float* ssq; const float* xk; float *outk, *outv; bf16_t *MK, *MV;
    __device__ __forceinline__ void row(f32x4 (&v)[2][2], int row, int pn, int wc, int fq) const {
        const int layer = pn >> 1; const bool isv = pn & 1;
        float* of = (isv ? outv : outk) + (size_t)layer * MMEM * 256; bf16_t* ob = (isv ? MV : MK) + (size_t)layer * MMEM * 256;
        const float rs = rsqrtf(ssq[row] * (1.f / 1024.f) + EPS);
#pragma unroll
        for (int bj = 0; bj < 2; ++bj)
#pragma unroll
            for (int n = 0; n < 2; ++n) v[bj][n] = v[bj][n] * rs;
        if (!isv) head_norm(v, xk + layer * 64, fq);
#pragma unroll
        for (int bj = 0; bj < 2; ++bj) {
            const size_t o = (size_t)row * 256 + wc * 64 + 32 * bj + 8 * fq;
            *(u32x4*)(ob + o) = pack8(v[bj][0], v[bj][1]);
            *(f32x4*)(of + o) = v[bj][0]; *(f32x4*)(of + o + 4) = v[bj][1];
        }
    }
    __device__ __forceinline__ void operator()(EPI_ARGS) const { BIG_ROWS(*this); }
};

struct EpiRes {
    const float* xin_p; const float* xin_s; float* xout; bf16_t* xb; float* ssq;
    __device__ __forceinline__ void row(f32x4 (&v)[2][2], int row, int pn, int wc, int fq) const {
        const int col0 = pn * 256 + wc * 32 + 8 * fq;
        const float* src = (row < MP ? xin_p + (size_t)row * DM : xin_s + (size_t)(row - MP) * DM) + col0;
        float ss = 0.f;
#pragma unroll
        for (int bj = 0; bj < 2; ++bj) {
            const f32x4 x0 = *(const f32x4*)(src + 128 * bj) + v[bj][0], x1 = *(const f32x4*)(src + 128 * bj + 4) + v[bj][1];
            float* o = xout + (size_t)row * DM + col0 + 128 * bj;
            *(f32x4*)o = x0; *(f32x4*)(o + 4) = x1;
            if (xb) *(u32x4*)(xb + (size_t)row * DM + col0 + 128 * bj) = pack8(x0, x1);
            ss += dot4(x0) + dot4(x1);
        }
        if (ssq) { ss += __shfl_xor(ss, 16); ss += __shfl_xor(ss, 32); if (fq == 0) atomicAdd(ssq + row, ss); }
    }
    __device__ __forceinline__ void operator()(EPI_ARGS) const { BIG_ROWS(*this); }
};

struct EpiFfn {
    const float* ssq; bf16_t* AU;
    __device__ __forceinline__ void row(f32x4 (&v)[2][2], int row, int pn, int wc, int fq) const {
        const int col0 = pn * 128 + wc * 32 + 8 * fq;
        const float rs = rsqrtf(ssq[row] * (1.f / 1024.f) + EPS);
#pragma unroll
        for (int bj = 0; bj < 2; ++bj) *(u32x4*)(AU + (size_t)row * NFF + bj * DFF + col0) = pack8(v[bj][0] * rs, v[bj][1] * rs);
    }
    __device__ __forceinline__ void operator()(EPI_ARGS) const { BIG_ROWS(*this); }
};

struct EpiInB {
    const float* ssq; bf16_t *U, *GV, *XQ; const float* xg; float* ssqv;
    __device__ __forceinline__ void row(f32x4 (&v)[2][2], int row, int pn, int wc, int fq) const {
        const float rs = rsqrtf(ssq[row] * (1.f / 1024.f) + EPS);
        if (pn < 6) {
            bf16_t* dst = pn < 3 ? U : GV; const int col0 = (pn % 3) * 256 + wc * 32 + 8 * fq;
            float ss = 0.f;
#pragma unroll
            for (int bj = 0; bj < 2; ++bj) {
                const f32x4 v0 = gelu4(v[bj][0] * rs), v1 = gelu4(v[bj][1] * rs);
                *(u32x4*)(dst + (size_t)row * 768 + col0 + 128 * bj) = pack8(v0, v1);
                ss += dot4(v0) + dot4(v1);
            }
            if (pn >= 3) { ss += __shfl_xor(ss, 16); ss += __shfl_xor(ss, 32); if (fq == 0) atomicAdd(ssqv + row, ss); }
        } else {
#pragma unroll
            for (int bj = 0; bj < 2; ++bj)
#pragma unroll
                for (int n = 0; n < 2; ++n) v[bj][n] = v[bj][n] * rs;
            head_norm(v, xg, fq);
#pragma unroll
            for (int bj = 0; bj < 2; ++bj) *(u32x4*)(XQ + (size_t)row * 256 + wc * 64 + 32 * bj + 8 * fq) = pack8(v[bj][0], v[bj][1]);
        }
    }
    __device__ __forceinline__ void operator()(EPI_ARGS) const { BIG_ROWS(*this); }
};

template <int MB, int NS>
__device__ __forceinline__ void wave_gemm_part(const bf16_t* A, int lda, int row0, const bf16_t* Bt, int K, int pn, int wc, int k0, f32x4 (&acc)[MB][2][2]) {
    const int lane = threadIdx.x & 63, fr = lane & 15, fq = lane >> 4;
    const bf16_t* ap = A + (size_t)(row0 + fr) * lda + 8 * fq + k0;
    const bf16_t* bp[2][2];
#pragma unroll
    for (int bj = 0; bj < 2; ++bj)
#pragma unroll
        for (int n = 0; n < 2; ++n) bp[bj][n] = Bt + (size_t)(pn * 256 + 128 * bj + 32 * wc + pg8::perm32(16 * n + fr)) * K + 8 * fq + k0;
#pragma unroll
    for (int m = 0; m < MB; ++m)
#pragma unroll
        for (int bj = 0; bj < 2; ++bj)
#pragma unroll
            for (int n = 0; n < 2; ++n) acc[m][bj][n] = (f32x4){0.f, 0.f, 0.f, 0.f};
#pragma unroll
    for (int s0 = 0; s0 < NS; s0 += 4) {
        bf16x8 af[4][MB], bf[4][2][2];
#pragma unroll
        for (int j = 0; j < 4; ++j) if (s0 + j < NS) {
#pragma unroll
            for (int m = 0; m < MB; ++m) af[j][m] = *(const bf16x8*)(ap + (size_t)m * 16 * lda + (s0 + j) * 32);
#pragma unroll
            for (int bj = 0; bj < 2; ++bj)
#pragma unroll
                for (int n = 0; n < 2; ++n) bf[j][bj][n] = *(const bf16x8*)(bp[bj][n] + (s0 + j) * 32);
        }
#pragma unroll
        for (int j = 0; j < 4; ++j) if (s0 + j < NS) {
#pragma unroll
            for (int m = 0; m < MB; ++m)
#pragma unroll
                for (int bj = 0; bj < 2; ++bj)
#pragma unroll
                    for (int n = 0; n < 2; ++n) acc[m][bj][n] = __builtin_amdgcn_mfma_f32_16x16x32_bf16(bf[j][bj][n], af[j][m], acc[m][bj][n], 0, 0, 0);
        }
    }
}
template <int MB>
__device__ __forceinline__ void sample_reduce_store(LAS unsigned char* lds, const f32x4 (&acc)[MB][2][2], int wave, int lane) {
    LAS f32x4* Pl = (LAS f32x4*)lds;
#pragma unroll
    for (int m = 0; m < MB; ++m)
#pragma unroll
        for (int bj = 0; bj < 2; ++bj)
#pragma unroll
            for (int n = 0; n < 2; ++n) Pl[((wave * MB + m) * 4 + bj * 2 + n) * 64 + lane] = acc[m][bj][n];
}
template <int MB>
__device__ __forceinline__ void sample_reduce_load(const LAS unsigned char* lds, f32x4 (&v)[2][2], int m, int lane) {
    const LAS f32x4* Pl = (const LAS f32x4*)lds;
#pragma unroll
    for (int bj = 0; bj < 2; ++bj)
#pragma unroll
        for (int n = 0; n < 2; ++n) { f32x4 sum = Pl[((0 * MB + m) * 4 + bj * 2 + n) * 64 + lane];
#pragma unroll
            for (int w = 1; w < 8; ++w) sum += Pl[((w * MB + m) * 4 + bj * 2 + n) * 64 + lane];
            v[bj][n] = sum; }
}
template <int MB, int NS, class Epi>
__device__ __forceinline__ void sample_gemm(LAS unsigned char* lds, const bf16_t* A, int lda, const bf16_t* Bt, int ntiles, const Epi& E, int blk, int nblk) {
    const int lane = threadIdx.x & 63, fr = lane & 15, fq = lane >> 4, wave = __builtin_amdgcn_readfirstlane(threadIdx.x >> 6);
    constexpr int NRB = MS / (16 * MB), K = 8 * NS * 32;
    const int ntask = NRB * ntiles * 4;
    for (int t = blk; t < ntask; t += nblk) {
        const int rb = t % NRB, cw = t / NRB, pn = cw >> 2, wc = cw & 3;
        f32x4 acc[MB][2][2];
        wave_gemm_part<MB, NS>(A, lda, MP + rb * 16 * MB, Bt, K, pn, wc, wave * NS * 32, acc);
        sample_reduce_store<MB>(lds, acc, wave, lane);
        __syncthreads();
        if (wave < MB) { f32x4 v[2][2]; sample_reduce_load<MB>(lds, v, wave, lane); E.row(v, MP + rb * 16 * MB + 16 * wave + fr, pn, wc, fq); }
        __syncthreads();
    }
}
template <int CTRL> __device__ __forceinline__ float dpp_f(float x) { return __int_as_float(__builtin_amdgcn_update_dpp(0, __float_as_int(x), CTRL, 0xf, 0xf, false)); }
__device__ __forceinline__ float silu_f(float c) { return c * __builtin_amdgcn_rcpf(1.f + __builtin_amdgcn_exp2f(-c * LOG2E)); }
__device__ __forceinline__ void sample_ffn(const Params& P, LAS unsigned char* lds, int layer, const float* ssq, int blk, int nblk) {
    const int lane = threadIdx.x & 63, fr = lane & 15, fq = lane >> 4, wave = __builtin_amdgcn_readfirstlane(threadIdx.x >> 6);
    const bf16_t* XB = (const bf16_t*)(P.ws + WS_XB); const bf16_t* Wt = (const bf16_t*)(P.ws + WS_WFFN) + (size_t)layer * NFF * DM; bf16_t* AU = (bf16_t*)(P.ws + WS_AU);
    const float* cw = P.in[25] + (size_t)layer * 3 * DFF; const float* cbp = P.in[26] + (size_t)layer * DFF; const float* st = P.in[6] + (size_t)layer * NDEC * 2 * DFF;
    float* convs = P.out + O_CONVS + (size_t)layer * NDEC * 2 * DFF;
    constexpr int MB = 4, NRB = MS / 64, NTASK = NRB * 22 * 4;
    for (int t = blk; t < NTASK; t += nblk) {
        const int rb = t % NRB, cwi = t / NRB, pn = cwi >> 2, wc = cwi & 3;
        f32x4 acc[MB][2][2];
        wave_gemm_part<MB, 4>(XB, DM, MP + rb * 64, Wt, DM, pn, wc, wave * 128, acc);
        sample_reduce_store<MB>(lds, acc, wave, lane);
        __syncthreads();
        if (wave < MB) {
            f32x4 v[2][2]; sample_reduce_load<MB>(lds, v, wave, lane);
            const int col0 = pn * 128 + wc * 32 + 8 * fq, s = fr & 3;
            const int row = MP + rb * 64 + 16 * wave + fr, nseq = (row - MP) >> 2;
            const float rs = rsqrtf(ssq[row] * (1.f / 1024.f) + EPS);
            float h[8];
#pragma unroll
            for (int e = 0; e < 8; ++e) {
                const float a = v[0][e >> 2][e & 3] * rs, up = v[1][e >> 2][e & 3] * rs;
                const float st0 = st[(size_t)(nseq * 2 + 0) * DFF + col0 + e], st1 = st[(size_t)(nseq * 2 + 1) * DFF + col0 + e];
                const float r1 = dpp_f<0x121>(a), r2 = dpp_f<0x122>(a);
                const float p1 = s >= 1 ? r1 : st1, p2 = s >= 2 ? r2 : (s == 1 ? st1 : st0);
                const float c = cbp[col0 + e] + cw[col0 + e] * p2 + cw[DFF + col0 + e] * p1 + cw[2 * DFF + col0 + e] * a;
                h[e] = silu_f(c) * up;
                if (s >= 2) convs[(size_t)(nseq * 2 + (s - 2)) * DFF + col0 + e] = a;
            }
            u32x4 w; w.x = cvtpk(h[0], h[1]); w.y = cvtpk(h[2], h[3]); w.z = cvtpk(h[4], h[5]); w.w = cvtpk(h[6], h[7]);
            *(u32x4*)(AU + (size_t)row * NFF + DFF + col0) = w;
        }
        __syncthreads();
    }
}

__device__ __forceinline__ void p0_transpose_item(const float* W, int K, int N, const float* gain, bf16_t* WT, int kb, int n0, int drow0, LAS float* scr, int lane) {
    const int k0 = 64 * kb;
#pragma unroll 8
    for (int i = 0; i < 32; ++i) { const int kk = 2 * i + (lane >> 5); float w = W[(size_t)(k0 + kk) * N + n0 + (lane & 31)]; if (gain) w *= gain[k0 + kk]; scr[kk * 33 + (lane & 31)] = w; }
    asm volatile("s_waitcnt lgkmcnt(0)" ::: "memory");
    const int c = lane & 7;
#pragma unroll
    for (int j = 0; j < 4; ++j) { const int n = (lane >> 3) + 8 * j; const LAS float* s = scr + (8 * c) * 33 + n;
        u32x4 o; o.x = cvtpk(s[0 * 33], s[1 * 33]); o.y = cvtpk(s[2 * 33], s[3 * 33]); o.z = cvtpk(s[4 * 33], s[5 * 33]); o.w = cvtpk(s[6 * 33], s[7 * 33]);
        *(u32x4*)(WT + (size_t)(drow0 + n) * K + k0 + 8 * c) = o; }
    asm volatile("s_waitcnt lgkmcnt(0)" ::: "memory");
}
__device__ __forceinline__ int map_headperm(int nb) { const int p = (nb * 32) & 255, bj = p >> 7, wc = (p >> 5) & 3; return ((nb * 32) & ~255) + 64 * wc + 32 * bj; }
__device__ __forceinline__ int map_ffn(int nb) { const int tile = nb >> 3, p = (nb & 7) * 32; return p < 128 ? 128 * tile + p : DFF + 128 * tile + (p - 128); }

__device__ __forceinline__ void row_to_bf16(const float* xrow, bf16_t* orow, float* ssq, int lane) {
    const f32x4* xr = (const f32x4*)xrow + lane; f32x4 v[4]; float s = 0.f;
#pragma unroll
    for (int j = 0; j < 4; ++j) { v[j] = xr[64 * j]; s += dot4(v[j]); }
    s = wave_sum(s);
    u32x2* o8 = (u32x2*)orow + lane;
#pragma unroll
    for (int j = 0; j < 4; ++j) { u32x2 w; w.x = cvtpk(v[j][0], v[j][1]); w.y = cvtpk(v[j][2], v[j][3]); o8[64 * j] = w; }
    if (lane == 0) *ssq = s;
}

__device__ __forceinline__ void p0_prologue(const Params& P, LAS unsigned char* lds, int G, int bid) {
    const int tid = threadIdx.x, lane = tid & 63, wave = __builtin_amdgcn_readfirstlane(tid >> 6);
    LAS float* scr = (LAS float*)(lds + wave * 16384);
    const int gw = bid * 8 + wave, NGW = G * 8;
    unsigned char* ws = P.ws;
    float* ssq = (float*)(ws + WS_SSQ);
    constexpr int I0 = 16 * 48, I1 = 16 * 32, I2 = 16 * 56, I3 = 16 * 32, I4 = 16 * 16, I6 = 16 * 176, I8 = 44 * 32;
    constexpr int NITEMS = I0 + I1 + I2 + I3 + 2 * I4 + 2 * I6 + 2 * I8;
    for (int it = gw; it < NITEMS; it += NGW) {
        int r = it;
        if (r < I0) { const int nb = r % 48, kb = r / 48; p0_transpose_item(P.in[11], 1024, NINA, P.in[8], (bf16_t*)(ws + WS_WINA), kb, map_headperm(nb), 32 * nb, scr, lane); continue; } r -= I0;
        if (r < I1) { const int nb = r % 32, kb = r / 32; p0_transpose_item(P.in[15], 1024, 1024, nullptr, (bf16_t*)(ws + WS_WOUTA), kb, 32 * nb, 32 * nb, scr, lane); continue; } r -= I1;
        if (r < I2) { const int nb = r % 56, kb = r / 56; p0_transpose_item(P.in[16], 1024, NINB, P.in[8] + 1024, (bf16_t*)(ws + WS_WINB), kb, nb < 48 ? 32 * nb : map_headperm(nb), 32 * nb, scr, lane); continue; } r -= I2;
        if (r < I3) { const int nb = r % 32, kb = r / 32; p0_transpose_item(P.in[20], 1024, 1024, nullptr, (bf16_t*)(ws + WS_WOUTB), kb, 32 * nb, 32 * nb, scr, lane); continue; } r -= I3;
        if (r < 2 * I4) { const int l = r / I4; r -= l * I4; const int nb = r % 16, kb = r / 16;
            p0_transpose_item(P.in[21] + (size_t)l * 1024 * 512, 1024, 512, P.in[10] + l * 1024, (bf16_t*)(ws + WS_WMKV) + (size_t)l * 512 * 1024, kb, map_headperm(nb), 32 * nb, scr, lane); continue; } r -= 2 * I4;
        if (r < 2 * I6) { const int l = r / I6; r -= l * I6; const int nb = r % 176, kb = r / 176;
            p0_transpose_item(P.in[24] + (size_t)l * 1024 * NFF, 1024, NFF, P.in[9] + l * 1024, (bf16_t*)(ws + WS_WFFN) + (size_t)l * NFF * 1024, kb, map_ffn(nb), 32 * nb, scr, lane); continue; } r -= 2 * I6;
        { const int l = r / I8; r -= l * I8; const int nb = r % 32, kb = r / 32;
            p0_transpose_item(P.in[27] + (size_t)l * DFF * 1024, DFF, 1024, nullptr, (bf16_t*)(ws + WS_WDOWN) + (size_t)l * 1024 * DFF, kb, 32 * nb, 32 * nb, scr, lane); }
    }
    bf16_t* XB = (bf16_t*)(ws + WS_XB); bf16_t* MEMB = (bf16_t*)(ws + WS_MEMB);
    for (int r = gw; r < M + MMEM; r += NGW) {
        if (r < MP) row_to_bf16(P.in[0] + (size_t)r * DM, XB + (size_t)r * DM, ssq + r, lane);
        else if (r < M) row_to_bf16(P.in[1] + (size_t)(r - MP) * DM, XB + (size_t)r * DM, ssq + r, lane);
        else row_to_bf16(P.in[7] + (size_t)(r - M) * DM, MEMB + (size_t)(r - M) * DM, ssq + 5 * M + (r - M), lane);
    }
    const int gt = bid * 512 + tid, NGT = G * 512;
    for (int i = gt; i < 4 * M; i += NGT) ssq[M + i] = 0.f;
    if (gt < 256) { float* GT = (float*)(ws + WS_GT); const int t4 = gt >> 6, d = gt & 63; GT[gt] = t4 == 0 ? P.in[12][d] : t4 == 1 ? P.in[13][d] : t4 == 2 ? 1.f : P.in[22][d]; }
    { bf16_t* WST = (bf16_t*)(ws + WS_WST); const float* wsb = P.in[18];
      for (int i = gt; i < 4 * 128 * 128; i += NGT) { const int ii = (i >> 7) & 127, jj = i & 127; const float w = jj <= ii ? wsb[i] : 0.f; WST[i] = (bf16_t)(cvtpk(w, 0.f) & 0xffffu); } }
    { const f32x4* ck = (const f32x4*)P.in[2]; const f32x4* cv = (const f32x4*)P.in[3]; f32x4* ok = (f32x4*)(P.out + O_WKS); f32x4* ov = (f32x4*)(P.out + O_WVS);
      for (int i = gt; i < NDEC * 124 * 64; i += NGT) { const int n = i / (124 * 64), r = i % (124 * 64); const size_t s = (size_t)n * 128 * 64 + 4 * 64 + r, d = (size_t)n * 128 * 64 + r; ok[d] = ck[s]; ov[d] = cv[s]; } }
}

__device__ __forceinline__ int crow(int r, int hi) { return (r & 3) + 8 * (r >> 2) + 4 * hi; }
__device__ __forceinline__ int kv_off(int row, int chunk) { return row * 128 + ((chunk ^ (row & 7)) << 4); }
__device__ __forceinline__ s16x4 vtr(const LAS unsigned char* p) { return __builtin_bit_cast(s16x4, __builtin_amdgcn_ds_read_tr16_b64_v4i16((LAS s16x4*)p)); }

struct AttnOfs { int k[4]; int v[2]; };
__device__ __forceinline__ AttnOfs attn_ofs() {
    const int lane = threadIdx.x & 63, r32 = lane & 31, hi = lane >> 5; AttnOfs a;
#pragma unroll
    for (int ks = 0; ks < 4; ++ks) a.k[ks] = r32 * 128 + (((2 * ks + hi) ^ (r32 & 7)) << 4);
    const int vkey = 4 * hi + ((lane & 15) >> 2), vcol = 16 * ((lane >> 4) & 1) + 4 * (lane & 3);
#pragma unroll
    for (int d0 = 0; d0 < 2; ++d0) a.v[d0] = vkey * 128 + (((4 * d0 + (vcol >> 3)) ^ vkey) << 4) + (vcol & 7) * 2;
    return a;
}
template <int CT, bool MASK, bool FIRST>
__device__ __forceinline__ void attn_chunk(const bf16x8 (&qf)[4], const AttnOfs& ao, const LAS unsigned char* Kb, const LAS unsigned char* Vb, int qpos, int kpos0, float slope2, LAS float* wsf, float& m, float& l, f32x16 (&o)[2]) {
    const int lane = threadIdx.x & 63, r32 = lane & 31, hi = lane >> 5;
    f32x16 s[CT];
#pragma unroll
    for (int t = 0; t < CT; ++t) {
#pragma unroll
        for (int r = 0; r < 16; ++r) s[t][r] = 0.f;
#pragma unroll
        for (int ks = 0; ks < 4; ++ks) { const bf16x8 kf = *(const LAS bf16x8*)(Kb + ao.k[ks] + t * 4096); s[t] = __builtin_amdgcn_mfma_f32_32x32x16_bf16(kf, qf[ks], s[t], 0, 0, 0); }
    }
    const float C2 = 0.125f * LOG2E;
    float mx = -1e30f;
    if (MASK) {
        int dbase = qpos - kpos0 - 4 * hi; asm volatile("" : "+v"(dbase));
        const float fdb = (float)dbase, lim = (float)(qpos < 127 ? qpos : 127), ns = -slope2;
#pragma unroll
        for (int t = 0; t < CT; ++t)
#pragma unroll
            for (int r = 0; r < 16; ++r) {
                const float fd = fdb - (float)(32 * t + (r & 3) + 8 * (r >> 2));
                float v = __builtin_fmaf(ns, fd, s[t][r] * C2);
                v = (fd >= 0.f && fd <= lim) ? v : -1e30f;
                s[t][r] = v; mx = fmaxf(mx, v);
            }
    } else {
#pragma unroll
        for (int t = 0; t < CT; ++t)
#pragma unroll
            for (int r = 0; r < 16; ++r) { const float v = s[t][r] * C2; s[t][r] = v; mx = fmaxf(mx, v); }
    }
    mx = fmaxf(mx, __shfl_xor(mx, 32));
    const float mn = fmaxf(m, mx), alpha = __builtin_amdgcn_exp2f(m - mn);
    m = mn;
    float sum = 0.f;
#pragma unroll
    for (int t = 0; t < CT; ++t)
#pragma unroll
        for (int r = 0; r < 16; ++r) { const float e = __builtin_amdgcn_exp2f(s[t][r] - mn); s[t][r] = e; sum += e; }
    l = l * alpha + sum;
    if (!FIRST) {
        if (hi == 0) wsf[r32] = alpha;
        asm volatile("s_waitcnt lgkmcnt(0)" ::: "memory");
#pragma unroll
        for (int r = 0; r < 16; ++r) { const float a = wsf[crow(r, hi)]; o[0][r] *= a; o[1][r] *= a; }
        asm volatile("s_waitcnt lgkmcnt(0)" ::: "memory");
    }
#pragma unroll
    for (int t = 0; t < CT; ++t)
#pragma unroll
        for (int k2 = 0; k2 < 2; ++k2) {
            u32x4 pw; pw.x = cvtpk(s[t][8 * k2 + 0], s[t][8 * k2 + 1]); pw.y = cvtpk(s[t][8 * k2 + 2], s[t][8 * k2 + 3]); pw.z = cvtpk(s[t][8 * k2 + 4], s[t][8 * k2 + 5]); pw.w = cvtpk(s[t][8 * k2 + 6], s[t][8 * k2 + 7]);
            const bf16x8 pa = __builtin_bit_cast(bf16x8, pw);
#pragma unroll
            for (int d0 = 0; d0 < 2; ++d0) {
                const LAS unsigned char* vp = Vb + ao.v[d0] + (32 * t + 16 * k2) * 128;
                const s16x4 lo = vtr(vp), hh = vtr(vp + 1024);
                const bf16x8 vf = (bf16x8){lo[0], lo[1], lo[2], lo[3], hh[0], hh[1], hh[2], hh[3]};
                o[d0] = __builtin_amdgcn_mfma_f32_32x32x16_bf16(pa, vf, o[d0], 0, 0, 0);
            }
        }
}
__device__ __forceinline__ void attn_init(bool mask, float sink2, float& m, float& l, f32x16 (&o)[2]) {
    const int hi = (threadIdx.x & 63) >> 5;
    m = mask ? sink2 : -1e30f; l = (mask && hi == 0) ? 1.f : 0.f;
#pragma unroll
    for (int r = 0; r < 16; ++r) { o[0][r] = 0.f; o[1][r] = 0.f; }
}
__device__ __forceinline__ void attn_finish(float l, LAS float* wsf, f32x16 (&o)[2], LAS unsigned short* stg) {
    const int lane = threadIdx.x & 63, r32 = lane & 31, hi = lane >> 5;
    l += __shfl_xor(l, 32);
    if (hi == 0) wsf[r32] = 1.0f / l;
    asm volatile("s_waitcnt lgkmcnt(0)" ::: "memory");
#pragma unroll
    for (int r = 0; r < 16; ++r) { const float li = wsf[crow(r, hi)]; const int q = crow(r, hi);
        stg[q * 64 + r32] = (unsigned short)(cvtpk(o[0][r] * li, 0.f) & 0xffffu); stg[q * 64 + 32 + r32] = (unsigned short)(cvtpk(o[1][r] * li, 0.f) & 0xffffu); }
    asm volatile("s_waitcnt lgkmcnt(0)" ::: "memory");
}
__device__ __forceinline__ void attn_swa(const bf16x8 (&qf)[4], const AttnOfs& ao, const LAS unsigned char* Kb, const LAS unsigned char* Vb, int qpos, int kpos0, float slope2, float sink2, LAS float* wsf, LAS unsigned short* stg) {
    float m, l; f32x16 o[2]; attn_init(true, sink2, m, l, o);
    attn_chunk<3, true, true>(qf, ao, Kb, Vb, qpos, kpos0, slope2, wsf, m, l, o);
    attn_chunk<2, true, false>(qf, ao, Kb + 96 * 128, Vb + 96 * 128, qpos, kpos0 + 96, slope2, wsf, m, l, o);
    attn_finish(l, wsf, o, stg);
}
__device__ __forceinline__ void attn_mem(const bf16x8 (&qf)[4], const AttnOfs& ao, const LAS unsigned char* Kb, const LAS unsigned char* Vb, LAS float* wsf, LAS unsigned short* stg) {
    float m, l; f32x16 o[2]; attn_init(false, 0.f, m, l, o);
    attn_chunk<2, false, true>(qf, ao, Kb, Vb, 0, 0, 0.f, wsf, m, l, o);
#pragma unroll 1
    for (int c = 1; c < 4; ++c) attn_chunk<2, false, false>(qf, ao, Kb + c * 64 * 128, Vb + c * 64 * 128, 0, 0, 0.f, wsf, m, l, o);
    attn_finish(l, wsf, o, stg);
}
__device__ __forceinline__ void stage_out(const LAS unsigned short* stg, bf16_t* gdst, size_t ld) {
    const int lane = threadIdx.x & 63;
#pragma unroll
    for (int i = 0; i < 4; ++i) { const int row = i * 8 + (lane >> 3), ch = lane & 7; *(u32x4*)(gdst + (size_t)row * ld + ch * 8) = *(const LAS u32x4*)(stg + row * 64 + ch * 8); }
    asm volatile("s_waitcnt lgkmcnt(0)" ::: "memory");
}

__device__ __forceinline__ void unit_swa_prompt(const Params& P, LAS unsigned char* lds, LAS float* wsf, int b, int qb, int g) {
    const int tid = threadIdx.x, lane = tid & 63, wave = __builtin_amdgcn_readfirstlane(tid >> 6), r32 = lane & 31, hi = lane >> 5;
    const bf16_t* Qg = (const bf16_t*)(P.ws + WS_Q); const bf16_t* Kg = (const bf16_t*)(P.ws + WS_K); const bf16_t* Vg = (const bf16_t*)(P.ws + WS_V); bf16_t* Og = (bf16_t*)(P.ws + WS_O);
    LAS unsigned char* Kl = lds; LAS unsigned char* Vl = lds + 49152; LAS unsigned short* stg = (LAS unsigned short*)(lds + 98304 + wave * 4096);
#pragma unroll 2
    for (int idx = tid; idx < 384 * 8; idx += 512) {
        const int row = idx >> 3, ch = idx & 7, t = 256 * qb - 128 + row;
        u32x4 kv = (u32x4){0u, 0u, 0u, 0u}, vv = kv;
        if (t >= 0) { const size_t o = (size_t)(b * SEQ + t) * 256 + g * 64 + ch * 8; kv = *(const u32x4*)(Kg + o); vv = *(const u32x4*)(Vg + o); }
        *(LAS u32x4*)(Kl + kv_off(row, ch)) = kv; *(LAS u32x4*)(Vl + kv_off(row, ch)) = vv;
    }
    __syncthreads();
    const AttnOfs ao = attn_ofs();
    const int t0 = 256 * qb + 32 * wave;
#pragma unroll 1
    for (int hh = 0; hh < 3; ++hh) {
        const int head = 3 * g + hh;
        bf16x8 qf[4];
#pragma unroll
        for (int ks = 0; ks < 4; ++ks) qf[ks] = *(const bf16x8*)(Qg + (size_t)(b * SEQ + t0 + r32) * 768 + head * 64 + 16 * ks + 8 * hi);
        attn_swa(qf, ao, Kl + 32 * wave * 128, Vl + 32 * wave * 128, t0 + r32, t0 - 128, alibi_slope(head) * LOG2E, P.in[14][head] * LOG2E, wsf, stg);
        stage_out(stg, Og + (size_t)(b * SEQ + t0) * DM + head * 64, DM);
    }
    __syncthreads();
}

__device__ __forceinline__ void unit_mem_prompt(const Params& P, LAS unsigned char* lds, LAS float* wsf, int layer, int b, int qb, int h) {
    const int tid = threadIdx.x, lane = tid & 63, wave = __builtin_amdgcn_readfirstlane(tid >> 6), r32 = lane & 31, hi = lane >> 5;
    const bf16_t* XQ = (const bf16_t*)(P.ws + WS_XQ); bf16_t* Og = (bf16_t*)(P.ws + WS_O);
    const bf16_t* MK = (const bf16_t*)(P.ws + WS_MK) + (size_t)layer * MMEM * 256; const bf16_t* MV = (const bf16_t*)(P.ws + WS_MV) + (size_t)layer * MMEM * 256;
    LAS unsigned char* Kl = lds; LAS unsigned char* Vl = lds + 32768; LAS unsigned short* stg = (LAS unsigned short*)(lds + 98304 + wave * 4096);
#pragma unroll 2
    for (int idx = tid; idx < 256 * 8; idx += 512) {
        const int row = idx >> 3, ch = idx & 7; const size_t o = (size_t)(b * NMEM + row) * 256 + h * 64 + ch * 8;
        *(LAS u32x4*)(Kl + kv_off(row, ch)) = *(const u32x4*)(MK + o); *(LAS u32x4*)(Vl + kv_off(row, ch)) = *(const u32x4*)(MV + o);
    }
    __syncthreads();
    const AttnOfs ao = attn_ofs();
    const int t0 = 256 * qb + 32 * wave;
    bf16x8 qf[4];
#pragma unroll
    for (int ks = 0; ks < 4; ++ks) qf[ks] = *(const bf16x8*)(XQ + (size_t)(b * SEQ + t0 + r32) * 256 + h * 64 + 16 * ks + 8 * hi);
    attn_mem(qf, ao, Kl, Vl, wsf, stg);
    stage_out(stg, Og + (size_t)(b * SEQ + t0) * DM + 768 + h * 64, DM);
    __syncthreads();
}

__device__ __forceinline__ u32x4 ld8f_pack(const float* p) { const f32x4 a = *(const f32x4*)p, b = *(const f32x4*)(p + 4); return pack8(a, b); }

__device__ __forceinline__ void unit_swa_sample(const Params& P, LAS unsigned char* lds, LAS float* wsf, int n, int gp) {
    const int tid = threadIdx.x, lane = tid & 63, wave = __builtin_amdgcn_readfirstlane(tid >> 6), r32 = lane & 31, hi = lane >> 5;
    const bf16_t* Qg = (const bf16_t*)(P.ws + WS_Q); const bf16_t* Kg = (const bf16_t*)(P.ws + WS_K); const bf16_t* Vg = (const bf16_t*)(P.ws + WS_V); bf16_t* Og = (bf16_t*)(P.ws + WS_O);
#pragma unroll 1
    for (int idx = tid; idx < 2 * 160 * 8; idx += 512) {
        const int gi = idx / 1280, rem = idx % 1280, row = rem >> 3, ch = rem & 7, g = 2 * gp + gi;
        LAS unsigned char* Kl = lds + gi * 40960; LAS unsigned char* Vl = Kl + 20480;
        u32x4 kv = (u32x4){0u, 0u, 0u, 0u}, vv = kv;
        if (row < 128) { const size_t o = ((size_t)(n * 128 + row) * 4 + g) * 64 + ch * 8; kv = ld8f_pack(P.in[2] + o); vv = ld8f_pack(P.in[3] + o); }
        else if (row < 132) { const size_t o = (size_t)(MP + 4 * n + row - 128) * 256 + g * 64 + ch * 8; kv = *(const u32x4*)(Kg + o); vv = *(const u32x4*)(Vg + o); }
        *(LAS u32x4*)(Kl + kv_off(row, ch)) = kv; *(LAS u32x4*)(Vl + kv_off(row, ch)) = vv;
    }
    __syncthreads();
    if (wave < 2) {
        LAS unsigned short* stg = (LAS unsigned short*)(lds + 98304 + wave * 4096);
        const AttnOfs ao = attn_ofs();
        const int g = 2 * gp + wave; const bool qv = r32 < 12; const int hh = qv ? (r32 >> 2) : 0, sidx = r32 & 3, head = 3 * g + hh;
        bf16x8 qf[4];
#pragma unroll
        for (int ks = 0; ks < 4; ++ks) { qf[ks] = *(const bf16x8*)(Qg + (size_t)(MP + 4 * n + sidx) * 768 + head * 64 + 16 * ks + 8 * hi); if (!qv) qf[ks] = (bf16x8){0, 0, 0, 0, 0, 0, 0, 0}; }
        const LAS unsigned char* Kl = lds + wave * 40960;
        attn_swa(qf, ao, Kl, Kl + 20480, 128 + sidx, 0, alibi_slope(head) * LOG2E, P.in[14][head] * LOG2E, wsf, stg);
        for (int i = lane; i < 96; i += 64) { const int q = i >> 3, ch = i & 7;
            *(u32x4*)(Og + (size_t)(MP + 4 * n + (q & 3)) * DM + (3 * g + (q >> 2)) * 64 + ch * 8) = *(const LAS u32x4*)(stg + q * 64 + ch * 8); }
        asm volatile("s_waitcnt lgkmcnt(0)" ::: "memory");
    }
    __syncthreads();
}

__device__ __forceinline__ void unit_mem_sample(const Params& P, LAS unsigned char* lds, LAS float* wsf, int layer, int n, int hp) {
    const int tid = threadIdx.x, lane = tid & 63, wave = __builtin_amdgcn_readfirstlane(tid >> 6), r32 = lane & 31, hi = lane >> 5;
    const bf16_t* XQ = (const bf16_t*)(P.ws + WS_XQ); bf16_t* Og = (bf16_t*)(P.ws + WS_O);
    const float* ck = P.in[4] + (size_t)(layer * NDEC + n) * NMEM * 256; const float* cv = P.in[5] + (size_t)(layer * NDEC + n) * NMEM * 256;
#pragma unroll 2
    for (int idx = tid; idx < 256 * 16; idx += 512) {
        const int row = idx >> 4, hsel = (idx >> 3) & 1, ch = idx & 7; const size_t o = (size_t)row * 256 + (2 * hp + hsel) * 64 + ch * 8;
        LAS unsigned char* Kl = lds + hsel * 65536;
        *(LAS u32x4*)(Kl + kv_off(row, ch)) = ld8f_pack(ck + o); *(LAS u32x4*)(Kl + 32768 + kv_off(row, ch)) = ld8f_pack(cv + o);
    }
    __syncthreads();
    if (wave < 2) {
        LAS unsigned short* stg = (LAS unsigned short*)(lds + OSTG2_OFF + wave * 4096);
        const AttnOfs ao = attn_ofs();
        const int h = 2 * hp + wave; const bool qv = r32 < 4;
        bf16x8 qf[4];
#pragma unroll
        for (int ks = 0; ks < 4; ++ks) { qf[ks] = *(const bf16x8*)(XQ + (size_t)(MP + 4 * n + (r32 & 3)) * 256 + h * 64 + 16 * ks + 8 * hi); if (!qv) qf[ks] = (bf16x8){0, 0, 0, 0, 0, 0, 0, 0}; }
        const LAS unsigned char* Kl = lds + wave * 65536;
        attn_mem(qf, ao, Kl, Kl + 32768, wsf, stg);
        if (lane < 32) { const int q = lane >> 3, ch = lane & 7;
            *(u32x4*)(Og + (size_t)(MP + 4 * n + q) * DM + 768 + h * 64 + ch * 8) = *(const LAS u32x4*)(stg + q * 64 + ch * 8); }
        asm volatile("s_waitcnt lgkmcnt(0)" ::: "memory");
    }
    __syncthreads();
}

__device__ __forceinline__ void unit_gmlp_prompt(const Params& P, LAS unsigned char* lds, int b, int c) {
    const int tid = threadIdx.x, lane = tid & 63, wave = __builtin_amdgcn_readfirstlane(tid >> 6), r32 = lane & 31, hi = lane >> 5;
    const bf16_t* U = (const bf16_t*)(P.ws + WS_U); const bf16_t* GV = (const bf16_t*)(P.ws + WS_GV); bf16_t* Og = (bf16_t*)(P.ws + WS_O);
    const bf16_t* WST = (const bf16_t*)(P.ws + WS_WST); const float* ssqv = (const float*)(P.ws + WS_SSQ) + 4 * M;
    const float* vg = P.in[17]; const float* bs = P.in[19]; float* cvp = P.out + O_CVP;
    const int rowb = b * SEQ + c * 128;
    const int ib = wave & 3, cb0 = 3 * (wave >> 2);
#pragma unroll 1
    for (int g = 0; g < 4; ++g) {
        for (int idx = tid; idx < 128 * 24; idx += 512) {
            const int j = idx / 24, ch = idx % 24; const int row = rowb + j, col = g * 192 + ch * 8;
            const float rv = rsqrtf(ssqv[row] * (1.f / 768.f) + EPS);
            const u32x4 w = *(const u32x4*)(GV + (size_t)row * 768 + col);
            const f32x4 g0 = *(const f32x4*)(vg + col), g1 = *(const f32x4*)(vg + col + 4);
            f32x4 v0 = (f32x4){bflo(w.x), bfhi(w.x), bflo(w.y), bfhi(w.y)}, v1 = (f32x4){bflo(w.z), bfhi(w.z), bflo(w.w), bfhi(w.w)};
            v0 = v0 * rv * g0; v1 = v1 * rv * g1;
            *(LAS u32x4*)(lds + j * 384 + ch * 16) = pack8(v0, v1);
            if (c == 31) { float* o = cvp + (size_t)(b * 128 + j) * 768 + col; *(f32x4*)o = v0; *(f32x4*)(o + 4) = v1; }
        }
        __syncthreads();
        f32x16 acc[3];
#pragma unroll
        for (int i = 0; i < 3; ++i)
#pragma unroll
            for (int r = 0; r < 16; ++r) acc[i][r] = 0.f;
        const int nks = 2 * (ib + 1);
#pragma unroll 1
        for (int ks = 0; ks < nks; ++ks) {
            const bf16x8 af = *(const bf16x8*)(WST + (size_t)(g * 128 + 32 * ib + r32) * 128 + 16 * ks + 8 * hi);
            const int j0 = 16 * ks + 8 * hi + ((lane & 15) >> 2);
#pragma unroll
            for (int i = 0; i < 3; ++i) {
                const int col = 32 * (cb0 + i) + 16 * ((lane >> 4) & 1) + 4 * (lane & 3);
                const s16x4 lo = vtr(lds + j0 * 384 + col * 2), hh = vtr(lds + (j0 + 4) * 384 + col * 2);
                const bf16x8 vf = (bf16x8){lo[0], lo[1], lo[2], lo[3], hh[0], hh[1], hh[2], hh[3]};
                acc[i] = __builtin_amdgcn_mfma_f32_32x32x16_bf16(af, vf, acc[i], 0, 0, 0);
            }
        }
        LAS float* stg = (LAS float*)(lds + 49152 + wave * 4096);
#pragma unroll 1
        for (int i = 0; i < 3; ++i) {
            const f32x16 a = i == 0 ? acc[0] : i == 1 ? acc[1] : acc[2];
#pragma unroll
            for (int r = 0; r < 16; ++r) { const int q = crow(r, hi); stg[q * 32 + r32] = a[r] + bs[g * 128 + 32 * ib + q]; }
            asm volatile("s_waitcnt lgkmcnt(0)" ::: "memory");
            const int q = lane >> 1, hf = lane & 1; const size_t ro = (size_t)(rowb + 32 * ib + q); const int col = g * 192 + 32 * (cb0 + i) + 16 * hf;
            const u32x4 u0 = *(const u32x4*)(U + ro * 768 + col), u1 = *(const u32x4*)(U + ro * 768 + col + 8);
            const LAS f32x4* sp = (const LAS f32x4*)(stg + q * 32 + 16 * hf);
            const f32x4 m0 = sp[0], m1 = sp[1], m2 = sp[2], m3 = sp[3];
            u32x4 o0, o1;
            o0.x = cvtpk(bflo(u0.x) * m0[0], bfhi(u0.x) * m0[1]); o0.y = cvtpk(bflo(u0.y) * m0[2], bfhi(u0.y) * m0[3]); o0.z = cvtpk(bflo(u0.z) * m1[0], bfhi(u0.z) * m1[1]); o0.w = cvtpk(bflo(u0.w) * m1[2], bfhi(u0.w) * m1[3]);
            o1.x = cvtpk(bflo(u1.x) * m2[0], bfhi(u1.x) * m2[1]); o1.y = cvtpk(bflo(u1.y) * m2[2], bfhi(u1.y) * m2[3]); o1.z = cvtpk(bflo(u1.z) * m3[0], bfhi(u1.z) * m3[1]); o1.w = cvtpk(bflo(u1.w) * m3[2], bfhi(u1.w) * m3[3]);
            *(u32x4*)(Og + ro * DM + col) = o0; *(u32x4*)(Og + ro * DM + col + 8) = o1;
            asm volatile("s_waitcnt lgkmcnt(0)" ::: "memory");
        }
        __syncthreads();
    }
}

__device__ __forceinline__ void gmlp_sample(const Params& P, int G, int bid) {
    const bf16_t* U = (const bf16_t*)(P.ws + WS_U); const bf16_t* GV = (const bf16_t*)(P.ws + WS_GV); bf16_t* Og = (bf16_t*)(P.ws + WS_O);
    const float* ssqv = (const float*)(P.ws + WS_SSQ) + 4 * M; const float* vg = P.in[17]; const float* wsb = P.in[18]; const float* bs = P.in[19]; float* cvs = P.out + O_CVS;
    for (int i = bid * 512 + threadIdx.x; i < NDEC * 768; i += G * 512) {
        const int n = i / 768, col = i % 768, g = col / 192; float vn[4];
#pragma unroll
        for (int s = 0; s < 4; ++s) { const int row = MP + 4 * n + s; vn[s] = bf2f(GV[(size_t)row * 768 + col]) * rsqrtf(ssqv[row] * (1.f / 768.f) + EPS) * vg[col]; cvs[(size_t)(4 * n + s) * 768 + col] = vn[s]; }
#pragma unroll
        for (int s = 0; s < 4; ++s) { float mx = bs[g * 128 + s];
#pragma unroll
            for (int j = 0; j < 4; ++j) if (j <= s) mx += wsb[(size_t)(g * 128 + s) * 128 + j] * vn[j];
            const int row = MP + 4 * n + s; Og[(size_t)row * DM + col] = f2bf_s(bf2f(U[(size_t)row * 768 + col]) * mx); }
    }
}

__device__ __forceinline__ void unpack8(const u32x4 w, float (&f)[8]) { f[0] = bflo(w.x); f[1] = bfhi(w.x); f[2] = bflo(w.y); f[3] = bfhi(w.y); f[4] = bflo(w.z); f[5] = bfhi(w.z); f[6] = bflo(w.w); f[7] = bfhi(w.w); }
__device__ __forceinline__ void conv_pass(const Params& P, int layer, int G, int bid) {
    bf16_t* AU = (bf16_t*)(P.ws + WS_AU);
    const float* cw = P.in[25] + (size_t)layer * 3 * DFF; const float* cbp = P.in[26] + (size_t)layer * DFF; const float* st = P.in[6] + (size_t)layer * NDEC * 2 * DFF;
    float* convp = P.out + O_CONVP + (size_t)layer * NBATCH * 2 * DFF; float* convs = P.out + O_CONVS + (size_t)layer * NDEC * 2 * DFF;
    constexpr int NCV = DFF / 8, RUN = 16, NRUNP = MP / RUN, NITP = NRUNP * NCV, NITS = NDEC * NCV;
    for (int it = bid * 512 + threadIdx.x; it < NITP; it += G * 512) {
        const bool smp = it >= NITP; const int jt = smp ? it - NITP : it; const int rr = jt / NCV, cv = jt % NCV, col = cv * 8;
        float w0[8], w1[8], w2[8], cb[8];
#pragma unroll
        for (int e = 0; e < 8; ++e) { w0[e] = cw[col + e]; w1[e] = cw[DFF + col + e]; w2[e] = cw[2 * DFF + col + e]; cb[e] = cbp[col + e]; }
        float am2[8], am1[8];
        int r0, nr;
        if (!smp) { r0 = rr * RUN; nr = RUN;
            if ((r0 & (SEQ - 1)) == 0) {
#pragma unroll
                for (int e = 0; e < 8; ++e) { am2[e] = 0.f; am1[e] = 0.f; } }
            else { unpack8(*(const u32x4*)(AU + (size_t)(r0 - 2) * NFF + col), am2); unpack8(*(const u32x4*)(AU + (size_t)(r0 - 1) * NFF + col), am1); }
        } else { r0 = MP + 4 * rr; nr = 4;
#pragma unroll
            for (int e = 0; e < 8; ++e) { am2[e] = st[(size_t)(rr * 2 + 0) * DFF + col + e]; am1[e] = st[(size_t)(rr * 2 + 1) * DFF + col + e]; } }
        for (int i = 0; i < nr; ++i) {
            const size_t ro = (size_t)(r0 + i) * NFF + col;
            float a[8], up[8]; unpack8(*(const u32x4*)(AU + ro), a); unpack8(*(const u32x4*)(AU + ro + DFF), up);
            float h[8];
#pragma unroll
            for (int e = 0; e < 8; ++e) { const float c = cb[e] + w0[e] * am2[e] + w1[e] * am1[e] + w2[e] * a[e]; const float sg = c * __builtin_amdgcn_rcpf(1.f + __builtin_amdgcn_exp2f(-c * LOG2E)); h[e] = sg * up[e]; am2[e] = am1[e]; am1[e] = a[e]; }
            u32x4 w; w.x = cvtpk(h[0], h[1]); w.y = cvtpk(h[2], h[3]); w.z = cvtpk(h[4], h[5]); w.w = cvtpk(h[6], h[7]);
            *(u32x4*)(AU + ro + DFF) = w;
        }
        if (!smp) { if (((r0 + RUN) & (SEQ - 1)) == 0) { const int b = r0 >> 12;
#pragma unroll
                for (int e = 0; e < 8; ++e) { convp[(size_t)(b * 2 + 0) * DFF + col + e] = am2[e]; convp[(size_t)(b * 2 + 1) * DFF + col + e] = am1[e]; } } }
        else {
#pragma unroll
            for (int e = 0; e < 8; ++e) { convs[(size_t)(rr * 2 + 0) * DFF + col + e] = am2[e]; convs[(size_t)(rr * 2 + 1) * DFF + col + e] = am1[e]; } }
    }
}


__global__ void __launch_bounds__(512, 2) mk_fwd(Params P) {
    extern __shared__ __attribute__((aligned(16))) unsigned char lds_raw[];
    LAS unsigned char* lds = (LAS unsigned char*)lds_raw;
    const int tid = threadIdx.x, wave = __builtin_amdgcn_readfirstlane(tid >> 6);
    const int G = gridDim.x, bid = blockIdx.x;
    LAS float* wsf = (LAS float*)(lds + WSF_OFF) + wave * 64;
    unsigned char* ws = P.ws;
    float* ssq = (float*)(ws + WS_SSQ);
    bf16_t* XB = (bf16_t*)(ws + WS_XB);
    cg::grid_group grid = cg::this_grid();
    const int lo = P.ph_lo, hi = P.ph_hi;
#ifndef PH_MASK
#define PH_MASK 0x1fff
#endif
#define IN(k) (((PH_MASK >> (k)) & 1) && lo <= (k) && (k) < hi)
#define SEAM(k) do { if (IN(k) && IN((k) + 1)) grid.sync(); } while (0)

    if (IN(0)) { for (int rep = 0; rep < (DUP == 0 ? 2 : 1); ++rep) p0_prologue(P, lds, G, bid); }
    SEAM(0);
    const int gwave = bid * 8 + wave, NW = G * 8;
    const bf16_t* XBs = XB;
    if (IN(1)) {
        EpiInA E{ssq, (bf16_t*)(ws + WS_Q), (const float*)(ws + WS_GT), P.out};
        { pg8::Gemm g{XB, (const bf16_t*)(ws + WS_WINA), DM, DM}; pg8::StaticOrder S; S.init(MP, NINA, G, bid);
          pg8::gemm_phase<EpiInA, true, true>(lds, g, S, E); }
        { pg8::Gemm g{(const bf16_t*)(ws + WS_MEMB), (const bf16_t*)(ws + WS_WMKV), DM, DM}; pg8::StaticOrder S; S.init(MMEM, 1024, G, bid);
          EpiMemKV E2{ssq + 5 * M, P.in[23], P.out + O_MKP, P.out + O_MVP, (bf16_t*)(ws + WS_MK), (bf16_t*)(ws + WS_MV)};
          pg8::gemm_phase<EpiMemKV, true, true>(lds, g, S, E2); }
        if (bid >= 32) sample_gemm<4, 4>(lds, XBs, DM, (const bf16_t*)(ws + WS_WINA), 6, E, bid - 32, G - 32);
    }
    SEAM(1);
    if (IN(2)) {
        for (int rep = 0; rep < (DUP == 2 ? 2 : 1); ++rep)
        for (int uidx = bid; uidx < 1536; uidx += G) {
            if (uidx < 512) unit_swa_prompt(P, lds, wsf, uidx >> 6, (uidx >> 2) & 15, uidx & 3);
            else if (uidx < 1024) { const int v = uidx - 512; unit_mem_prompt(P, lds, wsf, 0, v >> 6, (v >> 2) & 15, v & 3); }
            else if (uidx < 1280) { const int v = uidx - 1024; unit_mem_sample(P, lds, wsf, 0, v >> 1, v & 1); }
            else { const int v = uidx - 1280; unit_swa_sample(P, lds, wsf, v >> 1, v & 1); }
        }
    }
    SEAM(2);
    if (IN(3)) {
        pg8::Gemm g{(const bf16_t*)(ws + WS_O), (const bf16_t*)(ws + WS_WOUTA), DM, DM}; pg8::StaticOrder S; S.init(MP, DM, G, bid);
        EpiRes E{P.in[0], P.in[1], P.out + O_Y, XB, ssq + M};
        pg8::gemm_phase<EpiRes, true, true>(lds, g, S, E);
        sample_gemm<2, 4>(lds, (const bf16_t*)(ws + WS_O), DM, (const bf16_t*)(ws + WS_WOUTA), 4, E, bid, G);
    }
    SEAM(3);
    if (IN(4)) {
        pg8::Gemm g{XB, (const bf16_t*)(ws + WS_WFFN), DM, DM}; pg8::StaticOrder S; S.init(MP, NFF, G, bid);
        EpiFfn E{ssq + M, (bf16_t*)(ws + WS_AU)};
        pg8::gemm_phase<EpiFfn, true, true>(lds, g, S, E);
        sample_ffn(P, lds, 0, ssq + M, bid, G);
    }
    SEAM(4);
    if (IN(5)) conv_pass(P, 0, G, bid);
    SEAM(5);
    if (IN(6)) {
        pg8::Gemm g{(const bf16_t*)(ws + WS_AU) + DFF, (const bf16_t*)(ws + WS_WDOWN), NFF, DFF}; pg8::StaticOrder S; S.init(MP, DM, G, bid);
        EpiRes E{P.out + O_Y, P.out + O_Y + (size_t)MP * DM, P.out + O_Y, XB, ssq + 2 * M};
        pg8::gemm_phase<EpiRes, true, true>(lds, g, S, E);
        sample_gemm<2, 11>(lds, (const bf16_t*)(ws + WS_AU) + DFF, NFF, (const bf16_t*)(ws + WS_WDOWN), 4, E, bid, G);
    }
    SEAM(6);
    if (IN(7)) {
        pg8::Gemm g{XB, (const bf16_t*)(ws + WS_WINB), DM, DM}; pg8::StaticOrder S; S.init(MP, NINB, G, bid);
        EpiInB E{ssq + 2 * M, (bf16_t*)(ws + WS_U), (bf16_t*)(ws + WS_GV), (bf16_t*)(ws + WS_XQ), P.in[22] + 64, ssq + 4 * M};
        pg8::gemm_phase<EpiInB, true, true>(lds, g, S, E);
        if (bid >= G / 2) sample_gemm<4, 4>(lds, XBs, DM, (const bf16_t*)(ws + WS_WINB), 7, E, bid - G / 2, G - G / 2);
    }
    SEAM(7);
    if (IN(8)) {
        for (int rep = 0; rep < (DUP == 8 ? 2 : 1); ++rep)
        for (int uidx = bid; uidx < 1024; uidx += G) {
            if (uidx < 256) unit_gmlp_prompt(P, lds, uidx >> 5, uidx & 31);
            else if (uidx < 768) { const int v = uidx - 256; unit_mem_prompt(P, lds, wsf, 1, v >> 6, (v >> 2) & 15, v & 3); }
            else { const int v = uidx - 768; unit_mem_sample(P, lds, wsf, 1, v >> 1, v & 1); }
        }
        gmlp_sample(P, G, bid);
    }
    SEAM(8);
    if (IN(9)) {
        pg8::Gemm g{(const bf16_t*)(ws + WS_O), (const bf16_t*)(ws + WS_WOUTB), DM, DM}; pg8::StaticOrder S; S.init(MP, DM, G, bid);
        EpiRes E{P.out + O_Y, P.out + O_Y + (size_t)MP * DM, P.out + O_Y, XB, ssq + 3 * M};
        pg8::gemm_phase<EpiRes, true, true>(lds, g, S, E);
        sample_gemm<2, 4>(lds, (const bf16_t*)(ws + WS_O), DM, (const bf16_t*)(ws + WS_WOUTB), 4, E, bid, G);
    }
    SEAM(9);
    if (IN(10)) {
        pg8::Gemm g{XB, (const bf16_t*)(ws + WS_WFFN) + (size_t)NFF * DM, DM, DM}; pg8::StaticOrder S; S.init(MP, NFF, G, bid);
        EpiFfn E{ssq + 3 * M, (bf16_t*)(ws + WS_AU)};
        pg8::gemm_phase<EpiFfn, true, true>(lds, g, S, E);
        sample_ffn(P, lds, 1, ssq + 3 * M, bid, G);
    }
    SEAM(10);
    if (IN(11)) conv_pass(P, 1, G, bid);
    SEAM(11);
    if (IN(12)) {
        pg8::Gemm g{(const bf16_t*)(ws + WS_AU) + DFF, (const bf16_t*)(ws + WS_WDOWN) + (size_t)DM * DFF, NFF, DFF}; pg8::StaticOrder S; S.init(MP, DM, G, bid);
        EpiRes E{P.out + O_Y, P.out + O_Y + (size_t)MP * DM, P.out + O_Y, nullptr, nullptr};
        pg8::gemm_phase<EpiRes, true, true>(lds, g, S, E);
        sample_gemm<2, 11>(lds, (const bf16_t*)(ws + WS_AU) + DFF, NFF, (const bf16_t*)(ws + WS_WDOWN) + (size_t)DM * DFF, 4, E, bid, G);
    }
#undef IN
#undef SEAM
}

extern "C" void kernel_launch(void* const* d_in, const int* in_sizes, int n_in, void* d_out, int out_size, void* d_ws, size_t ws_size, hipStream_t stream) {
    static int grid = 0;
    if (grid == 0) {
        if (n_in != 28 || (size_t)out_size != O_END || ws_size < WS_END) { fprintf(stderr, "kernel_launch: unexpected shapes: n_in %d out %d ws %zu (need %zu)\n", n_in, out_size, ws_size, (size_t)WS_END); grid = -1; return; }
        int dev = 0, cus = 0, per_cu = 0;
        hipGetDevice(&dev); hipDeviceGetAttribute(&cus, hipDeviceAttributeMultiprocessorCount, dev);
        if (hipFuncSetAttribute((const void*)mk_fwd, hipFuncAttributeMaxDynamicSharedMemorySize, LDS_BYTES) != hipSuccess) { fprintf(stderr, "kernel_launch: hipFuncSetAttribute failed\n"); grid = -1; return; }
        hipOccupancyMaxActiveBlocksPerMultiprocessor(&per_cu, (const void*)mk_fwd, 512, LDS_BYTES);
        (void)hipGetLastError();
        if (per_cu < 1) { fprintf(stderr, "kernel_launch: occupancy query says %d blocks per CU\n", per_cu); per_cu = 1; }
        grid = cus;
    }
    if (grid < 0) return;
    Params p{};
    for (int i = 0; i < 28; ++i) p.in[i] = (const float*)d_in[i];
    p.out = (float*)d_out; p.ws = (unsigned char*)d_ws;
#if MK_N_LAUNCHES == 1
    p.ph_lo = 0; p.ph_hi = NPHASE;
    void* args[] = {&p};
    hipError_t e = hipLaunchCooperativeKernel((const void*)mk_fwd, dim3(grid), dim3(512), args, LDS_BYTES, stream);
    if (e != hipSuccess) fprintf(stderr, "cooperative launch failed: %s (grid %d)\n", hipGetErrorString(e), grid);
#else
    for (int ph = 0; ph < NPHASE; ++ph) {
        p.ph_lo = ph; p.ph_hi = ph + 1;
        hipLaunchKernelGGL(mk_fwd, dim3(grid), dim3(512), LDS_BYTES, stream, p);
    }
#endif
}
```

```cpp
#include <hip/hip_runtime.h>
#include <hip/hip_cooperative_groups.h>
#include <cstdio>
#include <cstdint>
namespace cg = cooperative_groups;

#ifndef MK_N_LAUNCHES
#define MK_N_LAUNCHES 1
#endif

#ifndef DUP
#define DUP -1
#endif
#define LAS __attribute__((address_space(3)))
typedef unsigned short bf16_t;
typedef short bf16x8 __attribute__((ext_vector_type(8)));
typedef short s16x4 __attribute__((ext_vector_type(4)));
typedef float f32x4 __attribute__((ext_vector_type(4)));
typedef float f32x2 __attribute__((ext_vector_type(2)));
typedef float f32x16 __attribute__((ext_vector_type(16)));
typedef unsigned u32x4 __attribute__((ext_vector_type(4)));
typedef unsigned u32x2 __attribute__((ext_vector_type(2)));
typedef __bf16 bf16x2_t __attribute__((ext_vector_type(2)));

constexpr int DM = 1024, NBATCH = 8, SEQ = 4096, MP = NBATCH * SEQ, NDEC = 128, DSEQ = 4, MS = NDEC * DSEQ, M = MP + MS;
constexpr int NMEM = 256, MMEM = NBATCH * NMEM;
constexpr int DFF = 2816, NFF = 2 * DFF;
constexpr int NINA = 1536, NINB = 1792;
constexpr float EPS = 1e-6f;
constexpr float LOG2E = 1.4426950408889634f;
constexpr int NPHASE = 11;

constexpr size_t O_Y = 0, O_WKP = 34078720, O_WVP = 34340864, O_CVP = 34603008, O_MKP = 35389440, O_MVP = 36438016, O_CONVP = 37486592,
                 O_WKS = 37576704, O_WVS = 41771008, O_CVS = 45965312, O_CONVS = 46358528, O_END = 47800320;

constexpr size_t MiB = 1u << 20;
constexpr size_t WS_SSQ = 0, WS_GT = 1 * MiB;
constexpr size_t WS_WINA = 2 * MiB, WS_WOUTA = 5 * MiB, WS_WINB = 7 * MiB, WS_WOUTB = 11 * MiB, WS_WMKV = 13 * MiB, WS_WFFN = 15 * MiB,
                 WS_WDOWN = 37 * MiB, WS_WST = 48 * MiB;
constexpr size_t WS_MEMB = 50 * MiB, WS_MK = 54 * MiB, WS_MV = 56 * MiB;
constexpr size_t WS_XB = 58 * MiB;
constexpr size_t WS_H = 124 * MiB;
constexpr size_t WS_Q = WS_H, WS_K = WS_Q + (size_t)M * 768 * 2, WS_V = WS_K + (size_t)M * 256 * 2, WS_XQ = WS_V + (size_t)M * 256 * 2,
                 WS_O = WS_XQ + (size_t)M * 256 * 2, WS_U = WS_O + (size_t)M * 1024 * 2, WS_GV = WS_U + (size_t)M * 768 * 2;
constexpr size_t WS_SIDE = 384 * MiB, SIDE_N = (size_t)128 * 2 * DFF;
constexpr size_t WS_END = WS_SIDE + 3 * SIDE_N * 4;
static_assert(WS_GV + (size_t)M * 768 * 2 <= WS_SIDE && WS_H + (size_t)M * DFF * 2 <= WS_SIDE, "mixer buffers / hidden below the side buffers");
static_assert(WS_END <= 512 * MiB, "ws");

namespace pg8 {
constexpr int BM = 256, BK = 64, HALF = 128, HTB = HALF * BK * 2, STAGE_BYTES = 8 * HTB, NXCD = 8, WGM = 8;
__host__ __device__ __forceinline__ int lds_byte(int r, int c) { const int st = (r >> 4) * 2 + (c >> 5), rr = r & 15, cc = c & 31, ob = rr * 64 + cc * 2; return st * 1024 + (ob ^ (((ob >> 9) & 1) << 5)); }
__host__ __device__ __forceinline__ void stage_rc(int b, int& R, int& C) { const int st = b / 1024, sb = b % 1024, swz = sb ^ (((sb >> 9) & 1) << 5); R = (st >> 1) * 16 + swz / 64; C = (st & 1) * 32 + (swz % 64) / 2; }
__host__ __device__ __forceinline__ int perm32(int rho) { const int n = rho >> 4, i = rho & 15; return 8 * (i >> 2) + 4 * n + (i & 3); }

struct Unit { int pm, pn; };
struct Gemm { const bf16_t* A; const bf16_t* Bt; int lda, K; };

struct StaticOrder {
    int nM, nN, nwg, G, c;
    __device__ void init(int Mr, int N, int G_, int c_) { nM = Mr / BM; nN = N / BM; nwg = nM * nN; G = G_; c = c_; }
    __device__ bool next(int i, Unit& u) const {
        const long L = (long)i * G + c; if (L >= nwg) return false;
        int wgid = (int)L; { const int q = nwg / NXCD, r = nwg % NXCD, xcd = wgid % NXCD, off = wgid / NXCD; wgid = (xcd < r ? xcd * (q + 1) : r * (q + 1) + (xcd - r) * q) + off; }
        const int nig = WGM * nN, gid = wgid / nig, fm = gid * WGM, gsz = (nM - fm) < WGM ? (nM - fm) : WGM;
        u.pm = fm + ((wgid % nig) % gsz); u.pn = (wgid % nig) / gsz; return true;
    }
};

template <class Epi, bool ALIGN_EPI, bool SP2>
__device__ __forceinline__ void gemm_phase(LAS unsigned char* lds, const Gemm g, const StaticOrder& S, const Epi& E) {
    const int tid = threadIdx.x, wid = __builtin_amdgcn_readfirstlane(tid >> 6), lane = tid & 63, wr = wid >> 2, wc = wid & 3, fr = lane & 15, fq = lane >> 4;
    const int K = g.K, nt = K / BK, lda = g.lda;
    unsigned voffA[2], voffB[2];
#pragma unroll
    for (int i = 0; i < 2; ++i) { int R, C; stage_rc(tid * 16 + i * 8192, R, C); const int Rb = (R & ~31) + perm32(R & 31);
        voffA[i] = (unsigned)(R * lda + C) * 2u; voffB[i] = (unsigned)(Rb * K + C) * 2u; }
    const size_t kstep = (size_t)(BK * 2);
    const size_t hstepA = (size_t)HALF * lda * 2, hstepB = (size_t)HALF * K * 2;
    const size_t tstepA = 2 * hstepA, tstepB = 2 * hstepB;
    const unsigned ldsw = (unsigned)wid * 1024u;
    const int aoff = lds_byte(wr * 64 + fr, fq * 8), boff = lds_byte(wc * 32 + fr, fq * 8);
#define PG8_SA(b, h) (((b) * 2 + (h)) * HTB)
#define PG8_SB(b, h) ((4 + (b) * 2 + (h)) * HTB)
#define PG8_STAGE(bufoff, gbase, voff) do { _Pragma("unroll") for (int _i = 0; _i < 2; ++_i) \
        __builtin_amdgcn_global_load_lds((const unsigned*)((const char*)(gbase) + (voff)[_i]), (LAS unsigned*)(lds + (bufoff) + ldsw + _i * 8192), 16, 0, 0); } while (0)
#define PG8_LDA(dst, b, h) do { _Pragma("unroll") for (int m = 0; m < 4; ++m) _Pragma("unroll") for (int k = 0; k < 2; ++k) dst[m][k] = *(const LAS bf16x8*)(lds + PG8_SA(b, h) + aoff + m * 2048 + k * 1024); } while (0)
#define PG8_LDB(dst, b, h) do { _Pragma("unroll") for (int n = 0; n < 2; ++n) _Pragma("unroll") for (int k = 0; k < 2; ++k) dst[n][k] = *(const LAS bf16x8*)(lds + PG8_SB(b, h) + boff + n * 2048 + k * 1024); } while (0)
#define PG8_MMA(ai, bj, At, Bt) do { __builtin_amdgcn_s_setprio(1); _Pragma("unroll") for (int m = 0; m < 4; ++m) _Pragma("unroll") for (int n = 0; n < 2; ++n) _Pragma("unroll") for (int k = 0; k < 2; ++k) \
        acc[ai][bj][m][n] = __builtin_amdgcn_mfma_f32_16x16x32_bf16(Bt[n][k], At[m][k], acc[ai][bj][m][n], 0, 0, 0); __builtin_amdgcn_s_setprio(0); } while (0)
#define PG8_WAIT_V(n) asm volatile("s_waitcnt vmcnt(" #n ")" ::: "memory")
#define PG8_WAIT_L(n) asm volatile("s_waitcnt lgkmcnt(" #n ")" ::: "memory")
#define PG8_BAR __builtin_amdgcn_s_barrier()
#define PG8_SCHED __builtin_amdgcn_sched_barrier(0)
    Unit cur, nxt; int ui = 0;
    if (!S.next(0, cur)) return;
    f32x4 acc[2][2][4][2];
#pragma unroll
    for (int a = 0; a < 2; ++a)
#pragma unroll
        for (int b = 0; b < 2; ++b)
#pragma unroll
            for (int m = 0; m < 4; ++m)
#pragma unroll
                for (int n = 0; n < 2; ++n) acc[a][b][m][n] = (f32x4){0.f, 0.f, 0.f, 0.f};
    bf16x8 At[4][2], B0[2][2], B1[2][2];
    const char* cA = (const char*)g.A + (size_t)cur.pm * tstepA; const char* cB = (const char*)g.Bt + (size_t)cur.pn * tstepB;
    if constexpr (SP2) {
        PG8_STAGE(PG8_SB(0, 0), cB, voffB); PG8_STAGE(PG8_SB(0, 1), cB + hstepB, voffB); PG8_STAGE(PG8_SA(0, 0), cA, voffA); PG8_STAGE(PG8_SA(0, 1), cA + hstepA, voffA);
        if (wr == 1) PG8_BAR;
        PG8_WAIT_V(2); PG8_BAR;
        PG8_STAGE(PG8_SB(1, 0), cB + kstep, voffB); PG8_STAGE(PG8_SA(1, 0), cA + kstep, voffA); PG8_STAGE(PG8_SB(1, 1), cB + hstepB + kstep, voffB);
        PG8_WAIT_V(6); PG8_BAR;
    } else {
        PG8_STAGE(PG8_SB(0, 0), cB, voffB); PG8_STAGE(PG8_SA(0, 0), cA, voffA); PG8_STAGE(PG8_SB(0, 1), cB + hstepB, voffB); PG8_STAGE(PG8_SA(0, 1), cA + hstepA, voffA);
        if (wr == 1) PG8_BAR;
        PG8_WAIT_V(4); PG8_BAR;
        PG8_STAGE(PG8_SB(1, 0), cB + kstep, voffB); PG8_STAGE(PG8_SA(1, 0), cA + kstep, voffA); PG8_STAGE(PG8_SB(1, 1), cB + hstepB + kstep, voffB);
        PG8_WAIT_V(6); PG8_BAR;
    }
    for (;;) {
        const bool has_next = S.next(ui + 1, nxt);
        const char* nA = has_next ? (const char*)g.A + (size_t)nxt.pm * tstepA : cA; const char* nB = has_next ? (const char*)g.Bt + (size_t)nxt.pn * tstepB : cB;
        for (int t = 0; t < nt; t += 2) {
            const bool last = (t == nt - 2);
            const char* a1 = cA + (size_t)(t + 1) * kstep;
            const char* a2 = last ? nA : cA + (size_t)(t + 2) * kstep; const char* b2 = last ? nB : cB + (size_t)(t + 2) * kstep;
            const char* a3 = a2 + kstep; const char* b3 = b2 + kstep;
            if constexpr (SP2) {
            PG8_LDB(B0, 0, 0); PG8_LDB(B1, 0, 1); PG8_SCHED; PG8_LDA(At, 0, 0); PG8_STAGE(PG8_SA(1, 1), a1 + hstepA, voffA);
            PG8_WAIT_V(8); PG8_WAIT_L(0); PG8_BAR; PG8_MMA(0, 0, At, B0); PG8_MMA(0, 1, At, B1); PG8_BAR; PG8_SCHED;
            PG8_LDA(At, 0, 1); PG8_STAGE(PG8_SB(0, 0), b2, voffB); PG8_STAGE(PG8_SB(0, 1), b2 + hstepB, voffB); PG8_STAGE(PG8_SA(0, 0), a2, voffA);
            PG8_WAIT_V(8); PG8_WAIT_L(0); PG8_BAR; PG8_MMA(1, 0, At, B0); PG8_MMA(1, 1, At, B1); PG8_BAR; PG8_SCHED;
            PG8_LDB(B0, 1, 0); PG8_LDB(B1, 1, 1); PG8_SCHED; PG8_LDA(At, 1, 0); PG8_STAGE(PG8_SA(0, 1), a2 + hstepA, voffA);
            PG8_WAIT_V(8); PG8_WAIT_L(0); PG8_BAR; PG8_MMA(0, 0, At, B0); PG8_MMA(0, 1, At, B1); PG8_BAR; PG8_SCHED;
            PG8_LDA(At, 1, 1); PG8_STAGE(PG8_SB(1, 0), b3, voffB); PG8_STAGE(PG8_SB(1, 1), b3 + hstepB, voffB); PG8_STAGE(PG8_SA(1, 0), a3, voffA);
            PG8_WAIT_V(8); PG8_WAIT_L(0); PG8_BAR; PG8_MMA(1, 0, At, B0); PG8_MMA(1, 1, At, B1); PG8_BAR; PG8_SCHED;
            } else {
            PG8_LDB(B0, 0, 0); PG8_SCHED; PG8_LDA(At, 0, 0); PG8_STAGE(PG8_SA(1, 1), a1 + hstepA, voffA);
            PG8_WAIT_L(8); PG8_BAR; PG8_WAIT_L(0); PG8_MMA(0, 0, At, B0); PG8_BAR; PG8_SCHED;
            PG8_LDB(B1, 0, 1); PG8_STAGE(PG8_SB(0, 0), b2, voffB);
            PG8_BAR; PG8_WAIT_L(0); PG8_MMA(0, 1, At, B1); PG8_BAR;
            PG8_LDA(At, 0, 1); PG8_STAGE(PG8_SA(0, 0), a2, voffA);
            PG8_BAR; PG8_WAIT_L(0); PG8_MMA(1, 0, At, B0); PG8_BAR; PG8_SCHED;
            PG8_STAGE(PG8_SB(0, 1), b2 + hstepB, voffB);
            PG8_WAIT_V(6); PG8_BAR; PG8_MMA(1, 1, At, B1); PG8_BAR;
            PG8_LDB(B0, 1, 0); PG8_SCHED; PG8_LDA(At, 1, 0); PG8_STAGE(PG8_SA(0, 1), a2 + hstepA, voffA);
            PG8_WAIT_L(8); PG8_BAR; PG8_WAIT_L(0); PG8_MMA(0, 0, At, B0); PG8_BAR; PG8_SCHED;
            PG8_LDB(B1, 1, 1); PG8_STAGE(PG8_SB(1, 0), b3, voffB);
            PG8_BAR; PG8_WAIT_L(0); PG8_MMA(0, 1, At, B1); PG8_BAR;
            PG8_LDA(At, 1, 1); PG8_STAGE(PG8_SA(1, 0), a3, voffA);
            PG8_BAR; PG8_WAIT_L(0); PG8_MMA(1, 0, At, B0); PG8_BAR; PG8_SCHED;
            PG8_STAGE(PG8_SB(1, 1), b3 + hstepB, voffB);
            PG8_WAIT_V(6); PG8_BAR; PG8_MMA(1, 1, At, B1); PG8_BAR;
            }
        }
        if constexpr (ALIGN_EPI) { if (wr == 0) PG8_BAR; }
        E(acc, cur, wr, wc, fr, fq);
        if (!has_next) break;
#pragma unroll
        for (int a = 0; a < 2; ++a)
#pragma unroll
            for (int b = 0; b < 2; ++b)
#pragma unroll
                for (int m = 0; m < 4; ++m)
#pragma unroll
                    for (int n = 0; n < 2; ++n) acc[a][b][m][n] = (f32x4){0.f, 0.f, 0.f, 0.f};
        cur = nxt; cA = nA; cB = nB; ++ui;
        if constexpr (ALIGN_EPI) { if (wr == 1) PG8_BAR; }
    }
    PG8_WAIT_V(0);
    if constexpr (!ALIGN_EPI) { if (wr == 0) PG8_BAR; }
    PG8_BAR;
#undef PG8_SA
#undef PG8_SB
#undef PG8_STAGE
#undef PG8_LDA
#undef PG8_LDB
#undef PG8_MMA
#undef PG8_WAIT_V
#undef PG8_WAIT_L
#undef PG8_BAR
#undef PG8_SCHED
}
}
using pg8::Unit;

constexpr int RING_BYTES = 131072, WSF_OFF = RING_BYTES, OSTG2_OFF = RING_BYTES + 4096, LDS_BYTES = 147456;
__device__ __forceinline__ unsigned cvtpk(float lo, float hi) { f32x2 v = {lo, hi}; bf16x2_t b = __builtin_convertvector(v, bf16x2_t); return __builtin_bit_cast(unsigned, b); }
__device__ __forceinline__ u32x4 pack8(const f32x4 a, const f32x4 b) { u32x4 w; w.x = cvtpk(a[0], a[1]); w.y = cvtpk(a[2], a[3]); w.z = cvtpk(b[0], b[1]); w.w = cvtpk(b[2], b[3]); return w; }
__device__ __forceinline__ float bf2f(unsigned short h) { return __uint_as_float((unsigned)h << 16); }
__device__ __forceinline__ float bflo(unsigned w) { return __uint_as_float(w << 16); }
__device__ __forceinline__ float bfhi(unsigned w) { return __uint_as_float(w & 0xffff0000u); }
__device__ __forceinline__ float wave_sum(float v) {
#pragma unroll
    for (int o = 1; o < 64; o <<= 1) v += __shfl_xor(v, o);
    return v;
}
__device__ __forceinline__ f32x2 gelu_pk(f32x2 v) {
    const f32x2 av = __builtin_elementwise_abs(v), d = av * 0.2316418882f + 1.0f;
    f32x2 t; t.x = __builtin_amdgcn_rcpf(d.x); t.y = __builtin_amdgcn_rcpf(d.y);
    f32x2 q = t * 0.5307027145f + (-0.7265760135f); q = q * t + 0.7107068705f; q = q * t + (-0.142248368f); q = q * t + 0.127414796f; q = q * t;
    const f32x2 s = (v * v) * (-0.72134752044f);
    f32x2 e; e.x = __builtin_amdgcn_exp2f(s.x); e.y = __builtin_amdgcn_exp2f(s.y);
    const f32x2 m = v * (q * e), r = v - m;
    f32x2 o; o.x = v.x < 0.f ? m.x : r.x; o.y = v.y < 0.f ? m.y : r.y; return o;
}
__device__ __forceinline__ f32x4 gelu4(f32x4 v) { const f32x2 a = gelu_pk((f32x2){v[0], v[1]}), b = gelu_pk((f32x2){v[2], v[3]}); return (f32x4){a.x, a.y, b.x, b.y}; }
__device__ __forceinline__ float dot4(f32x4 v) { return (v[0] * v[0] + v[1] * v[1]) + (v[2] * v[2] + v[3] * v[3]); }
__device__ __forceinline__ unsigned short f2bf_s(float f) { return (unsigned short)(cvtpk(f, 0.f) & 0xffffu); }
__device__ __forceinline__ float alibi_slope(int h) { return h < 8 ? exp2f(-(float)(h + 1)) : exp2f(-0.5f - (float)(h - 8)); }

struct Params {
    const float* in[28];
    float* out;
    unsigned char* ws;
    int ph_lo, ph_hi;
};

#define EPI_ARGS const f32x4 (&acc)[2][2][4][2], const Unit& u, int wr, int wc, int fr, int fq
#define FOR_AI_M _Pragma("unroll") for (int ai = 0; ai < 2; ++ai) _Pragma("unroll") for (int m = 0; m < 4; ++m)
#define BIG_ROWS(E) do { const int row0_ = u.pm * 256 + wr * 64 + fr; FOR_AI_M { f32x4 v_[2][2]; \
    _Pragma("unroll") for (int bj = 0; bj < 2; ++bj) _Pragma("unroll") for (int n = 0; n < 2; ++n) v_[bj][n] = acc[ai][bj][m][n]; \
    (E).row(v_, row0_ + ai * 128 + m * 16, u.pn, wc, fq); } } while (0)

__device__ __forceinline__ void head_norm(f32x4 (&v)[2][2], const float* gp, int fq) {
    float ss = (dot4(v[0][0]) + dot4(v[0][1])) + (dot4(v[1][0]) + dot4(v[1][1]));
    ss += __shfl_xor(ss, 16); ss += __shfl_xor(ss, 32);
    const float inv = rsqrtf(ss * (1.f / 64.f) + EPS);
#pragma unroll
    for (int bj = 0; bj < 2; ++bj)
#pragma unroll
        for (int n = 0; n < 2; ++n) { const f32x4 g = *(const f32x4*)(gp + 32 * bj + 8 * fq + 4 * n); v[bj][n] = v[bj][n] * inv * g; }
}

struct EpiInA {
    const float* ssq; bf16_t* Qb; const float* gt; float* out;
    __device__ __forceinline__ void row(f32x4 (&v)[2][2], int row, int pn, int wc, int fq) const {
        const int typ = pn < 3 ? 0 : pn - 2;
        const size_t doff = typ == 0 ? 0 : (size_t)M * 768 + (size_t)(typ - 1) * M * 256;
        const int ld = typ == 0 ? 768 : 256, cb = typ == 0 ? (pn * 4 + wc) * 64 : wc * 64;
        const float rs = rsqrtf(ssq[row] * (1.f / 1024.f) + EPS);
#pragma unroll
        for (int bj = 0; bj < 2; ++bj)
#pragma unroll
            for (int n = 0; n < 2; ++n) v[bj][n] = v[bj][n] * rs;
        if (typ != 2) head_norm(v, gt + typ * 64, fq);
#pragma unroll
        for (int bj = 0; bj < 2; ++bj) *(u32x4*)(Qb + doff + (size_t)row * ld + cb + 32 * bj + 8 * fq) = pack8(v[bj][0], v[bj][1]);
        if (typ == 1 || typ == 2) {
            long wo = -1;
            if (row >= MP) { const int ns = row - MP; wo = (long)O_WKS + (long)(typ - 1) * (long)(O_WVS - O_WKS) + (long)((ns >> 2) * 128 + 124 + (ns & 3)) * 256; }
            else if ((row & 4095) >= 3968) { const int b = row >> 12, t = row & 4095; wo = (long)O_WKP + (long)(typ - 1) * (long)(O_WVP - O_WKP) + (long)(b * 128 + t - 3968) * 256; }
            if (wo >= 0) { float* wout = out + wo;
#pragma unroll
                for (int bj = 0; bj < 2; ++bj)
#pragma unroll
                    for (int n = 0; n < 2; ++n) *(f32x4*)(wout + wc * 64 + 32 * bj + 8 * fq + 4 * n) = v[bj][n];
            }
        }
    }
    __device__ __forceinline__ void operator()(EPI_ARGS) const { BIG_ROWS(*this); }
};

struct EpiMemKV {
    const float* ssq; const float* xk; float *outk, *outv; bf16_t *MK, *MV;
    __device__ __forceinline__ void row(f32x4 (&v)[2][2], int row, int pn, int wc, int fq) const {
        const int layer = pn >> 1; const bool isv = pn & 1;
        float* of = (isv ? outv : outk) + (size_t)layer * MMEM * 256; bf16_t* ob = (isv ? MV : MK) + (size_t)layer * MMEM * 256;
        const float rs = rsqrtf(ssq[row] * (1.f / 1024.f) + EPS);
#pragma unroll
        for (int bj = 0; bj < 2; ++bj)
#pragma unroll
            for (int n = 0; n < 2; ++n) v[bj][n] = v[bj][n] * rs;
        if (!isv) head_norm(v, xk + layer * 64, fq);
#pragma unroll
        for (int bj = 0; bj < 2; ++bj) {
            const size_t o = (size_t)row * 256 + wc * 64 + 32 * bj + 8 * fq;
            *(u32x4*)(ob + o) = pack8(v[bj][0], v[bj][1]);
            *(f32x4*)(of + o) = v[bj][0]; *(f32x4*)(of + o + 4) = v[bj][1];
        }
    }
    __device__ __forceinline__ void operator()(EPI_ARGS) const { BIG_ROWS(*this); }
};

struct EpiRes {
    const float* xin_p; const float* xin_s; float* xout; bf16_t* xb; float* ssq;
    __device__ __forceinline__ void row(f32x4 (&v)[2][2], int row, int pn, int wc, int fq) const {
        const int col0 = pn * 256 + wc * 32 + 8 * fq;
        const float* src = (row < MP ? xin_p + (size_t)row * DM : xin_s + (size_t)(row - MP) * DM) + col0;
        float ss = 0.f;
#pragma unroll
        for (int bj = 0; bj < 2; ++bj) {
            const f32x4 x0 = *(const f32x4*)(src + 128 * bj) + v[bj][0], x1 = *(const f32x4*)(src + 128 * bj + 4) + v[bj][1];
            float* o = xout + (size_t)row * DM + col0 + 128 * bj;
            *(f32x4*)o = x0; *(f32x4*)(o + 4) = x1;
            if (xb) *(u32x4*)(xb + (size_t)row * DM + col0 + 128 * bj) = pack8(x0, x1);
            ss += dot4(x0) + dot4(x1);
        }
        if (ssq) { ss += __shfl_xor(ss, 16); ss += __shfl_xor(ss, 32); if (fq == 0) atomicAdd(ssq + row, ss); }
    }
    __device__ __forceinline__ void operator()(EPI_ARGS) const { BIG_ROWS(*this); }
};

template <int CTRL> __device__ __forceinline__ float dpp_f(float x) { return __int_as_float(__builtin_amdgcn_update_dpp(0, __float_as_int(x), CTRL, 0xf, 0xf, false)); }
__device__ __forceinline__ float silu_f(float c) { return c * __builtin_amdgcn_rcpf(1.f + __builtin_amdgcn_exp2f(-c * LOG2E)); }

struct EpiFfnConv {
    const float* ssq; bf16_t* H; const float* cw; const float* cbp; float* side; float* convp; LAS float* xch;
    __device__ __forceinline__ void operator()(EPI_ARGS) const {
        const int pm = u.pm, ts = pm & 15, col0 = u.pn * 128 + wc * 32 + 8 * fq;
        const int rowbase = pm * 256 + wr * 64 + fr;
        if (fr >= 14) {
#pragma unroll
            for (int ai = 0; ai < 2; ++ai) {
                const float rs = rsqrtf(ssq[rowbase + ai * 128 + 48] * (1.f / 1024.f) + EPS);
                LAS float* x = xch + ((2 * ai + wr) * 2 + (fr - 14)) * 128 + wc * 32 + 8 * fq;
                *(LAS f32x4*)x = acc[ai][0][3][0] * rs; *(LAS f32x4*)(x + 4) = acc[ai][0][3][1] * rs;
            }
        }
        asm volatile("s_waitcnt lgkmcnt(0)" ::: "memory"); __builtin_amdgcn_s_barrier(); asm volatile("" ::: "memory");
        float w0[8], w1[8], w2[8], cb[8];
#pragma unroll
        for (int e = 0; e < 8; ++e) { w0[e] = cw[col0 + e]; w1[e] = cw[DFF + col0 + e]; w2[e] = cw[2 * DFF + col0 + e]; cb[e] = cbp[col0 + e]; }
#pragma unroll
        for (int ai = 0; ai < 2; ++ai) {
            const int blk = 2 * ai + wr;
            float prev[8];
            if (blk > 0) { const LAS float* x = xch + ((blk - 1) * 2 + (fr >= 14 ? fr - 14 : 0)) * 128 + wc * 32 + 8 * fq; const f32x4 p0 = *(const LAS f32x4*)x, p1 = *(const LAS f32x4*)(x + 4);
#pragma unroll
                for (int e = 0; e < 4; ++e) { prev[e] = p0[e]; prev[4 + e] = p1[e]; } }
            else {
#pragma unroll
                for (int e = 0; e < 8; ++e) prev[e] = 0.f; }
#pragma unroll
            for (int m = 0; m < 4; ++m) {
                const int row = rowbase + ai * 128 + m * 16;
                const float rs = rsqrtf(ssq[row] * (1.f / 1024.f) + EPS);
                float a[8], c[8], h[8], up[8];
#pragma unroll
                for (int e = 0; e < 8; ++e) { a[e] = acc[ai][0][m][e >> 2][e & 3] * rs; up[e] = acc[ai][1][m][e >> 2][e & 3] * rs; }
#pragma unroll
                for (int e = 0; e < 8; ++e) {
                    const float s1 = fr == 15 ? prev[e] : a[e], s2 = fr >= 14 ? prev[e] : a[e];
                    const float p1 = dpp_f<0x121>(s1), p2 = dpp_f<0x122>(s2);
                    c[e] = cb[e] + w0[e] * p2 + w1[e] * p1 + w2[e] * a[e];
                    h[e] = silu_f(c[e]) * up[e];
                }
                u32x4 w; w.x = cvtpk(h[0], h[1]); w.y = cvtpk(h[2], h[3]); w.z = cvtpk(h[4], h[5]); w.w = cvtpk(h[6], h[7]);
                *(u32x4*)(H + (size_t)row * DFF + col0) = w;
                if (ai == 0 && m == 0) { if (wr == 0 && ts > 0 && fr < 2) { float* d = side + (size_t)(pm * 2 + fr) * DFF + col0;
                        *(f32x4*)d = (f32x4){c[0], c[1], c[2], c[3]}; *(f32x4*)(d + 4) = (f32x4){c[4], c[5], c[6], c[7]};
                        *(f32x4*)(d + SIDE_N) = (f32x4){up[0], up[1], up[2], up[3]}; *(f32x4*)(d + SIDE_N + 4) = (f32x4){up[4], up[5], up[6], up[7]}; } }
                if (ai == 1 && m == 3) { if (wr == 1 && fr >= 14) { float* d = ts < 15 ? side + 2 * SIDE_N + (size_t)(pm * 2 + fr - 14) * DFF + col0 : convp + (size_t)((pm >> 4) * 2 + fr - 14) * DFF + col0;
                        *(f32x4*)d = (f32x4){a[0], a[1], a[2], a[3]}; *(f32x4*)(d + 4) = (f32x4){a[4], a[5], a[6], a[7]}; } }
#pragma unroll
                for (int e = 0; e < 8; ++e) prev[e] = a[e];
            }
        }
    }
};
__device__ __forceinline__ void ffn_fixup(const Params& P, int layer, const pg8::StaticOrder& S) {
    bf16_t* H = (bf16_t*)(P.ws + WS_H); const float* side = (const float*)(P.ws + WS_SIDE); const float* cw = P.in[25] + (size_t)layer * 3 * DFF;
    Unit u; int last = -1;
    for (int i = 0; S.next(i, u); ++i) {
        const int pm = u.pm; if ((pm & 15) == 0 || pm == last) continue; last = pm;
        for (int c4 = threadIdx.x; c4 < DFF / 4; c4 += 512) { const int col = 4 * c4;
            const f32x4 cp0 = *(const f32x4*)(side + (size_t)(pm * 2) * DFF + col), cp1 = *(const f32x4*)(side + (size_t)(pm * 2 + 1) * DFF + col);
            const f32x4 u0 = *(const f32x4*)(side + SIDE_N + (size_t)(pm * 2) * DFF + col), u1 = *(const f32x4*)(side + SIDE_N + (size_t)(pm * 2 + 1) * DFF + col);
            const f32x4 am2 = *(const f32x4*)(side + 2 * SIDE_N + (size_t)((pm - 1) * 2) * DFF + col), am1 = *(const f32x4*)(side + 2 * SIDE_N + (size_t)((pm - 1) * 2 + 1) * DFF + col);
            const f32x4 w0 = *(const f32x4*)(cw + col), w1 = *(const f32x4*)(cw + DFF + col);
            const f32x4 c0 = cp0 + w0 * am2 + w1 * am1, c1 = cp1 + w0 * am1;
            u32x2 h0, h1;
            h0.x = cvtpk(silu_f(c0[0]) * u0[0], silu_f(c0[1]) * u0[1]); h0.y = cvtpk(silu_f(c0[2]) * u0[2], silu_f(c0[3]) * u0[3]);
            h1.x = cvtpk(silu_f(c1[0]) * u1[0], silu_f(c1[1]) * u1[1]); h1.y = cvtpk(silu_f(c1[2]) * u1[2], silu_f(c1[3]) * u1[3]);
            *(u32x2*)(H + (size_t)(pm * 256) * DFF + col) = h0; *(u32x2*)(H + (size_t)(pm * 256 + 1) * DFF + col) = h1; }
    }
    asm volatile("s_waitcnt vmcnt(0)" ::: "memory"); __syncthreads();
}

struct EpiInB {
    const float* ssq; bf16_t *U, *GV, *XQ; const float* xg; float* ssqv;
    __device__ __forceinline__ void row(f32x4 (&v)[2][2], int row, int pn, int wc, int fq) const {
        const float rs = rsqrtf(ssq[row] * (1.f / 1024.f) + EPS);
        if (pn < 6) {
            bf16_t* dst = pn < 3 ? U : GV; const int col0 = (pn % 3) * 256 + wc * 32 + 8 * fq;
            float ss = 0.f;
#pragma unroll
            for (int bj = 0; bj < 2; ++bj) {
                const f32x4 v0 = gelu4(v[bj][0] * rs), v1 = gelu4(v[bj][1] * rs);
                *(u32x4*)(dst + (size_t)row * 768 + col0 + 128 * bj) = pack8(v0, v1);
                ss += dot4(v0) + dot4(v1);
            }
            if (pn >= 3) { ss += __shfl_xor(ss, 16); ss += __shfl_xor(ss, 32); if (fq == 0) atomicAdd(ssqv + row, ss); }
        } else {
#pragma unroll
            for (int bj = 0; bj < 2; ++bj)
#pragma unroll
                for (int n = 0; n < 2; ++n) v[bj][n] = v[bj][n] * rs;
            head_norm(v, xg, fq);
#pragma unroll
            for (int bj = 0; bj < 2; ++bj) *(u32x4*)(XQ + (size_t)row * 256 + wc * 64 + 32 * bj + 8 * fq) = pack8(v[bj][0], v[bj][1]);
        }
    }
    __device__ __forceinline__ void operator()(EPI_ARGS) const { BIG_ROWS(*this); }
};

template <int MB, int NS>
__device__ __forceinline__ void wave_gemm_part(const bf16_t* A, int lda, int row0, const bf16_t* Bt, int K, int pn, int wc, int k0, f32x4 (&acc)[MB][2][2]) {
    const int lane = threadIdx.x & 63, fr = lane & 15, fq = lane >> 4;
    const bf16_t* ap = A + (size_t)(row0 + fr) * lda + 8 * fq + k0;
    const bf16_t* bp[2][2];
#pragma unroll
    for (int bj = 0; bj < 2; ++bj)
#pragma unroll
        for (int n = 0; n < 2; ++n) bp[bj][n] = Bt + (size_t)(pn * 256 + 128 * bj + 32 * wc + pg8::perm32(16 * n + fr)) * K + 8 * fq + k0;
#pragma unroll
    for (int m = 0; m < MB; ++m)
#pragma unroll
        for (int bj = 0; bj < 2; ++bj)
#pragma unroll
            for (int n = 0; n < 2; ++n) acc[m][bj][n] = (f32x4){0.f, 0.f, 0.f, 0.f};
#pragma unroll
    for (int s0 = 0; s0 < NS; s0 += 4) {
        bf16x8 af[4][MB], bf[4][2][2];
#pragma unroll
        for (int j = 0; j < 4; ++j) if (s0 + j < NS) {
#pragma unroll
            for (int m = 0; m < MB; ++m) af[j][m] = *(const bf16x8*)(ap + (size_t)m * 16 * lda + (s0 + j) * 32);
#pragma unroll
            for (int bj = 0; bj < 2; ++bj)
#pragma unroll
                for (int n = 0; n < 2; ++n) bf[j][bj][n] = *(const bf16x8*)(bp[bj][n] + (s0 + j) * 32);
        }
#pragma unroll
        for (int j = 0; j < 4; ++j) if (s0 + j < NS) {
#pragma unroll
            for (int m = 0; m < MB; ++m)
#pragma unroll
                for (int bj = 0; bj < 2; ++bj)
#pragma unroll
                    for (int n = 0; n < 2; ++n) acc[m][bj][n] = __builtin_amdgcn_mfma_f32_16x16x32_bf16(bf[j][bj][n], af[j][m], acc[m][bj][n], 0, 0, 0);
        }
    }
}
template <int MB>
__device__ __forceinline__ void sample_reduce_store(LAS unsigned char* lds, const f32x4 (&acc)[MB][2][2], int wave, int lane) {
    LAS f32x4* Pl = (LAS f32x4*)lds;
#pragma unroll
    for (int m = 0; m < MB; ++m)
#pragma unroll
        for (int bj = 0; bj < 2; ++bj)
#pragma unroll
            for (int n = 0; n < 2; ++n) Pl[((wave * MB + m) * 4 + bj * 2 + n) * 64 + lane] = acc[m][bj][n];
}
template <int MB>
__device__ __forceinline__ void sample_reduce_load(const LAS unsigned char* lds, f32x4 (&v)[2][2], int m, int lane) {
    const LAS f32x4* Pl = (const LAS f32x4*)lds;
#pragma unroll
    for (int bj = 0; bj < 2; ++bj)
#pragma unroll
        for (int n = 0; n < 2; ++n) { f32x4 sum = Pl[((0 * MB + m) * 4 + bj * 2 + n) * 64 + lane];
#pragma unroll
            for (int w = 1; w < 8; ++w) sum += Pl[((w * MB + m) * 4 + bj * 2 + n) * 64 + lane];
            v[bj][n] = sum; }
}
template <int MB, int NS, class Epi>
__device__ __forceinline__ void sample_gemm(LAS unsigned char* lds, const bf16_t* A, int lda, const bf16_t* Bt, int ntiles, const Epi& E, int blk, int nblk) {
    const int lane = threadIdx.x & 63, fr = lane & 15, fq = lane >> 4, wave = __builtin_amdgcn_readfirstlane(threadIdx.x >> 6);
    constexpr int NRB = MS / (16 * MB), K = 8 * NS * 32;
    const int ntask = NRB * ntiles * 4;
    for (int t = blk; t < ntask; t += nblk) {
        const int rb = t % NRB, cw = t / NRB, pn = cw >> 2, wc = cw & 3;
        f32x4 acc[MB][2][2];
        wave_gemm_part<MB, NS>(A, lda, MP + rb * 16 * MB, Bt, K, pn, wc, wave * NS * 32, acc);
        sample_reduce_store<MB>(lds, acc, wave, lane);
        __syncthreads();
        if (wave < MB) { f32x4 v[2][2]; sample_reduce_load<MB>(lds, v, wave, lane); E.row(v, MP + rb * 16 * MB + 16 * wave + fr, pn, wc, fq); }
        __syncthreads();
    }
}
__device__ __forceinline__ void sample_ffn(const Params& P, LAS unsigned char* lds, int layer, const float* ssq, int blk, int nblk) {
    const int lane = threadIdx.x & 63, fr = lane & 15, fq = lane >> 4, wave = __builtin_amdgcn_readfirstlane(threadIdx.x >> 6);
    const bf16_t* XB = (const bf16_t*)(P.ws + WS_XB); const bf16_t* Wt = (const bf16_t*)(P.ws + WS_WFFN) + (size_t)layer * NFF * DM; bf16_t* Hb = (bf16_t*)(P.ws + WS_H);
    const float* cw = P.in[25] + (size_t)layer * 3 * DFF; const float* cbp = P.in[26] + (size_t)layer * DFF; const float* st = P.in[6] + (size_t)layer * NDEC * 2 * DFF;
    float* convs = P.out + O_CONVS + (size_t)layer * NDEC * 2 * DFF;
    constexpr int MB = 4, NRB = MS / 64, NTASK = NRB * 22 * 4;
    for (int t = blk; t < NTASK; t += nblk) {
        const int rb = t % NRB, cwi = t / NRB, pn = cwi >> 2, wc = cwi & 3;
        f32x4 acc[MB][2][2];
        wave_gemm_part<MB, 4>(XB, DM, MP + rb * 64, Wt, DM, pn, wc, wave * 128, acc);
        sample_reduce_store<MB>(lds, acc, wave, lane);
        __syncthreads();
        if (wave < MB) {
            f32x4 v[2][2]; sample_reduce_load<MB>(lds, v, wave, lane);
            const int col0 = pn * 128 + wc * 32 + 8 * fq, s = fr & 3;
            const int row = MP + rb * 64 + 16 * wave + fr, nseq = (row - MP) >> 2;
            const float rs = rsqrtf(ssq[row] * (1.f / 1024.f) + EPS);
            float h[8];
#pragma unroll
            for (int e = 0; e < 8; ++e) {
                const float a = v[0][e >> 2][e & 3] * rs, up = v[1][e >> 2][e & 3] * rs;
                const float st0 = st[(size_t)(nseq * 2 + 0) * DFF + col0 + e], st1 = st[(size_t)(nseq * 2 + 1) * DFF + col0 + e];
                const float r1 = dpp_f<0x121>(a), r2 = dpp_f<0x122>(a);
                const float p1 = s >= 1 ? r1 : st1, p2 = s >= 2 ? r2 : (s == 1 ? st1 : st0);
                const float c = cbp[col0 + e] + cw[col0 + e] * p2 + cw[DFF + col0 + e] * p1 + cw[2 * DFF + col0 + e] * a;
                h[e] = silu_f(c) * up;
                if (s >= 2) convs[(size_t)(nseq * 2 + (s - 2)) * DFF + col0 + e] = a;
            }
            u32x4 w; w.x = cvtpk(h[0], h[1]); w.y = cvtpk(h[2], h[3]); w.z = cvtpk(h[4], h[5]); w.w = cvtpk(h[6], h[7]);
            *(u32x4*)(Hb + (size_t)row * DFF + col0) = w;
        }
        __syncthreads();
    }
}

__device__ __forceinline__ void p0_transpose_item(const float* W, int K, int N, const float* gain, bf16_t* WT, int kb, int n0, int drow0, LAS float* scr, int lane) {
    const int k0 = 64 * kb;
#pragma unroll 8
    for (int i = 0; i < 32; ++i) { const int kk = 2 * i + (lane >> 5); float w = W[(size_t)(k0 + kk) * N + n0 + (lane & 31)]; if (gain) w *= gain[k0 + kk]; scr[kk * 33 + (lane & 31)] = w; }
    asm volatile("s_waitcnt lgkmcnt(0)" ::: "memory");
    const int c = lane & 7;
#pragma unroll
    for (int j = 0; j < 4; ++j) { const int n = (lane >> 3) + 8 * j; const LAS float* s = scr + (8 * c) * 33 + n;
        u32x4 o; o.x = cvtpk(s[0 * 33], s[1 * 33]); o.y = cvtpk(s[2 * 33], s[3 * 33]); o.z = cvtpk(s[4 * 33], s[5 * 33]); o.w = cvtpk(s[6 * 33], s[7 * 33]);
        *(u32x4*)(WT + (size_t)(drow0 + n) * K + k0 + 8 * c) = o; }
    asm volatile("s_waitcnt lgkmcnt(0)" ::: "memory");
}
__device__ __forceinline__ int map_headperm(int nb) { const int p = (nb * 32) & 255, bj = p >> 7, wc = (p >> 5) & 3; return ((nb * 32) & ~255) + 64 * wc + 32 * bj; }
__device__ __forceinline__ int map_ffn(int nb) { const int tile = nb >> 3, p = (nb & 7) * 32; return p < 128 ? 128 * tile + p : DFF + 128 * tile + (p - 128); }

__device__ __forceinline__ void row_to_bf16(const float* xrow, bf16_t* orow, float* ssq, int lane) {
    const f32x4* xr = (const f32x4*)xrow + lane; f32x4 v[4]; float s = 0.f;
#pragma unroll
    for (int j = 0; j < 4; ++j) { v[j] = xr[64 * j]; s += dot4(v[j]); }
    s = wave_sum(s);
    u32x2* o8 = (u32x2*)orow + lane;
#pragma unroll
    for (int j = 0; j < 4; ++j) { u32x2 w; w.x = cvtpk(v[j][0], v[j][1]); w.y = cvtpk(v[j][2], v[j][3]); o8[64 * j] = w; }
    if (lane == 0) *ssq = s;
}

__device__ __forceinline__ void p0_prologue(const Params& P, LAS unsigned char* lds, int G, int bid) {
    const int tid = threadIdx.x, lane = tid & 63, wave = __builtin_amdgcn_readfirstlane(tid >> 6);
    LAS float* scr = (LAS float*)(lds + wave * 16384);
    const int gw = bid * 8 + wave, NGW = G * 8;
    unsigned char* ws = P.ws;
    float* ssq = (float*)(ws + WS_SSQ);
    constexpr int I0 = 16 * 48, I1 = 16 * 32, I2 = 16 * 56, I3 = 16 * 32, I4 = 16 * 16, I6 = 16 * 176, I8 = 44 * 32;
    constexpr int NITEMS = I0 + I1 + I2 + I3 + 2 * I4 + 2 * I6 + 2 * I8;
    for (int it = gw; it < NITEMS; it += NGW) {
        int r = it;
        if (r < I0) { const int nb = r % 48, kb = r / 48; p0_transpose_item(P.in[11], 1024, NINA, P.in[8], (bf16_t*)(ws + WS_WINA), kb, map_headperm(nb), 32 * nb, scr, lane); continue; } r -= I0;
        if (r < I1) { const int nb = r % 32, kb = r / 32; p0_transpose_item(P.in[15], 1024, 1024, nullptr, (bf16_t*)(ws + WS_WOUTA), kb, 32 * nb, 32 * nb, scr, lane); continue; } r -= I1;
        if (r < I2) { const int nb = r % 56, kb = r / 56; p0_transpose_item(P.in[16], 1024, NINB, P.in[8] + 1024, (bf16_t*)(ws + WS_WINB), kb, nb < 48 ? 32 * nb : map_headperm(nb), 32 * nb, scr, lane); continue; } r -= I2;
        if (r < I3) { const int nb = r % 32, kb = r / 32; p0_transpose_item(P.in[20], 1024, 1024, nullptr, (bf16_t*)(ws + WS_WOUTB), kb, 32 * nb, 32 * nb, scr, lane); continue; } r -= I3;
        if (r < 2 * I4) { const int l = r / I4; r -= l * I4; const int nb = r % 16, kb = r / 16;
            p0_transpose_item(P.in[21] + (size_t)l * 1024 * 512, 1024, 512, P.in[10] + l * 1024, (bf16_t*)(ws + WS_WMKV) + (size_t)l * 512 * 1024, kb, map_headperm(nb), 32 * nb, scr, lane); continue; } r -= 2 * I4;
        if (r < 2 * I6) { const int l = r / I6; r -= l * I6; const int nb = r % 176, kb = r / 176;
            p0_transpose_item(P.in[24] + (size_t)l * 1024 * NFF, 1024, NFF, P.in[9] + l * 1024, (bf16_t*)(ws + WS_WFFN) + (size_t)l * NFF * 1024, kb, map_ffn(nb), 32 * nb, scr, lane); continue; } r -= 2 * I6;
        { const int l = r / I8; r -= l * I8; const int nb = r % 32, kb = r / 32;
            p0_transpose_item(P.in[27] + (size_t)l * DFF * 1024, DFF, 1024, nullptr, (bf16_t*)(ws + WS_WDOWN) + (size_t)l * 1024 * DFF, kb, 32 * nb, 32 * nb, scr, lane); }
    }
    bf16_t* XB = (bf16_t*)(ws + WS_XB); bf16_t* MEMB = (bf16_t*)(ws + WS_MEMB);
    for (int r = gw; r < M + MMEM; r += NGW) {
        if (r < MP) row_to_bf16(P.in[0] + (size_t)r * DM, XB + (size_t)r * DM, ssq + r, lane);
        else if (r < M) row_to_bf16(P.in[1] + (size_t)(r - MP) * DM, XB + (size_t)r * DM, ssq + r, lane);
        else row_to_bf16(P.in[7] + (size_t)(r - M) * DM, MEMB + (size_t)(r - M) * DM, ssq + 5 * M + (r - M), lane);
    }
    const int gt = bid * 512 + tid, NGT = G * 512;
    for (int i = gt; i < 4 * M; i += NGT) ssq[M + i] = 0.f;
    if (gt < 256) { float* GT = (float*)(ws + WS_GT); const int t4 = gt >> 6, d = gt & 63; GT[gt] = t4 == 0 ? P.in[12][d] : t4 == 1 ? P.in[13][d] : t4 == 2 ? 1.f : P.in[22][d]; }
    { bf16_t* WST = (bf16_t*)(ws + WS_WST); const float* wsb = P.in[18];
      for (int i = gt; i < 4 * 128 * 128; i += NGT) { const int ii = (i >> 7) & 127, jj = i & 127; const float w = jj <= ii ? wsb[i] : 0.f; WST[i] = (bf16_t)(cvtpk(w, 0.f) & 0xffffu); } }
    { const f32x4* ck = (const f32x4*)P.in[2]; const f32x4* cv = (const f32x4*)P.in[3]; f32x4* ok = (f32x4*)(P.out + O_WKS); f32x4* ov = (f32x4*)(P.out + O_WVS);
      for (int i = gt; i < NDEC * 124 * 64; i += NGT) { const int n = i / (124 * 64), r = i % (124 * 64); const size_t s = (size_t)n * 128 * 64 + 4 * 64 + r, d = (size_t)n * 128 * 64 + r; ok[d] = ck[s]; ov[d] = cv[s]; } }
}

__device__ __forceinline__ int crow(int r, int hi) { return (r & 3) + 8 * (r >> 2) + 4 * hi; }
__device__ __forceinline__ int kv_off(int row, int chunk) { return row * 128 + ((chunk ^ (row & 7)) << 4); }
__device__ __forceinline__ s16x4 vtr(const LAS unsigned char* p) { return __builtin_bit_cast(s16x4, __builtin_amdgcn_ds_read_tr16_b64_v4i16((LAS s16x4*)p)); }

struct AttnOfs { int k[4]; int v[2]; };
__device__ __forceinline__ AttnOfs attn_ofs() {
    const int lane = threadIdx.x & 63, r32 = lane & 31, hi = lane >> 5; AttnOfs a;
#pragma unroll
    for (int ks = 0; ks < 4; ++ks) a.k[ks] = r32 * 128 + (((2 * ks + hi) ^ (r32 & 7)) << 4);
    const int vkey = 4 * hi + ((lane & 15) >> 2), vcol = 16 * ((lane >> 4) & 1) + 4 * (lane & 3);
#pragma unroll
    for (int d0 = 0; d0 < 2; ++d0) a.v[d0] = vkey * 128 + (((4 * d0 + (vcol >> 3)) ^ vkey) << 4) + (vcol & 7) * 2;
    return a;
}
template <int CT, bool MASK, bool FIRST>
__device__ __forceinline__ void attn_chunk(const bf16x8 (&qf)[4], const AttnOfs& ao, const LAS unsigned char* Kb, const LAS unsigned char* Vb, int qpos, int kpos0, float slope2, LAS float* wsf, float& m, float& l, f32x16 (&o)[2]) {
    const int lane = threadIdx.x & 63, r32 = lane & 31, hi = lane >> 5;
    f32x16 s[CT];
#pragma unroll
    for (int t = 0; t < CT; ++t) {
#pragma unroll
        for (int r = 0; r < 16; ++r) s[t][r] = 0.f;
#pragma unroll
        for (int ks = 0; ks < 4; ++ks) { const bf16x8 kf = *(const LAS bf16x8*)(Kb + ao.k[ks] + t * 4096); s[t] = __builtin_amdgcn_mfma_f32_32x32x16_bf16(kf, qf[ks], s[t], 0, 0, 0); }
    }
    const float C2 = 0.125f * LOG2E;
    float mx = -1e30f;
    if (MASK) {
        int dbase = qpos - kpos0 - 4 * hi; asm volatile("" : "+v"(dbase));
        const float fdb = (float)dbase, lim = (float)(qpos < 127 ? qpos : 127), ns = -slope2;
#pragma unroll
        for (int t = 0; t < CT; ++t)
#pragma unroll
            for (int r = 0; r < 16; ++r) {
                const float fd = fdb - (float)(32 * t + (r & 3) + 8 * (r >> 2));
                float v = __builtin_fmaf(ns, fd, s[t][r] * C2);
                v = (fd >= 0.f && fd <= lim) ? v : -1e30f;
                s[t][r] = v; mx = fmaxf(mx, v);
            }
    } else {
#pragma unroll
        for (int t = 0; t < CT; ++t)
#pragma unroll
            for (int r = 0; r < 16; ++r) { const float v = s[t][r] * C2; s[t][r] = v; mx = fmaxf(mx, v); }
    }
    mx = fmaxf(mx, __shfl_xor(mx, 32));
    const float mn = fmaxf(m, mx), alpha = __builtin_amdgcn_exp2f(m - mn);
    m = mn;
    float sum = 0.f;
#pragma unroll
    for (int t = 0; t < CT; ++t)
#pragma unroll
        for (int r = 0; r < 16; ++r) { const float e = __builtin_amdgcn_exp2f(s[t][r] - mn); s[t][r] = e; sum += e; }
    l = l * alpha + sum;
    if (!FIRST) {
        if (hi == 0) wsf[r32] = alpha;
        asm volatile("s_waitcnt lgkmcnt(0)" ::: "memory");
#pragma unroll
        for (int r = 0; r < 16; ++r) { const float a = wsf[crow(r, hi)]; o[0][r] *= a; o[1][r] *= a; }
        asm volatile("s_waitcnt lgkmcnt(0)" ::: "memory");
    }
#pragma unroll
    for (int t = 0; t < CT; ++t)
#pragma unroll
        for (int k2 = 0; k2 < 2; ++k2) {
            u32x4 pw; pw.x = cvtpk(s[t][8 * k2 + 0], s[t][8 * k2 + 1]); pw.y = cvtpk(s[t][8 * k2 + 2], s[t][8 * k2 + 3]); pw.z = cvtpk(s[t][8 * k2 + 4], s[t][8 * k2 + 5]); pw.w = cvtpk(s[t][8 * k2 + 6], s[t][8 * k2 + 7]);
            const bf16x8 pa = __builtin_bit_cast(bf16x8, pw);
#pragma unroll
            for (int d0 = 0; d0 < 2; ++d0) {
                const LAS unsigned char* vp = Vb + ao.v[d0] + (32 * t + 16 * k2) * 128;
                const s16x4 lo = vtr(vp), hh = vtr(vp + 1024);
                const bf16x8 vf = (bf16x8){lo[0], lo[1], lo[2], lo[3], hh[0], hh[1], hh[2], hh[3]};
                o[d0] = __builtin_amdgcn_mfma_f32_32x32x16_bf16(pa, vf, o[d0], 0, 0, 0);
            }
        }
}
__device__ __forceinline__ void attn_init(bool mask, float sink2, float& m, float& l, f32x16 (&o)[2]) {
    const int hi = (threadIdx.x & 63) >> 5;
    m = mask ? sink2 : -1e30f; l = (mask && hi == 0) ? 1.f : 0.f;
#pragma unroll
    for (int r = 0; r < 16; ++r) { o[0][r] = 0.f; o[1][r] = 0.f; }
}
__device__ __forceinline__ void attn_finish(float l, LAS float* wsf, f32x16 (&o)[2], LAS unsigned short* stg) {
    const int lane = threadIdx.x & 63, r32 = lane & 31, hi = lane >> 5;
    l += __shfl_xor(l, 32);
    if (hi == 0) wsf[r32] = 1.0f / l;
    asm volatile("s_waitcnt lgkmcnt(0)" ::: "memory");
#pragma unroll
    for (int r = 0; r < 16; ++r) { const float li = wsf[crow(r, hi)]; const int q = crow(r, hi);
        stg[q * 64 + r32] = (unsigned short)(cvtpk(o[0][r] * li, 0.f) & 0xffffu); stg[q * 64 + 32 + r32] = (unsigned short)(cvtpk(o[1][r] * li, 0.f) & 0xffffu); }
    asm volatile("s_waitcnt lgkmcnt(0)" ::: "memory");
}
__device__ __forceinline__ void attn_swa(const bf16x8 (&qf)[4], const AttnOfs& ao, const LAS unsigned char* Kb, const LAS unsigned char* Vb, int qpos, int kpos0, float slope2, float sink2, LAS float* wsf, LAS unsigned short* stg) {
    float m, l; f32x16 o[2]; attn_init(true, sink2, m, l, o);
    attn_chunk<3, true, true>(qf, ao, Kb, Vb, qpos, kpos0, slope2, wsf, m, l, o);
    attn_chunk<2, true, false>(qf, ao, Kb + 96 * 128, Vb + 96 * 128, qpos, kpos0 + 96, slope2, wsf, m, l, o);
    attn_finish(l, wsf, o, stg);
}
__device__ __forceinline__ void attn_mem(const bf16x8 (&qf)[4], const AttnOfs& ao, const LAS unsigned char* Kb, const LAS unsigned char* Vb, LAS float* wsf, LAS unsigned short* stg) {
    float m, l; f32x16 o[2]; attn_init(false, 0.f, m, l, o);
    attn_chunk<2, false, true>(qf, ao, Kb, Vb, 0, 0, 0.f, wsf, m, l, o);
#pragma unroll 1
    for (int c = 1; c < 4; ++c) attn_chunk<2, false, false>(qf, ao, Kb + c * 64 * 128, Vb + c * 64 * 128, 0, 0, 0.f, wsf, m, l, o);
    attn_finish(l, wsf, o, stg);
}
__device__ __forceinline__ void stage_out(const LAS unsigned short* stg, bf16_t* gdst, size_t ld) {
    const int lane = threadIdx.x & 63;
#pragma unroll
    for (int i = 0; i < 4; ++i) { const int row = i * 8 + (lane >> 3), ch = lane & 7; *(u32x4*)(gdst + (size_t)row * ld + ch * 8) = *(const LAS u32x4*)(stg + row * 64 + ch * 8); }
    asm volatile("s_waitcnt lgkmcnt(0)" ::: "memory");
}

__device__ __forceinline__ void unit_swa_prompt(const Params& P, LAS unsigned char* lds, LAS float* wsf, int b, int qb, int g) {
    const int tid = threadIdx.x, lane = tid & 63, wave = __builtin_amdgcn_readfirstlane(tid >> 6), r32 = lane & 31, hi = lane >> 5;
    const bf16_t* Qg = (const bf16_t*)(P.ws + WS_Q); const bf16_t* Kg = (const bf16_t*)(P.ws + WS_K); const bf16_t* Vg = (const bf16_t*)(P.ws + WS_V); bf16_t* Og = (bf16_t*)(P.ws + WS_O);
    LAS unsigned char* Kl = lds; LAS unsigned char* Vl = lds + 49152; LAS unsigned short* stg = (LAS unsigned short*)(lds + 98304 + wave * 4096);
#pragma unroll 2
    for (int idx = tid; idx < 384 * 8; idx += 512) {
        const int row = idx >> 3, ch = idx & 7, t = 256 * qb - 128 + row;
        u32x4 kv = (u32x4){0u, 0u, 0u, 0u}, vv = kv;
        if (t >= 0) { const size_t o = (size_t)(b * SEQ + t) * 256 + g * 64 + ch * 8; kv = *(const u32x4*)(Kg + o); vv = *(const u32x4*)(Vg + o); }
        *(LAS u32x4*)(Kl + kv_off(row, ch)) = kv; *(LAS u32x4*)(Vl + kv_off(row, ch)) = vv;
    }
    __syncthreads();
    const AttnOfs ao = attn_ofs();
    const int t0 = 256 * qb + 32 * wave;
#pragma unroll 1
    for (int hh = 0; hh < 3; ++hh) {
        const int head = 3 * g + hh;
        bf16x8 qf[4];
#pragma unroll
        for (int ks = 0; ks < 4; ++ks) qf[ks] = *(const bf16x8*)(Qg + (size_t)(b * SEQ + t0 + r32) * 768 + head * 64 + 16 * ks + 8 * hi);
        attn_swa(qf, ao, Kl + 32 * wave * 128, Vl + 32 * wave * 128, t0 + r32, t0 - 128, alibi_slope(head) * LOG2E, P.in[14][head] * LOG2E, wsf, stg);
        stage_out(stg, Og + (size_t)(b * SEQ + t0) * DM + head * 64, DM);
    }
    __syncthreads();
}

__device__ __forceinline__ void unit_mem_prompt(const Params& P, LAS unsigned char* lds, LAS float* wsf, int layer, int b, int qb, int h) {
    const int tid = threadIdx.x, lane = tid & 63, wave = __builtin_amdgcn_readfirstlane(tid >> 6), r32 = lane & 31, hi = lane >> 5;
    const bf16_t* XQ = (const bf16_t*)(P.ws + WS_XQ); bf16_t* Og = (bf16_t*)(P.ws + WS_O);
    const bf16_t* MK = (const bf16_t*)(P.ws + WS_MK) + (size_t)layer * MMEM * 256; const bf16_t* MV = (const bf16_t*)(P.ws + WS_MV) + (size_t)layer * MMEM * 256;
    LAS unsigned char* Kl = lds; LAS unsigned char* Vl = lds + 32768; LAS unsigned short* stg = (LAS unsigned short*)(lds + 98304 + wave * 4096);
#pragma unroll 2
    for (int idx = tid; idx < 256 * 8; idx += 512) {
        const int row = idx >> 3, ch = idx & 7; const size_t o = (size_t)(b * NMEM + row) * 256 + h * 64 + ch * 8;
        *(LAS u32x4*)(Kl + kv_off(row, ch)) = *(const u32x4*)(MK + o); *(LAS u32x4*)(Vl + kv_off(row, ch)) = *(const u32x4*)(MV + o);
    }
    __syncthreads();
    const AttnOfs ao = attn_ofs();
    const int t0 = 256 * qb + 32 * wave;
    bf16x8 qf[4];
#pragma unroll
    for (int ks = 0; ks < 4; ++ks) qf[ks] = *(const bf16x8*)(XQ + (size_t)(b * SEQ + t0 + r32) * 256 + h * 64 + 16 * ks + 8 * hi);
    attn_mem(qf, ao, Kl, Vl, wsf, stg);
    stage_out(stg, Og + (size_t)(b * SEQ + t0) * DM + 768 + h * 64, DM);
    __syncthreads();
}

__device__ __forceinline__ u32x4 ld8f_pack(const float* p) { const f32x4 a = *(const f32x4*)p, b = *(const f32x4*)(p + 4); return pack8(a, b); }

__device__ __forceinline__ void unit_swa_sample(const Params& P, LAS unsigned char* lds, LAS float* wsf, int n, int gp) {
    const int tid = threadIdx.x, lane = tid & 63, wave = __builtin_amdgcn_readfirstlane(tid >> 6), r32 = lane & 31, hi = lane >> 5;
    const bf16_t* Qg = (const bf16_t*)(P.ws + WS_Q); const bf16_t* Kg = (const bf16_t*)(P.ws + WS_K); const bf16_t* Vg = (const bf16_t*)(P.ws + WS_V); bf16_t* Og = (bf16_t*)(P.ws + WS_O);
#pragma unroll 1
    for (int idx = tid; idx < 2 * 160 * 8; idx += 512) {
        const int gi = idx / 1280, rem = idx % 1280, row = rem >> 3, ch = rem & 7, g = 2 * gp + gi;
        LAS unsigned char* Kl = lds + gi * 40960; LAS unsigned char* Vl = Kl + 20480;
        u32x4 kv = (u32x4){0u, 0u, 0u, 0u}, vv = kv;
        if (row < 128) { const size_t o = ((size_t)(n * 128 + row) * 4 + g) * 64 + ch * 8; kv = ld8f_pack(P.in[2] + o); vv = ld8f_pack(P.in[3] + o); }
        else if (row < 132) { const size_t o = (size_t)(MP + 4 * n + row - 128) * 256 + g * 64 + ch * 8; kv = *(const u32x4*)(Kg + o); vv = *(const u32x4*)(Vg + o); }
        *(LAS u32x4*)(Kl + kv_off(row, ch)) = kv; *(LAS u32x4*)(Vl + kv_off(row, ch)) = vv;
    }
    __syncthreads();
    if (wave < 2) {
        LAS unsigned short* stg = (LAS unsigned short*)(lds + 98304 + wave * 4096);
        const AttnOfs ao = attn_ofs();
        const int g = 2 * gp + wave; const bool qv = r32 < 12; const int hh = qv ? (r32 >> 2) : 0, sidx = r32 & 3, head = 3 * g + hh;
        bf16x8 qf[4];
#pragma unroll
        for (int ks = 0; ks < 4; ++ks) { qf[ks] = *(const bf16x8*)(Qg + (size_t)(MP + 4 * n + sidx) * 768 + head * 64 + 16 * ks + 8 * hi); if (!qv) qf[ks] = (bf16x8){0, 0, 0, 0, 0, 0, 0, 0}; }
        const LAS unsigned char* Kl = lds + wave * 40960;
        attn_swa(qf, ao, Kl, Kl + 20480, 128 + sidx, 0, alibi_slope(head) * LOG2E, P.in[14][head] * LOG2E, wsf, stg);
        for (int i = lane; i < 96; i += 64) { const int q = i >> 3, ch = i & 7;
            *(u32x4*)(Og + (size_t)(MP + 4 * n + (q & 3)) * DM + (3 * g + (q >> 2)) * 64 + ch * 8) = *(const LAS u32x4*)(stg + q * 64 + ch * 8); }
        asm volatile("s_waitcnt lgkmcnt(0)" ::: "memory");
    }
    __syncthreads();
}

__device__ __forceinline__ void unit_mem_sample(const Params& P, LAS unsigned char* lds, LAS float* wsf, int layer, int n, int hp) {
    const int tid = threadIdx.x, lane = tid & 63, wave = __builtin_amdgcn_readfirstlane(tid >> 6), r32 = lane & 31, hi = lane >> 5;
    const bf16_t* XQ = (const bf16_t*)(P.ws + WS_XQ); bf16_t* Og = (bf16_t*)(P.ws + WS_O);
    const float* ck = P.in[4] + (size_t)(layer * NDEC + n) * NMEM * 256; const float* cv = P.in[5] + (size_t)(layer * NDEC + n) * NMEM * 256;
#pragma unroll 2
    for (int idx = tid; idx < 256 * 16; idx += 512) {
        const int row = idx >> 4, hsel = (idx >> 3) & 1, ch = idx & 7; const size_t o = (size_t)row * 256 + (2 * hp + hsel) * 64 + ch * 8;
        LAS unsigned char* Kl = lds + hsel * 65536;
        *(LAS u32x4*)(Kl + kv_off(row, ch)) = ld8f_pack(ck + o); *(LAS u32x4*)(Kl + 32768 + kv_off(row, ch)) = ld8f_pack(cv + o);
    }
    __syncthreads();
    if (wave < 2) {
        LAS unsigned short* stg = (LAS unsigned short*)(lds + OSTG2_OFF + wave * 4096);
        const AttnOfs ao = attn_ofs();
        const int h = 2 * hp + wave; const bool qv = r32 < 4;
        bf16x8 qf[4];
#pragma unroll
        for (int ks = 0; ks < 4; ++ks) { qf[ks] = *(const bf16x8*)(XQ + (size_t)(MP + 4 * n + (r32 & 3)) * 256 + h * 64 + 16 * ks + 8 * hi); if (!qv) qf[ks] = (bf16x8){0, 0, 0, 0, 0, 0, 0, 0}; }
        const LAS unsigned char* Kl = lds + wave * 65536;
        attn_mem(qf, ao, Kl, Kl + 32768, wsf, stg);
        if (lane < 32) { const int q = lane >> 3, ch = lane & 7;
            *(u32x4*)(Og + (size_t)(MP + 4 * n + q) * DM + 768 + h * 64 + ch * 8) = *(const LAS u32x4*)(stg + q * 64 + ch * 8); }
        asm volatile("s_waitcnt lgkmcnt(0)" ::: "memory");
    }
    __syncthreads();
}

__device__ __forceinline__ void unit_gmlp_prompt(const Params& P, LAS unsigned char* lds, int b, int c) {
    const int tid = threadIdx.x, lane = tid & 63, wave = __builtin_amdgcn_readfirstlane(tid >> 6), r32 = lane & 31, hi = lane >> 5;
    const bf16_t* U = (const bf16_t*)(P.ws + WS_U); const bf16_t* GV = (const bf16_t*)(P.ws + WS_GV); bf16_t* Og = (bf16_t*)(P.ws + WS_O);
    const bf16_t* WST = (const bf16_t*)(P.ws + WS_WST); const float* ssqv = (const float*)(P.ws + WS_SSQ) + 4 * M;
    const float* vg = P.in[17]; const float* bs = P.in[19]; float* cvp = P.out + O_CVP;
    const int rowb = b * SEQ + c * 128;
    const int ib = wave & 3, cb0 = 3 * (wave >> 2);
#pragma unroll 1
    for (int g = 0; g < 4; ++g) {
        for (int idx = tid; idx < 128 * 24; idx += 512) {
            const int j = idx / 24, ch = idx % 24; const int row = rowb + j, col = g * 192 + ch * 8;
            const float rv = rsqrtf(ssqv[row] * (1.f / 768.f) + EPS);
            const u32x4 w = *(const u32x4*)(GV + (size_t)row * 768 + col);
            const f32x4 g0 = *(const f32x4*)(vg + col), g1 = *(const f32x4*)(vg + col + 4);
            f32x4 v0 = (f32x4){bflo(w.x), bfhi(w.x), bflo(w.y), bfhi(w.y)}, v1 = (f32x4){bflo(w.z), bfhi(w.z), bflo(w.w), bfhi(w.w)};
            v0 = v0 * rv * g0; v1 = v1 * rv * g1;
            *(LAS u32x4*)(lds + j * 384 + ch * 16) = pack8(v0, v1);
            if (c == 31) { float* o = cvp + (size_t)(b * 128 + j) * 768 + col; *(f32x4*)o = v0; *(f32x4*)(o + 4) = v1; }
        }
        __syncthreads();
        f32x16 acc[3];
#pragma unroll
        for (int i = 0; i < 3; ++i)
#pragma unroll
            for (int r = 0; r < 16; ++r) acc[i][r] = 0.f;
        const int nks = 2 * (ib + 1);
#pragma unroll 1
        for (int ks = 0; ks < nks; ++ks) {
            const bf16x8 af = *(const bf16x8*)(WST + (size_t)(g * 128 + 32 * ib + r32) * 128 + 16 * ks + 8 * hi);
            const int j0 = 16 * ks + 8 * hi + ((lane & 15) >> 2);
#pragma unroll
            for (int i = 0; i < 3; ++i) {
                const int col = 32 * (cb0 + i) + 16 * ((lane >> 4) & 1) + 4 * (lane & 3);
                const s16x4 lo = vtr(lds + j0 * 384 + col * 2), hh = vtr(lds + (j0 + 4) * 384 + col * 2);
                const bf16x8 vf = (bf16x8){lo[0], lo[1], lo[2], lo[3], hh[0], hh[1], hh[2], hh[3]};
                acc[i] = __builtin_amdgcn_mfma_f32_32x32x16_bf16(af, vf, acc[i], 0, 0, 0);
            }
        }
        LAS float* stg = (LAS float*)(lds + 49152 + wave * 4096);
#pragma unroll 1
        for (int i = 0; i < 3; ++i) {
            const f32x16 a = i == 0 ? acc[0] : i == 1 ? acc[1] : acc[2];
#pragma unroll
            for (int r = 0; r < 16; ++r) { const int q = crow(r, hi); stg[q * 32 + r32] = a[r] + bs[g * 128 + 32 * ib + q]; }
            asm volatile("s_waitcnt lgkmcnt(0)" ::: "memory");
            const int q = lane >> 1, hf = lane & 1; const size_t ro = (size_t)(rowb + 32 * ib + q); const int col = g * 192 + 32 * (cb0 + i) + 16 * hf;
            const u32x4 u0 = *(const u32x4*)(U + ro * 768 + col), u1 = *(const u32x4*)(U + ro * 768 + col + 8);
            const LAS f32x4* sp = (const LAS f32x4*)(stg + q * 32 + 16 * hf);
            const f32x4 m0 = sp[0], m1 = sp[1], m2 = sp[2], m3 = sp[3];
            u32x4 o0, o1;
            o0.x = cvtpk(bflo(u0.x) * m0[0], bfhi(u0.x) * m0[1]); o0.y = cvtpk(bflo(u0.y) * m0[2], bfhi(u0.y) * m0[3]); o0.z = cvtpk(bflo(u0.z) * m1[0], bfhi(u0.z) * m1[1]); o0.w = cvtpk(bflo(u0.w) * m1[2], bfhi(u0.w) * m1[3]);
            o1.x = cvtpk(bflo(u1.x) * m2[0], bfhi(u1.x) * m2[1]); o1.y = cvtpk(bflo(u1.y) * m2[2], bfhi(u1.y) * m2[3]); o1.z = cvtpk(bflo(u1.z) * m3[0], bfhi(u1.z) * m3[1]); o1.w = cvtpk(bflo(u1.w) * m3[2], bfhi(u1.w) * m3[3]);
            *(u32x4*)(Og + ro * DM + col) = o0; *(u32x4*)(Og + ro * DM + col + 8) = o1;
            asm volatile("s_waitcnt lgkmcnt(0)" ::: "memory");
        }
        __syncthreads();
    }
}

__device__ __forceinline__ void gmlp_sample(const Params& P, int G, int bid) {
    const bf16_t* U = (const bf16_t*)(P.ws + WS_U); const bf16_t* GV = (const bf16_t*)(P.ws + WS_GV); bf16_t* Og = (bf16_t*)(P.ws + WS_O);
    const float* ssqv = (const float*)(P.ws + WS_SSQ) + 4 * M; const float* vg = P.in[17]; const float* wsb = P.in[18]; const float* bs = P.in[19]; float* cvs = P.out + O_CVS;
    for (int i = bid * 512 + threadIdx.x; i < NDEC * 768; i += G * 512) {
        const int n = i / 768, col = i % 768, g = col / 192; float vn[4];
#pragma unroll
        for (int s = 0; s < 4; ++s) { const int row = MP + 4 * n + s; vn[s] = bf2f(GV[(size_t)row * 768 + col]) * rsqrtf(ssqv[row] * (1.f / 768.f) + EPS) * vg[col]; cvs[(size_t)(4 * n + s) * 768 + col] = vn[s]; }
#pragma unroll
        for (int s = 0; s < 4; ++s) { float mx = bs[g * 128 + s];
#pragma unroll
            for (int j = 0; j < 4; ++j) if (j <= s) mx += wsb[(size_t)(g * 128 + s) * 128 + j] * vn[j];
            const int row = MP + 4 * n + s; Og[(size_t)row * DM + col] = f2bf_s(bf2f(U[(size_t)row * 768 + col]) * mx); }
    }
}


__global__ void __launch_bounds__(512, 2) mk_fwd(Params P) {
    extern __shared__ __attribute__((aligned(16))) unsigned char lds_raw[];
    LAS unsigned char* lds = (LAS unsigned char*)lds_raw;
    const int tid = threadIdx.x, wave = __builtin_amdgcn_readfirstlane(tid >> 6);
    const int G = gridDim.x, bid = blockIdx.x;
    LAS float* wsf = (LAS float*)(lds + WSF_OFF) + wave * 64;
    unsigned char* ws = P.ws;
    float* ssq = (float*)(ws + WS_SSQ);
    bf16_t* XB = (bf16_t*)(ws + WS_XB);
    cg::grid_group grid = cg::this_grid();
    const int lo = P.ph_lo, hi = P.ph_hi;
#ifndef PH_MASK
#define PH_MASK 0x1fff
#endif
#define IN(k) (((PH_MASK >> (k)) & 1) && lo <= (k) && (k) < hi)
#define SEAM(k) do { if (IN(k) && IN((k) + 1)) grid.sync(); } while (0)

    if (IN(0)) { for (int rep = 0; rep < (DUP == 0 ? 2 : 1); ++rep) p0_prologue(P, lds, G, bid); }
    SEAM(0);
    const int gwave = bid * 8 + wave, NW = G * 8;
    const bf16_t* XBs = XB;
    if (IN(1)) {
        EpiInA E{ssq, (bf16_t*)(ws + WS_Q), (const float*)(ws + WS_GT), P.out};
        { pg8::Gemm g{XB, (const bf16_t*)(ws + WS_WINA), DM, DM}; pg8::StaticOrder S; S.init(MP, NINA, G, bid);
          pg8::gemm_phase<EpiInA, true, true>(lds, g, S, E); }
        { pg8::Gemm g{(const bf16_t*)(ws + WS_MEMB), (const bf16_t*)(ws + WS_WMKV), DM, DM}; pg8::StaticOrder S; S.init(MMEM, 1024, G, bid);
          EpiMemKV E2{ssq + 5 * M, P.in[23], P.out + O_MKP, P.out + O_MVP, (bf16_t*)(ws + WS_MK), (bf16_t*)(ws + WS_MV)};
          pg8::gemm_phase<EpiMemKV, true, true>(lds, g, S, E2); }
        if (bid >= 32) sample_gemm<4, 4>(lds, XBs, DM, (const bf16_t*)(ws + WS_WINA), 6, E, bid - 32, G - 32);
    }
    SEAM(1);
    if (IN(2)) {
        for (int rep = 0; rep < (DUP == 2 ? 2 : 1); ++rep)
        for (int uidx = bid; uidx < 1536; uidx += G) {
            if (uidx < 512) unit_swa_prompt(P, lds, wsf, uidx >> 6, (uidx >> 2) & 15, uidx & 3);
            else if (uidx < 1024) { const int v = uidx - 512; unit_mem_prompt(P, lds, wsf, 0, v >> 6, (v >> 2) & 15, v & 3); }
            else if (uidx < 1280) { const int v = uidx - 1024; unit_mem_sample(P, lds, wsf, 0, v >> 1, v & 1); }
            else { const int v = uidx - 1280; unit_swa_sample(P, lds, wsf, v >> 1, v & 1); }
        }
    }
    SEAM(2);
    if (IN(3)) {
        pg8::Gemm g{(const bf16_t*)(ws + WS_O), (const bf16_t*)(ws + WS_WOUTA), DM, DM}; pg8::StaticOrder S; S.init(MP, DM, G, bid);
        EpiRes E{P.in[0], P.in[1], P.out + O_Y, XB, ssq + M};
        pg8::gemm_phase<EpiRes, true, true>(lds, g, S, E);
        sample_gemm<2, 4>(lds, (const bf16_t*)(ws + WS_O), DM, (const bf16_t*)(ws + WS_WOUTA), 4, E, bid, G);
    }
    SEAM(3);
    if (IN(4)) {
        pg8::Gemm g{XB, (const bf16_t*)(ws + WS_WFFN), DM, DM}; pg8::StaticOrder S; S.init(MP, NFF, G, bid);
        EpiFfnConv E{ssq + M, (bf16_t*)(ws + WS_H), P.in[25], P.in[26], (float*)(ws + WS_SIDE), P.out + O_CONVP, (LAS float*)(lds + RING_BYTES)};
        pg8::gemm_phase<EpiFfnConv, true, true>(lds, g, S, E);
        sample_ffn(P, lds, 0, ssq + M, bid, G);
    }
    SEAM(4);
    if (IN(5)) {
        pg8::Gemm g{(const bf16_t*)(ws + WS_H), (const bf16_t*)(ws + WS_WDOWN), DFF, DFF}; pg8::StaticOrder S; S.init(MP, DM, G, bid);
        ffn_fixup(P, 0, S);
        EpiRes E{P.out + O_Y, P.out + O_Y + (size_t)MP * DM, P.out + O_Y, XB, ssq + 2 * M};
        pg8::gemm_phase<EpiRes, true, true>(lds, g, S, E);
        sample_gemm<2, 11>(lds, (const bf16_t*)(ws + WS_H), DFF, (const bf16_t*)(ws + WS_WDOWN), 4, E, bid, G);
    }
    SEAM(5);
    if (IN(6)) {
        pg8::Gemm g{XB, (const bf16_t*)(ws + WS_WINB), DM, DM}; pg8::StaticOrder S; S.init(MP, NINB, G, bid);
        EpiInB E{ssq + 2 * M, (bf16_t*)(ws + WS_U), (bf16_t*)(ws + WS_GV), (bf16_t*)(ws + WS_XQ), P.in[22] + 64, ssq + 4 * M};
        pg8::gemm_phase<EpiInB, true, true>(lds, g, S, E);
        if (bid >= G / 2) sample_gemm<4, 4>(lds, XBs, DM, (const bf16_t*)(ws + WS_WINB), 7, E, bid - G / 2, G - G / 2);
    }
    SEAM(6);
    if (IN(7)) {
        for (int rep = 0; rep < (DUP == 7 ? 2 : 1); ++rep)
        for (int uidx = bid; uidx < 1024; uidx += G) {
            if (uidx < 256) unit_gmlp_prompt(P, lds, uidx >> 5, uidx & 31);
            else if (uidx < 768) { const int v = uidx - 256; unit_mem_prompt(P, lds, wsf, 1, v >> 6, (v >> 2) & 15, v & 3); }
            else { const int v = uidx - 768; unit_mem_sample(P, lds, wsf, 1, v >> 1, v & 1); }
        }
        gmlp_sample(P, G, bid);
    }
    SEAM(7);
    if (IN(8)) {
        pg8::Gemm g{(const bf16_t*)(ws + WS_O), (const bf16_t*)(ws + WS_WOUTB), DM, DM}; pg8::StaticOrder S; S.init(MP, DM, G, bid);
        EpiRes E{P.out + O_Y, P.out + O_Y + (size_t)MP * DM, P.out + O_Y, XB, ssq + 3 * M};
        pg8::gemm_phase<EpiRes, true, true>(lds, g, S, E);
        sample_gemm<2, 4>(lds, (const bf16_t*)(ws + WS_O), DM, (const bf16_t*)(ws + WS_WOUTB), 4, E, bid, G);
    }
    SEAM(8);
    if (IN(9)) {
        pg8::Gemm g{XB, (const bf16_t*)(ws + WS_WFFN) + (size_t)NFF * DM, DM, DM}; pg8::StaticOrder S; S.init(MP, NFF, G, bid);
        EpiFfnConv E{ssq + 3 * M, (bf16_t*)(ws + WS_H), P.in[25] + 3 * DFF, P.in[26] + DFF, (float*)(ws + WS_SIDE), P.out + O_CONVP + (size_t)NBATCH * 2 * DFF, (LAS float*)(lds + RING_BYTES)};
        pg8::gemm_phase<EpiFfnConv, true, true>(lds, g, S, E);
        sample_ffn(P, lds, 1, ssq + 3 * M, bid, G);
    }
    SEAM(9);
    if (IN(10)) {
        pg8::Gemm g{(const bf16_t*)(ws + WS_H), (const bf16_t*)(ws + WS_WDOWN) + (size_t)DM * DFF, DFF, DFF}; pg8::StaticOrder S; S.init(MP, DM, G, bid);
        ffn_fixup(P, 1, S);
        EpiRes E{P.out + O_Y, P.out + O_Y + (size_t)MP * DM, P.out + O_Y, nullptr, nullptr};
        pg8::gemm_phase<EpiRes, true, true>(lds, g, S, E);
        sample_gemm<2, 11>(lds, (const bf16_t*)(ws + WS_H), DFF, (const bf16_t*)(ws + WS_WDOWN) + (size_t)DM * DFF, 4, E, bid, G);
    }
#undef IN
#undef SEAM
}

extern "C" void kernel_launch(void* const* d_in, const int* in_sizes, int n_in, void* d_out, int out_size, void* d_ws, size_t ws_size, hipStream_t stream) {
    static int grid = 0;
    if (grid == 0) {
        if (n_in != 28 || (size_t)out_size != O_END || ws_size < WS_END) { fprintf(stderr, "kernel_launch: unexpected shapes: n_in %d out %d ws %zu (need %zu)\n", n_in, out_size, ws_size, (size_t)WS_END); grid = -1; return; }
        int dev = 0, cus = 0, per_cu = 0;
        hipGetDevice(&dev); hipDeviceGetAttribute(&cus, hipDeviceAttributeMultiprocessorCount, dev);
        if (hipFuncSetAttribute((const void*)mk_fwd, hipFuncAttributeMaxDynamicSharedMemorySize, LDS_BYTES) != hipSuccess) { fprintf(stderr, "kernel_launch: hipFuncSetAttribute failed\n"); grid = -1; return; }
        hipOccupancyMaxActiveBlocksPerMultiprocessor(&per_cu, (const void*)mk_fwd, 512, LDS_BYTES);
        (void)hipGetLastError();
        if (per_cu < 1) { fprintf(stderr, "kernel_launch: occupancy query says %d blocks per CU\n", per_cu); per_cu = 1; }
        grid = cus;
    }
    if (grid < 0) return;
    Params p{};
    for (int i = 0; i < 28; ++i) p.in[i] = (const float*)d_in[i];
    p.out = (float*)d_out; p.ws = (unsigned char*)d_ws;
#if MK_N_LAUNCHES == 1
    p.ph_lo = 0; p.ph_hi = NPHASE;
    void* args[] = {&p};
    hipError_t e = hipLaunchCooperativeKernel((const void*)mk_fwd, dim3(grid), dim3(512), args, LDS_BYTES, stream);
    if (e != hipSuccess) fprintf(stderr, "cooperative launch failed: %s (grid %d)\n", hipGetErrorString(e), grid);
#else
    for (int ph = 0; ph < NPHASE; ++ph) {
        p.ph_lo = ph; p.ph_hi = ph + 1;
        hipLaunchKernelGGL(mk_fwd, dim3(grid), dim3(512), LDS_BYTES, stream, p);
    }
#endif
}
```

```cpp
#include <hip/hip_runtime.h>
#include <hip/hip_cooperative_groups.h>
#include <cstdio>
#include <cstdint>
namespace cg = cooperative_groups;

#ifndef MK_N_LAUNCHES
#define MK_N_LAUNCHES 1
#endif

#ifndef DUP
#define DUP -1
#endif
#define LAS __attribute__((address_space(3)))
typedef unsigned short bf16_t;
typedef short bf16x8 __attribute__((ext_vector_type(8)));
typedef short s16x4 __attribute__((ext_vector_type(4)));
typedef float f32x4 __attribute__((ext_vector_type(4)));
typedef float f32x2 __attribute__((ext_vector_type(2)));
typedef float f32x16 __attribute__((ext_vector_type(16)));
typedef unsigned u32x4 __attribute__((ext_vector_type(4)));
typedef unsigned u32x2 __attribute__((ext_vector_type(2)));
typedef __bf16 bf16x2_t __attribute__((ext_vector_type(2)));

constexpr int DM = 1024, NBATCH = 8, SEQ = 4096, MP = NBATCH * SEQ, NDEC = 128, DSEQ = 4, MS = NDEC * DSEQ, M = MP + MS;
constexpr int NMEM = 256, MMEM = NBATCH * NMEM;
constexpr int DFF = 2816, NFF = 2 * DFF;
constexpr int NINA = 1536, NINB = 1792;
constexpr float EPS = 1e-6f;
constexpr float LOG2E = 1.4426950408889634f;
constexpr int NPHASE = 11;

constexpr size_t O_Y = 0, O_WKP = 34078720, O_WVP = 34340864, O_CVP = 34603008, O_MKP = 35389440, O_MVP = 36438016, O_CONVP = 37486592,
                 O_WKS = 37576704, O_WVS = 41771008, O_CVS = 45965312, O_CONVS = 46358528, O_END = 47800320;

constexpr size_t MiB = 1u << 20;
constexpr size_t WS_SSQ = 0, WS_GT = 1 * MiB, WS_CTL = 1 * MiB + 65536, CTL_BYTES = 16384;
constexpr size_t WS_WINA = 2 * MiB, WS_WOUTA = 5 * MiB, WS_WINB = 7 * MiB, WS_WOUTB = 11 * MiB, WS_WMKV = 13 * MiB, WS_WFFN = 15 * MiB,
                 WS_WDOWN = 37 * MiB, WS_WST = 48 * MiB;
constexpr size_t WS_MEMB = 50 * MiB, WS_MK = 54 * MiB, WS_MV = 56 * MiB;
constexpr size_t WS_XB = 58 * MiB;
constexpr size_t WS_H = 124 * MiB;
constexpr size_t WS_Q = WS_H, WS_K = WS_Q + (size_t)M * 768 * 2, WS_V = WS_K + (size_t)M * 256 * 2, WS_XQ = WS_V + (size_t)M * 256 * 2,
                 WS_O = WS_XQ + (size_t)M * 256 * 2, WS_U = WS_O + (size_t)M * 1024 * 2, WS_GV = WS_U + (size_t)M * 768 * 2;
constexpr size_t WS_SIDE = 384 * MiB, SIDE_N = (size_t)128 * 2 * DFF;
constexpr size_t WS_END = WS_SIDE + 3 * SIDE_N * 4;
static_assert(WS_GV + (size_t)M * 768 * 2 <= WS_SIDE && WS_H + (size_t)M * DFF * 2 <= WS_SIDE, "mixer buffers / hidden below the side buffers");
static_assert(WS_END <= 512 * MiB, "ws");

namespace pg8 {
constexpr int BM = 256, BK = 64, HALF = 128, HTB = HALF * BK * 2, STAGE_BYTES = 8 * HTB, NXCD = 8, WGM = 8;
__host__ __device__ __forceinline__ int lds_byte(int r, int c) { const int st = (r >> 4) * 2 + (c >> 5), rr = r & 15, cc = c & 31, ob = rr * 64 + cc * 2; return st * 1024 + (ob ^ (((ob >> 9) & 1) << 5)); }
__host__ __device__ __forceinline__ void stage_rc(int b, int& R, int& C) { const int st = b / 1024, sb = b % 1024, swz = sb ^ (((sb >> 9) & 1) << 5); R = (st >> 1) * 16 + swz / 64; C = (st & 1) * 32 + (swz % 64) / 2; }
__host__ __device__ __forceinline__ int perm32(int rho) { const int n = rho >> 4, i = rho & 15; return 8 * (i >> 2) + 4 * n + (i & 3); }

struct Unit { int pm, pn; };
struct Gemm { const bf16_t* A; const bf16_t* Bt; int lda, K; };

struct StaticOrder {
    int nM, nN, nwg, G, c;
    __device__ void init(int Mr, int N, int G_, int c_) { nM = Mr / BM; nN = N / BM; nwg = nM * nN; G = G_; c = c_; }
    __device__ bool next(int i, Unit& u) const {
        const long L = (long)i * G + c; if (L >= nwg) return false;
        int wgid = (int)L; { const int q = nwg / NXCD, r = nwg % NXCD, xcd = wgid % NXCD, off = wgid / NXCD; wgid = (xcd < r ? xcd * (q + 1) : r * (q + 1) + (xcd - r) * q) + off; }
        const int nig = WGM * nN, gid = wgid / nig, fm = gid * WGM, gsz = (nM - fm) < WGM ? (nM - fm) : WGM;
        u.pm = fm + ((wgid % nig) % gsz); u.pn = (wgid % nig) / gsz; return true;
    }
};

template <class Epi, bool ALIGN_EPI, bool SP2>
__device__ __forceinline__ void gemm_phase(LAS unsigned char* lds, const Gemm g, const StaticOrder& S, const Epi& E) {
    const int tid = threadIdx.x, wid = __builtin_amdgcn_readfirstlane(tid >> 6), lane = tid & 63, wr = wid >> 2, wc = wid & 3, fr = lane & 15, fq = lane >> 4;
    const int K = g.K, nt = K / BK, lda = g.lda;
    unsigned voffA[2], voffB[2];
#pragma unroll
    for (int i = 0; i < 2; ++i) { int R, C; stage_rc(tid * 16 + i * 8192, R, C); const int Rb = (R & ~31) + perm32(R & 31);
        voffA[i] = (unsigned)(R * lda + C) * 2u; voffB[i] = (unsigned)(Rb * K + C) * 2u; }
    const size_t kstep = (size_t)(BK * 2);
    const size_t hstepA = (size_t)HALF * lda * 2, hstepB = (size_t)HALF * K * 2;
    const size_t tstepA = 2 * hstepA, tstepB = 2 * hstepB;
    const unsigned ldsw = (unsigned)wid * 1024u;
    const int aoff = lds_byte(wr * 64 + fr, fq * 8), boff = lds_byte(wc * 32 + fr, fq * 8);
#define PG8_SA(b, h) (((b) * 2 + (h)) * HTB)
#define PG8_SB(b, h) ((4 + (b) * 2 + (h)) * HTB)
#define PG8_STAGE(bufoff, gbase, voff) do { _Pragma("unroll") for (int _i = 0; _i < 2; ++_i) \
        __builtin_amdgcn_global_load_lds((const unsigned*)((const char*)(gbase) + (voff)[_i]), (LAS unsigned*)(lds + (bufoff) + ldsw + _i * 8192), 16, 0, 0); } while (0)
#define PG8_LDA(dst, b, h) do { _Pragma("unroll") for (int m = 0; m < 4; ++m) _Pragma("unroll") for (int k = 0; k < 2; ++k) dst[m][k] = *(const LAS bf16x8*)(lds + PG8_SA(b, h) + aoff + m * 2048 + k * 1024); } while (0)
#define PG8_LDB(dst, b, h) do { _Pragma("unroll") for (int n = 0; n < 2; ++n) _Pragma("unroll") for (int k = 0; k < 2; ++k) dst[n][k] = *(const LAS bf16x8*)(lds + PG8_SB(b, h) + boff + n * 2048 + k * 1024); } while (0)
#define PG8_MMA(ai, bj, At, Bt) do { __builtin_amdgcn_s_setprio(1); _Pragma("unroll") for (int m = 0; m < 4; ++m) _Pragma("unroll") for (int n = 0; n < 2; ++n) _Pragma("unroll") for (int k = 0; k < 2; ++k) \
        acc[ai][bj][m][n] = __builtin_amdgcn_mfma_f32_16x16x32_bf16(Bt[n][k], At[m][k], acc[ai][bj][m][n], 0, 0, 0); __builtin_amdgcn_s_setprio(0); } while (0)
#define PG8_WAIT_V(n) asm volatile("s_waitcnt vmcnt(" #n ")" ::: "memory")
#define PG8_WAIT_L(n) asm volatile("s_waitcnt lgkmcnt(" #n ")" ::: "memory")
#define PG8_BAR __builtin_amdgcn_s_barrier()
#define PG8_SCHED __builtin_amdgcn_sched_barrier(0)
    Unit cur, nxt; int ui = 0;
    if (!S.next(0, cur)) return;
    f32x4 acc[2][2][4][2];
#pragma unroll
    for (int a = 0; a < 2; ++a)
#pragma unroll
        for (int b = 0; b < 2; ++b)
#pragma unroll
            for (int m = 0; m < 4; ++m)
#pragma unroll
                for (int n = 0; n < 2; ++n) acc[a][b][m][n] = (f32x4){0.f, 0.f, 0.f, 0.f};
    bf16x8 At[4][2], B0[2][2], B1[2][2];
    const char* cA = (const char*)g.A + (size_t)cur.pm * tstepA; const char* cB = (const char*)g.Bt + (size_t)cur.pn * tstepB;
    if constexpr (SP2) {
        PG8_STAGE(PG8_SB(0, 0), cB, voffB); PG8_STAGE(PG8_SB(0, 1), cB + hstepB, voffB); PG8_STAGE(PG8_SA(0, 0), cA, voffA); PG8_STAGE(PG8_SA(0, 1), cA + hstepA, voffA);
        if (wr == 1) PG8_BAR;
        PG8_WAIT_V(2); PG8_BAR;
        PG8_STAGE(PG8_SB(1, 0), cB + kstep, voffB); PG8_STAGE(PG8_SA(1, 0), cA + kstep, voffA); PG8_STAGE(PG8_SB(1, 1), cB + hstepB + kstep, voffB);
        PG8_WAIT_V(6); PG8_BAR;
    } else {
        PG8_STAGE(PG8_SB(0, 0), cB, voffB); PG8_STAGE(PG8_SA(0, 0), cA, voffA); PG8_STAGE(PG8_SB(0, 1), cB + hstepB, voffB); PG8_STAGE(PG8_SA(0, 1), cA + hstepA, voffA);
        if (wr == 1) PG8_BAR;
        PG8_WAIT_V(4); PG8_BAR;
        PG8_STAGE(PG8_SB(1, 0), cB + kstep, voffB); PG8_STAGE(PG8_SA(1, 0), cA + kstep, voffA); PG8_STAGE(PG8_SB(1, 1), cB + hstepB + kstep, voffB);
        PG8_WAIT_V(6); PG8_BAR;
    }
    for (;;) {
        const bool has_next = S.next(ui + 1, nxt);
        const char* nA = has_next ? (const char*)g.A + (size_t)nxt.pm * tstepA : cA; const char* nB = has_next ? (const char*)g.Bt + (size_t)nxt.pn * tstepB : cB;
        for (int t = 0; t < nt; t += 2) {
            const bool last = (t == nt - 2);
            const char* a1 = cA + (size_t)(t + 1) * kstep;
            const char* a2 = last ? nA : cA + (size_t)(t + 2) * kstep; const char* b2 = last ? nB : cB + (size_t)(t + 2) * kstep;
            const char* a3 = a2 + kstep; const char* b3 = b2 + kstep;
            if constexpr (SP2) {
            PG8_LDB(B0, 0, 0); PG8_LDB(B1, 0, 1); PG8_SCHED; PG8_LDA(At, 0, 0); PG8_STAGE(PG8_SA(1, 1), a1 + hstepA, voffA);
            PG8_WAIT_V(8); PG8_WAIT_L(0); PG8_BAR; PG8_MMA(0, 0, At, B0); PG8_MMA(0, 1, At, B1); PG8_BAR; PG8_SCHED;
            PG8_LDA(At, 0, 1); PG8_STAGE(PG8_SB(0, 0), b2, voffB); PG8_STAGE(PG8_SB(0, 1), b2 + hstepB, voffB); PG8_STAGE(PG8_SA(0, 0), a2, voffA);
            PG8_WAIT_V(8); PG8_WAIT_L(0); PG8_BAR; PG8_MMA(1, 0, At, B0); PG8_MMA(1, 1, At, B1); PG8_BAR; PG8_SCHED;
            PG8_LDB(B0, 1, 0); PG8_LDB(B1, 1, 1); PG8_SCHED; PG8_LDA(At, 1, 0); PG8_STAGE(PG8_SA(0, 1), a2 + hstepA, voffA);
            PG8_WAIT_V(8); PG8_WAIT_L(0); PG8_BAR; PG8_MMA(0, 0, At, B0); PG8_MMA(0, 1, At, B1); PG8_BAR; PG8_SCHED;
            PG8_LDA(At, 1, 1); PG8_STAGE(PG8_SB(1, 0), b3, voffB); PG8_STAGE(PG8_SB(1, 1), b3 + hstepB, voffB); PG8_STAGE(PG8_SA(1, 0), a3, voffA);
            PG8_WAIT_V(8); PG8_WAIT_L(0); PG8_BAR; PG8_MMA(1, 0, At, B0); PG8_MMA(1, 1, At, B1); PG8_BAR; PG8_SCHED;
            } else {
            PG8_LDB(B0, 0, 0); PG8_SCHED; PG8_LDA(At, 0, 0); PG8_STAGE(PG8_SA(1, 1), a1 + hstepA, voffA);
            PG8_WAIT_L(8); PG8_BAR; PG8_WAIT_L(0); PG8_MMA(0, 0, At, B0); PG8_BAR; PG8_SCHED;
            PG8_LDB(B1, 0, 1); PG8_STAGE(PG8_SB(0, 0), b2, voffB);
            PG8_BAR; PG8_WAIT_L(0); PG8_MMA(0, 1, At, B1); PG8_BAR;
            PG8_LDA(At, 0, 1); PG8_STAGE(PG8_SA(0, 0), a2, voffA);
            PG8_BAR; PG8_WAIT_L(0); PG8_MMA(1, 0, At, B0); PG8_BAR; PG8_SCHED;
            PG8_STAGE(PG8_SB(0, 1), b2 + hstepB, voffB);
            PG8_WAIT_V(6); PG8_BAR; PG8_MMA(1, 1, At, B1); PG8_BAR;
            PG8_LDB(B0, 1, 0); PG8_SCHED; PG8_LDA(At, 1, 0); PG8_STAGE(PG8_SA(0, 1), a2 + hstepA, voffA);
            PG8_WAIT_L(8); PG8_BAR; PG8_WAIT_L(0); PG8_MMA(0, 0, At, B0); PG8_BAR; PG8_SCHED;
            PG8_LDB(B1, 1, 1); PG8_STAGE(PG8_SB(1, 0), b3, voffB);
            PG8_BAR; PG8_WAIT_L(0); PG8_MMA(0, 1, At, B1); PG8_BAR;
            PG8_LDA(At, 1, 1); PG8_STAGE(PG8_SA(1, 0), a3, voffA);
            PG8_BAR; PG8_WAIT_L(0); PG8_MMA(1, 0, At, B0); PG8_BAR; PG8_SCHED;
            PG8_STAGE(PG8_SB(1, 1), b3 + hstepB, voffB);
            PG8_WAIT_V(6); PG8_BAR; PG8_MMA(1, 1, At, B1); PG8_BAR;
            }
        }
        if constexpr (ALIGN_EPI) { if (wr == 0) PG8_BAR; }
        E(acc, cur, wr, wc, fr, fq);
        if (!has_next) break;
#pragma unroll
        for (int a = 0; a < 2; ++a)
#pragma unroll
            for (int b = 0; b < 2; ++b)
#pragma unroll
                for (int m = 0; m < 4; ++m)
#pragma unroll
                    for (int n = 0; n < 2; ++n) acc[a][b][m][n] = (f32x4){0.f, 0.f, 0.f, 0.f};
        cur = nxt; cA = nA; cB = nB; ++ui;
        if constexpr (ALIGN_EPI) { if (wr == 1) PG8_BAR; }
    }
    PG8_WAIT_V(0);
    if constexpr (!ALIGN_EPI) { if (wr == 0) PG8_BAR; }
    PG8_BAR;
#undef PG8_SA
#undef PG8_SB
#undef PG8_STAGE
#undef PG8_LDA
#undef PG8_LDB
#undef PG8_MMA
#undef PG8_WAIT_V
#undef PG8_WAIT_L
#undef PG8_BAR
#undef PG8_SCHED
}
}
using pg8::Unit;

constexpr int RING_BYTES = 131072, WSF_OFF = RING_BYTES, OSTG2_OFF = RING_BYTES + 4096, LDS_BYTES = 147456;
__device__ __forceinline__ unsigned cvtpk(float lo, float hi) { f32x2 v = {lo, hi}; bf16x2_t b = __builtin_convertvector(v, bf16x2_t); return __builtin_bit_cast(unsigned, b); }
__device__ __forceinline__ u32x4 pack8(const f32x4 a, const f32x4 b) { u32x4 w; w.x = cvtpk(a[0], a[1]); w.y = cvtpk(a[2], a[3]); w.z = cvtpk(b[0], b[1]); w.w = cvtpk(b[2], b[3]); return w; }
__device__ __forceinline__ float bf2f(unsigned short h) { return __uint_as_float((unsigned)h << 16); }
__device__ __forceinline__ float bflo(unsigned w) { return __uint_as_float(w << 16); }
__device__ __forceinline__ float bfhi(unsigned w) { return __uint_as_float(w & 0xffff0000u); }
__device__ __forceinline__ float wave_sum(float v) {
#pragma unroll
    for (int o = 1; o < 64; o <<= 1) v += __shfl_xor(v, o);
    return v;
}
__device__ __forceinline__ f32x2 gelu_pk(f32x2 v) {
    const f32x2 av = __builtin_elementwise_abs(v), d = av * 0.2316418882f + 1.0f;
    f32x2 t; t.x = __builtin_amdgcn_rcpf(d.x); t.y = __builtin_amdgcn_rcpf(d.y);
    f32x2 q = t * 0.5307027145f + (-0.7265760135f); q = q * t + 0.7107068705f; q = q * t + (-0.142248368f); q = q * t + 0.127414796f; q = q * t;
    const f32x2 s = (v * v) * (-0.72134752044f);
    f32x2 e; e.x = __builtin_amdgcn_exp2f(s.x); e.y = __builtin_amdgcn_exp2f(s.y);
    const f32x2 m = v * (q * e), r = v - m;
    f32x2 o; o.x = v.x < 0.f ? m.x : r.x; o.y = v.y < 0.f ? m.y : r.y; return o;
}
__device__ __forceinline__ f32x4 gelu4(f32x4 v) { const f32x2 a = gelu_pk((f32x2){v[0], v[1]}), b = gelu_pk((f32x2){v[2], v[3]}); return (f32x4){a.x, a.y, b.x, b.y}; }
__device__ __forceinline__ float dot4(f32x4 v) { return (v[0] * v[0] + v[1] * v[1]) + (v[2] * v[2] + v[3] * v[3]); }
__device__ __forceinline__ unsigned short f2bf_s(float f) { return (unsigned short)(cvtpk(f, 0.f) & 0xffffu); }
__device__ __forceinline__ float alibi_slope(int h) { return h < 8 ? exp2f(-(float)(h + 1)) : exp2f(-0.5f - (float)(h - 8)); }

struct Params {
    const float* in[28];
    float* out;
    unsigned char* ws;
    int ph_lo, ph_hi;
};

#define EPI_ARGS const f32x4 (&acc)[2][2][4][2], const Unit& u, int wr, int wc, int fr, int fq
#define FOR_AI_M _Pragma("unroll") for (int ai = 0; ai < 2; ++ai) _Pragma("unroll") for (int m = 0; m < 4; ++m)
#define BIG_ROWS(E) do { const int row0_ = u.pm * 256 + wr * 64 + fr; FOR_AI_M { f32x4 v_[2][2]; \
    _Pragma("unroll") for (int bj = 0; bj < 2; ++bj) _Pragma("unroll") for (int n = 0; n < 2; ++n) v_[bj][n] = acc[ai][bj][m][n]; \
    (E).row(v_, row0_ + ai * 128 + m * 16, u.pn, wc, fq); } } while (0)

__device__ __forceinline__ void head_norm(f32x4 (&v)[2][2], const float* gp, int fq) {
    float ss = (dot4(v[0][0]) + dot4(v[0][1])) + (dot4(v[1][0]) + dot4(v[1][1]));
    ss += __shfl_xor(ss, 16); ss += __shfl_xor(ss, 32);
    const float inv = rsqrtf(ss * (1.f / 64.f) + EPS);
#pragma unroll
    for (int bj = 0; bj < 2; ++bj)
#pragma unroll
        for (int n = 0; n < 2; ++n) { const f32x4 g = *(const f32x4*)(gp + 32 * bj + 8 * fq + 4 * n); v[bj][n] = v[bj][n] * inv * g; }
}

struct EpiInA {
    const float* ssq; bf16_t* Qb; const float* gt; float* out;
    __device__ __forceinline__ void row(f32x4 (&v)[2][2], int row, int pn, int wc, int fq) const {
        const int typ = pn < 3 ? 0 : pn - 2;
        const size_t doff = typ == 0 ? 0 : (size_t)M * 768 + (size_t)(typ - 1) * M * 256;
        const int ld = typ == 0 ? 768 : 256, cb = typ == 0 ? (pn * 4 + wc) * 64 : wc * 64;
        const float rs = rsqrtf(ssq[row] * (1.f / 1024.f) + EPS);
#pragma unroll
        for (int bj = 0; bj < 2; ++bj)
#pragma unroll
            for (int n = 0; n < 2; ++n) v[bj][n] = v[bj][n] * rs;
        if (typ != 2) head_norm(v, gt + typ * 64, fq);
#pragma unroll
        for (int bj = 0; bj < 2; ++bj) *(u32x4*)(Qb + doff + (size_t)row * ld + cb + 32 * bj + 8 * fq) = pack8(v[bj][0], v[bj][1]);
        if (typ == 1 || typ == 2) {
            long wo = -1;
            if (row >= MP) { const int ns = row - MP; wo = (long)O_WKS + (long)(typ - 1) * (long)(O_WVS - O_WKS) + (long)((ns >> 2) * 128 + 124 + (ns & 3)) * 256; }
            else if ((row & 4095) >= 3968) { const int b = row >> 12, t = row & 4095; wo = (long)O_WKP + (long)(typ - 1) * (long)(O_WVP - O_WKP) + (long)(b * 128 + t - 3968) * 256; }
            if (wo >= 0) { float* wout = out + wo;
#pragma unroll
                for (int bj = 0; bj < 2; ++bj)
#pragma unroll
                    for (int n = 0; n < 2; ++n) *(f32x4*)(wout + wc * 64 + 32 * bj + 8 * fq + 4 * n) = v[bj][n];
            }
        }
    }
    __device__ __forceinline__ void operator()(EPI_ARGS) const { BIG_ROWS(*this); }
};

struct EpiMemKV {
    const float* ssq; const float* xk; float *outk, *outv; bf16_t *MK, *MV;
    __device__ __forceinline__ void row(f32x4 (&v)[2][2], int row, int pn, int wc, int fq) const {
        const int layer = pn >> 1; const bool isv = pn & 1;
        float* of = (isv ? outv : outk) + (size_t)layer * MMEM * 256; bf16_t* ob = (isv ? MV : MK) + (size_t)layer * MMEM * 256;
        const float rs = rsqrtf(ssq[row] * (1.f / 1024.f) + EPS);
#pragma unroll
        for (int bj = 0; bj < 2; ++bj)
#pragma unroll
            for (int n = 0; n < 2; ++n) v[bj][n] = v[bj][n] * rs;
        if (!isv) head_norm(v, xk + layer * 64, fq);
#pragma unroll
        for (int bj = 0; bj < 2; ++bj) {
            const size_t o = (size_t)row * 256 + wc * 64 + 32 * bj + 8 * fq;
            *(u32x4*)(ob + o) = pack8(v[bj][0], v[bj][1]);
            *(f32x4*)(of + o) = v[bj][0]; *(f32x4*)(of + o + 4) = v[bj][1];
        }
    }
    __device__ __forceinline__ void operator()(EPI_ARGS) const { BIG_ROWS(*this); }
};

template <bool IN32, bool OUT32>
struct EpiRes {
    const float* xin_p; const float* xin_s; float* xout; bf16_t* xb; float* ssq;
    __device__ __forceinline__ void row(f32x4 (&v)[2][2], int row, int pn, int wc, int fq) const {
        const int col0 = pn * 256 + wc * 32 + 8 * fq;
        float ss = 0.f;
#pragma unroll
        for (int bj = 0; bj < 2; ++bj) {
            f32x4 x0, x1;
            if (IN32) { const float* src = (row < MP ? xin_p + (size_t)row * DM : xin_s + (size_t)(row - MP) * DM) + col0 + 128 * bj; x0 = *(const f32x4*)src; x1 = *(const f32x4*)(src + 4); }
            else { const u32x4 w = *(const u32x4*)(xb + (size_t)row * DM + col0 + 128 * bj); x0 = (f32x4){bflo(w.x), bfhi(w.x), bflo(w.y), bfhi(w.y)}; x1 = (f32x4){bflo(w.z), bfhi(w.z), bflo(w.w), bfhi(w.w)}; }
            x0 += v[bj][0]; x1 += v[bj][1];
            if (OUT32) { float* o = xout + (size_t)row * DM + col0 + 128 * bj; *(f32x4*)o = x0; *(f32x4*)(o + 4) = x1; }
            else { *(u32x4*)(xb + (size_t)row * DM + col0 + 128 * bj) = pack8(x0, x1); ss += dot4(x0) + dot4(x1); }
        }
        if (!OUT32) { ss += __shfl_xor(ss, 16); ss += __shfl_xor(ss, 32); if (fq == 0) atomicAdd(ssq + row, ss); }
    }
    __device__ __forceinline__ void operator()(EPI_ARGS) const { BIG_ROWS(*this); }
};

template <int CTRL> __device__ __forceinline__ float dpp_f(float x) { return __int_as_float(__builtin_amdgcn_update_dpp(0, __float_as_int(x), CTRL, 0xf, 0xf, false)); }
__device__ __forceinline__ float silu_f(float c) { return c * __builtin_amdgcn_rcpf(1.f + __builtin_amdgcn_exp2f(-c * LOG2E)); }

struct EpiFfnConv {
    const float* ssq; bf16_t* H; const float* cw; const float* cbp; float* side; float* convp; LAS float* xch;
    __device__ __forceinline__ void operator()(EPI_ARGS) const {
        const int pm = u.pm, ts = pm & 15, col0 = u.pn * 128 + wc * 32 + 8 * fq;
        const int rowbase = pm * 256 + wr * 64 + fr;
        if (fr >= 14) {
#pragma unroll
            for (int ai = 0; ai < 2; ++ai) {
                const float rs = rsqrtf(ssq[rowbase + ai * 128 + 48] * (1.f / 1024.f) + EPS);
                LAS float* x = xch + ((2 * ai + wr) * 2 + (fr - 14)) * 128 + wc * 32 + 8 * fq;
                *(LAS f32x4*)x = acc[ai][0][3][0] * rs; *(LAS f32x4*)(x + 4) = acc[ai][0][3][1] * rs;
            }
        }
        asm volatile("s_waitcnt lgkmcnt(0)" ::: "memory"); __builtin_amdgcn_s_barrier(); asm volatile("" ::: "memory");
        float w0[8], w1[8], w2[8], cb[8];
#pragma unroll
        for (int e = 0; e < 8; ++e) { w0[e] = cw[col0 + e]; w1[e] = cw[DFF + col0 + e]; w2[e] = cw[2 * DFF + col0 + e]; cb[e] = cbp[col0 + e]; }
#pragma unroll
        for (int ai = 0; ai < 2; ++ai) {
            const int blk = 2 * ai + wr;
            float prev[8];
            if (blk > 0) { const LAS float* x = xch + ((blk - 1) * 2 + (fr >= 14 ? fr - 14 : 0)) * 128 + wc * 32 + 8 * fq; const f32x4 p0 = *(const LAS f32x4*)x, p1 = *(const LAS f32x4*)(x + 4);
#pragma unroll
                for (int e = 0; e < 4; ++e) { prev[e] = p0[e]; prev[4 + e] = p1[e]; } }
            else {
#pragma unroll
                for (int e = 0; e < 8; ++e) prev[e] = 0.f; }
#pragma unroll
            for (int m = 0; m < 4; ++m) {
                const int row = rowbase + ai * 128 + m * 16;
                const float rs = rsqrtf(ssq[row] * (1.f / 1024.f) + EPS);
                float a[8], c[8], h[8], up[8];
#pragma unroll
                for (int e = 0; e < 8; ++e) { a[e] = acc[ai][0][m][e >> 2][e & 3] * rs; up[e] = acc[ai][1][m][e >> 2][e & 3] * rs; }
#pragma unroll
                for (int e = 0; e < 8; ++e) {
                    const float s1 = fr == 15 ? prev[e] : a[e], s2 = fr >= 14 ? prev[e] : a[e];
                    const float p1 = dpp_f<0x121>(s1), p2 = dpp_f<0x122>(s2);
                    c[e] = cb[e] + w0[e] * p2 + w1[e] * p1 + w2[e] * a[e];
                    h[e] = silu_f(c[e]) * up[e];
                }
                u32x4 w; w.x = cvtpk(h[0], h[1]); w.y = cvtpk(h[2], h[3]); w.z = cvtpk(h[4], h[5]); w.w = cvtpk(h[6], h[7]);
                *(u32x4*)(H + (size_t)row * DFF + col0) = w;
                if (ai == 0 && m == 0) { if (wr == 0 && ts > 0 && fr < 2) { float* d = side + (size_t)(pm * 2 + fr) * DFF + col0;
                        *(f32x4*)d = (f32x4){c[0], c[1], c[2], c[3]}; *(f32x4*)(d + 4) = (f32x4){c[4], c[5], c[6], c[7]};
                        *(f32x4*)(d + SIDE_N) = (f32x4){up[0], up[1], up[2], up[3]}; *(f32x4*)(d + SIDE_N + 4) = (f32x4){up[4], up[5], up[6], up[7]}; } }
                if (ai == 1 && m == 3) { if (wr == 1 && fr >= 14) { float* d = ts < 15 ? side + 2 * SIDE_N + (size_t)(pm * 2 + fr - 14) * DFF + col0 : convp + (size_t)((pm >> 4) * 2 + fr - 14) * DFF + col0;
                        *(f32x4*)d = (f32x4){a[0], a[1], a[2], a[3]}; *(f32x4*)(d + 4) = (f32x4){a[4], a[5], a[6], a[7]}; } }
#pragma unroll
                for (int e = 0; e < 8; ++e) prev[e] = a[e];
            }
        }
    }
};
__device__ __forceinline__ void ffn_fixup(const Params& P, int layer, const pg8::StaticOrder& S) {
    bf16_t* H = (bf16_t*)(P.ws + WS_H); const float* side = (const float*)(P.ws + WS_SIDE); const float* cw = P.in[25] + (size_t)layer * 3 * DFF;
    Unit u; int last = -1;
    for (int i = 0; S.next(i, u); ++i) {
        const int pm = u.pm; if ((pm & 15) == 0 || pm == last) continue; last = pm;
        for (int c4 = threadIdx.x; c4 < DFF / 4; c4 += 512) { const int col = 4 * c4;
            const f32x4 cp0 = *(const f32x4*)(side + (size_t)(pm * 2) * DFF + col), cp1 = *(const f32x4*)(side + (size_t)(pm * 2 + 1) * DFF + col);
            const f32x4 u0 = *(const f32x4*)(side + SIDE_N + (size_t)(pm * 2) * DFF + col), u1 = *(const f32x4*)(side + SIDE_N + (size_t)(pm * 2 + 1) * DFF + col);
            const f32x4 am2 = *(const f32x4*)(side + 2 * SIDE_N + (size_t)((pm - 1) * 2) * DFF + col), am1 = *(const f32x4*)(side + 2 * SIDE_N + (size_t)((pm - 1) * 2 + 1) * DFF + col);
            const f32x4 w0 = *(const f32x4*)(cw + col), w1 = *(const f32x4*)(cw + DFF + col);
            const f32x4 c0 = cp0 + w0 * am2 + w1 * am1, c1 = cp1 + w0 * am1;
            u32x2 h0, h1;
            h0.x = cvtpk(silu_f(c0[0]) * u0[0], silu_f(c0[1]) * u0[1]); h0.y = cvtpk(silu_f(c0[2]) * u0[2], silu_f(c0[3]) * u0[3]);
            h1.x = cvtpk(silu_f(c1[0]) * u1[0], silu_f(c1[1]) * u1[1]); h1.y = cvtpk(silu_f(c1[2]) * u1[2], silu_f(c1[3]) * u1[3]);
            *(u32x2*)(H + (size_t)(pm * 256) * DFF + col) = h0; *(u32x2*)(H + (size_t)(pm * 256 + 1) * DFF + col) = h1; }
    }
    asm volatile("s_waitcnt vmcnt(0)" ::: "memory"); __syncthreads();
}

struct EpiInB {
    const float* ssq; bf16_t *U, *GV, *XQ; const float* xg; float* ssqv;
    __device__ __forceinline__ void row(f32x4 (&v)[2][2], int row, int pn, int wc, int fq) const {
        const float rs = rsqrtf(ssq[row] * (1.f / 1024.f) + EPS);
        if (pn < 6) {
            bf16_t* dst = pn < 3 ? U : GV; const int col0 = (pn % 3) * 256 + wc * 32 + 8 * fq;
            float ss = 0.f;
#pragma unroll
            for (int bj = 0; bj < 2; ++bj) {
                const f32x4 v0 = gelu4(v[bj][0] * rs), v1 = gelu4(v[bj][1] * rs);
                *(u32x4*)(dst + (size_t)row * 768 + col0 + 128 * bj) = pack8(v0, v1);
                ss += dot4(v0) + dot4(v1);
            }
            if (pn >= 3) { ss += __shfl_xor(ss, 16); ss += __shfl_xor(ss, 32); if (fq == 0) atomicAdd(ssqv + row, ss); }
        } else {
#pragma unroll
            for (int bj = 0; bj < 2; ++bj)
#pragma unroll
                for (int n = 0; n < 2; ++n) v[bj][n] = v[bj][n] * rs;
            head_norm(v, xg, fq);
#pragma unroll
            for (int bj = 0; bj < 2; ++bj) *(u32x4*)(XQ + (size_t)row * 256 + wc * 64 + 32 * bj + 8 * fq) = pack8(v[bj][0], v[bj][1]);
        }
    }
    __device__ __forceinline__ void operator()(EPI_ARGS) const { BIG_ROWS(*this); }
};

template <int MB, int NS>
__device__ __forceinline__ void wave_gemm_part(const bf16_t* A, int lda, int row0, const bf16_t* Bt, int K, int pn, int wc, int k0, f32x4 (&acc)[MB][2][2]) {
    const int lane = threadIdx.x & 63, fr = lane & 15, fq = lane >> 4;
    const bf16_t* ap = A + (size_t)(row0 + fr) * lda + 8 * fq + k0;
    const bf16_t* bp[2][2];
#pragma unroll
    for (int bj = 0; bj < 2; ++bj)
#pragma unroll
        for (int n = 0; n < 2; ++n) bp[bj][n] = Bt + (size_t)(pn * 256 + 128 * bj + 32 * wc + pg8::perm32(16 * n + fr)) * K + 8 * fq + k0;
#pragma unroll
    for (int m = 0; m < MB; ++m)
#pragma unroll
        for (int bj = 0; bj < 2; ++bj)
#pragma unroll
            for (int n = 0; n < 2; ++n) acc[m][bj][n] = (f32x4){0.f, 0.f, 0.f, 0.f};
#pragma unroll
    for (int s0 = 0; s0 < NS; s0 += 4) {
        bf16x8 af[4][MB], bf[4][2][2];
#pragma unroll
        for (int j = 0; j < 4; ++j) if (s0 + j < NS) {
#pragma unroll
            for (int m = 0; m < MB; ++m) af[j][m] = *(const bf16x8*)(ap + (size_t)m * 16 * lda + (s0 + j) * 32);
#pragma unroll
            for (int bj = 0; bj < 2; ++bj)
#pragma unroll
                for (int n = 0; n < 2; ++n) bf[j][bj][n] = *(const bf16x8*)(bp[bj][n] + (s0 + j) * 32);
        }
#pragma unroll
        for (int j = 0; j < 4; ++j) if (s0 + j < NS) {
#pragma unroll
            for (int m = 0; m < MB; ++m)
#pragma unroll
                for (int bj = 0; bj < 2; ++bj)
#pragma unroll
                    for (int n = 0; n < 2; ++n) acc[m][bj][n] = __builtin_amdgcn_mfma_f32_16x16x32_bf16(bf[j][bj][n], af[j][m], acc[m][bj][n], 0, 0, 0);
        }
    }
}
template <int MB>
__device__ __forceinline__ void sample_reduce_store(LAS unsigned char* lds, const f32x4 (&acc)[MB][2][2], int wave, int lane) {
    LAS f32x4* Pl = (LAS f32x4*)lds;
#pragma unroll
    for (int m = 0; m < MB; ++m)
#pragma unroll
        for (int bj = 0; bj < 2; ++bj)
#pragma unroll
            for (int n = 0; n < 2; ++n) Pl[((wave * MB + m) * 4 + bj * 2 + n) * 64 + lane] = acc[m][bj][n];
}
template <int MB>
__device__ __forceinline__ void sample_reduce_load(const LAS unsigned char* lds, f32x4 (&v)[2][2], int m, int lane) {
    const LAS f32x4* Pl = (const LAS f32x4*)lds;
#pragma unroll
    for (int bj = 0; bj < 2; ++bj)
#pragma unroll
        for (int n = 0; n < 2; ++n) { f32x4 sum = Pl[((0 * MB + m) * 4 + bj * 2 + n) * 64 + lane];
#pragma unroll
            for (int w = 1; w < 8; ++w) sum += Pl[((w * MB + m) * 4 + bj * 2 + n) * 64 + lane];
            v[bj][n] = sum; }
}
template <int MB, int NS, class Epi>
__device__ __forceinline__ void sample_gemm(LAS unsigned char* lds, const bf16_t* A, int lda, const bf16_t* Bt, int ntiles, const Epi& E, int blk, int nblk) {
    const int lane = threadIdx.x & 63, fr = lane & 15, fq = lane >> 4, wave = __builtin_amdgcn_readfirstlane(threadIdx.x >> 6);
    constexpr int NRB = MS / (16 * MB), K = 8 * NS * 32;
    const int ntask = NRB * ntiles * 4;
    for (int t = blk; t < ntask; t += nblk) {
        const int rb = t % NRB, cw = t / NRB, pn = cw >> 2, wc = cw & 3;
        f32x4 acc[MB][2][2];
        wave_gemm_part<MB, NS>(A, lda, MP + rb * 16 * MB, Bt, K, pn, wc, wave * NS * 32, acc);
        sample_reduce_store<MB>(lds, acc, wave, lane);
        __syncthreads();
        if (wave < MB) { f32x4 v[2][2]; sample_reduce_load<MB>(lds, v, wave, lane); E.row(v, MP + rb * 16 * MB + 16 * wave + fr, pn, wc, fq); }
        __syncthreads();
    }
}
__device__ __forceinline__ void sample_ffn(const Params& P, LAS unsigned char* lds, int layer, const float* ssq, int blk, int nblk) {
    const int lane = threadIdx.x & 63, fr = lane & 15, fq = lane >> 4, wave = __builtin_amdgcn_readfirstlane(threadIdx.x >> 6);
    const bf16_t* XB = (const bf16_t*)(P.ws + WS_XB); const bf16_t* Wt = (const bf16_t*)(P.ws + WS_WFFN) + (size_t)layer * NFF * DM; bf16_t* Hb = (bf16_t*)(P.ws + WS_H);
    const float* cw = P.in[25] + (size_t)layer * 3 * DFF; const float* cbp = P.in[26] + (size_t)layer * DFF; const float* st = P.in[6] + (size_t)layer * NDEC * 2 * DFF;
    float* convs = P.out + O_CONVS + (size_t)layer * NDEC * 2 * DFF;
    constexpr int MB = 4, NRB = MS / 64, NTASK = NRB * 22 * 4;
    for (int t = blk; t < NTASK; t += nblk) {
        const int rb = t % NRB, cwi = t / NRB, pn = cwi >> 2, wc = cwi & 3;
        f32x4 acc[MB][2][2];
        wave_gemm_part<MB, 4>(XB, DM, MP + rb * 64, Wt, DM, pn, wc, wave * 128, acc);
        sample_reduce_store<MB>(lds, acc, wave, lane);
        __syncthreads();
        if (wave < MB) {
            f32x4 v[2][2]; sample_reduce_load<MB>(lds, v, wave, lane);
            const int col0 = pn * 128 + wc * 32 + 8 * fq, s = fr & 3;
            const int row = MP + rb * 64 + 16 * wave + fr, nseq = (row - MP) >> 2;
            const float rs = rsqrtf(ssq[row] * (1.f / 1024.f) + EPS);
            float h[8];
#pragma unroll
            for (int e = 0; e < 8; ++e) {
                const float a = v[0][e >> 2][e & 3] * rs, up = v[1][e >> 2][e & 3] * rs;
                const float st0 = st[(size_t)(nseq * 2 + 0) * DFF + col0 + e], st1 = st[(size_t)(nseq * 2 + 1) * DFF + col0 + e];
                const float r1 = dpp_f<0x121>(a), r2 = dpp_f<0x122>(a);
                const float p1 = s >= 1 ? r1 : st1, p2 = s >= 2 ? r2 : (s == 1 ? st1 : st0);
                const float c = cbp[col0 + e] + cw[col0 + e] * p2 + cw[DFF + col0 + e] * p1 + cw[2 * DFF + col0 + e] * a;
                h[e] = silu_f(c) * up;
                if (s >= 2) convs[(size_t)(nseq * 2 + (s - 2)) * DFF + col0 + e] = a;
            }
            u32x4 w; w.x = cvtpk(h[0], h[1]); w.y = cvtpk(h[2], h[3]); w.z = cvtpk(h[4], h[5]); w.w = cvtpk(h[6], h[7]);
            *(u32x4*)(Hb + (size_t)row * DFF + col0) = w;
        }
        __syncthreads();
    }
}

__device__ __forceinline__ void p0_transpose_item(const float* W, int K, int N, const float* gain, bf16_t* WT, int kb, int n0, int drow0, LAS float* scr, int lane) {
    const int k0 = 64 * kb;
#pragma unroll 8
    for (int i = 0; i < 32; ++i) { const int kk = 2 * i + (lane >> 5); float w = W[(size_t)(k0 + kk) * N + n0 + (lane & 31)]; if (gain) w *= gain[k0 + kk]; scr[kk * 33 + (lane & 31)] = w; }
    asm volatile("s_waitcnt lgkmcnt(0)" ::: "memory");
    const int c = lane & 7;
#pragma unroll
    for (int j = 0; j < 4; ++j) { const int n = (lane >> 3) + 8 * j; const LAS float* s = scr + (8 * c) * 33 + n;
        u32x4 o; o.x = cvtpk(s[0 * 33], s[1 * 33]); o.y = cvtpk(s[2 * 33], s[3 * 33]); o.z = cvtpk(s[4 * 33], s[5 * 33]); o.w = cvtpk(s[6 * 33], s[7 * 33]);
        *(u32x4*)(WT + (size_t)(drow0 + n) * K + k0 + 8 * c) = o; }
    asm volatile("s_waitcnt lgkmcnt(0)" ::: "memory");
}
__device__ __forceinline__ int map_headperm(int nb) { const int p = (nb * 32) & 255, bj = p >> 7, wc = (p >> 5) & 3; return ((nb * 32) & ~255) + 64 * wc + 32 * bj; }
__device__ __forceinline__ int map_ffn(int nb) { const int tile = nb >> 3, p = (nb & 7) * 32; return p < 128 ? 128 * tile + p : DFF + 128 * tile + (p - 128); }

__device__ __forceinline__ void row_to_bf16(const float* xrow, bf16_t* orow, float* ssq, int lane) {
    const f32x4* xr = (const f32x4*)xrow + lane; f32x4 v[4]; float s = 0.f;
#pragma unroll
    for (int j = 0; j < 4; ++j) { v[j] = xr[64 * j]; s += dot4(v[j]); }
    s = wave_sum(s);
    u32x2* o8 = (u32x2*)orow + lane;
#pragma unroll
    for (int j = 0; j < 4; ++j) { u32x2 w; w.x = cvtpk(v[j][0], v[j][1]); w.y = cvtpk(v[j][2], v[j][3]); o8[64 * j] = w; }
    if (lane == 0) *ssq = s;
}

__device__ __forceinline__ void p0_prologue(const Params& P, LAS unsigned char* lds, int G, int bid) {
    const int tid = threadIdx.x, lane = tid & 63, wave = __builtin_amdgcn_readfirstlane(tid >> 6);
    LAS float* scr = (LAS float*)(lds + wave * 16384);
    const int gw = bid * 8 + wave, NGW = G * 8;
    unsigned char* ws = P.ws;
    float* ssq = (float*)(ws + WS_SSQ);
    constexpr int I0 = 16 * 48, I1 = 16 * 32, I2 = 16 * 56, I3 = 16 * 32, I4 = 16 * 16, I6 = 16 * 176, I8 = 44 * 32;
    constexpr int NITEMS = I0 + I1 + I2 + I3 + 2 * I4 + 2 * I6 + 2 * I8;
    for (int it = gw; it < NITEMS; it += NGW) {
        int r = it;
        if (r < I0) { const int nb = r % 48, kb = r / 48; p0_transpose_item(P.in[11], 1024, NINA, P.in[8], (bf16_t*)(ws + WS_WINA), kb, map_headperm(nb), 32 * nb, scr, lane); continue; } r -= I0;
        if (r < I1) { const int nb = r % 32, kb = r / 32; p0_transpose_item(P.in[15], 1024, 1024, nullptr, (bf16_t*)(ws + WS_WOUTA), kb, 32 * nb, 32 * nb, scr, lane); continue; } r -= I1;
        if (r < I2) { const int nb = r % 56, kb = r / 56; p0_transpose_item(P.in[16], 1024, NINB, P.in[8] + 1024, (bf16_t*)(ws + WS_WINB), kb, nb < 48 ? 32 * nb : map_headperm(nb), 32 * nb, scr, lane); continue; } r -= I2;
        if (r < I3) { const int nb = r % 32, kb = r / 32; p0_transpose_item(P.in[20], 1024, 1024, nullptr, (bf16_t*)(ws + WS_WOUTB), kb, 32 * nb, 32 * nb, scr, lane); continue; } r -= I3;
        if (r < 2 * I4) { const int l = r / I4; r -= l * I4; const int nb = r % 16, kb = r / 16;
            p0_transpose_item(P.in[21] + (size_t)l * 1024 * 512, 1024, 512, P.in[10] + l * 1024, (bf16_t*)(ws + WS_WMKV) + (size_t)l * 512 * 1024, kb, map_headperm(nb), 32 * nb, scr, lane); continue; } r -= 2 * I4;
        if (r < 2 * I6) { const int l = r / I6; r -= l * I6; const int nb = r % 176, kb = r / 176;
            p0_transpose_item(P.in[24] + (size_t)l * 1024 * NFF, 1024, NFF, P.in[9] + l * 1024, (bf16_t*)(ws + WS_WFFN) + (size_t)l * NFF * 1024, kb, map_ffn(nb), 32 * nb, scr, lane); continue; } r -= 2 * I6;
        { const int l = r / I8; r -= l * I8; const int nb = r % 32, kb = r / 32;
            p0_transpose_item(P.in[27] + (size_t)l * DFF * 1024, DFF, 1024, nullptr, (bf16_t*)(ws + WS_WDOWN) + (size_t)l * 1024 * DFF, kb, 32 * nb, 32 * nb, scr, lane); }
    }
    bf16_t* XB = (bf16_t*)(ws + WS_XB); bf16_t* MEMB = (bf16_t*)(ws + WS_MEMB);
    for (int r = gw; r < M + MMEM; r += NGW) {
        if (r < MP) row_to_bf16(P.in[0] + (size_t)r * DM, XB + (size_t)r * DM, ssq + r, lane);
        else if (r < M) row_to_bf16(P.in[1] + (size_t)(r - MP) * DM, XB + (size_t)r * DM, ssq + r, lane);
        else row_to_bf16(P.in[7] + (size_t)(r - M) * DM, MEMB + (size_t)(r - M) * DM, ssq + 5 * M + (r - M), lane);
    }
    const int gt = bid * 512 + tid, NGT = G * 512;
    for (int i = gt; i < 4 * M; i += NGT) ssq[M + i] = 0.f;
    if (gt < 256) { float* GT = (float*)(ws + WS_GT); const int t4 = gt >> 6, d = gt & 63; GT[gt] = t4 == 0 ? P.in[12][d] : t4 == 1 ? P.in[13][d] : t4 == 2 ? 1.f : P.in[22][d]; }
    { bf16_t* WST = (bf16_t*)(ws + WS_WST); const float* wsb = P.in[18];
      for (int i = gt; i < 4 * 128 * 128; i += NGT) { const int ii = (i >> 7) & 127, jj = i & 127; const float w = jj <= ii ? wsb[i] : 0.f; WST[i] = (bf16_t)(cvtpk(w, 0.f) & 0xffffu); } }
    { const f32x4* ck = (const f32x4*)P.in[2]; const f32x4* cv = (const f32x4*)P.in[3]; f32x4* ok = (f32x4*)(P.out + O_WKS); f32x4* ov = (f32x4*)(P.out + O_WVS);
      for (int i = gt; i < NDEC * 124 * 64; i += NGT) { const int n = i / (124 * 64), r = i % (124 * 64); const size_t s = (size_t)n * 128 * 64 + 4 * 64 + r, d = (size_t)n * 128 * 64 + r; ok[d] = ck[s]; ov[d] = cv[s]; } }
}

__device__ __forceinline__ int crow(int r, int hi) { return (r & 3) + 8 * (r >> 2) + 4 * hi; }
__device__ __forceinline__ int kv_off(int row, int chunk) { return row * 128 + ((chunk ^ (row & 7)) << 4); }
__device__ __forceinline__ s16x4 vtr(const LAS unsigned char* p) { return __builtin_bit_cast(s16x4, __builtin_amdgcn_ds_read_tr16_b64_v4i16((LAS s16x4*)p)); }

struct AttnOfs { int k[4]; int v[2]; };
__device__ __forceinline__ AttnOfs attn_ofs() {
    const int lane = threadIdx.x & 63, r32 = lane & 31, hi = lane >> 5; AttnOfs a;
#pragma unroll
    for (int ks = 0; ks < 4; ++ks) a.k[ks] = r32 * 128 + (((2 * ks + hi) ^ (r32 & 7)) << 4);
    const int vkey = 4 * hi + ((lane & 15) >> 2), vcol = 16 * ((lane >> 4) & 1) + 4 * (lane & 3);
#pragma unroll
    for (int d0 = 0; d0 < 2; ++d0) a.v[d0] = vkey * 128 + (((4 * d0 + (vcol >> 3)) ^ vkey) << 4) + (vcol & 7) * 2;
    return a;
}
template <int CT, bool MASK, bool FIRST>
__device__ __forceinline__ void attn_chunk(const bf16x8 (&qf)[4], const AttnOfs& ao, const LAS unsigned char* Kb, const LAS unsigned char* Vb, int qpos, int kpos0, float slope2, LAS float* wsf, float& m, float& l, f32x16 (&o)[2]) {
    const int lane = threadIdx.x & 63, r32 = lane & 31, hi = lane >> 5;
    f32x16 s[CT];
#pragma unroll
    for (int t = 0; t < CT; ++t) {
#pragma unroll
        for (int r = 0; r < 16; ++r) s[t][r] = 0.f;
#pragma unroll
        for (int ks = 0; ks < 4; ++ks) { const bf16x8 kf = *(const LAS bf16x8*)(Kb + ao.k[ks] + t * 4096); s[t] = __builtin_amdgcn_mfma_f32_32x32x16_bf16(kf, qf[ks], s[t], 0, 0, 0); }
    }
    const float C2 = 0.125f * LOG2E;
    float mx = -1e30f;
    if (MASK) {
        int dbase = qpos - kpos0 - 4 * hi; asm volatile("" : "+v"(dbase));
        const float fdb = (float)dbase, lim = (float)(qpos < 127 ? qpos : 127), ns = -slope2;
#pragma unroll
        for (int t = 0; t < CT; ++t)
#pragma unroll
            for (int r = 0; r < 16; ++r) {
                const float fd = fdb - (float)(32 * t + (r & 3) + 8 * (r >> 2));
                float v = __builtin_fmaf(ns, fd, s[t][r] * C2);
                v = (fd >= 0.f && fd <= lim) ? v : -1e30f;
                s[t][r] = v; mx = fmaxf(mx, v);
            }
    } else {
#pragma unroll
        for (int t = 0; t < CT; ++t)
#pragma unroll
            for (int r = 0; r < 16; ++r) { const float v = s[t][r] * C2; s[t][r] = v; mx = fmaxf(mx, v); }
    }
    mx = fmaxf(mx, __shfl_xor(mx, 32));
    const float mn = fmaxf(m, mx), alpha = __builtin_amdgcn_exp2f(m - mn);
    m = mn;
    float sum = 0.f;
#pragma unroll
    for (int t = 0; t < CT; ++t)
#pragma unroll
        for (int r = 0; r < 16; ++r) { const float e = __builtin_amdgcn_exp2f(s[t][r] - mn); s[t][r] = e; sum += e; }
    l = l * alpha + sum;
    if (!FIRST) {
        if (hi == 0) wsf[r32] = alpha;
        asm volatile("s_waitcnt lgkmcnt(0)" ::: "memory");
#pragma unroll
        for (int r = 0; r < 16; ++r) { const float a = wsf[crow(r, hi)]; o[0][r] *= a; o[1][r] *= a; }
        asm volatile("s_waitcnt lgkmcnt(0)" ::: "memory");
    }
#pragma unroll
    for (int t = 0; t < CT; ++t)
#pragma unroll
        for (int k2 = 0; k2 < 2; ++k2) {
            u32x4 pw; pw.x = cvtpk(s[t][8 * k2 + 0], s[t][8 * k2 + 1]); pw.y = cvtpk(s[t][8 * k2 + 2], s[t][8 * k2 + 3]); pw.z = cvtpk(s[t][8 * k2 + 4], s[t][8 * k2 + 5]); pw.w = cvtpk(s[t][8 * k2 + 6], s[t][8 * k2 + 7]);
            const bf16x8 pa = __builtin_bit_cast(bf16x8, pw);
#pragma unroll
            for (int d0 = 0; d0 < 2; ++d0) {
                const LAS unsigned char* vp = Vb + ao.v[d0] + (32 * t + 16 * k2) * 128;
                const s16x4 lo = vtr(vp), hh = vtr(vp + 1024);
                const bf16x8 vf = (bf16x8){lo[0], lo[1], lo[2], lo[3], hh[0], hh[1], hh[2], hh[3]};
                o[d0] = __builtin_amdgcn_mfma_f32_32x32x16_bf16(pa, vf, o[d0], 0, 0, 0);
            }
        }
}
__device__ __forceinline__ void attn_init(bool mask, float sink2, float& m, float& l, f32x16 (&o)[2]) {
    const int hi = (threadIdx.x & 63) >> 5;
    m = mask ? sink2 : -1e30f; l = (mask && hi == 0) ? 1.f : 0.f;
#pragma unroll
    for (int r = 0; r < 16; ++r) { o[0][r] = 0.f; o[1][r] = 0.f; }
}
__device__ __forceinline__ void attn_finish(float l, LAS float* wsf, f32x16 (&o)[2], LAS unsigned short* stg) {
    const int lane = threadIdx.x & 63, r32 = lane & 31, hi = lane >> 5;
    l += __shfl_xor(l, 32);
    if (hi == 0) wsf[r32] = 1.0f / l;
    asm volatile("s_waitcnt lgkmcnt(0)" ::: "memory");
#pragma unroll
    for (int r = 0; r < 16; ++r) { const float li = wsf[crow(r, hi)]; const int q = crow(r, hi);
        stg[q * 64 + r32] = (unsigned short)(cvtpk(o[0][r] * li, 0.f) & 0xffffu); stg[q * 64 + 32 + r32] = (unsigned short)(cvtpk(o[1][r] * li, 0.f) & 0xffffu); }
    asm volatile("s_waitcnt lgkmcnt(0)" ::: "memory");
}
__device__ __forceinline__ void attn_swa(const bf16x8 (&qf)[4], const AttnOfs& ao, const LAS unsigned char* Kb, const LAS unsigned char* Vb, int qpos, int kpos0, float slope2, float sink2, LAS float* wsf, LAS unsigned short* stg) {
    float m, l; f32x16 o[2]; attn_init(true, sink2, m, l, o);
    attn_chunk<3, true, true>(qf, ao, Kb, Vb, qpos, kpos0, slope2, wsf, m, l, o);
    attn_chunk<2, true, false>(qf, ao, Kb + 96 * 128, Vb + 96 * 128, qpos, kpos0 + 96, slope2, wsf, m, l, o);
    attn_finish(l, wsf, o, stg);
}
__device__ __forceinline__ void attn_mem(const bf16x8 (&qf)[4], const AttnOfs& ao, const LAS unsigned char* Kb, const LAS unsigned char* Vb, LAS float* wsf, LAS unsigned short* stg) {
    float m, l; f32x16 o[2]; attn_init(false, 0.f, m, l, o);
    attn_chunk<2, false, true>(qf, ao, Kb, Vb, 0, 0, 0.f, wsf, m, l, o);
#pragma unroll 1
    for (int c = 1; c < 4; ++c) attn_chunk<2, false, false>(qf, ao, Kb + c * 64 * 128, Vb + c * 64 * 128, 0, 0, 0.f, wsf, m, l, o);
    attn_finish(l, wsf, o, stg);
}
__device__ __forceinline__ void stage_out(const LAS unsigned short* stg, bf16_t* gdst, size_t ld) {
    const int lane = threadIdx.x & 63;
#pragma unroll
    for (int i = 0; i < 4; ++i) { const int row = i * 8 + (lane >> 3), ch = lane & 7; *(u32x4*)(gdst + (size_t)row * ld + ch * 8) = *(const LAS u32x4*)(stg + row * 64 + ch * 8); }
    asm volatile("s_waitcnt lgkmcnt(0)" ::: "memory");
}

__device__ __forceinline__ void unit_swa_prompt(const Params& P, LAS unsigned char* lds, LAS float* wsf, int b, int qb, int g) {
    const int tid = threadIdx.x, lane = tid & 63, wave = __builtin_amdgcn_readfirstlane(tid >> 6), r32 = lane & 31, hi = lane >> 5;
    const bf16_t* Qg = (const bf16_t*)(P.ws + WS_Q); const bf16_t* Kg = (const bf16_t*)(P.ws + WS_K); const bf16_t* Vg = (const bf16_t*)(P.ws + WS_V); bf16_t* Og = (bf16_t*)(P.ws + WS_O);
    LAS unsigned char* Kl = lds; LAS unsigned char* Vl = lds + 49152; LAS unsigned short* stg = (LAS unsigned short*)(lds + 98304 + wave * 4096);
#pragma unroll 2
    for (int idx = tid; idx < 384 * 8; idx += 512) {
        const int row = idx >> 3, ch = idx & 7, t = 256 * qb - 128 + row;
        u32x4 kv = (u32x4){0u, 0u, 0u, 0u}, vv = kv;
        if (t >= 0) { const size_t o = (size_t)(b * SEQ + t) * 256 + g * 64 + ch * 8; kv = *(const u32x4*)(Kg + o); vv = *(const u32x4*)(Vg + o); }
        *(LAS u32x4*)(Kl + kv_off(row, ch)) = kv; *(LAS u32x4*)(Vl + kv_off(row, ch)) = vv;
    }
    __syncthreads();
    const AttnOfs ao = attn_ofs();
    const int t0 = 256 * qb + 32 * wave;
#pragma unroll 1
    for (int hh = 0; hh < 3; ++hh) {
        const int head = 3 * g + hh;
        bf16x8 qf[4];
#pragma unroll
        for (int ks = 0; ks < 4; ++ks) qf[ks] = *(const bf16x8*)(Qg + (size_t)(b * SEQ + t0 + r32) * 768 + head * 64 + 16 * ks + 8 * hi);
        attn_swa(qf, ao, Kl + 32 * wave * 128, Vl + 32 * wave * 128, t0 + r32, t0 - 128, alibi_slope(head) * LOG2E, P.in[14][head] * LOG2E, wsf, stg);
        stage_out(stg, Og + (size_t)(b * SEQ + t0) * DM + head * 64, DM);
    }
    __syncthreads();
}

__device__ __forceinline__ void unit_mem_prompt(const Params& P, LAS unsigned char* lds, LAS float* wsf, int layer, int b, int qb, int h) {
    const int tid = threadIdx.x, lane = tid & 63, wave = __builtin_amdgcn_readfirstlane(tid >> 6), r32 = lane & 31, hi = lane >> 5;
    const bf16_t* XQ = (const bf16_t*)(P.ws + WS_XQ); bf16_t* Og = (bf16_t*)(P.ws + WS_O);
    const bf16_t* MK = (const bf16_t*)(P.ws + WS_MK) + (size_t)layer * MMEM * 256; const bf16_t* MV = (const bf16_t*)(P.ws + WS_MV) + (size_t)layer * MMEM * 256;
    LAS unsigned char* Kl = lds; LAS unsigned char* Vl = lds + 32768; LAS unsigned short* stg = (LAS unsigned short*)(lds + 98304 + wave * 4096);
#pragma unroll 2
    for (int idx = tid; idx < 256 * 8; idx += 512) {
        const int row = idx >> 3, ch = idx & 7; const size_t o = (size_t)(b * NMEM + row) * 256 + h * 64 + ch * 8;
        *(LAS u32x4*)(Kl + kv_off(row, ch)) = *(const u32x4*)(MK + o); *(LAS u32x4*)(Vl + kv_off(row, ch)) = *(const u32x4*)(MV + o);
    }
    __syncthreads();
    const AttnOfs ao = attn_ofs();
    const int t0 = 256 * qb + 32 * wave;
    bf16x8 qf[4];
#pragma unroll
    for (int ks = 0; ks < 4; ++ks) qf[ks] = *(const bf16x8*)(XQ + (size_t)(b * SEQ + t0 + r32) * 256 + h * 64 + 16 * ks + 8 * hi);
    attn_mem(qf, ao, Kl, Vl, wsf, stg);
    stage_out(stg, Og + (size_t)(b * SEQ + t0) * DM + 768 + h * 64, DM);
    __syncthreads();
}

__device__ __forceinline__ u32x4 ld8f_pack(const float* p) { const f32x4 a = *(const f32x4*)p, b = *(const f32x4*)(p + 4); return pack8(a, b); }

__device__ __forceinline__ void unit_swa_sample(const Params& P, LAS unsigned char* lds, LAS float* wsf, int n, int gp) {
    const int tid = threadIdx.x, lane = tid & 63, wave = __builtin_amdgcn_readfirstlane(tid >> 6), r32 = lane & 31, hi = lane >> 5;
    const bf16_t* Qg = (const bf16_t*)(P.ws + WS_Q); const bf16_t* Kg = (const bf16_t*)(P.ws + WS_K); const bf16_t* Vg = (const bf16_t*)(P.ws + WS_V); bf16_t* Og = (bf16_t*)(P.ws + WS_O);
#pragma unroll 1
    for (int idx = tid; idx < 2 * 160 * 8; idx += 512) {
        const int gi = idx / 1280, rem = idx % 1280, row = rem >> 3, ch = rem & 7, g = 2 * gp + gi;
        LAS unsigned char* Kl = lds + gi * 40960; LAS unsigned char* Vl = Kl + 20480;
        u32x4 kv = (u32x4){0u, 0u, 0u, 0u}, vv = kv;
        if (row < 128) { const size_t o = ((size_t)(n * 128 + row) * 4 + g) * 64 + ch * 8; kv = ld8f_pack(P.in[2] + o); vv = ld8f_pack(P.in[3] + o); }
        else if (row < 132) { const size_t o = (size_t)(MP + 4 * n + row - 128) * 256 + g * 64 + ch * 8; kv = *(const u32x4*)(Kg + o); vv = *(const u32x4*)(Vg + o); }
        *(LAS u32x4*)(Kl + kv_off(row, ch)) = kv; *(LAS u32x4*)(Vl + kv_off(row, ch)) = vv;
    }
    __syncthreads();
    if (wave < 2) {
        LAS unsigned short* stg = (LAS unsigned short*)(lds + 98304 + wave * 4096);
        const AttnOfs ao = attn_ofs();
        const int g = 2 * gp + wave; const bool qv = r32 < 12; const int hh = qv ? (r32 >> 2) : 0, sidx = r32 & 3, head = 3 * g + hh;
        bf16x8 qf[4];
#pragma unroll
        for (int ks = 0; ks < 4; ++ks) { qf[ks] = *(const bf16x8*)(Qg + (size_t)(MP + 4 * n + sidx) * 768 + head * 64 + 16 * ks + 8 * hi); if (!qv) qf[ks] = (bf16x8){0, 0, 0, 0, 0, 0, 0, 0}; }
        const LAS unsigned char* Kl = lds + wave * 40960;
        attn_swa(qf, ao, Kl, Kl + 20480, 128 + sidx, 0, alibi_slope(head) * LOG2E, P.in[14][head] * LOG2E, wsf, stg);
        for (int i = lane; i < 96; i += 64) { const int q = i >> 3, ch = i & 7;
            *(u32x4*)(Og + (size_t)(MP + 4 * n + (q & 3)) * DM + (3 * g + (q >> 2)) * 64 + ch * 8) = *(const LAS u32x4*)(stg + q * 64 + ch * 8); }
        asm volatile("s_waitcnt lgkmcnt(0)" ::: "memory");
    }
    __syncthreads();
}

__device__ __forceinline__ void unit_mem_sample(const Params& P, LAS unsigned char* lds, LAS float* wsf, int layer, int n, int hp) {
    const int tid = threadIdx.x, lane = tid & 63, wave = __builtin_amdgcn_readfirstlane(tid >> 6), r32 = lane & 31, hi = lane >> 5;
    const bf16_t* XQ = (const bf16_t*)(P.ws + WS_XQ); bf16_t* Og = (bf16_t*)(P.ws + WS_O);
    const float* ck = P.in[4] + (size_t)(layer * NDEC + n) * NMEM * 256; const float* cv = P.in[5] + (size_t)(layer * NDEC + n) * NMEM * 256;
#pragma unroll 2
    for (int idx = tid; idx < 256 * 16; idx += 512) {
        const int row = idx >> 4, hsel = (idx >> 3) & 1, ch = idx & 7; const size_t o = (size_t)row * 256 + (2 * hp + hsel) * 64 + ch * 8;
        LAS unsigned char* Kl = lds + hsel * 65536;
        *(LAS u32x4*)(Kl + kv_off(row, ch)) = ld8f_pack(ck + o); *(LAS u32x4*)(Kl + 32768 + kv_off(row, ch)) = ld8f_pack(cv + o);
    }
    __syncthreads();
    if (wave < 2) {
        LAS unsigned short* stg = (LAS unsigned short*)(lds + OSTG2_OFF + wave * 4096);
        const AttnOfs ao = attn_ofs();
        const int h = 2 * hp + wave; const bool qv = r32 < 4;
        bf16x8 qf[4];
#pragma unroll
        for (int ks = 0; ks < 4; ++ks) { qf[ks] = *(const bf16x8*)(XQ + (size_t)(MP + 4 * n + (r32 & 3)) * 256 + h * 64 + 16 * ks + 8 * hi); if (!qv) qf[ks] = (bf16x8){0, 0, 0, 0, 0, 0, 0, 0}; }
        const LAS unsigned char* Kl = lds + wave * 65536;
        attn_mem(qf, ao, Kl, Kl + 32768, wsf, stg);
        if (lane < 32) { const int q = lane >> 3, ch = lane & 7;
            *(u32x4*)(Og + (size_t)(MP + 4 * n + q) * DM + 768 + h * 64 + ch * 8) = *(const LAS u32x4*)(stg + q * 64 + ch * 8); }
        asm volatile("s_waitcnt lgkmcnt(0)" ::: "memory");
    }
    __syncthreads();
}

__device__ __forceinline__ void unit_gmlp_prompt(const Params& P, LAS unsigned char* lds, int b, int c) {
    const int tid = threadIdx.x, lane = tid & 63, wave = __builtin_amdgcn_readfirstlane(tid >> 6), r32 = lane & 31, hi = lane >> 5;
    const bf16_t* U = (const bf16_t*)(P.ws + WS_U); const bf16_t* GV = (const bf16_t*)(P.ws + WS_GV); bf16_t* Og = (bf16_t*)(P.ws + WS_O);
    const bf16_t* WST = (const bf16_t*)(P.ws + WS_WST); const float* ssqv = (const float*)(P.ws + WS_SSQ) + 4 * M;
    const float* vg = P.in[17]; const float* bs = P.in[19]; float* cvp = P.out + O_CVP;
    const int rowb = b * SEQ + c * 128;
    const int ib = wave & 3, cb0 = 3 * (wave >> 2);
#pragma unroll 1
    for (int g = 0; g < 4; ++g) {
        for (int idx = tid; idx < 128 * 24; idx += 512) {
            const int j = idx / 24, ch = idx % 24; const int row = rowb + j, col = g * 192 + ch * 8;
            const float rv = rsqrtf(ssqv[row] * (1.f / 768.f) + EPS);
            const u32x4 w = *(const u32x4*)(GV + (size_t)row * 768 + col);
            const f32x4 g0 = *(const f32x4*)(vg + col), g1 = *(const f32x4*)(vg + col + 4);
            f32x4 v0 = (f32x4){bflo(w.x), bfhi(w.x), bflo(w.y), bfhi(w.y)}, v1 = (f32x4){bflo(w.z), bfhi(w.z), bflo(w.w), bfhi(w.w)};
            v0 = v0 * rv * g0; v1 = v1 * rv * g1;
            *(LAS u32x4*)(lds + j * 384 + ch * 16) = pack8(v0, v1);
            if (c == 31) { float* o = cvp + (size_t)(b * 128 + j) * 768 + col; *(f32x4*)o = v0; *(f32x4*)(o + 4) = v1; }
        }
        __syncthreads();
        f32x16 acc[3];
#pragma unroll
        for (int i = 0; i < 3; ++i)
#pragma unroll
            for (int r = 0; r < 16; ++r) acc[i][r] = 0.f;
        const int nks = 2 * (ib + 1);
#pragma unroll 1
        for (int ks = 0; ks < nks; ++ks) {
            const bf16x8 af = *(const bf16x8*)(WST + (size_t)(g * 128 + 32 * ib + r32) * 128 + 16 * ks + 8 * hi);
            const int j0 = 16 * ks + 8 * hi + ((lane & 15) >> 2);
#pragma unroll
            for (int i = 0; i < 3; ++i) {
                const int col = 32 * (cb0 + i) + 16 * ((lane >> 4) & 1) + 4 * (lane & 3);
                const s16x4 lo = vtr(lds + j0 * 384 + col * 2), hh = vtr(lds + (j0 + 4) * 384 + col * 2);
                const bf16x8 vf = (bf16x8){lo[0], lo[1], lo[2], lo[3], hh[0], hh[1], hh[2], hh[3]};
                acc[i] = __builtin_amdgcn_mfma_f32_32x32x16_bf16(af, vf, acc[i], 0, 0, 0);
            }
        }
        LAS float* stg = (LAS float*)(lds + 49152 + wave * 4096);
#pragma unroll 1
        for (int i = 0; i < 3; ++i) {
            const f32x16 a = i == 0 ? acc[0] : i == 1 ? acc[1] : acc[2];
#pragma unroll
            for (int r = 0; r < 16; ++r) { const int q = crow(r, hi); stg[q * 32 + r32] = a[r] + bs[g * 128 + 32 * ib + q]; }
            asm volatile("s_waitcnt lgkmcnt(0)" ::: "memory");
            const int q = lane >> 1, hf = lane & 1; const size_t ro = (size_t)(rowb + 32 * ib + q); const int col = g * 192 + 32 * (cb0 + i) + 16 * hf;
            const u32x4 u0 = *(const u32x4*)(U + ro * 768 + col), u1 = *(const u32x4*)(U + ro * 768 + col + 8);
            const LAS f32x4* sp = (const LAS f32x4*)(stg + q * 32 + 16 * hf);
            const f32x4 m0 = sp[0], m1 = sp[1], m2 = sp[2], m3 = sp[3];
            u32x4 o0, o1;
            o0.x = cvtpk(bflo(u0.x) * m0[0], bfhi(u0.x) * m0[1]); o0.y = cvtpk(bflo(u0.y) * m0[2], bfhi(u0.y) * m0[3]); o0.z = cvtpk(bflo(u0.z) * m1[0], bfhi(u0.z) * m1[1]); o0.w = cvtpk(bflo(u0.w) * m1[2], bfhi(u0.w) * m1[3]);
            o1.x = cvtpk(bflo(u1.x) * m2[0], bfhi(u1.x) * m2[1]); o1.y = cvtpk(bflo(u1.y) * m2[2], bfhi(u1.y) * m2[3]); o1.z = cvtpk(bflo(u1.z) * m3[0], bfhi(u1.z) * m3[1]); o1.w = cvtpk(bflo(u1.w) * m3[2], bfhi(u1.w) * m3[3]);
            *(u32x4*)(Og + ro * DM + col) = o0; *(u32x4*)(Og + ro * DM + col + 8) = o1;
            asm volatile("s_waitcnt lgkmcnt(0)" ::: "memory");
        }
        __syncthreads();
    }
}

__device__ __forceinline__ void gmlp_sample(const Params& P, int G, int bid) {
    const bf16_t* U = (const bf16_t*)(P.ws + WS_U); const bf16_t* GV = (const bf16_t*)(P.ws + WS_GV); bf16_t* Og = (bf16_t*)(P.ws + WS_O);
    const float* ssqv = (const float*)(P.ws + WS_SSQ) + 4 * M; const float* vg = P.in[17]; const float* wsb = P.in[18]; const float* bs = P.in[19]; float* cvs = P.out + O_CVS;
    for (int i = bid * 512 + threadIdx.x; i < NDEC * 768; i += G * 512) {
        const int n = i / 768, col = i % 768, g = col / 192; float vn[4];
#pragma unroll
        for (int s = 0; s < 4; ++s) { const int row = MP + 4 * n + s; vn[s] = bf2f(GV[(size_t)row * 768 + col]) * rsqrtf(ssqv[row] * (1.f / 768.f) + EPS) * vg[col]; cvs[(size_t)(4 * n + s) * 768 + col] = vn[s]; }
#pragma unroll
        for (int s = 0; s < 4; ++s) { float mx = bs[g * 128 + s];
#pragma unroll
            for (int j = 0; j < 4; ++j) if (j <= s) mx += wsb[(size_t)(g * 128 + s) * 128 + j] * vn[j];
            const int row = MP + 4 * n + s; Og[(size_t)row * DM + col] = f2bf_s(bf2f(U[(size_t)row * 768 + col]) * mx); }
    }
}

#define XB_TMO      128
#define XB_XCNT(j)  (256  + 64 * (j))
#define XB_XSUB(j)  (1280 + 64 * (j))
#define XB_XGEN(j)  (2304 + 64 * (j))
#define XB_TOP      3328
#define XB_TOPGEN   3392
#define XCD_BAR_WORDS 3456
#define XB_SPIN_CAP (1u << 22)
__device__ __forceinline__ unsigned xb_ld(unsigned* p)              { return __hip_atomic_load(p, __ATOMIC_RELAXED, __HIP_MEMORY_SCOPE_AGENT); }
__device__ __forceinline__ unsigned xb_add(unsigned* p, unsigned v) { return __hip_atomic_fetch_add(p, v, __ATOMIC_RELAXED, __HIP_MEMORY_SCOPE_AGENT); }
__device__ __forceinline__ unsigned xb_xcc_id() { return (unsigned)__builtin_amdgcn_s_getreg((3 << 11) | 20) & 0xFu; }
#define XB_SPIN(cond, bar) do { unsigned _sp = 0; while (cond) { __builtin_amdgcn_s_sleep(1); \
    if ((++_sp & 255u) == 0u) { if (xb_ld(&(bar)[XB_TMO])) break; if (_sp > XB_SPIN_CAP) { atomicAdd(&(bar)[XB_TMO], 1u); break; } } } } while (0)
struct XcdBarrier { unsigned* bar; unsigned x; volatile LAS unsigned* st; };
__device__ __forceinline__ XcdBarrier xcd_barrier_post(unsigned* bar, volatile LAS unsigned* st) {
    XcdBarrier b; b.bar = bar; b.x = xb_xcc_id(); b.st = st;
    if (threadIdx.x == 0) (void)xb_add(&bar[XB_XCNT(b.x)], 1u);
    return b;
}
__device__ __forceinline__ void xcd_barrier_complete(unsigned* bar, unsigned x, unsigned& nloc, unsigned& nx) {
    const unsigned G = gridDim.x * gridDim.y * gridDim.z;
    unsigned sum, cnt, mine, sp = 0u;
    for (;;) {
        sum = 0u; cnt = 0u; mine = 0u;
#pragma unroll
        for (unsigned j = 0; j < 16; ++j) { const unsigned c = xb_ld(&bar[XB_XCNT(j)]); sum += c; cnt += (c > 0u) ? 1u : 0u; mine = (j == x) ? c : mine; }
        if (sum == G) break;
        __builtin_amdgcn_s_sleep(1);
        if ((++sp & 255u) == 0u) { if (xb_ld(&bar[XB_TMO])) break; if (sp > XB_SPIN_CAP) { atomicAdd(&bar[XB_TMO], 1u); break; } }
    }
    nloc = mine > 0u ? mine : 1u; nx = cnt > 0u ? cnt : 1u;
}
__device__ __forceinline__ void xcd_barrier(const XcdBarrier& b) {
    asm volatile("s_waitcnt vmcnt(0)" ::: "memory");
    __syncthreads();
    if (threadIdx.x == 0) {
        unsigned* bar = b.bar;
        __builtin_amdgcn_s_waitcnt(0);
        unsigned nloc = b.st[0], nx = b.st[1];
        if (nloc == 0u) { xcd_barrier_complete(bar, b.x, nloc, nx); b.st[0] = nloc; b.st[1] = nx; }
        const unsigned old = xb_add(&bar[XB_XSUB(b.x)], 1u);
        const unsigned gen = old / nloc;
        if (old + 1u == (gen + 1u) * nloc) {
            __builtin_amdgcn_fence(__ATOMIC_RELEASE, "agent");
            asm volatile("s_waitcnt vmcnt(0)" ::: "memory");
            const unsigned og = xb_add(&bar[XB_TOP], 1u);
            const unsigned tg = og / nx;
            if (og + 1u == (tg + 1u) * nx) xb_add(&bar[XB_TOPGEN], 1u);
            else XB_SPIN(xb_ld(&bar[XB_TOPGEN]) == tg, bar);
            __builtin_amdgcn_fence(__ATOMIC_ACQUIRE, "agent");
            xb_add(&bar[XB_XGEN(b.x)], 1u);
            asm volatile("s_waitcnt vmcnt(0)" ::: "memory");
        } else {
            XB_SPIN(xb_ld(&bar[XB_XGEN(b.x)]) == gen, bar);
            __builtin_amdgcn_fence(__ATOMIC_ACQUIRE, "agent");
            asm volatile("s_waitcnt vmcnt(0)" ::: "memory");
        }
    }
    __syncthreads();
}


__global__ void __launch_bounds__(512, 2) mk_fwd(Params P) {
    extern __shared__ __attribute__((aligned(16))) unsigned char lds_raw[];
    LAS unsigned char* lds = (LAS unsigned char*)lds_raw;
    const int tid = threadIdx.x, wave = __builtin_amdgcn_readfirstlane(tid >> 6);
    const int G = gridDim.x, bid = blockIdx.x;
    LAS float* wsf = (LAS float*)(lds + WSF_OFF) + wave * 64;
    unsigned char* ws = P.ws;
    float* ssq = (float*)(ws + WS_SSQ);
    bf16_t* XB = (bf16_t*)(ws + WS_XB);
    cg::grid_group grid = cg::this_grid();
    const int lo = P.ph_lo, hi = P.ph_hi;
#ifndef PH_MASK
#define PH_MASK 0x1fff
#endif
#define IN(k) (((PH_MASK >> (k)) & 1) && lo <= (k) && (k) < hi)
#ifndef USE_XCD_BAR
#define USE_XCD_BAR 1
#endif
    volatile LAS unsigned* bst = (volatile LAS unsigned*)(lds + RING_BYTES + 16128);
    if (tid < 2) bst[tid] = 0u;
    __syncthreads();
    XcdBarrier xbar = xcd_barrier_post((unsigned*)(ws + WS_CTL), bst);
#define SEAM(k) do { if (IN(k) && IN((k) + 1)) { if (!USE_XCD_BAR || (k) == 0) grid.sync(); else xcd_barrier(xbar); } } while (0)

    if (IN(0)) { for (int rep = 0; rep < (DUP == 0 ? 2 : 1); ++rep) p0_prologue(P, lds, G, bid); }
    SEAM(0);
    const int gwave = bid * 8 + wave, NW = G * 8;
    const bf16_t* XBs = XB;
    if (IN(1)) {
        EpiInA E{ssq, (bf16_t*)(ws + WS_Q), (const float*)(ws + WS_GT), P.out};
        { pg8::Gemm g{XB, (const bf16_t*)(ws + WS_WINA), DM, DM}; pg8::StaticOrder S; S.init(MP, NINA, G, bid);
          pg8::gemm_phase<EpiInA, true, true>(lds, g, S, E); }
        { pg8::Gemm g{(const bf16_t*)(ws + WS_MEMB), (const bf16_t*)(ws + WS_WMKV), DM, DM}; pg8::StaticOrder S; S.init(MMEM, 1024, G, bid);
          EpiMemKV E2{ssq + 5 * M, P.in[23], P.out + O_MKP, P.out + O_MVP, (bf16_t*)(ws + WS_MK), (bf16_t*)(ws + WS_MV)};
          pg8::gemm_phase<EpiMemKV, true, true>(lds, g, S, E2); }
        if (bid >= 32) sample_gemm<4, 4>(lds, XBs, DM, (const bf16_t*)(ws + WS_WINA), 6, E, bid - 32, G - 32);
    }
    SEAM(1);
    if (IN(2)) {
        for (int rep = 0; rep < (DUP == 2 ? 2 : 1); ++rep)
        for (int uidx = bid; uidx < 1536; uidx += G) {
            if (uidx < 512) unit_swa_prompt(P, lds, wsf, uidx >> 6, (uidx >> 2) & 15, uidx & 3);
            else if (uidx < 1024) { const int v = uidx - 512; unit_mem_prompt(P, lds, wsf, 0, v >> 6, (v >> 2) & 15, v & 3); }
            else if (uidx < 1280) { const int v = uidx - 1024; unit_mem_sample(P, lds, wsf, 0, v >> 1, v & 1); }
            else { const int v = uidx - 1280; unit_swa_sample(P, lds, wsf, v >> 1, v & 1); }
        }
    }
    SEAM(2);
    if (IN(3)) {
        pg8::Gemm g{(const bf16_t*)(ws + WS_O), (const bf16_t*)(ws + WS_WOUTA), DM, DM}; pg8::StaticOrder S; S.init(MP, DM, G, bid);
        EpiRes<true, false> E{P.in[0], P.in[1], nullptr, XB, ssq + M};
        pg8::gemm_phase<EpiRes<true, false>, true, true>(lds, g, S, E);
        sample_gemm<2, 4>(lds, (const bf16_t*)(ws + WS_O), DM, (const bf16_t*)(ws + WS_WOUTA), 4, E, bid, G);
    }
    SEAM(3);
    if (IN(4)) {
        pg8::Gemm g{XB, (const bf16_t*)(ws + WS_WFFN), DM, DM}; pg8::StaticOrder S; S.init(MP, NFF, G, bid);
        EpiFfnConv E{ssq + M, (bf16_t*)(ws + WS_H), P.in[25], P.in[26], (float*)(ws + WS_SIDE), P.out + O_CONVP, (LAS float*)(lds + RING_BYTES)};
        pg8::gemm_phase<EpiFfnConv, true, true>(lds, g, S, E);
        sample_ffn(P, lds, 0, ssq + M, bid, G);
    }
    SEAM(4);
    if (IN(5)) {
        pg8::Gemm g{(const bf16_t*)(ws + WS_H), (const bf16_t*)(ws + WS_WDOWN), DFF, DFF}; pg8::StaticOrder S; S.init(MP, DM, G, bid);
        ffn_fixup(P, 0, S);
        EpiRes<false, false> E{nullptr, nullptr, nullptr, XB, ssq + 2 * M};
        pg8::gemm_phase<EpiRes<false, false>, true, true>(lds, g, S, E);
        sample_gemm<2, 11>(lds, (const bf16_t*)(ws + WS_H), DFF, (const bf16_t*)(ws + WS_WDOWN), 4, E, bid, G);
    }
    SEAM(5);
    if (IN(6)) {
        pg8::Gemm g{XB, (const bf16_t*)(ws + WS_WINB), DM, DM}; pg8::StaticOrder S; S.init(MP, NINB, G, bid);
        EpiInB E{ssq + 2 * M, (bf16_t*)(ws + WS_U), (bf16_t*)(ws + WS_GV), (bf16_t*)(ws + WS_XQ), P.in[22] + 64, ssq + 4 * M};
        pg8::gemm_phase<EpiInB, true, true>(lds, g, S, E);
        if (bid >= G / 2) sample_gemm<4, 4>(lds, XBs, DM, (const bf16_t*)(ws + WS_WINB), 7, E, bid - G / 2, G - G / 2);
    }
    SEAM(6);
    if (IN(7)) {
        for (int rep = 0; rep < (DUP == 7 ? 2 : 1); ++rep)
        for (int uidx = bid; uidx < 1024; uidx += G) {
            if (uidx < 256) unit_gmlp_prompt(P, lds, uidx >> 5, uidx & 31);
            else if (uidx < 768) { const int v = uidx - 256; unit_mem_prompt(P, lds, wsf, 1, v >> 6, (v >> 2) & 15, v & 3); }
            else { const int v = uidx - 768; unit_mem_sample(P, lds, wsf, 1, v >> 1, v & 1); }
        }
        gmlp_sample(P, G, bid);
    }
    SEAM(7);
    if (IN(8)) {
        pg8::Gemm g{(const bf16_t*)(ws + WS_O), (const bf16_t*)(ws + WS_WOUTB), DM, DM}; pg8::StaticOrder S; S.init(MP, DM, G, bid);
        EpiRes<false, false> E{nullptr, nullptr, nullptr, XB, ssq + 3 * M};
        pg8::gemm_phase<EpiRes<false, false>, true, true>(lds, g, S, E);
        sample_gemm<2, 4>(lds, (const bf16_t*)(ws + WS_O), DM, (const bf16_t*)(ws + WS_WOUTB), 4, E, bid, G);
    }
    SEAM(8);
    if (IN(9)) {
        pg8::Gemm g{XB, (const bf16_t*)(ws + WS_WFFN) + (size_t)NFF * DM, DM, DM}; pg8::StaticOrder S; S.init(MP, NFF, G, bid);
        EpiFfnConv E{ssq + 3 * M, (bf16_t*)(ws + WS_H), P.in[25] + 3 * DFF, P.in[26] + DFF, (float*)(ws + WS_SIDE), P.out + O_CONVP + (size_t)NBATCH * 2 * DFF, (LAS float*)(lds + RING_BYTES)};
        pg8::gemm_phase<EpiFfnConv, true, true>(lds, g, S, E);
        sample_ffn(P, lds, 1, ssq + 3 * M, bid, G);
    }
    SEAM(9);
    if (IN(10)) {
        pg8::Gemm g{(const bf16_t*)(ws + WS_H), (const bf16_t*)(ws + WS_WDOWN) + (size_t)DM * DFF, DFF, DFF}; pg8::StaticOrder S; S.init(MP, DM, G, bid);
        ffn_fixup(P, 1, S);
        EpiRes<false, true> E{nullptr, nullptr, P.out + O_Y, XB, nullptr};
        pg8::gemm_phase<EpiRes<false, true>, true, true>(lds, g, S, E);
        sample_gemm<2, 11>(lds, (const bf16_t*)(ws + WS_H), DFF, (const bf16_t*)(ws + WS_WDOWN) + (size_t)DM * DFF, 4, E, bid, G);
    }
#undef IN
#undef SEAM
}

extern "C" void kernel_launch(void* const* d_in, const int* in_sizes, int n_in, void* d_out, int out_size, void* d_ws, size_t ws_size, hipStream_t stream) {
    static int grid = 0;
    if (grid == 0) {
        if (n_in != 28 || (size_t)out_size != O_END || ws_size < WS_END) { fprintf(stderr, "kernel_launch: unexpected shapes: n_in %d out %d ws %zu (need %zu)\n", n_in, out_size, ws_size, (size_t)WS_END); grid = -1; return; }
        int dev = 0, cus = 0, per_cu = 0;
        hipGetDevice(&dev); hipDeviceGetAttribute(&cus, hipDeviceAttributeMultiprocessorCount, dev);
        if (hipFuncSetAttribute((const void*)mk_fwd, hipFuncAttributeMaxDynamicSharedMemorySize, LDS_BYTES) != hipSuccess) { fprintf(stderr, "kernel_launch: hipFuncSetAttribute failed\n"); grid = -1; return; }
        hipOccupancyMaxActiveBlocksPerMultiprocessor(&per_cu, (const void*)mk_fwd, 512, LDS_BYTES);
        (void)hipGetLastError();
        if (per_cu < 1) { fprintf(stderr, "kernel_launch: occupancy query says %d blocks per CU\n", per_cu); per_cu = 1; }
        grid = cus;
    }
    if (grid < 0) return;
    if (hipMemsetAsync((char*)d_ws + WS_CTL, 0, CTL_BYTES, stream) != hipSuccess) { fprintf(stderr, "kernel_launch: memset failed\n"); return; }
    Params p{};
    for (int i = 0; i < 28; ++i) p.in[i] = (const float*)d_in[i];
    p.out = (float*)d_out; p.ws = (unsigned char*)d_ws;
#if MK_N_LAUNCHES == 1
    p.ph_lo = 0; p.ph_hi = NPHASE;
    void* args[] = {&p};
    hipError_t e = hipLaunchCooperativeKernel((const void*)mk_fwd, dim3(grid), dim3(512), args, LDS_BYTES, stream);
    if (e != hipSuccess) fprintf(stderr, "cooperative launch failed: %s (grid %d)\n", hipGetErrorString(e), grid);
#else
    for (int ph = 0; ph < NPHASE; ++ph) {
        p.ph_lo = ph; p.ph_hi = ph + 1;
        hipLaunchKernelGGL(mk_fwd, dim3(grid), dim3(512), LDS_BYTES, stream, p);
    }
#endif
}
```

```cpp
#include <hip/hip_runtime.h>
#include <hip/hip_cooperative_groups.h>
#include <cstdio>
#include <cstdint>
namespace cg = cooperative_groups;

#ifndef MK_N_LAUNCHES
#define MK_N_LAUNCHES 1
#endif

#ifndef DUP
#define DUP -1
#endif
#define LAS __attribute__((address_space(3)))
typedef unsigned short bf16_t;
typedef short bf16x8 __attribute__((ext_vector_type(8)));
typedef short s16x4 __attribute__((ext_vector_type(4)));
typedef float f32x4 __attribute__((ext_vector_type(4)));
typedef float f32x2 __attribute__((ext_vector_type(2)));
typedef float f32x16 __attribute__((ext_vector_type(16)));
typedef unsigned u32x4 __attribute__((ext_vector_type(4)));
typedef unsigned u32x2 __attribute__((ext_vector_type(2)));
typedef __bf16 bf16x2_t __attribute__((ext_vector_type(2)));

constexpr int DM = 1024, NBATCH = 8, SEQ = 4096, MP = NBATCH * SEQ, NDEC = 128, DSEQ = 4, MS = NDEC * DSEQ, M = MP + MS;
constexpr int NMEM = 256, MMEM = NBATCH * NMEM;
constexpr int DFF = 2816, NFF = 2 * DFF;
constexpr int NINA = 1536, NINB = 1792;
constexpr float EPS = 1e-6f;
constexpr float LOG2E = 1.4426950408889634f;
constexpr int NPHASE = 11;

constexpr size_t O_Y = 0, O_WKP = 34078720, O_WVP = 34340864, O_CVP = 34603008, O_MKP = 35389440, O_MVP = 36438016, O_CONVP = 37486592,
                 O_WKS = 37576704, O_WVS = 41771008, O_CVS = 45965312, O_CONVS = 46358528, O_END = 47800320;

constexpr size_t MiB = 1u << 20;
constexpr size_t WS_SSQ = 0, WS_GT = 1 * MiB, WS_CTL = 1 * MiB + 65536, CTL_BYTES = 16384;
constexpr size_t WS_WINA = 2 * MiB, WS_WOUTA = 5 * MiB, WS_WINB = 7 * MiB, WS_WOUTB = 11 * MiB, WS_WMKV = 13 * MiB, WS_WFFN = 15 * MiB,
                 WS_WDOWN = 37 * MiB, WS_WST = 48 * MiB;
constexpr size_t WS_MEMB = 50 * MiB, WS_MK = 54 * MiB, WS_MV = 56 * MiB;
constexpr size_t WS_XB = 58 * MiB;
constexpr size_t WS_H = 124 * MiB;
constexpr size_t WS_Q = WS_H, WS_K = WS_Q + (size_t)M * 768 * 2, WS_V = WS_K + (size_t)M * 256 * 2, WS_XQ = WS_V + (size_t)M * 256 * 2,
                 WS_O = WS_XQ + (size_t)M * 256 * 2, WS_U = WS_O + (size_t)M * 1024 * 2, WS_GV = WS_U + (size_t)M * 768 * 2;
constexpr size_t WS_SIDE = 384 * MiB, SIDE_N = (size_t)128 * 2 * DFF;
constexpr size_t WS_END = WS_SIDE + 3 * SIDE_N * 4;
static_assert(WS_GV + (size_t)M * 768 * 2 <= WS_SIDE && WS_H + (size_t)M * DFF * 2 <= WS_SIDE, "mixer buffers / hidden below the side buffers");
static_assert(WS_END <= 512 * MiB, "ws");

namespace pg8 {
constexpr int BM = 256, BK = 64, HALF = 128, HTB = HALF * BK * 2, STAGE_BYTES = 8 * HTB, NXCD = 8, WGM = 8;
__host__ __device__ __forceinline__ int lds_byte(int r, int c) { const int st = (r >> 4) * 2 + (c >> 5), rr = r & 15, cc = c & 31, ob = rr * 64 + cc * 2; return st * 1024 + (ob ^ (((ob >> 9) & 1) << 5)); }
__host__ __device__ __forceinline__ void stage_rc(int b, int& R, int& C) { const int st = b / 1024, sb = b % 1024, swz = sb ^ (((sb >> 9) & 1) << 5); R = (st >> 1) * 16 + swz / 64; C = (st & 1) * 32 + (swz % 64) / 2; }
__host__ __device__ __forceinline__ int perm32(int rho) { const int n = rho >> 4, i = rho & 15; return 8 * (i >> 2) + 4 * n + (i & 3); }

struct Unit { int pm, pn; };
struct Gemm { const bf16_t* A; const bf16_t* Bt; int lda, K; };

struct StaticOrder {
    int nM, nN, nwg, G, c;
    __device__ void init(int Mr, int N, int G_, int c_) { nM = Mr / BM; nN = N / BM; nwg = nM * nN; G = G_; c = c_; }
    __device__ bool next(int i, Unit& u) const {
        const long L = (long)i * G + c; if (L >= nwg) return false;
        int wgid = (int)L; { const int q = nwg / NXCD, r = nwg % NXCD, xcd = wgid % NXCD, off = wgid / NXCD; wgid = (xcd < r ? xcd * (q + 1) : r * (q + 1) + (xcd - r) * q) + off; }
        const int nig = WGM * nN, gid = wgid / nig, fm = gid * WGM, gsz = (nM - fm) < WGM ? (nM - fm) : WGM;
        u.pm = fm + ((wgid % nig) % gsz); u.pn = (wgid % nig) / gsz; return true;
    }
};

template <class Epi, bool ALIGN_EPI, bool SP2>
__device__ __forceinline__ void gemm_phase(LAS unsigned char* lds, const Gemm g, const StaticOrder& S, const Epi& E) {
    const int tid = threadIdx.x, wid = __builtin_amdgcn_readfirstlane(tid >> 6), lane = tid & 63, wr = wid >> 2, wc = wid & 3, fr = lane & 15, fq = lane >> 4;
    const int K = g.K, nt = K / BK, lda = g.lda;
    unsigned voffA[2], voffB[2];
#pragma unroll
    for (int i = 0; i < 2; ++i) { int R, C; stage_rc(tid * 16 + i * 8192, R, C); const int Rb = (R & ~31) + perm32(R & 31);
        voffA[i] = (unsigned)(R * lda + C) * 2u; voffB[i] = (unsigned)(Rb * K + C) * 2u; }
    const size_t kstep = (size_t)(BK * 2);
    const size_t hstepA = (size_t)HALF * lda * 2, hstepB = (size_t)HALF * K * 2;
    const size_t tstepA = 2 * hstepA, tstepB = 2 * hstepB;
    const unsigned ldsw = (unsigned)wid * 1024u;
    const int aoff = lds_byte(wr * 64 + fr, fq * 8), boff = lds_byte(wc * 32 + fr, fq * 8);
#define PG8_SA(b, h) (((b) * 2 + (h)) * HTB)
#define PG8_SB(b, h) ((4 + (b) * 2 + (h)) * HTB)
#define PG8_STAGE(bufoff, gbase, voff) do { _Pragma("unroll") for (int _i = 0; _i < 2; ++_i) \
        __builtin_amdgcn_global_load_lds((const unsigned*)((const char*)(gbase) + (voff)[_i]), (LAS unsigned*)(lds + (bufoff) + ldsw + _i * 8192), 16, 0, 0); } while (0)
#define PG8_LDA(dst, b, h) do { _Pragma("unroll") for (int m = 0; m < 4; ++m) _Pragma("unroll") for (int k = 0; k < 2; ++k) dst[m][k] = *(const LAS bf16x8*)(lds + PG8_SA(b, h) + aoff + m * 2048 + k * 1024); } while (0)
#define PG8_LDB(dst, b, h) do { _Pragma("unroll") for (int n = 0; n < 2; ++n) _Pragma("unroll") for (int k = 0; k < 2; ++k) dst[n][k] = *(const LAS bf16x8*)(lds + PG8_SB(b, h) + boff + n * 2048 + k * 1024); } while (0)
#define PG8_MMA(ai, bj, At, Bt) do { __builtin_amdgcn_s_setprio(1); _Pragma("unroll") for (int m = 0; m < 4; ++m) _Pragma("unroll") for (int n = 0; n < 2; ++n) _Pragma("unroll") for (int k = 0; k < 2; ++k) \
        acc[ai][bj][m][n] = __builtin_amdgcn_mfma_f32_16x16x32_bf16(Bt[n][k], At[m][k], acc[ai][bj][m][n], 0, 0, 0); __builtin_amdgcn_s_setprio(0); } while (0)
#define PG8_WAIT_V(n) asm volatile("s_waitcnt vmcnt(" #n ")" ::: "memory")
#define PG8_WAIT_L(n) asm volatile("s_waitcnt lgkmcnt(" #n ")" ::: "memory")
#define PG8_BAR __builtin_amdgcn_s_barrier()
#define PG8_SCHED __builtin_amdgcn_sched_barrier(0)
    Unit cur, nxt; int ui = 0;
    if (!S.next(0, cur)) return;
    f32x4 acc[2][2][4][2];
#pragma unroll
    for (int a = 0; a < 2; ++a)
#pragma unroll
        for (int b = 0; b < 2; ++b)
#pragma unroll
            for (int m = 0; m < 4; ++m)
#pragma unroll
                for (int n = 0; n < 2; ++n) acc[a][b][m][n] = (f32x4){0.f, 0.f, 0.f, 0.f};
    bf16x8 At[4][2], B0[2][2], B1[2][2];
    const char* cA = (const char*)g.A + (size_t)cur.pm * tstepA; const char* cB = (const char*)g.Bt + (size_t)cur.pn * tstepB;
    if constexpr (SP2) {
        PG8_STAGE(PG8_SB(0, 0), cB, voffB); PG8_STAGE(PG8_SB(0, 1), cB + hstepB, voffB); PG8_STAGE(PG8_SA(0, 0), cA, voffA); PG8_STAGE(PG8_SA(0, 1), cA + hstepA, voffA);
        if (wr == 1) PG8_BAR;
        PG8_WAIT_V(2); PG8_BAR;
        PG8_STAGE(PG8_SB(1, 0), cB + kstep, voffB); PG8_STAGE(PG8_SA(1, 0), cA + kstep, voffA); PG8_STAGE(PG8_SB(1, 1), cB + hstepB + kstep, voffB);
        PG8_WAIT_V(6); PG8_BAR;
    } else {
        PG8_STAGE(PG8_SB(0, 0), cB, voffB); PG8_STAGE(PG8_SA(0, 0), cA, voffA); PG8_STAGE(PG8_SB(0, 1), cB + hstepB, voffB); PG8_STAGE(PG8_SA(0, 1), cA + hstepA, voffA);
        if (wr == 1) PG8_BAR;
        PG8_WAIT_V(4); PG8_BAR;
        PG8_STAGE(PG8_SB(1, 0), cB + kstep, voffB); PG8_STAGE(PG8_SA(1, 0), cA + kstep, voffA); PG8_STAGE(PG8_SB(1, 1), cB + hstepB + kstep, voffB);
        PG8_WAIT_V(6); PG8_BAR;
    }
    for (;;) {
        const bool has_next = S.next(ui + 1, nxt);
        const char* nA = has_next ? (const char*)g.A + (size_t)nxt.pm * tstepA : cA; const char* nB = has_next ? (const char*)g.Bt + (size_t)nxt.pn * tstepB : cB;
        for (int t = 0; t < nt; t += 2) {
            const bool last = (t == nt - 2);
            const char* a1 = cA + (size_t)(t + 1) * kstep;
            const char* a2 = last ? nA : cA + (size_t)(t + 2) * kstep; const char* b2 = last ? nB : cB + (size_t)(t + 2) * kstep;
            const char* a3 = a2 + kstep; const char* b3 = b2 + kstep;
            if constexpr (SP2) {
            PG8_LDB(B0, 0, 0); PG8_LDB(B1, 0, 1); PG8_SCHED; PG8_LDA(At, 0, 0); PG8_STAGE(PG8_SA(1, 1), a1 + hstepA, voffA);
            PG8_WAIT_V(8); PG8_WAIT_L(0); PG8_BAR; PG8_MMA(0, 0, At, B0); PG8_MMA(0, 1, At, B1); PG8_BAR; PG8_SCHED;
            PG8_LDA(At, 0, 1); PG8_STAGE(PG8_SB(0, 0), b2, voffB); PG8_STAGE(PG8_SB(0, 1), b2 + hstepB, voffB); PG8_STAGE(PG8_SA(0, 0), a2, voffA);
            PG8_WAIT_V(8); PG8_WAIT_L(0); PG8_BAR; PG8_MMA(1, 0, At, B0); PG8_MMA(1, 1, At, B1); PG8_BAR; PG8_SCHED;
            PG8_LDB(B0, 1, 0); PG8_LDB(B1, 1, 1); PG8_SCHED; PG8_LDA(At, 1, 0); PG8_STAGE(PG8_SA(0, 1), a2 + hstepA, voffA);
            PG8_WAIT_V(8); PG8_WAIT_L(0); PG8_BAR; PG8_MMA(0, 0, At, B0); PG8_MMA(0, 1, At, B1); PG8_BAR; PG8_SCHED;
            PG8_LDA(At, 1, 1); PG8_STAGE(PG8_SB(1, 0), b3, voffB); PG8_STAGE(PG8_SB(1, 1), b3 + hstepB, voffB); PG8_STAGE(PG8_SA(1, 0), a3, voffA);
            PG8_WAIT_V(8); PG8_WAIT_L(0); PG8_BAR; PG8_MMA(1, 0, At, B0); PG8_MMA(1, 1, At, B1); PG8_BAR; PG8_SCHED;
            } else {
            PG8_LDB(B0, 0, 0); PG8_SCHED; PG8_LDA(At, 0, 0); PG8_STAGE(PG8_SA(1, 1), a1 + hstepA, voffA);
            PG8_WAIT_L(8); PG8_BAR; PG8_WAIT_L(0); PG8_MMA(0, 0, At, B0); PG8_BAR; PG8_SCHED;
            PG8_LDB(B1, 0, 1); PG8_STAGE(PG8_SB(0, 0), b2, voffB);
            PG8_BAR; PG8_WAIT_L(0); PG8_MMA(0, 1, At, B1); PG8_BAR;
            PG8_LDA(At, 0, 1); PG8_STAGE(PG8_SA(0, 0), a2, voffA);
            PG8_BAR; PG8_WAIT_L(0); PG8_MMA(1, 0, At, B0); PG8_BAR; PG8_SCHED;
            PG8_STAGE(PG8_SB(0, 1), b2 + hstepB, voffB);
            PG8_WAIT_V(6); PG8_BAR; PG8_MMA(1, 1, At, B1); PG8_BAR;
            PG8_LDB(B0, 1, 0); PG8_SCHED; PG8_LDA(At, 1, 0); PG8_STAGE(PG8_SA(0, 1), a2 + hstepA, voffA);
            PG8_WAIT_L(8); PG8_BAR; PG8_WAIT_L(0); PG8_MMA(0, 0, At, B0); PG8_BAR; PG8_SCHED;
            PG8_LDB(B1, 1, 1); PG8_STAGE(PG8_SB(1, 0), b3, voffB);
            PG8_BAR; PG8_WAIT_L(0); PG8_MMA(0, 1, At, B1); PG8_BAR;
            PG8_LDA(At, 1, 1); PG8_STAGE(PG8_SA(1, 0), a3, voffA);
            PG8_BAR; PG8_WAIT_L(0); PG8_MMA(1, 0, At, B0); PG8_BAR; PG8_SCHED;
            PG8_STAGE(PG8_SB(1, 1), b3 + hstepB, voffB);
            PG8_WAIT_V(6); PG8_BAR; PG8_MMA(1, 1, At, B1); PG8_BAR;
            }
        }
        if constexpr (ALIGN_EPI) { if (wr == 0) PG8_BAR; }
        E(acc, cur, wr, wc, fr, fq);
        if (!has_next) break;
#pragma unroll
        for (int a = 0; a < 2; ++a)
#pragma unroll
            for (int b = 0; b < 2; ++b)
#pragma unroll
                for (int m = 0; m < 4; ++m)
#pragma unroll
                    for (int n = 0; n < 2; ++n) acc[a][b][m][n] = (f32x4){0.f, 0.f, 0.f, 0.f};
        cur = nxt; cA = nA; cB = nB; ++ui;
        if constexpr (ALIGN_EPI) { if (wr == 1) PG8_BAR; }
    }
    PG8_WAIT_V(0);
    if constexpr (!ALIGN_EPI) { if (wr == 0) PG8_BAR; }
    PG8_BAR;
#undef PG8_SA
#undef PG8_SB
#undef PG8_STAGE
#undef PG8_LDA
#undef PG8_LDB
#undef PG8_MMA
#undef PG8_WAIT_V
#undef PG8_WAIT_L
#undef PG8_BAR
#undef PG8_SCHED
}
}
using pg8::Unit;

constexpr int RING_BYTES = 131072, WSF_OFF = RING_BYTES, OSTG2_OFF = RING_BYTES + 4096, LDS_BYTES = 147456;
__device__ __forceinline__ unsigned cvtpk(float lo, float hi) { f32x2 v = {lo, hi}; bf16x2_t b = __builtin_convertvector(v, bf16x2_t); return __builtin_bit_cast(unsigned, b); }
__device__ __forceinline__ u32x4 pack8(const f32x4 a, const f32x4 b) { u32x4 w; w.x = cvtpk(a[0], a[1]); w.y = cvtpk(a[2], a[3]); w.z = cvtpk(b[0], b[1]); w.w = cvtpk(b[2], b[3]); return w; }
__device__ __forceinline__ float bf2f(unsigned short h) { return __uint_as_float((unsigned)h << 16); }
__device__ __forceinline__ float bflo(unsigned w) { return __uint_as_float(w << 16); }
__device__ __forceinline__ float bfhi(unsigned w) { return __uint_as_float(w & 0xffff0000u); }
__device__ __forceinline__ float wave_sum(float v) {
#pragma unroll
    for (int o = 1; o < 64; o <<= 1) v += __shfl_xor(v, o);
    return v;
}
__device__ __forceinline__ f32x2 gelu_pk(f32x2 v) {
    const f32x2 av = __builtin_elementwise_abs(v), d = av * 0.2316418882f + 1.0f;
    f32x2 t; t.x = __builtin_amdgcn_rcpf(d.x); t.y = __builtin_amdgcn_rcpf(d.y);
    f32x2 q = t * 0.5307027145f + (-0.7265760135f); q = q * t + 0.7107068705f; q = q * t + (-0.142248368f); q = q * t + 0.127414796f; q = q * t;
    const f32x2 s = (v * v) * (-0.72134752044f);
    f32x2 e; e.x = __builtin_amdgcn_exp2f(s.x); e.y = __builtin_amdgcn_exp2f(s.y);
    const f32x2 m = v * (q * e), r = v - m;
    f32x2 o; o.x = v.x < 0.f ? m.x : r.x; o.y = v.y < 0.f ? m.y : r.y; return o;
}
__device__ __forceinline__ f32x4 gelu4(f32x4 v) { const f32x2 a = gelu_pk((f32x2){v[0], v[1]}), b = gelu_pk((f32x2){v[2], v[3]}); return (f32x4){a.x, a.y, b.x, b.y}; }
__device__ __forceinline__ float dot4(f32x4 v) { return (v[0] * v[0] + v[1] * v[1]) + (v[2] * v[2] + v[3] * v[3]); }
__device__ __forceinline__ unsigned short f2bf_s(float f) { return (unsigned short)(cvtpk(f, 0.f) & 0xffffu); }
__device__ __forceinline__ float alibi_slope(int h) { return h < 8 ? exp2f(-(float)(h + 1)) : exp2f(-0.5f - (float)(h - 8)); }

struct Params {
    const float* in[28];
    float* out;
    unsigned char* ws;
    int ph_lo, ph_hi;
};

#define EPI_ARGS const f32x4 (&acc)[2][2][4][2], const Unit& u, int wr, int wc, int fr, int fq
#define FOR_AI_M _Pragma("unroll") for (int ai = 0; ai < 2; ++ai) _Pragma("unroll") for (int m = 0; m < 4; ++m)
#define BIG_ROWS(E) do { const int row0_ = u.pm * 256 + wr * 64 + fr; FOR_AI_M { f32x4 v_[2][2]; \
    _Pragma("unroll") for (int bj = 0; bj < 2; ++bj) _Pragma("unroll") for (int n = 0; n < 2; ++n) v_[bj][n] = acc[ai][bj][m][n]; \
    (E).row(v_, row0_ + ai * 128 + m * 16, u.pn, wc, fq); } } while (0)

__device__ __forceinline__ void head_norm(f32x4 (&v)[2][2], const float* gp, int fq) {
    float ss = (dot4(v[0][0]) + dot4(v[0][1])) + (dot4(v[1][0]) + dot4(v[1][1]));
    ss += __shfl_xor(ss, 16); ss += __shfl_xor(ss, 32);
    const float inv = rsqrtf(ss * (1.f / 64.f) + EPS);
#pragma unroll
    for (int bj = 0; bj < 2; ++bj)
#pragma unroll
        for (int n = 0; n < 2; ++n) { const f32x4 g = *(const f32x4*)(gp + 32 * bj + 8 * fq + 4 * n); v[bj][n] = v[bj][n] * inv * g; }
}

struct EpiInA {
    const float* ssq; bf16_t* Qb; const float* gt; float* out;
    __device__ __forceinline__ void row(f32x4 (&v)[2][2], int row, int pn, int wc, int fq) const {
        const int typ = pn < 3 ? 0 : pn - 2;
        const size_t doff = typ == 0 ? 0 : (size_t)M * 768 + (size_t)(typ - 1) * M * 256;
        const int ld = typ == 0 ? 768 : 256, cb = typ == 0 ? (pn * 4 + wc) * 64 : wc * 64;
        const float rs = rsqrtf(ssq[row] * (1.f / 1024.f) + EPS);
#pragma unroll
        for (int bj = 0; bj < 2; ++bj)
#pragma unroll
            for (int n = 0; n < 2; ++n) v[bj][n] = v[bj][n] * rs;
        if (typ != 2) head_norm(v, gt + typ * 64, fq);
#pragma unroll
        for (int bj = 0; bj < 2; ++bj) *(u32x4*)(Qb + doff + (size_t)row * ld + cb + 32 * bj + 8 * fq) = pack8(v[bj][0], v[bj][1]);
        if (typ == 1 || typ == 2) {
            long wo = -1;
            if (row >= MP) { const int ns = row - MP; wo = (long)O_WKS + (long)(typ - 1) * (long)(O_WVS - O_WKS) + (long)((ns >> 2) * 128 + 124 + (ns & 3)) * 256; }
            else if ((row & 4095) >= 3968) { const int b = row >> 12, t = row & 4095; wo = (long)O_WKP + (long)(typ - 1) * (long)(O_WVP - O_WKP) + (long)(b * 128 + t - 3968) * 256; }
            if (wo >= 0) { float* wout = out + wo;
#pragma unroll
                for (int bj = 0; bj < 2; ++bj)
#pragma unroll
                    for (int n = 0; n < 2; ++n) *(f32x4*)(wout + wc * 64 + 32 * bj + 8 * fq + 4 * n) = v[bj][n];
            }
        }
    }
    __device__ __forceinline__ void operator()(EPI_ARGS) const { BIG_ROWS(*this); }
};

struct EpiMemKV {
    const float* ssq; const float* xk; float *outk, *outv; bf16_t *MK, *MV;
    __device__ __forceinline__ void row(f32x4 (&v)[2][2], int row, int pn, int wc, int fq) const {
        const int layer = pn >> 1; const bool isv = pn & 1;
        float* of = (isv ? outv : outk) + (size_t)layer * MMEM * 256; bf16_t* ob = (isv ? MV : MK) + (size_t)layer * MMEM * 256;
        const float rs = rsqrtf(ssq[row] * (1.f / 1024.f) + EPS);
#pragma unroll
        for (int bj = 0; bj < 2; ++bj)
#pragma unroll
            for (int n = 0; n < 2; ++n) v[bj][n] = v[bj][n] * rs;
        if (!isv) head_norm(v, xk + layer * 64, fq);
#pragma unroll
        for (int bj = 0; bj < 2; ++bj) {
            const size_t o = (size_t)row * 256 + wc * 64 + 32 * bj + 8 * fq;
            *(u32x4*)(ob + o) = pack8(v[bj][0], v[bj][1]);
            *(f32x4*)(of + o) = v[bj][0]; *(f32x4*)(of + o + 4) = v[bj][1];
        }
    }
    __device__ __forceinline__ void operator()(EPI_ARGS) const { BIG_ROWS(*this); }
};

template <bool IN32, bool OUT32>
struct EpiRes {
    const float* xin_p; const float* xin_s; float* xout; bf16_t* xb; float* ssq;
    __device__ __forceinline__ void row(f32x4 (&v)[2][2], int row, int pn, int wc, int fq) const {
        const int col0 = pn * 256 + wc * 32 + 8 * fq;
        float ss = 0.f;
#pragma unroll
        for (int bj = 0; bj < 2; ++bj) {
            f32x4 x0, x1;
            if (IN32) { const float* src = (row < MP ? xin_p + (size_t)row * DM : xin_s + (size_t)(row - MP) * DM) + col0 + 128 * bj; x0 = *(const f32x4*)src; x1 = *(const f32x4*)(src + 4); }
            else { const u32x4 w = *(const u32x4*)(xb + (size_t)row * DM + col0 + 128 * bj); x0 = (f32x4){bflo(w.x), bfhi(w.x), bflo(w.y), bfhi(w.y)}; x1 = (f32x4){bflo(w.z), bfhi(w.z), bflo(w.w), bfhi(w.w)}; }
            x0 += v[bj][0]; x1 += v[bj][1];
            if (OUT32) { float* o = xout + (size_t)row * DM + col0 + 128 * bj; *(f32x4*)o = x0; *(f32x4*)(o + 4) = x1; }
            else { *(u32x4*)(xb + (size_t)row * DM + col0 + 128 * bj) = pack8(x0, x1); ss += dot4(x0) + dot4(x1); }
        }
        if (!OUT32) { ss += __shfl_xor(ss, 16); ss += __shfl_xor(ss, 32); if (fq == 0) atomicAdd(ssq + row, ss); }
    }
    __device__ __forceinline__ void operator()(EPI_ARGS) const { BIG_ROWS(*this); }
};

template <int CTRL> __device__ __forceinline__ float dpp_f(float x) { return __int_as_float(__builtin_amdgcn_update_dpp(0, __float_as_int(x), CTRL, 0xf, 0xf, false)); }
__device__ __forceinline__ float silu_f(float c) { return c * __builtin_amdgcn_rcpf(1.f + __builtin_amdgcn_exp2f(-c * LOG2E)); }

struct EpiFfnConv {
    const float* ssq; bf16_t* H; const float* cw; const float* cbp; float* side; float* convp; LAS float* xch;
    __device__ __forceinline__ void operator()(EPI_ARGS) const {
        const int pm = u.pm, ts = pm & 15, col0 = u.pn * 128 + wc * 32 + 8 * fq;
        const int rowbase = pm * 256 + wr * 64 + fr;
        if (fr >= 14) {
#pragma unroll
            for (int ai = 0; ai < 2; ++ai) {
                const float rs = rsqrtf(ssq[rowbase + ai * 128 + 48] * (1.f / 1024.f) + EPS);
                LAS float* x = xch + ((2 * ai + wr) * 2 + (fr - 14)) * 128 + wc * 32 + 8 * fq;
                *(LAS f32x4*)x = acc[ai][0][3][0] * rs; *(LAS f32x4*)(x + 4) = acc[ai][0][3][1] * rs;
            }
        }
        asm volatile("s_waitcnt lgkmcnt(0)" ::: "memory"); __builtin_amdgcn_s_barrier(); asm volatile("" ::: "memory");
        float w0[8], w1[8], w2[8], cb[8];
#pragma unroll
        for (int e = 0; e < 8; ++e) { w0[e] = cw[col0 + e]; w1[e] = cw[DFF + col0 + e]; w2[e] = cw[2 * DFF + col0 + e]; cb[e] = cbp[col0 + e]; }
#pragma unroll
        for (int ai = 0; ai < 2; ++ai) {
            const int blk = 2 * ai + wr;
            float prev[8];
            if (blk > 0) { const LAS float* x = xch + ((blk - 1) * 2 + (fr >= 14 ? fr - 14 : 0)) * 128 + wc * 32 + 8 * fq; const f32x4 p0 = *(const LAS f32x4*)x, p1 = *(const LAS f32x4*)(x + 4);
#pragma unroll
                for (int e = 0; e < 4; ++e) { prev[e] = p0[e]; prev[4 + e] = p1[e]; } }
            else {
#pragma unroll
                for (int e = 0; e < 8; ++e) prev[e] = 0.f; }
#pragma unroll
            for (int m = 0; m < 4; ++m) {
                const int row = rowbase + ai * 128 + m * 16;
                const float rs = rsqrtf(ssq[row] * (1.f / 1024.f) + EPS);
                float a[8], c[8], h[8], up[8];
#pragma unroll
                for (int e = 0; e < 8; ++e) { a[e] = acc[ai][0][m][e >> 2][e & 3] * rs; up[e] = acc[ai][1][m][e >> 2][e & 3] * rs; }
#pragma unroll
                for (int e = 0; e < 8; ++e) {
                    const float s1 = fr == 15 ? prev[e] : a[e], s2 = fr >= 14 ? prev[e] : a[e];
                    const float p1 = dpp_f<0x121>(s1), p2 = dpp_f<0x122>(s2);
                    c[e] = cb[e] + w0[e] * p2 + w1[e] * p1 + w2[e] * a[e];
                    h[e] = silu_f(c[e]) * up[e];
                }
                u32x4 w; w.x = cvtpk(h[0], h[1]); w.y = cvtpk(h[2], h[3]); w.z = cvtpk(h[4], h[5]); w.w = cvtpk(h[6], h[7]);
                *(u32x4*)(H + (size_t)row * DFF + col0) = w;
                if (ai == 0 && m == 0) { if (wr == 0 && ts > 0 && fr < 2) { float* d = side + (size_t)(pm * 2 + fr) * DFF + col0;
                        *(f32x4*)d = (f32x4){c[0], c[1], c[2], c[3]}; *(f32x4*)(d + 4) = (f32x4){c[4], c[5], c[6], c[7]};
                        *(f32x4*)(d + SIDE_N) = (f32x4){up[0], up[1], up[2], up[3]}; *(f32x4*)(d + SIDE_N + 4) = (f32x4){up[4], up[5], up[6], up[7]}; } }
                if (ai == 1 && m == 3) { if (wr == 1 && fr >= 14) { float* d = ts < 15 ? side + 2 * SIDE_N + (size_t)(pm * 2 + fr - 14) * DFF + col0 : convp + (size_t)((pm >> 4) * 2 + fr - 14) * DFF + col0;
                        *(f32x4*)d = (f32x4){a[0], a[1], a[2], a[3]}; *(f32x4*)(d + 4) = (f32x4){a[4], a[5], a[6], a[7]}; } }
#pragma unroll
                for (int e = 0; e < 8; ++e) prev[e] = a[e];
            }
        }
    }
};
__device__ __forceinline__ void ffn_fixup(const Params& P, int layer, const pg8::StaticOrder& S) {
    bf16_t* H = (bf16_t*)(P.ws + WS_H); const float* side = (const float*)(P.ws + WS_SIDE); const float* cw = P.in[25] + (size_t)layer * 3 * DFF;
    Unit u; int last = -1;
    for (int i = 0; S.next(i, u); ++i) {
        const int pm = u.pm; if ((pm & 15) == 0 || pm == last) continue; last = pm;
        for (int c4 = threadIdx.x; c4 < DFF / 4; c4 += 512) { const int col = 4 * c4;
            const f32x4 cp0 = *(const f32x4*)(side + (size_t)(pm * 2) * DFF + col), cp1 = *(const f32x4*)(side + (size_t)(pm * 2 + 1) * DFF + col);
            const f32x4 u0 = *(const f32x4*)(side + SIDE_N + (size_t)(pm * 2) * DFF + col), u1 = *(const f32x4*)(side + SIDE_N + (size_t)(pm * 2 + 1) * DFF + col);
            const f32x4 am2 = *(const f32x4*)(side + 2 * SIDE_N + (size_t)((pm - 1) * 2) * DFF + col), am1 = *(const f32x4*)(side + 2 * SIDE_N + (size_t)((pm - 1) * 2 + 1) * DFF + col);
            const f32x4 w0 = *(const f32x4*)(cw + col), w1 = *(const f32x4*)(cw + DFF + col);
            const f32x4 c0 = cp0 + w0 * am2 + w1 * am1, c1 = cp1 + w0 * am1;
            u32x2 h0, h1;
            h0.x = cvtpk(silu_f(c0[0]) * u0[0], silu_f(c0[1]) * u0[1]); h0.y = cvtpk(silu_f(c0[2]) * u0[2], silu_f(c0[3]) * u0[3]);
            h1.x = cvtpk(silu_f(c1[0]) * u1[0], silu_f(c1[1]) * u1[1]); h1.y = cvtpk(silu_f(c1[2]) * u1[2], silu_f(c1[3]) * u1[3]);
            *(u32x2*)(H + (size_t)(pm * 256) * DFF + col) = h0; *(u32x2*)(H + (size_t)(pm * 256 + 1) * DFF + col) = h1; }
    }
    asm volatile("s_waitcnt vmcnt(0)" ::: "memory"); __syncthreads();
}

struct EpiInB {
    const float* ssq; bf16_t *U, *GV, *XQ; const float* xg; float* ssqv;
    __device__ __forceinline__ void row(f32x4 (&v)[2][2], int row, int pn, int wc, int fq) const {
        const float rs = rsqrtf(ssq[row] * (1.f / 1024.f) + EPS);
        if (pn < 6) {
            bf16_t* dst = pn < 3 ? U : GV; const int col0 = (pn % 3) * 256 + wc * 32 + 8 * fq;
            float ss = 0.f;
#pragma unroll
            for (int bj = 0; bj < 2; ++bj) {
                const f32x4 v0 = gelu4(v[bj][0] * rs), v1 = gelu4(v[bj][1] * rs);
                *(u32x4*)(dst + (size_t)row * 768 + col0 + 128 * bj) = pack8(v0, v1);
                ss += dot4(v0) + dot4(v1);
            }
            if (pn >= 3) { ss += __shfl_xor(ss, 16); ss += __shfl_xor(ss, 32); if (fq == 0) atomicAdd(ssqv + row, ss); }
        } else {
#pragma unroll
            for (int bj = 0; bj < 2; ++bj)
#pragma unroll
                for (int n = 0; n < 2; ++n) v[bj][n] = v[bj][n] * rs;
            head_norm(v, xg, fq);
#pragma unroll
            for (int bj = 0; bj < 2; ++bj) *(u32x4*)(XQ + (size_t)row * 256 + wc * 64 + 32 * bj + 8 * fq) = pack8(v[bj][0], v[bj][1]);
        }
    }
    __device__ __forceinline__ void operator()(EPI_ARGS) const { BIG_ROWS(*this); }
};

template <int MB, int NS>
__device__ __forceinline__ void wave_gemm_part(const bf16_t* A, int lda, int row0, const bf16_t* Bt, int K, int pn, int wc, int k0, f32x4 (&acc)[MB][2][2]) {
    const int lane = threadIdx.x & 63, fr = lane & 15, fq = lane >> 4;
    const bf16_t* ap = A + (size_t)(row0 + fr) * lda + 8 * fq + k0;
    const bf16_t* bp[2][2];
#pragma unroll
    for (int bj = 0; bj < 2; ++bj)
#pragma unroll
        for (int n = 0; n < 2; ++n) bp[bj][n] = Bt + (size_t)(pn * 256 + 128 * bj + 32 * wc + pg8::perm32(16 * n + fr)) * K + 8 * fq + k0;
#pragma unroll
    for (int m = 0; m < MB; ++m)
#pragma unroll
        for (int bj = 0; bj < 2; ++bj)
#pragma unroll
            for (int n = 0; n < 2; ++n) acc[m][bj][n] = (f32x4){0.f, 0.f, 0.f, 0.f};
#pragma unroll
    for (int s0 = 0; s0 < NS; s0 += 4) {
        bf16x8 af[4][MB], bf[4][2][2];
#pragma unroll
        for (int j = 0; j < 4; ++j) if (s0 + j < NS) {
#pragma unroll
            for (int m = 0; m < MB; ++m) af[j][m] = *(const bf16x8*)(ap + (size_t)m * 16 * lda + (s0 + j) * 32);
#pragma unroll
            for (int bj = 0; bj < 2; ++bj)
#pragma unroll
                for (int n = 0; n < 2; ++n) bf[j][bj][n] = *(const bf16x8*)(bp[bj][n] + (s0 + j) * 32);
        }
#pragma unroll
        for (int j = 0; j < 4; ++j) if (s0 + j < NS) {
#pragma unroll
            for (int m = 0; m < MB; ++m)
#pragma unroll
                for (int bj = 0; bj < 2; ++bj)
#pragma unroll
                    for (int n = 0; n < 2; ++n) acc[m][bj][n] = __builtin_amdgcn_mfma_f32_16x16x32_bf16(bf[j][bj][n], af[j][m], acc[m][bj][n], 0, 0, 0);
        }
    }
}
template <int MB>
__device__ __forceinline__ void sample_reduce_store(LAS unsigned char* lds, const f32x4 (&acc)[MB][2][2], int wave, int lane) {
    LAS f32x4* Pl = (LAS f32x4*)lds;
#pragma unroll
    for (int m = 0; m < MB; ++m)
#pragma unroll
        for (int bj = 0; bj < 2; ++bj)
#pragma unroll
            for (int n = 0; n < 2; ++n) Pl[((wave * MB + m) * 4 + bj * 2 + n) * 64 + lane] = acc[m][bj][n];
}
template <int MB>
__device__ __forceinline__ void sample_reduce_load(const LAS unsigned char* lds, f32x4 (&v)[2][2], int m, int lane) {
    const LAS f32x4* Pl = (const LAS f32x4*)lds;
#pragma unroll
    for (int bj = 0; bj < 2; ++bj)
#pragma unroll
        for (int n = 0; n < 2; ++n) { f32x4 sum = Pl[((0 * MB + m) * 4 + bj * 2 + n) * 64 + lane];
#pragma unroll
            for (int w = 1; w < 8; ++w) sum += Pl[((w * MB + m) * 4 + bj * 2 + n) * 64 + lane];
            v[bj][n] = sum; }
}
template <int MB, int NS, class Epi>
__device__ __forceinline__ void sample_gemm(LAS unsigned char* lds, const bf16_t* A, int lda, const bf16_t* Bt, int ntiles, const Epi& E, int blk, int nblk) {
    const int lane = threadIdx.x & 63, fr = lane & 15, fq = lane >> 4, wave = __builtin_amdgcn_readfirstlane(threadIdx.x >> 6);
    constexpr int NRB = MS / (16 * MB), K = 8 * NS * 32;
    const int ntask = NRB * ntiles * 4;
    for (int t = blk; t < ntask; t += nblk) {
        const int rb = t % NRB, cw = t / NRB, pn = cw >> 2, wc = cw & 3;
        f32x4 acc[MB][2][2];
        wave_gemm_part<MB, NS>(A, lda, MP + rb * 16 * MB, Bt, K, pn, wc, wave * NS * 32, acc);
        sample_reduce_store<MB>(lds, acc, wave, lane);
        __syncthreads();
        if (wave < MB) { f32x4 v[2][2]; sample_reduce_load<MB>(lds, v, wave, lane); E.row(v, MP + rb * 16 * MB + 16 * wave + fr, pn, wc, fq); }
        __syncthreads();
    }
}
__device__ __forceinline__ void sample_ffn(const Params& P, LAS unsigned char* lds, int layer, const float* ssq, int blk, int nblk) {
    const int lane = threadIdx.x & 63, fr = lane & 15, fq = lane >> 4, wave = __builtin_amdgcn_readfirstlane(threadIdx.x >> 6);
    const bf16_t* XB = (const bf16_t*)(P.ws + WS_XB); const bf16_t* Wt = (const bf16_t*)(P.ws + WS_WFFN) + (size_t)layer * NFF * DM; bf16_t* Hb = (bf16_t*)(P.ws + WS_H);
    const float* cw = P.in[25] + (size_t)layer * 3 * DFF; const float* cbp = P.in[26] + (size_t)layer * DFF; const float* st = P.in[6] + (size_t)layer * NDEC * 2 * DFF;
    float* convs = P.out + O_CONVS + (size_t)layer * NDEC * 2 * DFF;
    constexpr int MB = 4, NRB = MS / 64, NTASK = NRB * 22 * 4;
    for (int t = blk; t < NTASK; t += nblk) {
        const int rb = t % NRB, cwi = t / NRB, pn = cwi >> 2, wc = cwi & 3;
        f32x4 acc[MB][2][2];
        wave_gemm_part<MB, 4>(XB, DM, MP + rb * 64, Wt, DM, pn, wc, wave * 128, acc);
        sample_reduce_store<MB>(lds, acc, wave, lane);
        __syncthreads();
        if (wave < MB) {
            f32x4 v[2][2]; sample_reduce_load<MB>(lds, v, wave, lane);
            const int col0 = pn * 128 + wc * 32 + 8 * fq, s = fr & 3;
            const int row = MP + rb * 64 + 16 * wave + fr, nseq = (row - MP) >> 2;
            const float rs = rsqrtf(ssq[row] * (1.f / 1024.f) + EPS);
            float h[8];
#pragma unroll
            for (int e = 0; e < 8; ++e) {
                const float a = v[0][e >> 2][e & 3] * rs, up = v[1][e >> 2][e & 3] * rs;
                const float st0 = st[(size_t)(nseq * 2 + 0) * DFF + col0 + e], st1 = st[(size_t)(nseq * 2 + 1) * DFF + col0 + e];
                const float r1 = dpp_f<0x121>(a), r2 = dpp_f<0x122>(a);
                const float p1 = s >= 1 ? r1 : st1, p2 = s >= 2 ? r2 : (s == 1 ? st1 : st0);
                const float c = cbp[col0 + e] + cw[col0 + e] * p2 + cw[DFF + col0 + e] * p1 + cw[2 * DFF + col0 + e] * a;
                h[e] = silu_f(c) * up;
                if (s >= 2) convs[(size_t)(nseq * 2 + (s - 2)) * DFF + col0 + e] = a;
            }
            u32x4 w; w.x = cvtpk(h[0], h[1]); w.y = cvtpk(h[2], h[3]); w.z = cvtpk(h[4], h[5]); w.w = cvtpk(h[6], h[7]);
            *(u32x4*)(Hb + (size_t)row * DFF + col0) = w;
        }
        __syncthreads();
    }
}

__device__ __forceinline__ void p0_transpose_item(const float* W, int K, int N, const float* gain, bf16_t* WT, int kb, int n0, int drow0, LAS float* scr, int lane) {
    const int k0 = 64 * kb;
#pragma unroll 8
    for (int i = 0; i < 32; ++i) { const int kk = 2 * i + (lane >> 5); float w = W[(size_t)(k0 + kk) * N + n0 + (lane & 31)]; if (gain) w *= gain[k0 + kk]; scr[kk * 33 + (lane & 31)] = w; }
    asm volatile("s_waitcnt lgkmcnt(0)" ::: "memory");
    const int c = lane & 7;
#pragma unroll
    for (int j = 0; j < 4; ++j) { const int n = (lane >> 3) + 8 * j; const LAS float* s = scr + (8 * c) * 33 + n;
        u32x4 o; o.x = cvtpk(s[0 * 33], s[1 * 33]); o.y = cvtpk(s[2 * 33], s[3 * 33]); o.z = cvtpk(s[4 * 33], s[5 * 33]); o.w = cvtpk(s[6 * 33], s[7 * 33]);
        *(u32x4*)(WT + (size_t)(drow0 + n) * K + k0 + 8 * c) = o; }
    asm volatile("s_waitcnt lgkmcnt(0)" ::: "memory");
}
__device__ __forceinline__ int map_headperm(int nb) { const int p = (nb * 32) & 255, bj = p >> 7, wc = (p >> 5) & 3; return ((nb * 32) & ~255) + 64 * wc + 32 * bj; }
__device__ __forceinline__ int map_ffn(int nb) { const int tile = nb >> 3, p = (nb & 7) * 32; return p < 128 ? 128 * tile + p : DFF + 128 * tile + (p - 128); }

__device__ __forceinline__ void row_to_bf16(const float* xrow, bf16_t* orow, float* ssq, int lane) {
    const f32x4* xr = (const f32x4*)xrow + lane; f32x4 v[4]; float s = 0.f;
#pragma unroll
    for (int j = 0; j < 4; ++j) { v[j] = xr[64 * j]; s += dot4(v[j]); }
    s = wave_sum(s);
    u32x2* o8 = (u32x2*)orow + lane;
#pragma unroll
    for (int j = 0; j < 4; ++j) { u32x2 w; w.x = cvtpk(v[j][0], v[j][1]); w.y = cvtpk(v[j][2], v[j][3]); o8[64 * j] = w; }
    if (lane == 0) *ssq = s;
}

__device__ __forceinline__ void p0_prologue(const Params& P, LAS unsigned char* lds, int G, int bid) {
    const int tid = threadIdx.x, lane = tid & 63, wave = __builtin_amdgcn_readfirstlane(tid >> 6);
    LAS float* scr = (LAS float*)(lds + wave * 16384);
    const int gw = bid * 8 + wave, NGW = G * 8;
    unsigned char* ws = P.ws;
    float* ssq = (float*)(ws + WS_SSQ);
    constexpr int I0 = 16 * 48, I1 = 16 * 32, I2 = 16 * 56, I3 = 16 * 32, I4 = 16 * 16, I6 = 16 * 176, I8 = 44 * 32;
    constexpr int NITEMS = I0 + I1 + I2 + I3 + 2 * I4 + 2 * I6 + 2 * I8;
    for (int it = gw; it < NITEMS; it += NGW) {
        int r = it;
        if (r < I0) { const int nb = r % 48, kb = r / 48; p0_transpose_item(P.in[11], 1024, NINA, P.in[8], (bf16_t*)(ws + WS_WINA), kb, map_headperm(nb), 32 * nb, scr, lane); continue; } r -= I0;
        if (r < I1) { const int nb = r % 32, kb = r / 32; p0_transpose_item(P.in[15], 1024, 1024, nullptr, (bf16_t*)(ws + WS_WOUTA), kb, 32 * nb, 32 * nb, scr, lane); continue; } r -= I1;
        if (r < I2) { const int nb = r % 56, kb = r / 56; p0_transpose_item(P.in[16], 1024, NINB, P.in[8] + 1024, (bf16_t*)(ws + WS_WINB), kb, nb < 48 ? 32 * nb : map_headperm(nb), 32 * nb, scr, lane); continue; } r -= I2;
        if (r < I3) { const int nb = r % 32, kb = r / 32; p0_transpose_item(P.in[20], 1024, 1024, nullptr, (bf16_t*)(ws + WS_WOUTB), kb, 32 * nb, 32 * nb, scr, lane); continue; } r -= I3;
        if (r < 2 * I4) { const int l = r / I4; r -= l * I4; const int nb = r % 16, kb = r / 16;
            p0_transpose_item(P.in[21] + (size_t)l * 1024 * 512, 1024, 512, P.in[10] + l * 1024, (bf16_t*)(ws + WS_WMKV) + (size_t)l * 512 * 1024, kb, map_headperm(nb), 32 * nb, scr, lane); continue; } r -= 2 * I4;
        if (r < 2 * I6) { const int l = r / I6; r -= l * I6; const int nb = r % 176, kb = r / 176;
            p0_transpose_item(P.in[24] + (size_t)l * 1024 * NFF, 1024, NFF, P.in[9] + l * 1024, (bf16_t*)(ws + WS_WFFN) + (size_t)l * NFF * 1024, kb, map_ffn(nb), 32 * nb, scr, lane); continue; } r -= 2 * I6;
        { const int l = r / I8; r -= l * I8; const int nb = r % 32, kb = r / 32;
            p0_transpose_item(P.in[27] + (size_t)l * DFF * 1024, DFF, 1024, nullptr, (bf16_t*)(ws + WS_WDOWN) + (size_t)l * 1024 * DFF, kb, 32 * nb, 32 * nb, scr, lane); }
    }
    bf16_t* XB = (bf16_t*)(ws + WS_XB); bf16_t* MEMB = (bf16_t*)(ws + WS_MEMB);
    for (int r = gw; r < M + MMEM; r += NGW) {
        if (r < MP) row_to_bf16(P.in[0] + (size_t)r * DM, XB + (size_t)r * DM, ssq + r, lane);
        else if (r < M) row_to_bf16(P.in[1] + (size_t)(r - MP) * DM, XB + (size_t)r * DM, ssq + r, lane);
        else row_to_bf16(P.in[7] + (size_t)(r - M) * DM, MEMB + (size_t)(r - M) * DM, ssq + 5 * M + (r - M), lane);
    }
    const int gt = bid * 512 + tid, NGT = G * 512;
    for (int i = gt; i < 4 * M; i += NGT) ssq[M + i] = 0.f;
    if (gt < 256) { float* GT = (float*)(ws + WS_GT); const int t4 = gt >> 6, d = gt & 63; GT[gt] = t4 == 0 ? P.in[12][d] : t4 == 1 ? P.in[13][d] : t4 == 2 ? 1.f : P.in[22][d]; }
    { bf16_t* WST = (bf16_t*)(ws + WS_WST); const float* wsb = P.in[18];
      for (int i = gt; i < 4 * 128 * 128; i += NGT) { const int ii = (i >> 7) & 127, jj = i & 127; const float w = jj <= ii ? wsb[i] : 0.f; WST[i] = (bf16_t)(cvtpk(w, 0.f) & 0xffffu); } }
    { const f32x4* ck = (const f32x4*)P.in[2]; const f32x4* cv = (const f32x4*)P.in[3]; f32x4* ok = (f32x4*)(P.out + O_WKS); f32x4* ov = (f32x4*)(P.out + O_WVS);
      for (int i = gt; i < NDEC * 124 * 64; i += NGT) { const int n = i / (124 * 64), r = i % (124 * 64); const size_t s = (size_t)n * 128 * 64 + 4 * 64 + r, d = (size_t)n * 128 * 64 + r; ok[d] = ck[s]; ov[d] = cv[s]; } }
}

__device__ __forceinline__ int crow(int r, int hi) { return (r & 3) + 8 * (r >> 2) + 4 * hi; }
__device__ __forceinline__ int kv_off(int row, int chunk) { return row * 128 + ((chunk ^ (row & 7)) << 4); }
__device__ __forceinline__ s16x4 vtr(const LAS unsigned char* p) { return __builtin_bit_cast(s16x4, __builtin_amdgcn_ds_read_tr16_b64_v4i16((LAS s16x4*)p)); }

struct AttnOfs { int k[4]; int v[2]; };
__device__ __forceinline__ AttnOfs attn_ofs() {
    const int lane = threadIdx.x & 63, r32 = lane & 31, hi = lane >> 5; AttnOfs a;
#pragma unroll
    for (int ks = 0; ks < 4; ++ks) a.k[ks] = r32 * 128 + (((2 * ks + hi) ^ (r32 & 7)) << 4);
    const int vkey = 4 * hi + ((lane & 15) >> 2), vcol = 16 * ((lane >> 4) & 1) + 4 * (lane & 3);
#pragma unroll
    for (int d0 = 0; d0 < 2; ++d0) a.v[d0] = vkey * 128 + (((4 * d0 + (vcol >> 3)) ^ vkey) << 4) + (vcol & 7) * 2;
    return a;
}
template <int CT, bool MASK, bool FIRST>
__device__ __forceinline__ void attn_chunk(const bf16x8 (&qf)[4], const AttnOfs& ao, const LAS unsigned char* Kb, const LAS unsigned char* Vb, int qpos, int kpos0, float slope2, LAS float* wsf, float& m, float& l, f32x16 (&o)[2]) {
    const int lane = threadIdx.x & 63, r32 = lane & 31, hi = lane >> 5;
    f32x16 s[CT];
#pragma unroll
    for (int t = 0; t < CT; ++t) {
#pragma unroll
        for (int r = 0; r < 16; ++r) s[t][r] = 0.f;
#pragma unroll
        for (int ks = 0; ks < 4; ++ks) { const bf16x8 kf = *(const LAS bf16x8*)(Kb + ao.k[ks] + t * 4096); s[t] = __builtin_amdgcn_mfma_f32_32x32x16_bf16(kf, qf[ks], s[t], 0, 0, 0); }
    }
    const float C2 = 0.125f * LOG2E;
    float mx = -1e30f;
    if (MASK) {
        int dbase = qpos - kpos0 - 4 * hi; asm volatile("" : "+v"(dbase));
        const float fdb = (float)dbase, lim = (float)(qpos < 127 ? qpos : 127), ns = -slope2;
#pragma unroll
        for (int t = 0; t < CT; ++t)
#pragma unroll
            for (int r = 0; r < 16; ++r) {
                const float fd = fdb - (float)(32 * t + (r & 3) + 8 * (r >> 2));
                float v = __builtin_fmaf(ns, fd, s[t][r] * C2);
                v = (fd >= 0.f && fd <= lim) ? v : -1e30f;
                s[t][r] = v; mx = fmaxf(mx, v);
            }
    } else {
#pragma unroll
        for (int t = 0; t < CT; ++t)
#pragma unroll
            for (int r = 0; r < 16; ++r) { const float v = s[t][r] * C2; s[t][r] = v; mx = fmaxf(mx, v); }
    }
    mx = fmaxf(mx, __shfl_xor(mx, 32));
    const float mn = fmaxf(m, mx), alpha = __builtin_amdgcn_exp2f(m - mn);
    m = mn;
    float sum = 0.f;
#pragma unroll
    for (int t = 0; t < CT; ++t)
#pragma unroll
        for (int r = 0; r < 16; ++r) { const float e = __builtin_amdgcn_exp2f(s[t][r] - mn); s[t][r] = e; sum += e; }
    l = l * alpha + sum;
    if (!FIRST) {
        if (hi == 0) wsf[r32] = alpha;
        asm volatile("s_waitcnt lgkmcnt(0)" ::: "memory");
#pragma unroll
        for (int r = 0; r < 16; ++r) { const float a = wsf[crow(r, hi)]; o[0][r] *= a; o[1][r] *= a; }
        asm volatile("s_waitcnt lgkmcnt(0)" ::: "memory");
    }
#pragma unroll
    for (int t = 0; t < CT; ++t)
#pragma unroll
        for (int k2 = 0; k2 < 2; ++k2) {
            u32x4 pw; pw.x = cvtpk(s[t][8 * k2 + 0], s[t][8 * k2 + 1]); pw.y = cvtpk(s[t][8 * k2 + 2], s[t][8 * k2 + 3]); pw.z = cvtpk(s[t][8 * k2 + 4], s[t][8 * k2 + 5]); pw.w = cvtpk(s[t][8 * k2 + 6], s[t][8 * k2 + 7]);
            const bf16x8 pa = __builtin_bit_cast(bf16x8, pw);
#pragma unroll
            for (int d0 = 0; d0 < 2; ++d0) {
                const LAS unsigned char* vp = Vb + ao.v[d0] + (32 * t + 16 * k2) * 128;
                const s16x4 lo = vtr(vp), hh = vtr(vp + 1024);
                const bf16x8 vf = (bf16x8){lo[0], lo[1], lo[2], lo[3], hh[0], hh[1], hh[2], hh[3]};
                o[d0] = __builtin_amdgcn_mfma_f32_32x32x16_bf16(pa, vf, o[d0], 0, 0, 0);
            }
        }
}
__device__ __forceinline__ void attn_init(bool mask, float sink2, float& m, float& l, f32x16 (&o)[2]) {
    const int hi = (threadIdx.x & 63) >> 5;
    m = mask ? sink2 : -1e30f; l = (mask && hi == 0) ? 1.f : 0.f;
#pragma unroll
    for (int r = 0; r < 16; ++r) { o[0][r] = 0.f; o[1][r] = 0.f; }
}
__device__ __forceinline__ void attn_finish(float l, LAS float* wsf, f32x16 (&o)[2], LAS unsigned short* stg) {
    const int lane = threadIdx.x & 63, r32 = lane & 31, hi = lane >> 5;
    l += __shfl_xor(l, 32);
    if (hi == 0) wsf[r32] = 1.0f / l;
    asm volatile("s_waitcnt lgkmcnt(0)" ::: "memory");
#pragma unroll
    for (int r = 0; r < 16; ++r) { const float li = wsf[crow(r, hi)]; const int q = crow(r, hi);
        stg[q * 64 + r32] = (unsigned short)(cvtpk(o[0][r] * li, 0.f) & 0xffffu); stg[q * 64 + 32 + r32] = (unsigned short)(cvtpk(o[1][r] * li, 0.f) & 0xffffu); }
    asm volatile("s_waitcnt lgkmcnt(0)" ::: "memory");
}
__device__ __forceinline__ void attn_swa(const bf16x8 (&qf)[4], const AttnOfs& ao, const LAS unsigned char* Kb, const LAS unsigned char* Vb, int qpos, int kpos0, float slope2, float sink2, LAS float* wsf, LAS unsigned short* stg) {
    float m, l; f32x16 o[2]; attn_init(true, sink2, m, l, o);
    attn_chunk<3, true, true>(qf, ao, Kb, Vb, qpos, kpos0, slope2, wsf, m, l, o);
    attn_chunk<2, true, false>(qf, ao, Kb + 96 * 128, Vb + 96 * 128, qpos, kpos0 + 96, slope2, wsf, m, l, o);
    attn_finish(l, wsf, o, stg);
}
__device__ __forceinline__ void attn_mem(const bf16x8 (&qf)[4], const AttnOfs& ao, const LAS unsigned char* Kb, const LAS unsigned char* Vb, LAS float* wsf, LAS unsigned short* stg) {
    float m, l; f32x16 o[2]; attn_init(false, 0.f, m, l, o);
    attn_chunk<2, false, true>(qf, ao, Kb, Vb, 0, 0, 0.f, wsf, m, l, o);
#pragma unroll 1
    for (int c = 1; c < 4; ++c) attn_chunk<2, false, false>(qf, ao, Kb + c * 64 * 128, Vb + c * 64 * 128, 0, 0, 0.f, wsf, m, l, o);
    attn_finish(l, wsf, o, stg);
}
__device__ __forceinline__ void stage_out(const LAS unsigned short* stg, bf16_t* gdst, size_t ld) {
    const int lane = threadIdx.x & 63;
#pragma unroll
    for (int i = 0; i < 4; ++i) { const int row = i * 8 + (lane >> 3), ch = lane & 7; *(u32x4*)(gdst + (size_t)row * ld + ch * 8) = *(const LAS u32x4*)(stg + row * 64 + ch * 8); }
    asm volatile("s_waitcnt lgkmcnt(0)" ::: "memory");
}

__device__ __forceinline__ void unit_swa_prompt(const Params& P, LAS unsigned char* lds, LAS float* wsf, int b, int qb, int g) {
    const int tid = threadIdx.x, lane = tid & 63, wave = __builtin_amdgcn_readfirstlane(tid >> 6), r32 = lane & 31, hi = lane >> 5;
    const bf16_t* Qg = (const bf16_t*)(P.ws + WS_Q); const bf16_t* Kg = (const bf16_t*)(P.ws + WS_K); const bf16_t* Vg = (const bf16_t*)(P.ws + WS_V); bf16_t* Og = (bf16_t*)(P.ws + WS_O);
    LAS unsigned char* Kl = lds; LAS unsigned char* Vl = lds + 49152; LAS unsigned short* stg = (LAS unsigned short*)(lds + 98304 + wave * 4096);
#pragma unroll 2
    for (int idx = tid; idx < 384 * 8; idx += 512) {
        const int row = idx >> 3, ch = idx & 7, t = 256 * qb - 128 + row;
        u32x4 kv = (u32x4){0u, 0u, 0u, 0u}, vv = kv;
        if (t >= 0) { const size_t o = (size_t)(b * SEQ + t) * 256 + g * 64 + ch * 8; kv = *(const u32x4*)(Kg + o); vv = *(const u32x4*)(Vg + o); }
        *(LAS u32x4*)(Kl + kv_off(row, ch)) = kv; *(LAS u32x4*)(Vl + kv_off(row, ch)) = vv;
    }
    __syncthreads();
    const AttnOfs ao = attn_ofs();
    const int t0 = 256 * qb + 32 * wave;
#pragma unroll 1
    for (int hh = 0; hh < 3; ++hh) {
        const int head = 3 * g + hh;
        bf16x8 qf[4];
#pragma unroll
        for (int ks = 0; ks < 4; ++ks) qf[ks] = *(const bf16x8*)(Qg + (size_t)(b * SEQ + t0 + r32) * 768 + head * 64 + 16 * ks + 8 * hi);
        attn_swa(qf, ao, Kl + 32 * wave * 128, Vl + 32 * wave * 128, t0 + r32, t0 - 128, alibi_slope(head) * LOG2E, P.in[14][head] * LOG2E, wsf, stg);
        stage_out(stg, Og + (size_t)(b * SEQ + t0) * DM + head * 64, DM);
    }
    __syncthreads();
}

__device__ __forceinline__ void unit_mem_prompt(const Params& P, LAS unsigned char* lds, LAS float* wsf, int layer, int b, int qb, int h) {
    const int tid = threadIdx.x, lane = tid & 63, wave = __builtin_amdgcn_readfirstlane(tid >> 6), r32 = lane & 31, hi = lane >> 5;
    const bf16_t* XQ = (const bf16_t*)(P.ws + WS_XQ); bf16_t* Og = (bf16_t*)(P.ws + WS_O);
    const bf16_t* MK = (const bf16_t*)(P.ws + WS_MK) + (size_t)layer * MMEM * 256; const bf16_t* MV = (const bf16_t*)(P.ws + WS_MV) + (size_t)layer * MMEM * 256;
    LAS unsigned char* Kl = lds; LAS unsigned char* Vl = lds + 32768; LAS unsigned short* stg = (LAS unsigned short*)(lds + 98304 + wave * 4096);
#pragma unroll 2
    for (int idx = tid; idx < 256 * 8; idx += 512) {
        const int row = idx >> 3, ch = idx & 7; const size_t o = (size_t)(b * NMEM + row) * 256 + h * 64 + ch * 8;
        *(LAS u32x4*)(Kl + kv_off(row, ch)) = *(const u32x4*)(MK + o); *(LAS u32x4*)(Vl + kv_off(row, ch)) = *(const u32x4*)(MV + o);
    }
    __syncthreads();
    const AttnOfs ao = attn_ofs();
    const int t0 = 256 * qb + 32 * wave;
    bf16x8 qf[4];
#pragma unroll
    for (int ks = 0; ks < 4; ++ks) qf[ks] = *(const bf16x8*)(XQ + (size_t)(b * SEQ + t0 + r32) * 256 + h * 64 + 16 * ks + 8 * hi);
    attn_mem(qf, ao, Kl, Vl, wsf, stg);
    stage_out(stg, Og + (size_t)(b * SEQ + t0) * DM + 768 + h * 64, DM);
    __syncthreads();
}

__device__ __forceinline__ u32x4 ld8f_pack(const float* p) { const f32x4 a = *(const f32x4*)p, b = *(const f32x4*)(p + 4); return pack8(a, b); }

__device__ __forceinline__ void unit_swa_sample(const Params& P, LAS unsigned char* lds, LAS float* wsf, int n, int gp) {
    const int tid = threadIdx.x, lane = tid & 63, wave = __builtin_amdgcn_readfirstlane(tid >> 6), r32 = lane & 31, hi = lane >> 5;
    const bf16_t* Qg = (const bf16_t*)(P.ws + WS_Q); const bf16_t* Kg = (const bf16_t*)(P.ws + WS_K); const bf16_t* Vg = (const bf16_t*)(P.ws + WS_V); bf16_t* Og = (bf16_t*)(P.ws + WS_O);
#pragma unroll 1
    for (int idx = tid; idx < 2 * 160 * 8; idx += 512) {
        const int gi = idx / 1280, rem = idx % 1280, row = rem >> 3, ch = rem & 7, g = 2 * gp + gi;
        LAS unsigned char* Kl = lds + gi * 40960; LAS unsigned char* Vl = Kl + 20480;
        u32x4 kv = (u32x4){0u, 0u, 0u, 0u}, vv = kv;
        if (row < 128) { const size_t o = ((size_t)(n * 128 + row) * 4 + g) * 64 + ch * 8; kv = ld8f_pack(P.in[2] + o); vv = ld8f_pack(P.in[3] + o); }
        else if (row < 132) { const size_t o = (size_t)(MP + 4 * n + row - 128) * 256 + g * 64 + ch * 8; kv = *(const u32x4*)(Kg + o); vv = *(const u32x4*)(Vg + o); }
        *(LAS u32x4*)(Kl + kv_off(row, ch)) = kv; *(LAS u32x4*)(Vl + kv_off(row, ch)) = vv;
    }
    __syncthreads();
    if (wave < 2) {
        LAS unsigned short* stg = (LAS unsigned short*)(lds + 98304 + wave * 4096);
        const AttnOfs ao = attn_ofs();
        const int g = 2 * gp + wave; const bool qv = r32 < 12; const int hh = qv ? (r32 >> 2) : 0, sidx = r32 & 3, head = 3 * g + hh;
        bf16x8 qf[4];
#pragma unroll
        for (int ks = 0; ks < 4; ++ks) { qf[ks] = *(const bf16x8*)(Qg + (size_t)(MP + 4 * n + sidx) * 768 + head * 64 + 16 * ks + 8 * hi); if (!qv) qf[ks] = (bf16x8){0, 0, 0, 0, 0, 0, 0, 0}; }
        const LAS unsigned char* Kl = lds + wave * 40960;
        attn_swa(qf, ao, Kl, Kl + 20480, 128 + sidx, 0, alibi_slope(head) * LOG2E, P.in[14][head] * LOG2E, wsf, stg);
        for (int i = lane; i < 96; i += 64) { const int q = i >> 3, ch = i & 7;
            *(u32x4*)(Og + (size_t)(MP + 4 * n + (q & 3)) * DM + (3 * g + (q >> 2)) * 64 + ch * 8) = *(const LAS u32x4*)(stg + q * 64 + ch * 8); }
        asm volatile("s_waitcnt lgkmcnt(0)" ::: "memory");
    }
    __syncthreads();
}

__device__ __forceinline__ void unit_mem_sample(const Params& P, LAS unsigned char* lds, LAS float* wsf, int layer, int n, int hp) {
    const int tid = threadIdx.x, lane = tid & 63, wave = __builtin_amdgcn_readfirstlane(tid >> 6), r32 = lane & 31, hi = lane >> 5;
    const bf16_t* XQ = (const bf16_t*)(P.ws + WS_XQ); bf16_t* Og = (bf16_t*)(P.ws + WS_O);
    const float* ck = P.in[4] + (size_t)(layer * NDEC + n) * NMEM * 256; const float* cv = P.in[5] + (size_t)(layer * NDEC + n) * NMEM * 256;
#pragma unroll 2
    for (int idx = tid; idx < 256 * 16; idx += 512) {
        const int row = idx >> 4, hsel = (idx >> 3) & 1, ch = idx & 7; const size_t o = (size_t)row * 256 + (2 * hp + hsel) * 64 + ch * 8;
        LAS unsigned char* Kl = lds + hsel * 65536;
        *(LAS u32x4*)(Kl + kv_off(row, ch)) = ld8f_pack(ck + o); *(LAS u32x4*)(Kl + 32768 + kv_off(row, ch)) = ld8f_pack(cv + o);
    }
    __syncthreads();
    if (wave < 2) {
        LAS unsigned short* stg = (LAS unsigned short*)(lds + OSTG2_OFF + wave * 4096);
        const AttnOfs ao = attn_ofs();
        const int h = 2 * hp + wave; const bool qv = r32 < 4;
        bf16x8 qf[4];
#pragma unroll
        for (int ks = 0; ks < 4; ++ks) { qf[ks] = *(const bf16x8*)(XQ + (size_t)(MP + 4 * n + (r32 & 3)) * 256 + h * 64 + 16 * ks + 8 * hi); if (!qv) qf[ks] = (bf16x8){0, 0, 0, 0, 0, 0, 0, 0}; }
        const LAS unsigned char* Kl = lds + wave * 65536;
        attn_mem(qf, ao, Kl, Kl + 32768, wsf, stg);
        if (lane < 32) { const int q = lane >> 3, ch = lane & 7;
            *(u32x4*)(Og + (size_t)(MP + 4 * n + q) * DM + 768 + h * 64 + ch * 8) = *(const LAS u32x4*)(stg + q * 64 + ch * 8); }
        asm volatile("s_waitcnt lgkmcnt(0)" ::: "memory");
    }
    __syncthreads();
}

__device__ __forceinline__ void unit_gmlp_prompt(const Params& P, LAS unsigned char* lds, int b, int c) {
    const int tid = threadIdx.x, lane = tid & 63, wave = __builtin_amdgcn_readfirstlane(tid >> 6), r32 = lane & 31, hi = lane >> 5;
    const bf16_t* U = (const bf16_t*)(P.ws + WS_U); const bf16_t* GV = (const bf16_t*)(P.ws + WS_GV); bf16_t* Og = (bf16_t*)(P.ws + WS_O);
    const bf16_t* WST = (const bf16_t*)(P.ws + WS_WST); const float* ssqv = (const float*)(P.ws + WS_SSQ) + 4 * M;
    const float* vg = P.in[17]; const float* bs = P.in[19]; float* cvp = P.out + O_CVP;
    const int rowb = b * SEQ + c * 128;
    const int ib = wave & 3, cb0 = 3 * (wave >> 2);
#pragma unroll 1
    for (int g = 0; g < 4; ++g) {
        for (int idx = tid; idx < 128 * 24; idx += 512) {
            const int j = idx / 24, ch = idx % 24; const int row = rowb + j, col = g * 192 + ch * 8;
            const float rv = rsqrtf(ssqv[row] * (1.f / 768.f) + EPS);
            const u32x4 w = *(const u32x4*)(GV + (size_t)row * 768 + col);
            const f32x4 g0 = *(const f32x4*)(vg + col), g1 = *(const f32x4*)(vg + col + 4);
            f32x4 v0 = (f32x4){bflo(w.x), bfhi(w.x), bflo(w.y), bfhi(w.y)}, v1 = (f32x4){bflo(w.z), bfhi(w.z), bflo(w.w), bfhi(w.w)};
            v0 = v0 * rv * g0; v1 = v1 * rv * g1;
            *(LAS u32x4*)(lds + j * 384 + ch * 16) = pack8(v0, v1);
            if (c == 31) { float* o = cvp + (size_t)(b * 128 + j) * 768 + col; *(f32x4*)o = v0; *(f32x4*)(o + 4) = v1; }
        }
        __syncthreads();
        f32x16 acc[3];
#pragma unroll
        for (int i = 0; i < 3; ++i)
#pragma unroll
            for (int r = 0; r < 16; ++r) acc[i][r] = 0.f;
        const int nks = 2 * (ib + 1);
#pragma unroll 1
        for (int ks = 0; ks < nks; ++ks) {
            const bf16x8 af = *(const bf16x8*)(WST + (size_t)(g * 128 + 32 * ib + r32) * 128 + 16 * ks + 8 * hi);
            const int j0 = 16 * ks + 8 * hi + ((lane & 15) >> 2);
#pragma unroll
            for (int i = 0; i < 3; ++i) {
                const int col = 32 * (cb0 + i) + 16 * ((lane >> 4) & 1) + 4 * (lane & 3);
                const s16x4 lo = vtr(lds + j0 * 384 + col * 2), hh = vtr(lds + (j0 + 4) * 384 + col * 2);
                const bf16x8 vf = (bf16x8){lo[0], lo[1], lo[2], lo[3], hh[0], hh[1], hh[2], hh[3]};
                acc[i] = __builtin_amdgcn_mfma_f32_32x32x16_bf16(af, vf, acc[i], 0, 0, 0);
            }
        }
        LAS float* stg = (LAS float*)(lds + 49152 + wave * 4096);
#pragma unroll 1
        for (int i = 0; i < 3; ++i) {
            const f32x16 a = i == 0 ? acc[0] : i == 1 ? acc[1] : acc[2];
#pragma unroll
            for (int r = 0; r < 16; ++r) { const int q = crow(r, hi); stg[q * 32 + r32] = a[r] + bs[g * 128 + 32 * ib + q]; }
            asm volatile("s_waitcnt lgkmcnt(0)" ::: "memory");
            const int q = lane >> 1, hf = lane & 1; const size_t ro = (size_t)(rowb + 32 * ib + q); const int col = g * 192 + 32 * (cb0 + i) + 16 * hf;
            const u32x4 u0 = *(const u32x4*)(U + ro * 768 + col), u1 = *(const u32x4*)(U + ro * 768 + col + 8);
            const LAS f32x4* sp = (const LAS f32x4*)(stg + q * 32 + 16 * hf);
            const f32x4 m0 = sp[0], m1 = sp[1], m2 = sp[2], m3 = sp[3];
            u32x4 o0, o1;
            o0.x = cvtpk(bflo(u0.x) * m0[0], bfhi(u0.x) * m0[1]); o0.y = cvtpk(bflo(u0.y) * m0[2], bfhi(u0.y) * m0[3]); o0.z = cvtpk(bflo(u0.z) * m1[0], bfhi(u0.z) * m1[1]); o0.w = cvtpk(bflo(u0.w) * m1[2], bfhi(u0.w) * m1[3]);
            o1.x = cvtpk(bflo(u1.x) * m2[0], bfhi(u1.x) * m2[1]); o1.y = cvtpk(bflo(u1.y) * m2[2], bfhi(u1.y) * m2[3]); o1.z = cvtpk(bflo(u1.z) * m3[0], bfhi(u1.z) * m3[1]); o1.w = cvtpk(bflo(u1.w) * m3[2], bfhi(u1.w) * m3[3]);
            *(u32x4*)(Og + ro * DM + col) = o0; *(u32x4*)(Og + ro * DM + col + 8) = o1;
            asm volatile("s_waitcnt lgkmcnt(0)" ::: "memory");
        }
        __syncthreads();
    }
}

__device__ __forceinline__ void gmlp_sample(const Params& P, int G, int bid) {
    const bf16_t* U = (const bf16_t*)(P.ws + WS_U); const bf16_t* GV = (const bf16_t*)(P.ws + WS_GV); bf16_t* Og = (bf16_t*)(P.ws + WS_O);
    const float* ssqv = (const float*)(P.ws + WS_SSQ) + 4 * M; const float* vg = P.in[17]; const float* wsb = P.in[18]; const float* bs = P.in[19]; float* cvs = P.out + O_CVS;
    for (int i = bid * 512 + threadIdx.x; i < NDEC * 768; i += G * 512) {
        const int n = i / 768, col = i % 768, g = col / 192; float vn[4];
#pragma unroll
        for (int s = 0; s < 4; ++s) { const int row = MP + 4 * n + s; vn[s] = bf2f(GV[(size_t)row * 768 + col]) * rsqrtf(ssqv[row] * (1.f / 768.f) + EPS) * vg[col]; cvs[(size_t)(4 * n + s) * 768 + col] = vn[s]; }
#pragma unroll
        for (int s = 0; s < 4; ++s) { float mx = bs[g * 128 + s];
#pragma unroll
            for (int j = 0; j < 4; ++j) if (j <= s) mx += wsb[(size_t)(g * 128 + s) * 128 + j] * vn[j];
            const int row = MP + 4 * n + s; Og[(size_t)row * DM + col] = f2bf_s(bf2f(U[(size_t)row * 768 + col]) * mx); }
    }
}

#define XB_TMO      128
#define XB_XCNT(j)  (256  + 64 * (j))
#define XB_XSUB(j)  (1280 + 64 * (j))
#define XB_XGEN(j)  (2304 + 64 * (j))
#define XB_TOP      3328
#define XB_TOPGEN   3392
#define XCD_BAR_WORDS 3456
#define XB_SPIN_CAP (1u << 22)
__device__ __forceinline__ unsigned xb_ld(unsigned* p)              { return __hip_atomic_load(p, __ATOMIC_RELAXED, __HIP_MEMORY_SCOPE_AGENT); }
__device__ __forceinline__ unsigned xb_add(unsigned* p, unsigned v) { return __hip_atomic_fetch_add(p, v, __ATOMIC_RELAXED, __HIP_MEMORY_SCOPE_AGENT); }
__device__ __forceinline__ unsigned xb_xcc_id() { return (unsigned)__builtin_amdgcn_s_getreg((3 << 11) | 20) & 0xFu; }
#define XB_SPIN(cond, bar) do { unsigned _sp = 0; while (cond) { __builtin_amdgcn_s_sleep(1); \
    if ((++_sp & 255u) == 0u) { if (xb_ld(&(bar)[XB_TMO])) break; if (_sp > XB_SPIN_CAP) { atomicAdd(&(bar)[XB_TMO], 1u); break; } } } } while (0)
struct XcdBarrier { unsigned* bar; unsigned x; volatile LAS unsigned* st; };
__device__ __forceinline__ XcdBarrier xcd_barrier_post(unsigned* bar, volatile LAS unsigned* st) {
    XcdBarrier b; b.bar = bar; b.x = xb_xcc_id(); b.st = st;
    if (threadIdx.x == 0) (void)xb_add(&bar[XB_XCNT(b.x)], 1u);
    return b;
}
__device__ __forceinline__ void xcd_barrier_complete(unsigned* bar, unsigned x, unsigned& nloc, unsigned& nx) {
    const unsigned G = gridDim.x * gridDim.y * gridDim.z;
    unsigned sum, cnt, mine, sp = 0u;
    for (;;) {
        sum = 0u; cnt = 0u; mine = 0u;
#pragma unroll
        for (unsigned j = 0; j < 16; ++j) { const unsigned c = xb_ld(&bar[XB_XCNT(j)]); sum += c; cnt += (c > 0u) ? 1u : 0u; mine = (j == x) ? c : mine; }
        if (sum == G) break;
        __builtin_amdgcn_s_sleep(1);
        if ((++sp & 255u) == 0u) { if (xb_ld(&bar[XB_TMO])) break; if (sp > XB_SPIN_CAP) { atomicAdd(&bar[XB_TMO], 1u); break; } }
    }
    nloc = mine > 0u ? mine : 1u; nx = cnt > 0u ? cnt : 1u;
}
__device__ __forceinline__ void xcd_barrier(const XcdBarrier& b) {
    asm volatile("s_waitcnt vmcnt(0)" ::: "memory");
    __syncthreads();
    if (threadIdx.x == 0) {
        unsigned* bar = b.bar;
        __builtin_amdgcn_s_waitcnt(0);
        unsigned nloc = b.st[0], nx = b.st[1];
        if (nloc == 0u) { xcd_barrier_complete(bar, b.x, nloc, nx); b.st[0] = nloc; b.st[1] = nx; }
        const unsigned old = xb_add(&bar[XB_XSUB(b.x)], 1u);
        const unsigned gen = old / nloc;
        if (old + 1u == (gen + 1u) * nloc) {
            __builtin_amdgcn_fence(__ATOMIC_RELEASE, "agent");
            asm volatile("s_waitcnt vmcnt(0)" ::: "memory");
            const unsigned og = xb_add(&bar[XB_TOP], 1u);
            const unsigned tg = og / nx;
            if (og + 1u == (tg + 1u) * nx) xb_add(&bar[XB_TOPGEN], 1u);
            else XB_SPIN(xb_ld(&bar[XB_TOPGEN]) == tg, bar);
            __builtin_amdgcn_fence(__ATOMIC_ACQUIRE, "agent");
            xb_add(&bar[XB_XGEN(b.x)], 1u);
            asm volatile("s_waitcnt vmcnt(0)" ::: "memory");
        } else {
            XB_SPIN(xb_ld(&bar[XB_XGEN(b.x)]) == gen, bar);
            __builtin_amdgcn_fence(__ATOMIC_ACQUIRE, "agent");
            asm volatile("s_waitcnt vmcnt(0)" ::: "memory");
        }
    }
    __syncthreads();
}


__global__ void __launch_bounds__(512, 2) mk_fwd(Params P) {
    extern __shared__ __attribute__((aligned(16))) unsigned char lds_raw[];
    LAS unsigned char* lds = (LAS unsigned char*)lds_raw;
    const int tid = threadIdx.x, wave = __builtin_amdgcn_readfirstlane(tid >> 6);
    const int G = gridDim.x, bid = blockIdx.x;
    LAS float* wsf = (LAS float*)(lds + WSF_OFF) + wave * 64;
    unsigned char* ws = P.ws;
    float* ssq = (float*)(ws + WS_SSQ);
    bf16_t* XB = (bf16_t*)(ws + WS_XB);
    cg::grid_group grid = cg::this_grid();
    const int lo = P.ph_lo, hi = P.ph_hi;
#ifndef PH_MASK
#define PH_MASK 0x1fff
#endif
#define IN(k) (((PH_MASK >> (k)) & 1) && lo <= (k) && (k) < hi)
#ifndef USE_XCD_BAR
#define USE_XCD_BAR 1
#endif
    volatile LAS unsigned* bst = (volatile LAS unsigned*)(lds + RING_BYTES + 16128);
    if (tid < 2) bst[tid] = 0u;
    __syncthreads();
    XcdBarrier xbar = xcd_barrier_post((unsigned*)(ws + WS_CTL), bst);
#define SEAM(k) do { if (IN(k) && IN((k) + 1)) { if (!USE_XCD_BAR) grid.sync(); else xcd_barrier(xbar); } } while (0)

    if (IN(0)) { for (int rep = 0; rep < (DUP == 0 ? 2 : 1); ++rep) p0_prologue(P, lds, G, bid); }
    SEAM(0);
    const int gwave = bid * 8 + wave, NW = G * 8;
    const bf16_t* XBs = XB;
    if (IN(1)) {
        EpiInA E{ssq, (bf16_t*)(ws + WS_Q), (const float*)(ws + WS_GT), P.out};
        const bool early = (bid & 1) != 0;
        if (bid >= 32 && early) sample_gemm<4, 4>(lds, XBs, DM, (const bf16_t*)(ws + WS_WINA), 6, E, bid - 32, G - 32);
        { pg8::Gemm g{XB, (const bf16_t*)(ws + WS_WINA), DM, DM}; pg8::StaticOrder S; S.init(MP, NINA, G, bid);
          pg8::gemm_phase<EpiInA, true, true>(lds, g, S, E); }
        { pg8::Gemm g{(const bf16_t*)(ws + WS_MEMB), (const bf16_t*)(ws + WS_WMKV), DM, DM}; pg8::StaticOrder S; S.init(MMEM, 1024, G, bid);
          EpiMemKV E2{ssq + 5 * M, P.in[23], P.out + O_MKP, P.out + O_MVP, (bf16_t*)(ws + WS_MK), (bf16_t*)(ws + WS_MV)};
          pg8::gemm_phase<EpiMemKV, true, true>(lds, g, S, E2); }
        if (bid >= 32 && !early) sample_gemm<4, 4>(lds, XBs, DM, (const bf16_t*)(ws + WS_WINA), 6, E, bid - 32, G - 32);
    }
    SEAM(1);
    if (IN(2)) {
        for (int rep = 0; rep < (DUP == 2 ? 2 : 1); ++rep)
        for (int j = 0; j < 6; ++j) { const int jj = (bid & 1) ? (j + 4) % 6 : j; const int uidx = bid + jj * G; if (uidx >= 1536) continue;
            if (uidx < 512) unit_swa_prompt(P, lds, wsf, uidx >> 6, (uidx >> 2) & 15, uidx & 3);
            else if (uidx < 1024) { const int v = uidx - 512; unit_mem_prompt(P, lds, wsf, 0, v >> 6, (v >> 2) & 15, v & 3); }
            else if (uidx < 1280) { const int v = uidx - 1024; unit_mem_sample(P, lds, wsf, 0, v >> 1, v & 1); }
            else { const int v = uidx - 1280; unit_swa_sample(P, lds, wsf, v >> 1, v & 1); }
        }
    }
    SEAM(2);
    if (IN(3)) {
        pg8::Gemm g{(const bf16_t*)(ws + WS_O), (const bf16_t*)(ws + WS_WOUTA), DM, DM}; pg8::StaticOrder S; S.init(MP, DM, G, bid);
        EpiRes<true, false> E{P.in[0], P.in[1], nullptr, XB, ssq + M};
        if (bid & 1) sample_gemm<2, 4>(lds, (const bf16_t*)(ws + WS_O), DM, (const bf16_t*)(ws + WS_WOUTA), 4, E, bid, G);
        pg8::gemm_phase<EpiRes<true, false>, true, true>(lds, g, S, E);
        if (!(bid & 1)) sample_gemm<2, 4>(lds, (const bf16_t*)(ws + WS_O), DM, (const bf16_t*)(ws + WS_WOUTA), 4, E, bid, G);
    }
    SEAM(3);
    if (IN(4)) {
        pg8::Gemm g{XB, (const bf16_t*)(ws + WS_WFFN), DM, DM}; pg8::StaticOrder S; S.init(MP, NFF, G, bid);
        EpiFfnConv E{ssq + M, (bf16_t*)(ws + WS_H), P.in[25], P.in[26], (float*)(ws + WS_SIDE), P.out + O_CONVP, (LAS float*)(lds + RING_BYTES)};
        if (bid & 1) sample_ffn(P, lds, 0, ssq + M, bid, G);
        pg8::gemm_phase<EpiFfnConv, true, true>(lds, g, S, E);
        if (!(bid & 1)) sample_ffn(P, lds, 0, ssq + M, bid, G);
    }
    SEAM(4);
    if (IN(5)) {
        pg8::Gemm g{(const bf16_t*)(ws + WS_H), (const bf16_t*)(ws + WS_WDOWN), DFF, DFF}; pg8::StaticOrder S; S.init(MP, DM, G, bid);
        ffn_fixup(P, 0, S);
        EpiRes<false, false> E{nullptr, nullptr, nullptr, XB, ssq + 2 * M};
        if (bid & 1) sample_gemm<2, 11>(lds, (const bf16_t*)(ws + WS_H), DFF, (const bf16_t*)(ws + WS_WDOWN), 4, E, bid, G);
        pg8::gemm_phase<EpiRes<false, false>, true, true>(lds, g, S, E);
        if (!(bid & 1)) sample_gemm<2, 11>(lds, (const bf16_t*)(ws + WS_H), DFF, (const bf16_t*)(ws + WS_WDOWN), 4, E, bid, G);
    }
    SEAM(5);
    if (IN(6)) {
        pg8::Gemm g{XB, (const bf16_t*)(ws + WS_WINB), DM, DM}; pg8::StaticOrder S; S.init(MP, NINB, G, bid);
        EpiInB E{ssq + 2 * M, (bf16_t*)(ws + WS_U), (bf16_t*)(ws + WS_GV), (bf16_t*)(ws + WS_XQ), P.in[22] + 64, ssq + 4 * M};
        pg8::gemm_phase<EpiInB, true, true>(lds, g, S, E);
        if (bid >= G / 2) sample_gemm<4, 4>(lds, XBs, DM, (const bf16_t*)(ws + WS_WINB), 7, E, bid - G / 2, G - G / 2);
    }
    SEAM(6);
    if (IN(7)) {
        for (int rep = 0; rep < (DUP == 7 ? 2 : 1); ++rep)
        for (int j = 0; j < 4; ++j) { const int jj = (bid & 1) ? (j + 3) % 4 : j; const int uidx = bid + jj * G; if (uidx >= 1024) continue;
            if (uidx < 256) unit_gmlp_prompt(P, lds, uidx >> 5, uidx & 31);
            else if (uidx < 768) { const int v = uidx - 256; unit_mem_prompt(P, lds, wsf, 1, v >> 6, (v >> 2) & 15, v & 3); }
            else { const int v = uidx - 768; unit_mem_sample(P, lds, wsf, 1, v >> 1, v & 1); }
        }
        gmlp_sample(P, G, bid);
    }
    SEAM(7);
    if (IN(8)) {
        pg8::Gemm g{(const bf16_t*)(ws + WS_O), (const bf16_t*)(ws + WS_WOUTB), DM, DM}; pg8::StaticOrder S; S.init(MP, DM, G, bid);
        EpiRes<false, false> E{nullptr, nullptr, nullptr, XB, ssq + 3 * M};
        if (bid & 1) sample_gemm<2, 4>(lds, (const bf16_t*)(ws + WS_O), DM, (const bf16_t*)(ws + WS_WOUTB), 4, E, bid, G);
        pg8::gemm_phase<EpiRes<false, false>, true, true>(lds, g, S, E);
        if (!(bid & 1)) sample_gemm<2, 4>(lds, (const bf16_t*)(ws + WS_O), DM, (const bf16_t*)(ws + WS_WOUTB), 4, E, bid, G);
    }
    SEAM(8);
    if (IN(9)) {
        pg8::Gemm g{XB, (const bf16_t*)(ws + WS_WFFN) + (size_t)NFF * DM, DM, DM}; pg8::StaticOrder S; S.init(MP, NFF, G, bid);
        EpiFfnConv E{ssq + 3 * M, (bf16_t*)(ws + WS_H), P.in[25] + 3 * DFF, P.in[26] + DFF, (float*)(ws + WS_SIDE), P.out + O_CONVP + (size_t)NBATCH * 2 * DFF, (LAS float*)(lds + RING_BYTES)};
        if (bid & 1) sample_ffn(P, lds, 1, ssq + 3 * M, bid, G);
        pg8::gemm_phase<EpiFfnConv, true, true>(lds, g, S, E);
        if (!(bid & 1)) sample_ffn(P, lds, 1, ssq + 3 * M, bid, G);
    }
    SEAM(9);
    if (IN(10)) {
        pg8::Gemm g{(const bf16_t*)(ws + WS_H), (const bf16_t*)(ws + WS_WDOWN) + (size_t)DM * DFF, DFF, DFF}; pg8::StaticOrder S; S.init(MP, DM, G, bid);
        ffn_fixup(P, 1, S);
        EpiRes<false, true> E{nullptr, nullptr, P.out + O_Y, XB, nullptr};
        if (bid & 1) sample_gemm<2, 11>(lds, (const bf16_t*)(ws + WS_H), DFF, (const bf16_t*)(ws + WS_WDOWN) + (size_t)DM * DFF, 4, E, bid, G);
        pg8::gemm_phase<EpiRes<false, true>, true, true>(lds, g, S, E);
        if (!(bid & 1)) sample_gemm<2, 11>(lds, (const bf16_t*)(ws + WS_H), DFF, (const bf16_t*)(ws + WS_WDOWN) + (size_t)DM * DFF, 4, E, bid, G);
    }
#undef IN
#undef SEAM
}

extern "C" void kernel_launch(void* const* d_in, const int* in_sizes, int n_in, void* d_out, int out_size, void* d_ws, size_t ws_size, hipStream_t stream) {
    static int grid = 0;
    if (grid == 0) {
        if (n_in != 28 || (size_t)out_size != O_END || ws_size < WS_END) { fprintf(stderr, "kernel_launch: unexpected shapes: n_in %d out %d ws %zu (need %zu)\n", n_in, out_size, ws_size, (size_t)WS_END); grid = -1; return; }
        int dev = 0, cus = 0, per_cu = 0;
        hipGetDevice(&dev); hipDeviceGetAttribute(&cus, hipDeviceAttributeMultiprocessorCount, dev);
        if (hipFuncSetAttribute((const void*)mk_fwd, hipFuncAttributeMaxDynamicSharedMemorySize, LDS_BYTES) != hipSuccess) { fprintf(stderr, "kernel_launch: hipFuncSetAttribute failed\n"); grid = -1; return; }
        hipOccupancyMaxActiveBlocksPerMultiprocessor(&per_cu, (const void*)mk_fwd, 512, LDS_BYTES);
        (void)hipGetLastError();
        if (per_cu < 1) { fprintf(stderr, "kernel_launch: occupancy query says %d blocks per CU\n", per_cu); per_cu = 1; }
        grid = cus;
    }
    if (grid < 0) return;
    if (hipMemsetAsync((char*)d_ws + WS_CTL, 0, CTL_BYTES, stream) != hipSuccess) { fprintf(stderr, "kernel_launch: memset failed\n"); return; }
    Params p{};
    for (int i = 0; i < 28; ++i) p.in[i] = (const float*)d_in[i];
    p.out = (float*)d_out; p.ws = (unsigned char*)d_ws;
#if MK_N_LAUNCHES == 1
    p.ph_lo = 0; p.ph_hi = NPHASE;
    void* args[] = {&p};
    hipError_t e = hipLaunchCooperativeKernel((const void*)mk_fwd, dim3(grid), dim3(512), args, LDS_BYTES, stream);
    if (e != hipSuccess) fprintf(stderr, "cooperative launch failed: %s (grid %d)\n", hipGetErrorString(e), grid);
#else
    for (int ph = 0; ph < NPHASE; ++ph) {
        p.ph_lo = ph; p.ph_hi = ph + 1;
        hipLaunchKernelGGL(mk_fwd, dim3(grid), dim3(512), LDS_BYTES, stream, p);
    }
#endif
}
```

```cpp
#include <hip/hip_runtime.h>
#include <hip/hip_cooperative_groups.h>
#include <cstdio>
#include <cstdint>
namespace cg = cooperative_groups;

#ifndef MK_N_LAUNCHES
#define MK_N_LAUNCHES 1
#endif

#ifndef TPROBE
#define TPROBE -1
#endif
#ifndef DUP
#define DUP -1
#endif
#define LAS __attribute__((address_space(3)))
typedef unsigned short bf16_t;
typedef short bf16x8 __attribute__((ext_vector_type(8)));
typedef short s16x4 __attribute__((ext_vector_type(4)));
typedef float f32x4 __attribute__((ext_vector_type(4)));
typedef float f32x2 __attribute__((ext_vector_type(2)));
typedef float f32x16 __attribute__((ext_vector_type(16)));
typedef unsigned u32x4 __attribute__((ext_vector_type(4)));
typedef unsigned u32x2 __attribute__((ext_vector_type(2)));
typedef __bf16 bf16x2_t __attribute__((ext_vector_type(2)));

constexpr int DM = 1024, NBATCH = 8, SEQ = 4096, MP = NBATCH * SEQ, NDEC = 128, DSEQ = 4, MS = NDEC * DSEQ, M = MP + MS;
constexpr int NMEM = 256, MMEM = NBATCH * NMEM;
constexpr int DFF = 2816, NFF = 2 * DFF;
constexpr int NINA = 1536, NINB = 1792;
constexpr float EPS = 1e-6f;
constexpr float LOG2E = 1.4426950408889634f;
constexpr int NPHASE = 11;

constexpr size_t O_Y = 0, O_WKP = 34078720, O_WVP = 34340864, O_CVP = 34603008, O_MKP = 35389440, O_MVP = 36438016, O_CONVP = 37486592,
                 O_WKS = 37576704, O_WVS = 41771008, O_CVS = 45965312, O_CONVS = 46358528, O_END = 47800320;

constexpr size_t MiB = 1u << 20;
constexpr size_t WS_SSQ = 0, WS_GT = 1 * MiB, WS_CTL = 1 * MiB + 65536, CTL_BYTES = 16384;
constexpr size_t WS_WINA = 2 * MiB, WS_WOUTA = 5 * MiB, WS_WINB = 7 * MiB, WS_WOUTB = 11 * MiB, WS_WMKV = 13 * MiB, WS_WFFN = 15 * MiB,
                 WS_WDOWN = 37 * MiB, WS_WST = 48 * MiB;
constexpr size_t WS_MEMB = 50 * MiB, WS_MK = 54 * MiB, WS_MV = 56 * MiB;
constexpr size_t WS_XB = 58 * MiB;
constexpr size_t WS_H = 124 * MiB;
constexpr size_t WS_Q = WS_H, WS_K = WS_Q + (size_t)M * 768 * 2, WS_V = WS_K + (size_t)M * 256 * 2, WS_XQ = WS_V + (size_t)M * 256 * 2,
                 WS_O = WS_XQ + (size_t)M * 256 * 2, WS_U = WS_O + (size_t)M * 1024 * 2, WS_GV = WS_U + (size_t)M * 768 * 2;
constexpr size_t WS_SIDE = 384 * MiB, SIDE_N = (size_t)128 * 2 * DFF;
constexpr size_t WS_END = WS_SIDE + 3 * SIDE_N * 4;
static_assert(WS_GV + (size_t)M * 768 * 2 <= WS_SIDE && WS_H + (size_t)M * DFF * 2 <= WS_SIDE, "mixer buffers / hidden below the side buffers");
static_assert(WS_END <= 512 * MiB, "ws");

namespace pg8 {
constexpr int BM = 256, BK = 64, HALF = 128, HTB = HALF * BK * 2, STAGE_BYTES = 8 * HTB, NXCD = 8, WGM = 8;
__host__ __device__ __forceinline__ int lds_byte(int r, int c) { const int st = (r >> 4) * 2 + (c >> 5), rr = r & 15, cc = c & 31, ob = rr * 64 + cc * 2; return st * 1024 + (ob ^ (((ob >> 9) & 1) << 5)); }
__host__ __device__ __forceinline__ void stage_rc(int b, int& R, int& C) { const int st = b / 1024, sb = b % 1024, swz = sb ^ (((sb >> 9) & 1) << 5); R = (st >> 1) * 16 + swz / 64; C = (st & 1) * 32 + (swz % 64) / 2; }
__host__ __device__ __forceinline__ int perm32(int rho) { const int n = rho >> 4, i = rho & 15; return 8 * (i >> 2) + 4 * n + (i & 3); }

struct Unit { int pm, pn; };
struct Gemm { const bf16_t* A; const bf16_t* Bt; int lda, K; };

struct StaticOrder {
    int nM, nN, nwg, G, c;
    __device__ void init(int Mr, int N, int G_, int c_) { nM = Mr / BM; nN = N / BM; nwg = nM * nN; G = G_; c = c_; }
    __device__ bool next(int i, Unit& u) const {
        const long L = (long)i * G + c; if (L >= nwg) return false;
        int wgid = (int)L; { const int q = nwg / NXCD, r = nwg % NXCD, xcd = wgid % NXCD, off = wgid / NXCD; wgid = (xcd < r ? xcd * (q + 1) : r * (q + 1) + (xcd - r) * q) + off; }
        const int nig = WGM * nN, gid = wgid / nig, fm = gid * WGM, gsz = (nM - fm) < WGM ? (nM - fm) : WGM;
        u.pm = fm + ((wgid % nig) % gsz); u.pn = (wgid % nig) / gsz; return true;
    }
};

template <class Epi, bool ALIGN_EPI, bool SP2>
__device__ __forceinline__ void gemm_phase(LAS unsigned char* lds, const Gemm g, const StaticOrder& S, const Epi& E) {
    const int tid = threadIdx.x, wid = __builtin_amdgcn_readfirstlane(tid >> 6), lane = tid & 63, wr = wid >> 2, wc = wid & 3, fr = lane & 15, fq = lane >> 4;
    const int K = g.K, nt = K / BK, lda = g.lda;
    unsigned voffA[2], voffB[2];
#pragma unroll
    for (int i = 0; i < 2; ++i) { int R, C; stage_rc(tid * 16 + i * 8192, R, C); const int Rb = (R & ~31) + perm32(R & 31);
        voffA[i] = (unsigned)(R * lda + C) * 2u; voffB[i] = (unsigned)(Rb * K + C) * 2u; }
    const size_t kstep = (size_t)(BK * 2);
    const size_t hstepA = (size_t)HALF * lda * 2, hstepB = (size_t)HALF * K * 2;
    const size_t tstepA = 2 * hstepA, tstepB = 2 * hstepB;
    const unsigned ldsw = (unsigned)wid * 1024u;
    const int aoff = lds_byte(wr * 64 + fr, fq * 8), boff = lds_byte(wc * 32 + fr, fq * 8);
#define PG8_SA(b, h) (((b) * 2 + (h)) * HTB)
#define PG8_SB(b, h) ((4 + (b) * 2 + (h)) * HTB)
#define PG8_STAGE(bufoff, gbase, voff) do { _Pragma("unroll") for (int _i = 0; _i < 2; ++_i) \
        __builtin_amdgcn_global_load_lds((const unsigned*)((const char*)(gbase) + (voff)[_i]), (LAS unsigned*)(lds + (bufoff) + ldsw + _i * 8192), 16, 0, 0); } while (0)
#define PG8_LDA(dst, b, h) do { _Pragma("unroll") for (int m = 0; m < 4; ++m) _Pragma("unroll") for (int k = 0; k < 2; ++k) dst[m][k] = *(const LAS bf16x8*)(lds + PG8_SA(b, h) + aoff + m * 2048 + k * 1024); } while (0)
#define PG8_LDB(dst, b, h) do { _Pragma("unroll") for (int n = 0; n < 2; ++n) _Pragma("unroll") for (int k = 0; k < 2; ++k) dst[n][k] = *(const LAS bf16x8*)(lds + PG8_SB(b, h) + boff + n * 2048 + k * 1024); } while (0)
#define PG8_MMA(ai, bj, At, Bt) do { __builtin_amdgcn_s_setprio(1); _Pragma("unroll") for (int m = 0; m < 4; ++m) _Pragma("unroll") for (int n = 0; n < 2; ++n) _Pragma("unroll") for (int k = 0; k < 2; ++k) \
        acc[ai][bj][m][n] = __builtin_amdgcn_mfma_f32_16x16x32_bf16(Bt[n][k], At[m][k], acc[ai][bj][m][n], 0, 0, 0); __builtin_amdgcn_s_setprio(0); } while (0)
#define PG8_WAIT_V(n) asm volatile("s_waitcnt vmcnt(" #n ")" ::: "memory")
#define PG8_WAIT_L(n) asm volatile("s_waitcnt lgkmcnt(" #n ")" ::: "memory")
#define PG8_BAR __builtin_amdgcn_s_barrier()
#define PG8_SCHED __builtin_amdgcn_sched_barrier(0)
    Unit cur, nxt; int ui = 0;
    if (!S.next(0, cur)) return;
    f32x4 acc[2][2][4][2];
#pragma unroll
    for (int a = 0; a < 2; ++a)
#pragma unroll
        for (int b = 0; b < 2; ++b)
#pragma unroll
            for (int m = 0; m < 4; ++m)
#pragma unroll
                for (int n = 0; n < 2; ++n) acc[a][b][m][n] = (f32x4){0.f, 0.f, 0.f, 0.f};
    bf16x8 At[4][2], B0[2][2], B1[2][2];
    const char* cA = (const char*)g.A + (size_t)cur.pm * tstepA; const char* cB = (const char*)g.Bt + (size_t)cur.pn * tstepB;
    if constexpr (SP2) {
        PG8_STAGE(PG8_SB(0, 0), cB, voffB); PG8_STAGE(PG8_SB(0, 1), cB + hstepB, voffB); PG8_STAGE(PG8_SA(0, 0), cA, voffA); PG8_STAGE(PG8_SA(0, 1), cA + hstepA, voffA);
        if (wr == 1) PG8_BAR;
        PG8_WAIT_V(2); PG8_BAR;
        PG8_STAGE(PG8_SB(1, 0), cB + kstep, voffB); PG8_STAGE(PG8_SA(1, 0), cA + kstep, voffA); PG8_STAGE(PG8_SB(1, 1), cB + hstepB + kstep, voffB);
        PG8_WAIT_V(6); PG8_BAR;
    } else {
        PG8_STAGE(PG8_SB(0, 0), cB, voffB); PG8_STAGE(PG8_SA(0, 0), cA, voffA); PG8_STAGE(PG8_SB(0, 1), cB + hstepB, voffB); PG8_STAGE(PG8_SA(0, 1), cA + hstepA, voffA);
        if (wr == 1) PG8_BAR;
        PG8_WAIT_V(4); PG8_BAR;
        PG8_STAGE(PG8_SB(1, 0), cB + kstep, voffB); PG8_STAGE(PG8_SA(1, 0), cA + kstep, voffA); PG8_STAGE(PG8_SB(1, 1), cB + hstepB + kstep, voffB);
        PG8_WAIT_V(6); PG8_BAR;
    }
    for (;;) {
        const bool has_next = S.next(ui + 1, nxt);
        const char* nA = has_next ? (const char*)g.A + (size_t)nxt.pm * tstepA : cA; const char* nB = has_next ? (const char*)g.Bt + (size_t)nxt.pn * tstepB : cB;
        for (int t = 0; t < nt; t += 2) {
            const bool last = (t == nt - 2);
            const char* a1 = cA + (size_t)(t + 1) * kstep;
            const char* a2 = last ? nA : cA + (size_t)(t + 2) * kstep; const char* b2 = last ? nB : cB + (size_t)(t + 2) * kstep;
            const char* a3 = a2 + kstep; const char* b3 = b2 + kstep;
            if constexpr (SP2) {
            PG8_LDB(B0, 0, 0); PG8_LDB(B1, 0, 1); PG8_SCHED; PG8_LDA(At, 0, 0); PG8_STAGE(PG8_SA(1, 1), a1 + hstepA, voffA);
            PG8_WAIT_V(8); PG8_WAIT_L(0); PG8_BAR; PG8_MMA(0, 0, At, B0); PG8_MMA(0, 1, At, B1); PG8_BAR; PG8_SCHED;
            PG8_LDA(At, 0, 1); PG8_STAGE(PG8_SB(0, 0), b2, voffB); PG8_STAGE(PG8_SB(0, 1), b2 + hstepB, voffB); PG8_STAGE(PG8_SA(0, 0), a2, voffA);
            PG8_WAIT_V(8); PG8_WAIT_L(0); PG8_BAR; PG8_MMA(1, 0, At, B0); PG8_MMA(1, 1, At, B1); PG8_BAR; PG8_SCHED;
            PG8_LDB(B0, 1, 0); PG8_LDB(B1, 1, 1); PG8_SCHED; PG8_LDA(At, 1, 0); PG8_STAGE(PG8_SA(0, 1), a2 + hstepA, voffA);
            PG8_WAIT_V(8); PG8_WAIT_L(0); PG8_BAR; PG8_MMA(0, 0, At, B0); PG8_MMA(0, 1, At, B1); PG8_BAR; PG8_SCHED;
            PG8_LDA(At, 1, 1); PG8_STAGE(PG8_SB(1, 0), b3, voffB); PG8_STAGE(PG8_SB(1, 1), b3 + hstepB, voffB); PG8_STAGE(PG8_SA(1, 0), a3, voffA);
            PG8_WAIT_V(8); PG8_WAIT_L(0); PG8_BAR; PG8_MMA(1, 0, At, B0); PG8_MMA(1, 1, At, B1); PG8_BAR; PG8_SCHED;
            } else {
            PG8_LDB(B0, 0, 0); PG8_SCHED; PG8_LDA(At, 0, 0); PG8_STAGE(PG8_SA(1, 1), a1 + hstepA, voffA);
            PG8_WAIT_L(8); PG8_BAR; PG8_WAIT_L(0); PG8_MMA(0, 0, At, B0); PG8_BAR; PG8_SCHED;
            PG8_LDB(B1, 0, 1); PG8_STAGE(PG8_SB(0, 0), b2, voffB);
            PG8_BAR; PG8_WAIT_L(0); PG8_MMA(0, 1, At, B1); PG8_BAR;
            PG8_LDA(At, 0, 1); PG8_STAGE(PG8_SA(0, 0), a2, voffA);
            PG8_BAR; PG8_WAIT_L(0); PG8_MMA(1, 0, At, B0); PG8_BAR; PG8_SCHED;
            PG8_STAGE(PG8_SB(0, 1), b2 + hstepB, voffB);
            PG8_WAIT_V(6); PG8_BAR; PG8_MMA(1, 1, At, B1); PG8_BAR;
            PG8_LDB(B0, 1, 0); PG8_SCHED; PG8_LDA(At, 1, 0); PG8_STAGE(PG8_SA(0, 1), a2 + hstepA, voffA);
            PG8_WAIT_L(8); PG8_BAR; PG8_WAIT_L(0); PG8_MMA(0, 0, At, B0); PG8_BAR; PG8_SCHED;
            PG8_LDB(B1, 1, 1); PG8_STAGE(PG8_SB(1, 0), b3, voffB);
            PG8_BAR; PG8_WAIT_L(0); PG8_MMA(0, 1, At, B1); PG8_BAR;
            PG8_LDA(At, 1, 1); PG8_STAGE(PG8_SA(1, 0), a3, voffA);
            PG8_BAR; PG8_WAIT_L(0); PG8_MMA(1, 0, At, B0); PG8_BAR; PG8_SCHED;
            PG8_STAGE(PG8_SB(1, 1), b3 + hstepB, voffB);
            PG8_WAIT_V(6); PG8_BAR; PG8_MMA(1, 1, At, B1); PG8_BAR;
            }
        }
        if constexpr (ALIGN_EPI) { if (wr == 0) PG8_BAR; }
        E(acc, cur, wr, wc, fr, fq);
        if (!has_next) break;
#pragma unroll
        for (int a = 0; a < 2; ++a)
#pragma unroll
            for (int b = 0; b < 2; ++b)
#pragma unroll
                for (int m = 0; m < 4; ++m)
#pragma unroll
                    for (int n = 0; n < 2; ++n) acc[a][b][m][n] = (f32x4){0.f, 0.f, 0.f, 0.f};
        cur = nxt; cA = nA; cB = nB; ++ui;
        if constexpr (ALIGN_EPI) { if (wr == 1) PG8_BAR; }
    }
    PG8_WAIT_V(0);
    if constexpr (!ALIGN_EPI) { if (wr == 0) PG8_BAR; }
    PG8_BAR;
#undef PG8_SA
#undef PG8_SB
#undef PG8_STAGE
#undef PG8_LDA
#undef PG8_LDB
#undef PG8_MMA
#undef PG8_WAIT_V
#undef PG8_WAIT_L
#undef PG8_BAR
#undef PG8_SCHED
}
}
using pg8::Unit;

constexpr int RING_BYTES = 131072, WSF_OFF = RING_BYTES, OSTG2_OFF = RING_BYTES + 4096, BST_OFF = RING_BYTES + 16384, LDS_BYTES = BST_OFF + 256;
__device__ __forceinline__ unsigned cvtpk(float lo, float hi) { f32x2 v = {lo, hi}; bf16x2_t b = __builtin_convertvector(v, bf16x2_t); return __builtin_bit_cast(unsigned, b); }
__device__ __forceinline__ u32x4 pack8(const f32x4 a, const f32x4 b) { u32x4 w; w.x = cvtpk(a[0], a[1]); w.y = cvtpk(a[2], a[3]); w.z = cvtpk(b[0], b[1]); w.w = cvtpk(b[2], b[3]); return w; }
__device__ __forceinline__ float bf2f(unsigned short h) { return __uint_as_float((unsigned)h << 16); }
__device__ __forceinline__ float bflo(unsigned w) { return __uint_as_float(w << 16); }
__device__ __forceinline__ float bfhi(unsigned w) { return __uint_as_float(w & 0xffff0000u); }
__device__ __forceinline__ float wave_sum(float v) {
#pragma unroll
    for (int o = 1; o < 64; o <<= 1) v += __shfl_xor(v, o);
    return v;
}
__device__ __forceinline__ f32x2 gelu_pk(f32x2 v) {
    const f32x2 av = __builtin_elementwise_abs(v), d = av * 0.2316418882f + 1.0f;
    f32x2 t; t.x = __builtin_amdgcn_rcpf(d.x); t.y = __builtin_amdgcn_rcpf(d.y);
    f32x2 q = t * 0.5307027145f + (-0.7265760135f); q = q * t + 0.7107068705f; q = q * t + (-0.142248368f); q = q * t + 0.127414796f; q = q * t;
    const f32x2 s = (v * v) * (-0.72134752044f);
    f32x2 e; e.x = __builtin_amdgcn_exp2f(s.x); e.y = __builtin_amdgcn_exp2f(s.y);
    const f32x2 m = v * (q * e), r = v - m;
    f32x2 o; o.x = v.x < 0.f ? m.x : r.x; o.y = v.y < 0.f ? m.y : r.y; return o;
}
__device__ __forceinline__ f32x4 gelu4(f32x4 v) { const f32x2 a = gelu_pk((f32x2){v[0], v[1]}), b = gelu_pk((f32x2){v[2], v[3]}); return (f32x4){a.x, a.y, b.x, b.y}; }
__device__ __forceinline__ float dot4(f32x4 v) { return (v[0] * v[0] + v[1] * v[1]) + (v[2] * v[2] + v[3] * v[3]); }
__device__ __forceinline__ unsigned short f2bf_s(float f) { return (unsigned short)(cvtpk(f, 0.f) & 0xffffu); }
__device__ __forceinline__ float alibi_slope(int h) { return h < 8 ? exp2f(-(float)(h + 1)) : exp2f(-0.5f - (float)(h - 8)); }

struct Params {
    const float* in[28];
    float* out;
    unsigned char* ws;
    int ph_lo, ph_hi;
};

#define EPI_ARGS const f32x4 (&acc)[2][2][4][2], const Unit& u, int wr, int wc, int fr, int fq
#define FOR_AI_M _Pragma("unroll") for (int ai = 0; ai < 2; ++ai) _Pragma("unroll") for (int m = 0; m < 4; ++m)
#define BIG_ROWS(E) do { const int row0_ = u.pm * 256 + wr * 64 + fr; float rs_[2][4]; \
    FOR_AI_M rs_[ai][m] = (E).ssq[row0_ + ai * 128 + m * 16]; \
    FOR_AI_M { f32x4 v_[2][2]; \
    _Pragma("unroll") for (int bj = 0; bj < 2; ++bj) _Pragma("unroll") for (int n = 0; n < 2; ++n) v_[bj][n] = acc[ai][bj][m][n]; \
    (E).row(v_, rsqrtf(rs_[ai][m] * (1.f / 1024.f) + EPS), row0_ + ai * 128 + m * 16, u.pn, wc, fq); } } while (0)

__device__ __forceinline__ void head_norm(f32x4 (&v)[2][2], const float* gp, int fq) {
    float ss = (dot4(v[0][0]) + dot4(v[0][1])) + (dot4(v[1][0]) + dot4(v[1][1]));
    ss += __shfl_xor(ss, 16); ss += __shfl_xor(ss, 32);
    const float inv = rsqrtf(ss * (1.f / 64.f) + EPS);
#pragma unroll
    for (int bj = 0; bj < 2; ++bj)
#pragma unroll
        for (int n = 0; n < 2; ++n) { const f32x4 g = *(const f32x4*)(gp + 32 * bj + 8 * fq + 4 * n); v[bj][n] = v[bj][n] * inv * g; }
}

struct EpiInA {
    const float* ssq; bf16_t* Qb; const float* gt; float* out;
    __device__ __forceinline__ void row(f32x4 (&v)[2][2], float rs, int row, int pn, int wc, int fq) const {
        const int typ = pn < 3 ? 0 : pn - 2;
        const size_t doff = typ == 0 ? 0 : (size_t)M * 768 + (size_t)(typ - 1) * M * 256;
        const int ld = typ == 0 ? 768 : 256, cb = typ == 0 ? (pn * 4 + wc) * 64 : wc * 64;
#pragma unroll
        for (int bj = 0; bj < 2; ++bj)
#pragma unroll
            for (int n = 0; n < 2; ++n) v[bj][n] = v[bj][n] * rs;
        if (typ != 2) head_norm(v, gt + typ * 64, fq);
#pragma unroll
        for (int bj = 0; bj < 2; ++bj) *(u32x4*)(Qb + doff + (size_t)row * ld + cb + 32 * bj + 8 * fq) = pack8(v[bj][0], v[bj][1]);
        if (typ == 1 || typ == 2) {
            long wo = -1;
            if (row >= MP) { const int ns = row - MP; wo = (long)O_WKS + (long)(typ - 1) * (long)(O_WVS - O_WKS) + (long)((ns >> 2) * 128 + 124 + (ns & 3)) * 256; }
            else if ((row & 4095) >= 3968) { const int b = row >> 12, t = row & 4095; wo = (long)O_WKP + (long)(typ - 1) * (long)(O_WVP - O_WKP) + (long)(b * 128 + t - 3968) * 256; }
            if (wo >= 0) { float* wout = out + wo;
#pragma unroll
                for (int bj = 0; bj < 2; ++bj)
#pragma unroll
                    for (int n = 0; n < 2; ++n) *(f32x4*)(wout + wc * 64 + 32 * bj + 8 * fq + 4 * n) = v[bj][n];
            }
        }
    }
    __device__ __forceinline__ void operator()(EPI_ARGS) const { BIG_ROWS(*this); }
};

struct EpiMemKV {
    const float* ssq; const float* xk; float *outk, *outv; bf16_t *MK, *MV;
    __device__ __forceinline__ void row(f32x4 (&v)[2][2], float rs, int row, int pn, int wc, int fq) const {
        const int layer = pn >> 1; const bool isv = pn & 1;
        float* of = (isv ? outv : outk) + (size_t)layer * MMEM * 256; bf16_t* ob = (isv ? MV : MK) + (size_t)layer * MMEM * 256;
#pragma unroll
        for (int bj = 0; bj < 2; ++bj)
#pragma unroll
            for (int n = 0; n < 2; ++n) v[bj][n] = v[bj][n] * rs;
        if (!isv) head_norm(v, xk + layer * 64, fq);
#pragma unroll
        for (int bj = 0; bj < 2; ++bj) {
            const size_t o = (size_t)row * 256 + wc * 64 + 32 * bj + 8 * fq;
            *(u32x4*)(ob + o) = pack8(v[bj][0], v[bj][1]);
            *(f32x4*)(of + o) = v[bj][0]; *(f32x4*)(of + o + 4) = v[bj][1];
        }
    }
    __device__ __forceinline__ void operator()(EPI_ARGS) const { BIG_ROWS(*this); }
};

__device__ __forceinline__ void rowsum4_atomic(float s0, float s1, float s2, float s3, float* ssq_rbase_fr, int fq) {
    s0 += __shfl_xor(s0, 16); s1 += __shfl_xor(s1, 16); s2 += __shfl_xor(s2, 16); s3 += __shfl_xor(s3, 16);
    s0 += __shfl_xor(s0, 32); s1 += __shfl_xor(s1, 32); s2 += __shfl_xor(s2, 32); s3 += __shfl_xor(s3, 32);
    const float sel = fq == 0 ? s0 : fq == 1 ? s1 : fq == 2 ? s2 : s3;
    atomicAdd(ssq_rbase_fr + 16 * fq, sel);
}
template <bool IN32, bool OUT32>
struct EpiRes {
    const float* xin_p; const float* xin_s; float* xout; bf16_t* xb; float* ssq;
    __device__ __forceinline__ void finish(f32x4 x0, f32x4 x1, int row, int col, float& ss) const {
        if (OUT32) { float* o = xout + (size_t)row * DM + col; *(f32x4*)o = x0; *(f32x4*)(o + 4) = x1; }
        else { *(u32x4*)(xb + (size_t)row * DM + col) = pack8(x0, x1); ss += dot4(x0) + dot4(x1); }
    }
    __device__ __forceinline__ void rowsum(float ss, int row, int fq) const { if (!OUT32) { ss += __shfl_xor(ss, 16); ss += __shfl_xor(ss, 32); if (fq == 0) atomicAdd(ssq + row, ss); } }
    __device__ __forceinline__ void row(f32x4 (&v)[2][2], float, int row, int pn, int wc, int fq) const {
        const int col0 = pn * 256 + wc * 32 + 8 * fq; float ss = 0.f;
#pragma unroll
        for (int bj = 0; bj < 2; ++bj) {
            f32x4 x0, x1;
            if (IN32) { const float* src = (row < MP ? xin_p + (size_t)row * DM : xin_s + (size_t)(row - MP) * DM) + col0 + 128 * bj; x0 = *(const f32x4*)src; x1 = *(const f32x4*)(src + 4); }
            else { const u32x4 w = *(const u32x4*)(xb + (size_t)row * DM + col0 + 128 * bj); x0 = (f32x4){bflo(w.x), bfhi(w.x), bflo(w.y), bfhi(w.y)}; x1 = (f32x4){bflo(w.z), bfhi(w.z), bflo(w.w), bfhi(w.w)}; }
            finish(x0 + v[bj][0], x1 + v[bj][1], row, col0 + 128 * bj, ss);
        }
        rowsum(ss, row, fq);
    }
    __device__ __forceinline__ void operator()(EPI_ARGS) const {
        const int row0 = u.pm * 256 + wr * 64 + fr, col0 = u.pn * 256 + wc * 32 + 8 * fq;
        if (IN32) {
#pragma unroll
            for (int ai = 0; ai < 2; ++ai) {
                f32x4 r[4][2][2];
#pragma unroll
                for (int m = 0; m < 4; ++m)
#pragma unroll
                    for (int bj = 0; bj < 2; ++bj) { const float* src = xin_p + (size_t)(row0 + ai * 128 + m * 16) * DM + col0 + 128 * bj; r[m][bj][0] = *(const f32x4*)src; r[m][bj][1] = *(const f32x4*)(src + 4); }
                float ssm[4];
#pragma unroll
                for (int m = 0; m < 4; ++m) { const int row = row0 + ai * 128 + m * 16; ssm[m] = 0.f;
#pragma unroll
                    for (int bj = 0; bj < 2; ++bj) finish(r[m][bj][0] + acc[ai][bj][m][0], r[m][bj][1] + acc[ai][bj][m][1], row, col0 + 128 * bj, ssm[m]); }
                if (!OUT32) rowsum4_atomic(ssm[0], ssm[1], ssm[2], ssm[3], ssq + row0 + ai * 128, fq);
            }
        } else {
#pragma unroll
            for (int ai = 0; ai < 2; ++ai) {
                u32x4 r[4][2];
#pragma unroll
                for (int m = 0; m < 4; ++m)
#pragma unroll
                    for (int bj = 0; bj < 2; ++bj) r[m][bj] = *(const u32x4*)(xb + (size_t)(row0 + ai * 128 + m * 16) * DM + col0 + 128 * bj);
                float ssm[4];
#pragma unroll
                for (int m = 0; m < 4; ++m) { const int row = row0 + ai * 128 + m * 16; ssm[m] = 0.f;
#pragma unroll
                    for (int bj = 0; bj < 2; ++bj) { const u32x4 w = r[m][bj];
                        const f32x4 x0 = (f32x4){bflo(w.x), bfhi(w.x), bflo(w.y), bfhi(w.y)}, x1 = (f32x4){bflo(w.z), bfhi(w.z), bflo(w.w), bfhi(w.w)};
                        finish(x0 + acc[ai][bj][m][0], x1 + acc[ai][bj][m][1], row, col0 + 128 * bj, ssm[m]); } }
                if (!OUT32) rowsum4_atomic(ssm[0], ssm[1], ssm[2], ssm[3], ssq + row0 + ai * 128, fq);
                asm volatile("" ::: "memory");
            }
        }
    }
};

template <int CTRL> __device__ __forceinline__ float dpp_f(float x) { return __int_as_float(__builtin_amdgcn_update_dpp(0, __float_as_int(x), CTRL, 0xf, 0xf, false)); }
__device__ __forceinline__ float silu_f(float c) { return c * __builtin_amdgcn_rcpf(1.f + __builtin_amdgcn_exp2f(-c * LOG2E)); }

struct EpiFfnConv {
    const float* ssq; bf16_t* H; const float* cw; const float* cbp; float* side; float* convp; LAS float* xch;
    __device__ __forceinline__ void operator()(EPI_ARGS) const {
        const int pm = u.pm, ts = pm & 15, col0 = u.pn * 128 + wc * 32 + 8 * fq;
        const int rowbase = pm * 256 + wr * 64 + fr;
        float rsv[2][4];
        FOR_AI_M rsv[ai][m] = ssq[rowbase + ai * 128 + m * 16];
        float w0[8], w1[8], w2[8], cb[8];
#pragma unroll
        for (int e = 0; e < 8; e += 4) { const f32x4 a0 = *(const f32x4*)(cw + col0 + e), a1 = *(const f32x4*)(cw + DFF + col0 + e), a2 = *(const f32x4*)(cw + 2 * DFF + col0 + e), a3 = *(const f32x4*)(cbp + col0 + e);
#pragma unroll
            for (int j = 0; j < 4; ++j) { w0[e + j] = a0[j]; w1[e + j] = a1[j]; w2[e + j] = a2[j]; cb[e + j] = a3[j]; } }
        FOR_AI_M rsv[ai][m] = rsqrtf(rsv[ai][m] * (1.f / 1024.f) + EPS);
        if (fr >= 14) {
#pragma unroll
            for (int ai = 0; ai < 2; ++ai) {
                const float rs = rsv[ai][3];
                LAS float* x = xch + ((2 * ai + wr) * 2 + (fr - 14)) * 128 + wc * 32 + 8 * fq;
                *(LAS f32x4*)x = acc[ai][0][3][0] * rs; *(LAS f32x4*)(x + 4) = acc[ai][0][3][1] * rs;
            }
        }
        asm volatile("s_waitcnt lgkmcnt(0)" ::: "memory"); __builtin_amdgcn_s_barrier(); asm volatile("" ::: "memory");
#pragma unroll
        for (int ai = 0; ai < 2; ++ai) {
            const int blk = 2 * ai + wr;
            float prev[8];
            if (blk > 0) { const LAS float* x = xch + ((blk - 1) * 2 + (fr >= 14 ? fr - 14 : 0)) * 128 + wc * 32 + 8 * fq; const f32x4 p0 = *(const LAS f32x4*)x, p1 = *(const LAS f32x4*)(x + 4);
#pragma unroll
                for (int e = 0; e < 4; ++e) { prev[e] = p0[e]; prev[4 + e] = p1[e]; } }
            else {
#pragma unroll
                for (int e = 0; e < 8; ++e) prev[e] = 0.f; }
#pragma unroll
            for (int m = 0; m < 4; ++m) {
                const int row = rowbase + ai * 128 + m * 16;
                const float rs = rsv[ai][m];
                float a[8], c[8], h[8], up[8];
#pragma unroll
                for (int e = 0; e < 8; ++e) { a[e] = acc[ai][0][m][e >> 2][e & 3] * rs; up[e] = acc[ai][1][m][e >> 2][e & 3] * rs; }
#pragma unroll
                for (int e = 0; e < 8; ++e) {
                    const float s1 = fr == 15 ? prev[e] : a[e], s2 = fr >= 14 ? prev[e] : a[e];
                    const float p1 = dpp_f<0x121>(s1), p2 = dpp_f<0x122>(s2);
                    c[e] = cb[e] + w0[e] * p2 + w1[e] * p1 + w2[e] * a[e];
                    h[e] = silu_f(c[e]) * up[e];
                }
                u32x4 w; w.x = cvtpk(h[0], h[1]); w.y = cvtpk(h[2], h[3]); w.z = cvtpk(h[4], h[5]); w.w = cvtpk(h[6], h[7]);
                *(u32x4*)(H + (size_t)row * DFF + col0) = w;
                if (ai == 0 && m == 0) { if (wr == 0 && ts > 0 && fr < 2) { float* d = side + (size_t)(pm * 2 + fr) * DFF + col0;
                        *(f32x4*)d = (f32x4){c[0], c[1], c[2], c[3]}; *(f32x4*)(d + 4) = (f32x4){c[4], c[5], c[6], c[7]};
                        *(f32x4*)(d + SIDE_N) = (f32x4){up[0], up[1], up[2], up[3]}; *(f32x4*)(d + SIDE_N + 4) = (f32x4){up[4], up[5], up[6], up[7]}; } }
                if (ai == 1 && m == 3) { if (wr == 1 && fr >= 14) { float* d = ts < 15 ? side + 2 * SIDE_N + (size_t)(pm * 2 + fr - 14) * DFF + col0 : convp + (size_t)((pm >> 4) * 2 + fr - 14) * DFF + col0;
                        *(f32x4*)d = (f32x4){a[0], a[1], a[2], a[3]}; *(f32x4*)(d + 4) = (f32x4){a[4], a[5], a[6], a[7]}; } }
#pragma unroll
                for (int e = 0; e < 8; ++e) prev[e] = a[e];
            }
        }
    }
};
struct EpiFfnNull {
    const float* ssq; bf16_t* H;
    __device__ __forceinline__ void row(f32x4 (&v)[2][2], float rs, int row, int pn, int wc, int fq) const {
        *(u32x4*)(H + (size_t)row * DFF + pn * 128 + wc * 32 + 8 * fq) = pack8(v[0][0] * rs + v[1][0], v[0][1] * rs + v[1][1]);
    }
    __device__ __forceinline__ void operator()(EPI_ARGS) const { BIG_ROWS(*this); }
};
__device__ __forceinline__ void ffn_fixup(const Params& P, int layer, const pg8::StaticOrder& S) {
    bf16_t* H = (bf16_t*)(P.ws + WS_H); const float* side = (const float*)(P.ws + WS_SIDE); const float* cw = P.in[25] + (size_t)layer * 3 * DFF;
    Unit u; int last = -1;
    for (int i = 0; S.next(i, u); ++i) {
        const int pm = u.pm; if ((pm & 15) == 0 || pm == last) continue; last = pm;
        for (int c4 = threadIdx.x; c4 < DFF / 4; c4 += 512) { const int col = 4 * c4;
            const f32x4 cp0 = *(const f32x4*)(side + (size_t)(pm * 2) * DFF + col), cp1 = *(const f32x4*)(side + (size_t)(pm * 2 + 1) * DFF + col);
            const f32x4 u0 = *(const f32x4*)(side + SIDE_N + (size_t)(pm * 2) * DFF + col), u1 = *(const f32x4*)(side + SIDE_N + (size_t)(pm * 2 + 1) * DFF + col);
            const f32x4 am2 = *(const f32x4*)(side + 2 * SIDE_N + (size_t)((pm - 1) * 2) * DFF + col), am1 = *(const f32x4*)(side + 2 * SIDE_N + (size_t)((pm - 1) * 2 + 1) * DFF + col);
            const f32x4 w0 = *(const f32x4*)(cw + col), w1 = *(const f32x4*)(cw + DFF + col);
            const f32x4 c0 = cp0 + w0 * am2 + w1 * am1, c1 = cp1 + w0 * am1;
            u32x2 h0, h1;
            h0.x = cvtpk(silu_f(c0[0]) * u0[0], silu_f(c0[1]) * u0[1]); h0.y = cvtpk(silu_f(c0[2]) * u0[2], silu_f(c0[3]) * u0[3]);
            h1.x = cvtpk(silu_f(c1[0]) * u1[0], silu_f(c1[1]) * u1[1]); h1.y = cvtpk(silu_f(c1[2]) * u1[2], silu_f(c1[3]) * u1[3]);
            *(u32x2*)(H + (size_t)(pm * 256) * DFF + col) = h0; *(u32x2*)(H + (size_t)(pm * 256 + 1) * DFF + col) = h1; }
    }
    asm volatile("s_waitcnt vmcnt(0)" ::: "memory"); __syncthreads();
}

struct EpiInB {
    const float* ssq; bf16_t *U, *GV, *XQ; const float* xg; float* ssqv;
    __device__ __forceinline__ void row(f32x4 (&v)[2][2], float rs, int row, int pn, int wc, int fq) const {
        if (pn < 6) {
            bf16_t* dst = pn < 3 ? U : GV; const int col0 = (pn % 3) * 256 + wc * 32 + 8 * fq;
            float ss = 0.f;
#pragma unroll
            for (int bj = 0; bj < 2; ++bj) {
                const f32x4 v0 = gelu4(v[bj][0] * rs), v1 = gelu4(v[bj][1] * rs);
                *(u32x4*)(dst + (size_t)row * 768 + col0 + 128 * bj) = pack8(v0, v1);
                ss += dot4(v0) + dot4(v1);
            }
            if (pn >= 3) { ss += __shfl_xor(ss, 16); ss += __shfl_xor(ss, 32); if (fq == 0) atomicAdd(ssqv + row, ss); }
        } else {
#pragma unroll
            for (int bj = 0; bj < 2; ++bj)
#pragma unroll
                for (int n = 0; n < 2; ++n) v[bj][n] = v[bj][n] * rs;
            head_norm(v, xg, fq);
#pragma unroll
            for (int bj = 0; bj < 2; ++bj) *(u32x4*)(XQ + (size_t)row * 256 + wc * 64 + 32 * bj + 8 * fq) = pack8(v[bj][0], v[bj][1]);
        }
    }
    __device__ __forceinline__ void operator()(EPI_ARGS) const {
        if (u.pn < 3 || u.pn >= 6) { BIG_ROWS(*this); return; }
        const int row0 = u.pm * 256 + wr * 64 + fr, col0 = (u.pn - 3) * 256 + wc * 32 + 8 * fq;
        float rsv[2][4];
        FOR_AI_M rsv[ai][m] = ssq[row0 + ai * 128 + m * 16];
#pragma unroll
        for (int ai = 0; ai < 2; ++ai) {
            float ssm[4];
#pragma unroll
            for (int m = 0; m < 4; ++m) { const int row = row0 + ai * 128 + m * 16; const float rs = rsqrtf(rsv[ai][m] * (1.f / 1024.f) + EPS); ssm[m] = 0.f;
#pragma unroll
                for (int bj = 0; bj < 2; ++bj) {
                    const f32x4 v0 = gelu4(acc[ai][bj][m][0] * rs), v1 = gelu4(acc[ai][bj][m][1] * rs);
                    *(u32x4*)(GV + (size_t)row * 768 + col0 + 128 * bj) = pack8(v0, v1);
                    ssm[m] += dot4(v0) + dot4(v1);
                } }
            rowsum4_atomic(ssm[0], ssm[1], ssm[2], ssm[3], ssqv + row0 + ai * 128, fq);
        }
    }
};

template <int MB> struct WgFrags { bf16x8 af[4][MB], bf[4][2][2]; };
template <int MB, int NB>
__device__ __forceinline__ void wg_load(WgFrags<MB>& F, const bf16_t* A, int lda, int row0, const bf16_t* Bt, int K, int pn, int wc, int k0, int s0) {
    const int lane = threadIdx.x & 63, fr = lane & 15, fq = lane >> 4;
    const bf16_t* ap = A + (size_t)(row0 + fr) * lda + 8 * fq + k0 + s0 * 32;
#pragma unroll
    for (int j = 0; j < NB; ++j)
#pragma unroll
        for (int m = 0; m < MB; ++m) F.af[j][m] = *(const bf16x8*)(ap + (size_t)m * 16 * lda + j * 32);
#pragma unroll
    for (int bj = 0; bj < 2; ++bj)
#pragma unroll
        for (int n = 0; n < 2; ++n) { const bf16_t* bp = Bt + (size_t)(pn * 256 + 128 * bj + 32 * wc + pg8::perm32(16 * n + fr)) * K + 8 * fq + k0 + s0 * 32;
#pragma unroll
            for (int j = 0; j < NB; ++j) F.bf[j][bj][n] = *(const bf16x8*)(bp + j * 32); }
}
template <int MB, int NB>
__device__ __forceinline__ void wg_mma(const WgFrags<MB>& F, f32x4 (&acc)[MB][2][2]) {
#pragma unroll
    for (int j = 0; j < NB; ++j)
#pragma unroll
        for (int m = 0; m < MB; ++m)
#pragma unroll
            for (int bj = 0; bj < 2; ++bj)
#pragma unroll
                for (int n = 0; n < 2; ++n) acc[m][bj][n] = __builtin_amdgcn_mfma_f32_16x16x32_bf16(F.bf[j][bj][n], F.af[j][m], acc[m][bj][n], 0, 0, 0);
}
template <int MB>
__device__ __forceinline__ void sample_reduce_store(LAS unsigned char* lds, const f32x4 (&acc)[MB][2][2], int wave, int lane) {
    LAS f32x4* Pl = (LAS f32x4*)lds;
#pragma unroll
    for (int m = 0; m < MB; ++m)
#pragma unroll
        for (int bj = 0; bj < 2; ++bj)
#pragma unroll
            for (int n = 0; n < 2; ++n) Pl[((wave * MB + m) * 4 + bj * 2 + n) * 64 + lane] = acc[m][bj][n];
}
template <int MB>
__device__ __forceinline__ void sample_reduce_finish(LAS unsigned char* lds, int wave, int lane) {
    LAS f32x4* Pl = (LAS f32x4*)lds; LAS f32x4* Rl = (LAS f32x4*)(lds + RING_BYTES);
    __syncthreads();
#pragma unroll
    for (int i = 0; i < (MB * 4) / 8 + ((MB * 4) % 8 ? 1 : 0); ++i) { const int slot = wave + 8 * i;
        if (slot < MB * 4) { f32x4 sum = Pl[slot * 64 + lane];
#pragma unroll
            for (int w = 1; w < 8; ++w) sum += Pl[(w * MB * 4 + slot) * 64 + lane];
            Rl[slot * 64 + lane] = sum; } }
    __syncthreads();
}
template <int MB>
__device__ __forceinline__ void sample_reduce(LAS unsigned char* lds, const f32x4 (&acc)[MB][2][2], int wave, int lane) {
    sample_reduce_store<MB>(lds, acc, wave, lane); sample_reduce_finish<MB>(lds, wave, lane);
}
template <int MB>
__device__ __forceinline__ void sample_reduce_load(const LAS unsigned char* lds, f32x4 (&v)[2][2], int m, int lane) {
    const LAS f32x4* Rl = (const LAS f32x4*)(lds + RING_BYTES);
#pragma unroll
    for (int bj = 0; bj < 2; ++bj)
#pragma unroll
        for (int n = 0; n < 2; ++n) v[bj][n] = Rl[(m * 4 + bj * 2 + n) * 64 + lane];
}
template <int MB, int NS, class Epi>
__device__ __forceinline__ void sample_gemm(LAS unsigned char* lds, const bf16_t* A, int lda, const bf16_t* Bt, int ntiles, const Epi& E, int blk, int nblk, int rowbase = MP, int nrows = MS) {
    const int lane = threadIdx.x & 63, fr = lane & 15, fq = lane >> 4, wave = __builtin_amdgcn_readfirstlane(threadIdx.x >> 6);
    constexpr int K = 8 * NS * 32, NB0 = NS < 4 ? NS : 4;
    const int NRB = nrows / (16 * MB);
    const int ntask = NRB * ntiles * 4;
    if (blk >= ntask) return;
    WgFrags<MB> F;
    { const int rb = blk % NRB, cw = blk / NRB; wg_load<MB, NB0>(F, A, lda, rowbase + rb * 16 * MB, Bt, K, cw >> 2, cw & 3, wave * NS * 32, 0); }
    for (int t = blk; t < ntask; t += nblk) {
        const int rb = t % NRB, cw = t / NRB, pn = cw >> 2, wc = cw & 3, row0 = rowbase + rb * 16 * MB;
        f32x4 acc[MB][2][2];
#pragma unroll
        for (int m = 0; m < MB; ++m)
#pragma unroll
            for (int bj = 0; bj < 2; ++bj)
#pragma unroll
                for (int n = 0; n < 2; ++n) acc[m][bj][n] = (f32x4){0.f, 0.f, 0.f, 0.f};
        wg_mma<MB, NB0>(F, acc);
#pragma unroll
        for (int s0 = 4; s0 < NS; s0 += 4) {
            if (NS - s0 >= 4) { wg_load<MB, 4>(F, A, lda, row0, Bt, K, pn, wc, wave * NS * 32, s0); wg_mma<MB, 4>(F, acc); }
            else { wg_load<MB, (NS % 4 ? NS % 4 : 4)>(F, A, lda, row0, Bt, K, pn, wc, wave * NS * 32, s0); wg_mma<MB, (NS % 4 ? NS % 4 : 4)>(F, acc); }
        }
        const int tn = t + nblk;
        if (tn < ntask) { const int rbn = tn % NRB, cwn = tn / NRB; wg_load<MB, NB0>(F, A, lda, rowbase + rbn * 16 * MB, Bt, K, cwn >> 2, cwn & 3, wave * NS * 32, 0); }
        const int row = row0 + 16 * (wave % MB) + fr; float rsq = 0.f;
        if (wave < MB && E.ssq) rsq = E.ssq[row];
        sample_reduce<MB>(lds, acc, wave, lane);
        if (wave < MB) { const float rs = E.ssq ? rsqrtf(rsq * (1.f / 1024.f) + EPS) : 1.f;
            f32x4 v[2][2]; sample_reduce_load<MB>(lds, v, wave, lane); E.row(v, rs, row, pn, wc, fq); }
    }
    __syncthreads();
}
__device__ __forceinline__ void sample_ffn(const Params& P, LAS unsigned char* lds, int layer, const float* ssq, int blk, int nblk) {
    const int lane = threadIdx.x & 63, fr = lane & 15, fq = lane >> 4, wave = __builtin_amdgcn_readfirstlane(threadIdx.x >> 6);
    const bf16_t* XB = (const bf16_t*)(P.ws + WS_XB); const bf16_t* Wt = (const bf16_t*)(P.ws + WS_WFFN) + (size_t)layer * NFF * DM; bf16_t* Hb = (bf16_t*)(P.ws + WS_H);
    const float* cw = P.in[25] + (size_t)layer * 3 * DFF; const float* cbp = P.in[26] + (size_t)layer * DFF; const float* st = P.in[6] + (size_t)layer * NDEC * 2 * DFF;
    float* convs = P.out + O_CONVS + (size_t)layer * NDEC * 2 * DFF;
    constexpr int MB = 4, NRB = MS / 64, NTASK = NRB * 22 * 4;
    if (blk >= NTASK) return;
    WgFrags<MB> F;
    { const int rb = blk % NRB, cwi = blk / NRB; wg_load<MB, 4>(F, XB, DM, MP + rb * 64, Wt, DM, cwi >> 2, cwi & 3, wave * 128, 0); }
    for (int t = blk; t < NTASK; t += nblk) {
        const int rb = t % NRB, cwi = t / NRB, pn = cwi >> 2, wc = cwi & 3;
        f32x4 acc[MB][2][2];
#pragma unroll
        for (int m = 0; m < MB; ++m)
#pragma unroll
            for (int bj = 0; bj < 2; ++bj)
#pragma unroll
                for (int n = 0; n < 2; ++n) acc[m][bj][n] = (f32x4){0.f, 0.f, 0.f, 0.f};
        wg_mma<MB, 4>(F, acc);
        const int tn = t + nblk;
        if (tn < NTASK) { const int rbn = tn % NRB, cwn = tn / NRB; wg_load<MB, 4>(F, XB, DM, MP + rbn * 64, Wt, DM, cwn >> 2, cwn & 3, wave * 128, 0); }
        sample_reduce_store<MB>(lds, acc, wave, lane);
        const int col0 = pn * 128 + wc * 32 + 8 * fq, s = fr & 3;
        const int row = MP + rb * 64 + 16 * (wave & 3) + fr, nseq = (row - MP) >> 2;
        f32x4 q0[2], q1[2], k0[2], k1[2], k2[2], kb[2]; float rsq = 0.f;
        if (wave < MB) {
            rsq = ssq[row];
#pragma unroll
            for (int e = 0; e < 2; ++e) {
                q0[e] = *(const f32x4*)(st + (size_t)(nseq * 2 + 0) * DFF + col0 + 4 * e); q1[e] = *(const f32x4*)(st + (size_t)(nseq * 2 + 1) * DFF + col0 + 4 * e);
            }
        }
        sample_reduce_finish<MB>(lds, wave, lane);
        if (wave < MB) {
#pragma unroll
            for (int e = 0; e < 2; ++e) { k0[e] = *(const f32x4*)(cw + col0 + 4 * e); k1[e] = *(const f32x4*)(cw + DFF + col0 + 4 * e); k2[e] = *(const f32x4*)(cw + 2 * DFF + col0 + 4 * e); kb[e] = *(const f32x4*)(cbp + col0 + 4 * e); }
            f32x4 v[2][2]; sample_reduce_load<MB>(lds, v, wave, lane);
            const float rs = rsqrtf(rsq * (1.f / 1024.f) + EPS);
            float h[8]; f32x4 av[2];
#pragma unroll
            for (int e = 0; e < 8; ++e) {
                const float a = v[0][e >> 2][e & 3] * rs, up = v[1][e >> 2][e & 3] * rs;
                const float st0 = q0[e >> 2][e & 3], st1 = q1[e >> 2][e & 3];
                const float r1 = dpp_f<0x121>(a), r2 = dpp_f<0x122>(a);
                const float p1 = s >= 1 ? r1 : st1, p2 = s >= 2 ? r2 : (s == 1 ? st1 : st0);
                const float c = kb[e >> 2][e & 3] + k0[e >> 2][e & 3] * p2 + k1[e >> 2][e & 3] * p1 + k2[e >> 2][e & 3] * a;
                h[e] = silu_f(c) * up; av[e >> 2][e & 3] = a;
            }
            if (s >= 2) { float* d = convs + (size_t)(nseq * 2 + (s - 2)) * DFF + col0; *(f32x4*)d = av[0]; *(f32x4*)(d + 4) = av[1]; }
            u32x4 w; w.x = cvtpk(h[0], h[1]); w.y = cvtpk(h[2], h[3]); w.z = cvtpk(h[4], h[5]); w.w = cvtpk(h[6], h[7]);
            *(u32x4*)(Hb + (size_t)row * DFF + col0) = w;
        }
    }
    __syncthreads();
}

__device__ __forceinline__ void p0_transpose_item(const float* W, int K, int N, const float* gain, bf16_t* WT, int kb, int n0, int drow0, LAS float* scr, int lane) {
    const int k0 = 64 * kb;
    float wv[32];
#pragma unroll
    for (int i = 0; i < 32; ++i) wv[i] = W[(size_t)(k0 + 2 * i + (lane >> 5)) * N + n0 + (lane & 31)];
    if (gain) {
#pragma unroll
        for (int i = 0; i < 32; ++i) wv[i] *= gain[k0 + 2 * i + (lane >> 5)]; }
#pragma unroll
    for (int i = 0; i < 32; ++i) scr[(2 * i + (lane >> 5)) * 33 + (lane & 31)] = wv[i];
    asm volatile("s_waitcnt lgkmcnt(0)" ::: "memory");
    const int c = lane & 7;
#pragma unroll
    for (int j = 0; j < 4; ++j) { const int n = (lane >> 3) + 8 * j; const LAS float* s = scr + (8 * c) * 33 + n;
        u32x4 o; o.x = cvtpk(s[0 * 33], s[1 * 33]); o.y = cvtpk(s[2 * 33], s[3 * 33]); o.z = cvtpk(s[4 * 33], s[5 * 33]); o.w = cvtpk(s[6 * 33], s[7 * 33]);
        *(u32x4*)(WT + (size_t)(drow0 + n) * K + k0 + 8 * c) = o; }
    asm volatile("s_waitcnt lgkmcnt(0)" ::: "memory");
}
__device__ __forceinline__ int map_headperm(int nb) { const int p = (nb * 32) & 255, bj = p >> 7, wc = (p >> 5) & 3; return ((nb * 32) & ~255) + 64 * wc + 32 * bj; }
__device__ __forceinline__ int map_ffn(int nb) { const int tile = nb >> 3, p = (nb & 7) * 32; return p < 128 ? 128 * tile + p : DFF + 128 * tile + (p - 128); }

template <int NR>
__device__ __forceinline__ void rows_to_bf16(const float* xrow, bf16_t* orow, float* ssq, int lane) {
    f32x4 v[NR][4];
#pragma unroll
    for (int r = 0; r < NR; ++r)
#pragma unroll
        for (int j = 0; j < 4; ++j) v[r][j] = ((const f32x4*)(xrow + (size_t)r * DM))[lane + 64 * j];
#pragma unroll
    for (int r = 0; r < NR; ++r) {
        float s = 0.f;
#pragma unroll
        for (int j = 0; j < 4; ++j) s += dot4(v[r][j]);
        s = wave_sum(s);
        u32x2* o8 = (u32x2*)(orow + (size_t)r * DM) + lane;
#pragma unroll
        for (int j = 0; j < 4; ++j) { u32x2 w; w.x = cvtpk(v[r][j][0], v[r][j][1]); w.y = cvtpk(v[r][j][2], v[r][j][3]); o8[64 * j] = w; }
        if (lane == 0) ssq[r] = s;
    }
}

__device__ __forceinline__ void p0_prologue(const Params& P, LAS unsigned char* lds, int G, int bid, int part) {
    const int tid = threadIdx.x, lane = tid & 63, wave = __builtin_amdgcn_readfirstlane(tid >> 6);
    LAS float* scr = (LAS float*)(lds + wave * 16384);
    const int gw = bid * 8 + wave, NGW = G * 8;
    unsigned char* ws = P.ws;
    float* ssq = (float*)(ws + WS_SSQ);
    const int gt = bid * 512 + tid, NGT = G * 512;
    constexpr int I0 = 16 * 48, I1 = 16 * 32, I2 = 16 * 56, I3 = 16 * 32, I4 = 16 * 16, I6 = 16 * 176, I8 = 44 * 32;
    if (part == 1) {
        constexpr int NITEMS = I3 + I6 + I8;
        for (int it = gw; it < NITEMS; it += NGW) {
            int r = it;
            if (r < I3) { const int nb = r % 32, kb = r / 32; p0_transpose_item(P.in[20], 1024, 1024, nullptr, (bf16_t*)(ws + WS_WOUTB), kb, 32 * nb, 32 * nb, scr, lane); continue; } r -= I3;
            if (r < I6) { const int nb = r % 176, kb = r / 176;
                p0_transpose_item(P.in[24] + (size_t)1024 * NFF, 1024, NFF, P.in[9] + 1024, (bf16_t*)(ws + WS_WFFN) + (size_t)NFF * 1024, kb, map_ffn(nb), 32 * nb, scr, lane); continue; } r -= I6;
            { const int nb = r % 32, kb = r / 32;
                p0_transpose_item(P.in[27] + (size_t)DFF * 1024, DFF, 1024, nullptr, (bf16_t*)(ws + WS_WDOWN) + (size_t)1024 * DFF, kb, 32 * nb, 32 * nb, scr, lane); }
        }
        { const f32x4* ck = (const f32x4*)P.in[2]; const f32x4* cv = (const f32x4*)P.in[3]; f32x4* ok = (f32x4*)(P.out + O_WKS); f32x4* ov = (f32x4*)(P.out + O_WVS);
          for (int i = gt; i < NDEC * 124 * 64; i += NGT) { const int n = i / (124 * 64), r = i % (124 * 64); const size_t s = (size_t)n * 128 * 64 + 4 * 64 + r, d = (size_t)n * 128 * 64 + r; ok[d] = ck[s]; ov[d] = cv[s]; } }
        return;
    }
    constexpr int NITEMS = I0 + I1 + I2 + 2 * I4 + I6 + I8;
    for (int it = gw; it < NITEMS; it += NGW) {
        int r = it;
        if (r < I0) { const int nb = r % 48, kb = r / 48; p0_transpose_item(P.in[11], 1024, NINA, P.in[8], (bf16_t*)(ws + WS_WINA), kb, map_headperm(nb), 32 * nb, scr, lane); continue; } r -= I0;
        if (r < I1) { const int nb = r % 32, kb = r / 32; p0_transpose_item(P.in[15], 1024, 1024, nullptr, (bf16_t*)(ws + WS_WOUTA), kb, 32 * nb, 32 * nb, scr, lane); continue; } r -= I1;
        if (r < I2) { const int nb = r % 56, kb = r / 56; p0_transpose_item(P.in[16], 1024, NINB, P.in[8] + 1024, (bf16_t*)(ws + WS_WINB), kb, nb < 48 ? 32 * nb : map_headperm(nb), 32 * nb, scr, lane); continue; } r -= I2;
        if (r < 2 * I4) { const int l = r / I4; r -= l * I4; const int nb = r % 16, kb = r / 16;
            p0_transpose_item(P.in[21] + (size_t)l * 1024 * 512, 1024, 512, P.in[10] + l * 1024, (bf16_t*)(ws + WS_WMKV) + (size_t)l * 512 * 1024, kb, map_headperm(nb), 32 * nb, scr, lane); continue; } r -= 2 * I4;
        if (r < I6) { const int nb = r % 176, kb = r / 176;
            p0_transpose_item(P.in[24], 1024, NFF, P.in[9], (bf16_t*)(ws + WS_WFFN), kb, map_ffn(nb), 32 * nb, scr, lane); continue; } r -= I6;
        { const int nb = r % 32, kb = r / 32;
            p0_transpose_item(P.in[27], DFF, 1024, nullptr, (bf16_t*)(ws + WS_WDOWN), kb, 32 * nb, 32 * nb, scr, lane); }
    }
    bf16_t* XB = (bf16_t*)(ws + WS_XB); bf16_t* MEMB = (bf16_t*)(ws + WS_MEMB);
    for (int r4 = gw; r4 < (M + MMEM) / 4; r4 += NGW) { const int r = 4 * r4;
        if (r < MP) rows_to_bf16<4>(P.in[0] + (size_t)r * DM, XB + (size_t)r * DM, ssq + r, lane);
        else if (r < M) rows_to_bf16<4>(P.in[1] + (size_t)(r - MP) * DM, XB + (size_t)r * DM, ssq + r, lane);
        else rows_to_bf16<4>(P.in[7] + (size_t)(r - M) * DM, MEMB + (size_t)(r - M) * DM, ssq + 5 * M + (r - M), lane);
    }
    for (int i = gt; i < 4 * M; i += NGT) ssq[M + i] = 0.f;
    if (gt < 256) { float* GT = (float*)(ws + WS_GT); const int t4 = gt >> 6, d = gt & 63; GT[gt] = t4 == 0 ? P.in[12][d] : t4 == 1 ? P.in[13][d] : t4 == 2 ? 1.f : P.in[22][d]; }
    { bf16_t* WST = (bf16_t*)(ws + WS_WST); const float* wsb = P.in[18];
      for (int i = gt; i < 4 * 128 * 128; i += NGT) { const int ii = (i >> 7) & 127, jj = i & 127; const float w = jj <= ii ? wsb[i] : 0.f; WST[i] = (bf16_t)(cvtpk(w, 0.f) & 0xffffu); } }
}

__device__ __forceinline__ int crow(int r, int hi) { return (r & 3) + 8 * (r >> 2) + 4 * hi; }
__device__ __forceinline__ int kv_off(int row, int chunk) { return row * 128 + ((chunk ^ (row & 7)) << 4); }
__device__ __forceinline__ s16x4 vtr(const LAS unsigned char* p) { return __builtin_bit_cast(s16x4, __builtin_amdgcn_ds_read_tr16_b64_v4i16((LAS s16x4*)p)); }

struct AttnOfs { int k[4]; int v[2]; };
__device__ __forceinline__ AttnOfs attn_ofs() {
    const int lane = threadIdx.x & 63, r32 = lane & 31, hi = lane >> 5; AttnOfs a;
#pragma unroll
    for (int ks = 0; ks < 4; ++ks) a.k[ks] = r32 * 128 + (((2 * ks + hi) ^ (r32 & 7)) << 4);
    const int vkey = 4 * hi + ((lane & 15) >> 2), vcol = 16 * ((lane >> 4) & 1) + 4 * (lane & 3);
#pragma unroll
    for (int d0 = 0; d0 < 2; ++d0) a.v[d0] = vkey * 128 + (((4 * d0 + (vcol >> 3)) ^ vkey) << 4) + (vcol & 7) * 2;
    return a;
}
template <int CT, bool MASK, bool FIRST>
__device__ __forceinline__ void attn_chunk(const bf16x8 (&qf)[4], const AttnOfs& ao, const LAS unsigned char* Kb, const LAS unsigned char* Vb, int qpos, int kpos0, float slope2, LAS float* wsf, float& m, float& l, f32x16 (&o)[2]) {
    const int lane = threadIdx.x & 63, r32 = lane & 31, hi = lane >> 5;
    f32x16 s[CT];
#pragma unroll
    for (int t = 0; t < CT; ++t) {
#pragma unroll
        for (int r = 0; r < 16; ++r) s[t][r] = 0.f;
#pragma unroll
        for (int ks = 0; ks < 4; ++ks) { const bf16x8 kf = *(const LAS bf16x8*)(Kb + ao.k[ks] + t * 4096); s[t] = __builtin_amdgcn_mfma_f32_32x32x16_bf16(kf, qf[ks], s[t], 0, 0, 0); }
        if (CT > 2) __builtin_amdgcn_sched_barrier(0);
    }
    const float C2 = 0.125f * LOG2E;
    float mx = -1e30f;
    if (MASK) {
        int dbase = qpos - kpos0 - 4 * hi; asm volatile("" : "+v"(dbase));
        const float fdb = (float)dbase, lim = (float)(qpos < 127 ? qpos : 127), ns = -slope2;
#pragma unroll
        for (int t = 0; t < CT; ++t)
#pragma unroll
            for (int r = 0; r < 16; ++r) {
                const float fd = fdb - (float)(32 * t + (r & 3) + 8 * (r >> 2));
                float v = __builtin_fmaf(ns, fd, s[t][r] * C2);
                v = (fd >= 0.f && fd <= lim) ? v : -1e30f;
                s[t][r] = v; mx = fmaxf(mx, v);
            }
    } else {
#pragma unroll
        for (int t = 0; t < CT; ++t)
#pragma unroll
            for (int r = 0; r < 16; ++r) { const float v = s[t][r] * C2; s[t][r] = v; mx = fmaxf(mx, v); }
    }
    mx = fmaxf(mx, __shfl_xor(mx, 32));
    const float mn = fmaxf(m, mx), alpha = __builtin_amdgcn_exp2f(m - mn);
    m = mn;
    float sum = 0.f;
#pragma unroll
    for (int t = 0; t < CT; ++t)
#pragma unroll
        for (int r = 0; r < 16; ++r) { const float e = __builtin_amdgcn_exp2f(s[t][r] - mn); s[t][r] = e; sum += e; }
    l = l * alpha + sum;
    if (!FIRST) {
        if (hi == 0) wsf[r32] = alpha;
        asm volatile("s_waitcnt lgkmcnt(0)" ::: "memory");
#pragma unroll
        for (int r = 0; r < 16; ++r) { const float a = wsf[crow(r, hi)]; o[0][r] *= a; o[1][r] *= a; }
        asm volatile("s_waitcnt lgkmcnt(0)" ::: "memory");
    }
#pragma unroll
    for (int t = 0; t < CT; ++t)
#pragma unroll
        for (int k2 = 0; k2 < 2; ++k2) {
            u32x4 pw; pw.x = cvtpk(s[t][8 * k2 + 0], s[t][8 * k2 + 1]); pw.y = cvtpk(s[t][8 * k2 + 2], s[t][8 * k2 + 3]); pw.z = cvtpk(s[t][8 * k2 + 4], s[t][8 * k2 + 5]); pw.w = cvtpk(s[t][8 * k2 + 6], s[t][8 * k2 + 7]);
            const bf16x8 pa = __builtin_bit_cast(bf16x8, pw);
#pragma unroll
            for (int d0 = 0; d0 < 2; ++d0) {
                const LAS unsigned char* vp = Vb + ao.v[d0] + (32 * t + 16 * k2) * 128;
                const s16x4 lo = vtr(vp), hh = vtr(vp + 1024);
                const bf16x8 vf = (bf16x8){lo[0], lo[1], lo[2], lo[3], hh[0], hh[1], hh[2], hh[3]};
                o[d0] = __builtin_amdgcn_mfma_f32_32x32x16_bf16(pa, vf, o[d0], 0, 0, 0);
            }
        }
}
__device__ __forceinline__ void attn_init(bool mask, float sink2, float& m, float& l, f32x16 (&o)[2]) {
    const int hi = (threadIdx.x & 63) >> 5;
    m = mask ? sink2 : -1e30f; l = (mask && hi == 0) ? 1.f : 0.f;
#pragma unroll
    for (int r = 0; r < 16; ++r) { o[0][r] = 0.f; o[1][r] = 0.f; }
}
__device__ __forceinline__ void attn_finish(float l, LAS float* wsf, f32x16 (&o)[2], LAS unsigned short* stg) {
    const int lane = threadIdx.x & 63, r32 = lane & 31, hi = lane >> 5;
    l += __shfl_xor(l, 32);
    if (hi == 0) wsf[r32] = 1.0f / l;
    asm volatile("s_waitcnt lgkmcnt(0)" ::: "memory");
#pragma unroll
    for (int r = 0; r < 16; ++r) { const float li = wsf[crow(r, hi)]; const int q = crow(r, hi);
        stg[q * 64 + r32] = (unsigned short)(cvtpk(o[0][r] * li, 0.f) & 0xffffu); stg[q * 64 + 32 + r32] = (unsigned short)(cvtpk(o[1][r] * li, 0.f) & 0xffffu); }
    asm volatile("s_waitcnt lgkmcnt(0)" ::: "memory");
}
__device__ __forceinline__ void attn_swa(const bf16x8 (&qf)[4], const AttnOfs& ao, const LAS unsigned char* Kb, const LAS unsigned char* Vb, int qpos, int kpos0, float slope2, float sink2, LAS float* wsf, LAS unsigned short* stg) {
    float m, l; f32x16 o[2]; attn_init(true, sink2, m, l, o);
#pragma unroll 1
    for (int t = 0; t < 4; t += 2) attn_chunk<2, true, false>(qf, ao, Kb + t * 4096, Vb + t * 4096, qpos, kpos0 + 32 * t, slope2, wsf, m, l, o);
    attn_chunk<1, true, false>(qf, ao, Kb + 4 * 4096, Vb + 4 * 4096, qpos, kpos0 + 128, slope2, wsf, m, l, o);
    attn_finish(l, wsf, o, stg);
}
__device__ __forceinline__ void attn_mem(const bf16x8 (&qf)[4], const AttnOfs& ao, const LAS unsigned char* Kb, const LAS unsigned char* Vb, LAS float* wsf, LAS unsigned short* stg) {
    float m, l; f32x16 o[2]; attn_init(false, 0.f, m, l, o);
    attn_chunk<2, false, true>(qf, ao, Kb, Vb, 0, 0, 0.f, wsf, m, l, o);
#pragma unroll 1
    for (int c = 1; c < 4; ++c) attn_chunk<2, false, false>(qf, ao, Kb + c * 64 * 128, Vb + c * 64 * 128, 0, 0, 0.f, wsf, m, l, o);
    attn_finish(l, wsf, o, stg);
}
__device__ __forceinline__ void stage_out(const LAS unsigned short* stg, bf16_t* gdst, size_t ld) {
    const int lane = threadIdx.x & 63;
#pragma unroll
    for (int i = 0; i < 4; ++i) { const int row = i * 8 + (lane >> 3), ch = lane & 7; *(u32x4*)(gdst + (size_t)row * ld + ch * 8) = *(const LAS u32x4*)(stg + row * 64 + ch * 8); }
    asm volatile("s_waitcnt lgkmcnt(0)" ::: "memory");
}

__device__ __forceinline__ void unit_swa_prompt(const Params& P, LAS unsigned char* lds, LAS float* wsf, int b, int qb, int g) {
    const int tid = threadIdx.x, lane = tid & 63, wave = __builtin_amdgcn_readfirstlane(tid >> 6), r32 = lane & 31, hi = lane >> 5;
    const bf16_t* Qg = (const bf16_t*)(P.ws + WS_Q); const bf16_t* Kg = (const bf16_t*)(P.ws + WS_K); const bf16_t* Vg = (const bf16_t*)(P.ws + WS_V); bf16_t* Og = (bf16_t*)(P.ws + WS_O);
    LAS unsigned char* Kl = lds; LAS unsigned char* Vl = lds + 49152; LAS unsigned short* stg = (LAS unsigned short*)(lds + 98304 + wave * 4096);
    const int t0 = 256 * qb + 32 * wave;
    const bf16_t* qp = Qg + (size_t)(b * SEQ + t0 + r32) * 768 + (3 * g) * 64 + 8 * hi;
#pragma unroll 3
    for (int idx = tid; idx < 384 * 8; idx += 512) {
        const int row = idx >> 3, ch = idx & 7, t = 256 * qb - 128 + row;
        u32x4 kv = (u32x4){0u, 0u, 0u, 0u}, vv = kv;
        if (t >= 0) { const size_t o = (size_t)(b * SEQ + t) * 256 + g * 64 + ch * 8; kv = *(const u32x4*)(Kg + o); vv = *(const u32x4*)(Vg + o); }
        *(LAS u32x4*)(Kl + kv_off(row, ch)) = kv; *(LAS u32x4*)(Vl + kv_off(row, ch)) = vv;
    }
    __syncthreads();
    const AttnOfs ao = attn_ofs();
#pragma unroll 1
    for (int hh = 0; hh < 3; ++hh) {
        const int head = 3 * g + hh;
        bf16x8 qf[4];
#pragma unroll
        for (int ks = 0; ks < 4; ++ks) qf[ks] = *(const bf16x8*)(qp + hh * 64 + 16 * ks);
        attn_swa(qf, ao, Kl + 32 * wave * 128, Vl + 32 * wave * 128, t0 + r32, t0 - 128, alibi_slope(head) * LOG2E, P.in[14][head] * LOG2E, wsf, stg);
        stage_out(stg, Og + (size_t)(b * SEQ + t0) * DM + head * 64, DM);
    }
    __syncthreads();
}

__device__ __forceinline__ void unit_mem_prompt(const Params& P, LAS unsigned char* lds, LAS float* wsf, int layer, int b, int qb, int h) {
    const int tid = threadIdx.x, lane = tid & 63, wave = __builtin_amdgcn_readfirstlane(tid >> 6), r32 = lane & 31, hi = lane >> 5;
    const bf16_t* XQ = (const bf16_t*)(P.ws + WS_XQ); bf16_t* Og = (bf16_t*)(P.ws + WS_O);
    const bf16_t* MK = (const bf16_t*)(P.ws + WS_MK) + (size_t)layer * MMEM * 256; const bf16_t* MV = (const bf16_t*)(P.ws + WS_MV) + (size_t)layer * MMEM * 256;
    LAS unsigned char* Kl = lds; LAS unsigned char* Vl = lds + 32768; LAS unsigned short* stg = (LAS unsigned short*)(lds + 98304 + wave * 4096);
    const int t0 = 256 * qb + 32 * wave;
    bf16x8 qf[4];
#pragma unroll
    for (int ks = 0; ks < 4; ++ks) qf[ks] = *(const bf16x8*)(XQ + (size_t)(b * SEQ + t0 + r32) * 256 + h * 64 + 16 * ks + 8 * hi);
#pragma unroll
    for (int idx = tid; idx < 256 * 8; idx += 512) {
        const int row = idx >> 3, ch = idx & 7; const size_t o = (size_t)(b * NMEM + row) * 256 + h * 64 + ch * 8;
        *(LAS u32x4*)(Kl + kv_off(row, ch)) = *(const u32x4*)(MK + o); *(LAS u32x4*)(Vl + kv_off(row, ch)) = *(const u32x4*)(MV + o);
    }
    __syncthreads();
    const AttnOfs ao = attn_ofs();
    attn_mem(qf, ao, Kl, Vl, wsf, stg);
    stage_out(stg, Og + (size_t)(b * SEQ + t0) * DM + 768 + h * 64, DM);
    __syncthreads();
}

__device__ __forceinline__ u32x4 ld8f_pack(const float* p) { const f32x4 a = *(const f32x4*)p, b = *(const f32x4*)(p + 4); return pack8(a, b); }

__device__ __forceinline__ void unit_swa_sample(const Params& P, LAS unsigned char* lds, LAS float* wsf, int n, int gp) {
    const int tid = threadIdx.x, lane = tid & 63, wave = __builtin_amdgcn_readfirstlane(tid >> 6), r32 = lane & 31, hi = lane >> 5;
    const bf16_t* Qg = (const bf16_t*)(P.ws + WS_Q); const bf16_t* Kg = (const bf16_t*)(P.ws + WS_K); const bf16_t* Vg = (const bf16_t*)(P.ws + WS_V); bf16_t* Og = (bf16_t*)(P.ws + WS_O);
#pragma unroll 2
    for (int idx = tid; idx < 2 * 160 * 8; idx += 512) {
        const int gi = idx / 1280, rem = idx % 1280, row = rem >> 3, ch = rem & 7, g = 2 * gp + gi;
        LAS unsigned char* Kl = lds + gi * 40960; LAS unsigned char* Vl = Kl + 20480;
        u32x4 kv = (u32x4){0u, 0u, 0u, 0u}, vv = kv;
        if (row < 128) { const size_t o = ((size_t)(n * 128 + row) * 4 + g) * 64 + ch * 8; kv = ld8f_pack(P.in[2] + o); vv = ld8f_pack(P.in[3] + o); }
        else if (row < 132) { const size_t o = (size_t)(MP + 4 * n + row - 128) * 256 + g * 64 + ch * 8; kv = *(const u32x4*)(Kg + o); vv = *(const u32x4*)(Vg + o); }
        *(LAS u32x4*)(Kl + kv_off(row, ch)) = kv; *(LAS u32x4*)(Vl + kv_off(row, ch)) = vv;
    }
    __syncthreads();
    if (wave < 2) {
        LAS unsigned short* stg = (LAS unsigned short*)(lds + 98304 + wave * 4096);
        const AttnOfs ao = attn_ofs();
        const int g = 2 * gp + wave; const bool qv = r32 < 12; const int hh = qv ? (r32 >> 2) : 0, sidx = r32 & 3, head = 3 * g + hh;
        bf16x8 qf[4];
#pragma unroll
        for (int ks = 0; ks < 4; ++ks) { qf[ks] = *(const bf16x8*)(Qg + (size_t)(MP + 4 * n + sidx) * 768 + head * 64 + 16 * ks + 8 * hi); if (!qv) qf[ks] = (bf16x8){0, 0, 0, 0, 0, 0, 0, 0}; }
        const LAS unsigned char* Kl = lds + wave * 40960;
        attn_swa(qf, ao, Kl, Kl + 20480, 128 + sidx, 0, alibi_slope(head) * LOG2E, P.in[14][head] * LOG2E, wsf, stg);
        for (int i = lane; i < 96; i += 64) { const int q = i >> 3, ch = i & 7;
            *(u32x4*)(Og + (size_t)(MP + 4 * n + (q & 3)) * DM + (3 * g + (q >> 2)) * 64 + ch * 8) = *(const LAS u32x4*)(stg + q * 64 + ch * 8); }
        asm volatile("s_waitcnt lgkmcnt(0)" ::: "memory");
    }
    __syncthreads();
}

__device__ __forceinline__ void unit_mem_sample(const Params& P, LAS unsigned char* lds, LAS float* wsf, int layer, int n, int hp) {
    const int tid = threadIdx.x, lane = tid & 63, wave = __builtin_amdgcn_readfirstlane(tid >> 6), r32 = lane & 31, hi = lane >> 5;
    const bf16_t* XQ = (const bf16_t*)(P.ws + WS_XQ); bf16_t* Og = (bf16_t*)(P.ws + WS_O);
    const float* ck = P.in[4] + (size_t)(layer * NDEC + n) * NMEM * 256; const float* cv = P.in[5] + (size_t)(layer * NDEC + n) * NMEM * 256;
#pragma unroll 2
    for (int idx = tid; idx < 256 * 16; idx += 512) {
        const int row = idx >> 4, hsel = (idx >> 3) & 1, ch = idx & 7; const size_t o = (size_t)row * 256 + (2 * hp + hsel) * 64 + ch * 8;
        LAS unsigned char* Kl = lds + hsel * 65536;
        *(LAS u32x4*)(Kl + kv_off(row, ch)) = ld8f_pack(ck + o); *(LAS u32x4*)(Kl + 32768 + kv_off(row, ch)) = ld8f_pack(cv + o);
    }
    __syncthreads();
    if (wave < 2) {
        LAS unsigned short* stg = (LAS unsigned short*)(lds + OSTG2_OFF + wave * 4096);
        const AttnOfs ao = attn_ofs();
        const int h = 2 * hp + wave; const bool qv = r32 < 4;
        bf16x8 qf[4];
#pragma unroll
        for (int ks = 0; ks < 4; ++ks) { qf[ks] = *(const bf16x8*)(XQ + (size_t)(MP + 4 * n + (r32 & 3)) * 256 + h * 64 + 16 * ks + 8 * hi); if (!qv) qf[ks] = (bf16x8){0, 0, 0, 0, 0, 0, 0, 0}; }
        const LAS unsigned char* Kl = lds + wave * 65536;
        attn_mem(qf, ao, Kl, Kl + 32768, wsf, stg);
        if (lane < 32) { const int q = lane >> 3, ch = lane & 7;
            *(u32x4*)(Og + (size_t)(MP + 4 * n + q) * DM + 768 + h * 64 + ch * 8) = *(const LAS u32x4*)(stg + q * 64 + ch * 8); }
        asm volatile("s_waitcnt lgkmcnt(0)" ::: "memory");
    }
    __syncthreads();
}

__device__ __forceinline__ void unit_gmlp_prompt(const Params& P, LAS unsigned char* lds, int b, int c) {
    const int tid = threadIdx.x, lane = tid & 63, wave = __builtin_amdgcn_readfirstlane(tid >> 6), r32 = lane & 31, hi = lane >> 5;
    const bf16_t* U = (const bf16_t*)(P.ws + WS_U); const bf16_t* GV = (const bf16_t*)(P.ws + WS_GV); bf16_t* Og = (bf16_t*)(P.ws + WS_O);
    const bf16_t* WST = (const bf16_t*)(P.ws + WS_WST); const float* ssqv = (const float*)(P.ws + WS_SSQ) + 4 * M;
    const float* vg = P.in[17]; const float* bs = P.in[19]; float* cvp = P.out + O_CVP;
    const int rowb = b * SEQ + c * 128;
    const int ib = wave & 3, cb0 = 3 * (wave >> 2);
#pragma unroll 1
    for (int g = 0; g < 4; ++g) {
        for (int idx = tid; idx < 128 * 24; idx += 512) {
            const int j = idx / 24, ch = idx % 24; const int row = rowb + j, col = g * 192 + ch * 8;
            const float rv = rsqrtf(ssqv[row] * (1.f / 768.f) + EPS);
            const u32x4 w = *(const u32x4*)(GV + (size_t)row * 768 + col);
            const f32x4 g0 = *(const f32x4*)(vg + col), g1 = *(const f32x4*)(vg + col + 4);
            f32x4 v0 = (f32x4){bflo(w.x), bfhi(w.x), bflo(w.y), bfhi(w.y)}, v1 = (f32x4){bflo(w.z), bfhi(w.z), bflo(w.w), bfhi(w.w)};
            v0 = v0 * rv * g0; v1 = v1 * rv * g1;
            *(LAS u32x4*)(lds + j * 384 + ch * 16) = pack8(v0, v1);
            if (c == 31) { float* o = cvp + (size_t)(b * 128 + j) * 768 + col; *(f32x4*)o = v0; *(f32x4*)(o + 4) = v1; }
        }
        __syncthreads();
        f32x16 acc[3];
#pragma unroll
        for (int i = 0; i < 3; ++i)
#pragma unroll
            for (int r = 0; r < 16; ++r) acc[i][r] = 0.f;
        const int nks = 2 * (ib + 1);
#pragma unroll 1
        for (int ks = 0; ks < nks; ++ks) {
            const bf16x8 af = *(const bf16x8*)(WST + (size_t)(g * 128 + 32 * ib + r32) * 128 + 16 * ks + 8 * hi);
            const int j0 = 16 * ks + 8 * hi + ((lane & 15) >> 2);
#pragma unroll
            for (int i = 0; i < 3; ++i) {
                const int col = 32 * (cb0 + i) + 16 * ((lane >> 4) & 1) + 4 * (lane & 3);
                const s16x4 lo = vtr(lds + j0 * 384 + col * 2), hh = vtr(lds + (j0 + 4) * 384 + col * 2);
                const bf16x8 vf = (bf16x8){lo[0], lo[1], lo[2], lo[3], hh[0], hh[1], hh[2], hh[3]};
                acc[i] = __builtin_amdgcn_mfma_f32_32x32x16_bf16(af, vf, acc[i], 0, 0, 0);
            }
        }
        LAS float* stg = (LAS float*)(lds + 49152 + wave * 4096);
#pragma unroll 1
        for (int i = 0; i < 3; ++i) {
            const f32x16 a = i == 0 ? acc[0] : i == 1 ? acc[1] : acc[2];
#pragma unroll
            for (int r = 0; r < 16; ++r) { const int q = crow(r, hi); stg[q * 32 + r32] = a[r] + bs[g * 128 + 32 * ib + q]; }
            asm volatile("s_waitcnt lgkmcnt(0)" ::: "memory");
            const int q = lane >> 1, hf = lane & 1; const size_t ro = (size_t)(rowb + 32 * ib + q); const int col = g * 192 + 32 * (cb0 + i) + 16 * hf;
            const u32x4 u0 = *(const u32x4*)(U + ro * 768 + col), u1 = *(const u32x4*)(U + ro * 768 + col + 8);
            const LAS f32x4* sp = (const LAS f32x4*)(stg + q * 32 + 16 * hf);
            const f32x4 m0 = sp[0], m1 = sp[1], m2 = sp[2], m3 = sp[3];
            u32x4 o0, o1;
            o0.x = cvtpk(bflo(u0.x) * m0[0], bfhi(u0.x) * m0[1]); o0.y = cvtpk(bflo(u0.y) * m0[2], bfhi(u0.y) * m0[3]); o0.z = cvtpk(bflo(u0.z) * m1[0], bfhi(u0.z) * m1[1]); o0.w = cvtpk(bflo(u0.w) * m1[2], bfhi(u0.w) * m1[3]);
            o1.x = cvtpk(bflo(u1.x) * m2[0], bfhi(u1.x) * m2[1]); o1.y = cvtpk(bflo(u1.y) * m2[2], bfhi(u1.y) * m2[3]); o1.z = cvtpk(bflo(u1.z) * m3[0], bfhi(u1.z) * m3[1]); o1.w = cvtpk(bflo(u1.w) * m3[2], bfhi(u1.w) * m3[3]);
            *(u32x4*)(Og + ro * DM + col) = o0; *(u32x4*)(Og + ro * DM + col + 8) = o1;
            asm volatile("s_waitcnt lgkmcnt(0)" ::: "memory");
        }
        __syncthreads();
    }
}

__device__ __forceinline__ void gmlp_sample(const Params& P, int G, int bid) {
    const bf16_t* U = (const bf16_t*)(P.ws + WS_U); const bf16_t* GV = (const bf16_t*)(P.ws + WS_GV); bf16_t* Og = (bf16_t*)(P.ws + WS_O);
    const float* ssqv = (const float*)(P.ws + WS_SSQ) + 4 * M; const float* vg = P.in[17]; const float* wsb = P.in[18]; const float* bs = P.in[19]; float* cvs = P.out + O_CVS;
    for (int i = bid * 512 + threadIdx.x; i < NDEC * 768; i += G * 512) {
        const int n = i / 768, col = i % 768, g = col / 192; float vn[4];
#pragma unroll
        for (int s = 0; s < 4; ++s) { const int row = MP + 4 * n + s; vn[s] = bf2f(GV[(size_t)row * 768 + col]) * rsqrtf(ssqv[row] * (1.f / 768.f) + EPS) * vg[col]; cvs[(size_t)(4 * n + s) * 768 + col] = vn[s]; }
#pragma unroll
        for (int s = 0; s < 4; ++s) { float mx = bs[g * 128 + s];
#pragma unroll
            for (int j = 0; j < 4; ++j) if (j <= s) mx += wsb[(size_t)(g * 128 + s) * 128 + j] * vn[j];
            const int row = MP + 4 * n + s; Og[(size_t)row * DM + col] = f2bf_s(bf2f(U[(size_t)row * 768 + col]) * mx); }
    }
}

#define XB_TMO      128
#define XB_XCNT(j)  (256  + 64 * (j))
#define XB_XSUB(j)  (1280 + 64 * (j))
#define XB_XGEN(j)  (2304 + 64 * (j))
#define XB_TOP      3328
#define XB_TOPGEN   3392
#define XCD_BAR_WORDS 3456
#define XB_SPIN_CAP (1u << 22)
__device__ __forceinline__ unsigned xb_ld(unsigned* p)              { return __hip_atomic_load(p, __ATOMIC_RELAXED, __HIP_MEMORY_SCOPE_AGENT); }
__device__ __forceinline__ unsigned xb_add(unsigned* p, unsigned v) { return __hip_atomic_fetch_add(p, v, __ATOMIC_RELAXED, __HIP_MEMORY_SCOPE_AGENT); }
__device__ __forceinline__ unsigned xb_xcc_id() { return (unsigned)__builtin_amdgcn_s_getreg((3 << 11) | 20) & 0xFu; }
#define XB_SPIN(cond, bar) do { unsigned _sp = 0; while (cond) { __builtin_amdgcn_s_sleep(1); \
    if ((++_sp & 255u) == 0u) { if (xb_ld(&(bar)[XB_TMO])) break; if (_sp > XB_SPIN_CAP) { atomicAdd(&(bar)[XB_TMO], 1u); break; } } } } while (0)
struct XcdBarrier { unsigned* bar; unsigned x; volatile LAS unsigned* st; };
__device__ __forceinline__ XcdBarrier xcd_barrier_post(unsigned* bar, volatile LAS unsigned* st) {
    XcdBarrier b; b.bar = bar; b.x = xb_xcc_id(); b.st = st;
    if (threadIdx.x == 0) (void)xb_add(&bar[XB_XCNT(b.x)], 1u);
    return b;
}
__device__ __forceinline__ void xcd_barrier_complete(unsigned* bar, unsigned x, unsigned& nloc, unsigned& nx) {
    const unsigned G = gridDim.x * gridDim.y * gridDim.z;
    unsigned sum, cnt, mine, sp = 0u;
    for (;;) {
        sum = 0u; cnt = 0u; mine = 0u;
#pragma unroll
        for (unsigned j = 0; j < 16; ++j) { const unsigned c = xb_ld(&bar[XB_XCNT(j)]); sum += c; cnt += (c > 0u) ? 1u : 0u; mine = (j == x) ? c : mine; }
        if (sum == G) break;
        __builtin_amdgcn_s_sleep(1);
        if ((++sp & 255u) == 0u) { if (xb_ld(&bar[XB_TMO])) break; if (sp > XB_SPIN_CAP) { atomicAdd(&bar[XB_TMO], 1u); break; } }
    }
    nloc = mine > 0u ? mine : 1u; nx = cnt > 0u ? cnt : 1u;
}
__device__ __forceinline__ void xcd_barrier(const XcdBarrier& b) {
    asm volatile("s_waitcnt vmcnt(0)" ::: "memory");
    __syncthreads();
    if (threadIdx.x == 0) {
        unsigned* bar = b.bar;
        __builtin_amdgcn_s_waitcnt(0);
        unsigned nloc = b.st[0], nx = b.st[1];
        if (nloc == 0u) { xcd_barrier_complete(bar, b.x, nloc, nx); b.st[0] = nloc; b.st[1] = nx; }
        const unsigned old = xb_add(&bar[XB_XSUB(b.x)], 1u);
        const unsigned gen = old / nloc;
        if (old + 1u == (gen + 1u) * nloc) {
            __builtin_amdgcn_fence(__ATOMIC_RELEASE, "agent");
            asm volatile("s_waitcnt vmcnt(0)" ::: "memory");
            const unsigned og = xb_add(&bar[XB_TOP], 1u);
            const unsigned tg = og / nx;
            if (og + 1u == (tg + 1u) * nx) xb_add(&bar[XB_TOPGEN], 1u);
            else XB_SPIN(xb_ld(&bar[XB_TOPGEN]) == tg, bar);
            __builtin_amdgcn_fence(__ATOMIC_ACQUIRE, "agent");
            xb_add(&bar[XB_XGEN(b.x)], 1u);
            asm volatile("s_waitcnt vmcnt(0)" ::: "memory");
        } else {
            XB_SPIN(xb_ld(&bar[XB_XGEN(b.x)]) == gen, bar);
            __builtin_amdgcn_fence(__ATOMIC_ACQUIRE, "agent");
            asm volatile("s_waitcnt vmcnt(0)" ::: "memory");
        }
    }
    __syncthreads();
}


__global__ void __launch_bounds__(512, 2) mk_fwd(Params P) {
    extern __shared__ __attribute__((aligned(16))) unsigned char lds_raw[];
    LAS unsigned char* lds = (LAS unsigned char*)lds_raw;
    const int tid = threadIdx.x, wave = __builtin_amdgcn_readfirstlane(tid >> 6);
    const int G = gridDim.x, bid = blockIdx.x;
    LAS float* wsf = (LAS float*)(lds + WSF_OFF) + wave * 64;
    unsigned char* ws = P.ws;
    float* ssq = (float*)(ws + WS_SSQ);
    bf16_t* XB = (bf16_t*)(ws + WS_XB);
    cg::grid_group grid = cg::this_grid();
    const int lo = P.ph_lo, hi = P.ph_hi;
#ifndef PH_MASK
#define PH_MASK 0x1fff
#endif
#define IN(k) (((PH_MASK >> (k)) & 1) && lo <= (k) && (k) < hi)
#ifndef USE_XCD_BAR
#define USE_XCD_BAR 1
#endif
    volatile LAS unsigned* bst = (volatile LAS unsigned*)(lds + BST_OFF);
    if (tid < 2) bst[tid] = 0u;
    __syncthreads();
    XcdBarrier xbar = xcd_barrier_post((unsigned*)(ws + WS_CTL), bst);
    unsigned long long t_prev = 0ull, t_probe = 0ull;
    if (TPROBE == 200 && bid == 0) { const unsigned long long t0 = __builtin_amdgcn_s_memrealtime(); while (__builtin_amdgcn_s_memrealtime() - t0 < 20000ull) __builtin_amdgcn_s_sleep(8); }
    if (TPROBE >= 0) t_prev = __builtin_amdgcn_s_memrealtime();
    const unsigned long long t_start = t_prev;
#define SEAM(k) do { if (IN(k) && IN((k) + 1)) { if (!USE_XCD_BAR) grid.sync(); else xcd_barrier(xbar); } \
    if (TPROBE >= 0) { const unsigned long long tn = __builtin_amdgcn_s_memrealtime(); if (TPROBE == (k)) t_probe = tn - t_prev; t_prev = tn; } } while (0)

    if (IN(0)) { p0_prologue(P, lds, G, bid, 0); }
    SEAM(0);
    const int gwave = bid * 8 + wave, NW = G * 8;
    const bf16_t* XBs = XB;
    if (IN(1)) {
        EpiInA E{ssq, (bf16_t*)(ws + WS_Q), (const float*)(ws + WS_GT), P.out};
        const bool early = (bid & 1) != 0;
        EpiMemKV E2{ssq + 5 * M, P.in[23], P.out + O_MKP, P.out + O_MVP, (bf16_t*)(ws + WS_MK), (bf16_t*)(ws + WS_MV)};
        if (early) { sample_gemm<4, 4>(lds, XBs, DM, (const bf16_t*)(ws + WS_WINA), 6, E, bid >> 1, G >> 1);
                     sample_gemm<4, 4>(lds, (const bf16_t*)(ws + WS_MEMB), DM, (const bf16_t*)(ws + WS_WMKV), 4, E2, bid >> 1, G >> 1, 0, MMEM / 2); }
        { pg8::Gemm g{XB, (const bf16_t*)(ws + WS_WINA), DM, DM}; pg8::StaticOrder S; S.init(MP, NINA, G, bid);
          { unsigned long long tu0 = 0ull; if (TPROBE == 30) tu0 = __builtin_amdgcn_s_memrealtime();
          pg8::gemm_phase<EpiInA, true, true>(lds, g, S, E);
          if (TPROBE == 30) t_probe = 4ull * (__builtin_amdgcn_s_memrealtime() - tu0); } }
        { unsigned long long tu0 = 0ull; if (TPROBE == 31) tu0 = __builtin_amdgcn_s_memrealtime();
        if (!early) sample_gemm<4, 4>(lds, (const bf16_t*)(ws + WS_MEMB), DM, (const bf16_t*)(ws + WS_WMKV), 4, E2, bid >> 1, G >> 1, MMEM / 2, MMEM / 2);
        if (TPROBE == 31) t_probe = 10ull * (__builtin_amdgcn_s_memrealtime() - tu0); }
    }
    SEAM(1);
    if (IN(2)) {
        const int ns2 = (1536 + G - 1) / G;
        for (int j = 0; j < ns2; ++j) { const int jj = ((bid & 1) && ns2 == 6) ? (j + 4) % 6 : j; const int uidx = bid + jj * G; if (uidx >= 1536) continue;
            unsigned long long tu0 = 0ull; if (TPROBE >= 20 && TPROBE < 30) tu0 = __builtin_amdgcn_s_memrealtime();
#ifndef UM
#define UM 15
#endif
            if (uidx < 512) { if (UM & 1) unit_swa_prompt(P, lds, wsf, uidx >> 6, (uidx >> 2) & 15, uidx & 3); }
            else if (uidx < 1024) { const int v = uidx - 512; if (UM & 2) unit_mem_prompt(P, lds, wsf, 0, v >> 6, (v >> 2) & 15, v & 3); }
            else if (uidx < 1280) { const int v = uidx - 1024; if (UM & 4) unit_mem_sample(P, lds, wsf, 0, v >> 1, v & 1); }
            else { const int v = uidx - 1280; if (UM & 8) unit_swa_sample(P, lds, wsf, v >> 1, v & 1); }
            if (TPROBE >= 20 && TPROBE < 30 && jj == TPROBE - 20) t_probe = 10ull * (__builtin_amdgcn_s_memrealtime() - tu0);
        }
    }
    SEAM(2);
    if (IN(3)) {
        pg8::Gemm g{(const bf16_t*)(ws + WS_O), (const bf16_t*)(ws + WS_WOUTA), DM, DM}; pg8::StaticOrder S; S.init(MP, DM, G, bid);
        EpiRes<false, false> E{nullptr, nullptr, nullptr, XB, ssq + M};
        if (bid & 1) sample_gemm<2, 4>(lds, (const bf16_t*)(ws + WS_O), DM, (const bf16_t*)(ws + WS_WOUTA), 4, E, bid, G);
        pg8::gemm_phase<EpiRes<false, false>, true, true>(lds, g, S, E);
        if (!(bid & 1)) sample_gemm<2, 4>(lds, (const bf16_t*)(ws + WS_O), DM, (const bf16_t*)(ws + WS_WOUTA), 4, E, bid, G);
    }
    SEAM(3);
    if (IN(4)) {
        pg8::Gemm g{XB, (const bf16_t*)(ws + WS_WFFN), DM, DM}; pg8::StaticOrder S; S.init(MP, NFF, G, bid);
        EpiFfnConv E{ssq + M, (bf16_t*)(ws + WS_H), P.in[25], P.in[26], (float*)(ws + WS_SIDE), P.out + O_CONVP, (LAS float*)(lds + RING_BYTES)};
        if (bid & 1) sample_ffn(P, lds, 0, ssq + M, bid, G);
        pg8::gemm_phase<EpiFfnConv, true, true>(lds, g, S, E);
        if (DUP == 41) { EpiFfnNull EN{ssq + M, (bf16_t*)(ws + 400 * MiB)}; pg8::gemm_phase<EpiFfnNull, true, true>(lds, g, S, EN); }
        if (DUP == 42) { EpiFfnConv E3{ssq + M, (bf16_t*)(ws + 400 * MiB), P.in[25], P.in[26], (float*)(ws + WS_SIDE), P.out + O_CONVP, (LAS float*)(lds + RING_BYTES)}; pg8::gemm_phase<EpiFfnConv, true, true>(lds, g, S, E3); }
        if (!(bid & 1)) sample_ffn(P, lds, 0, ssq + M, bid, G);
    }
    SEAM(4);
    if (IN(5)) {
        pg8::Gemm g{(const bf16_t*)(ws + WS_H), (const bf16_t*)(ws + WS_WDOWN), DFF, DFF}; pg8::StaticOrder S; S.init(MP, DM, G, bid);
        ffn_fixup(P, 0, S);
        EpiRes<false, false> E{nullptr, nullptr, nullptr, XB, ssq + 2 * M};
        if (bid & 1) sample_gemm<2, 11>(lds, (const bf16_t*)(ws + WS_H), DFF, (const bf16_t*)(ws + WS_WDOWN), 4, E, bid, G);
        pg8::gemm_phase<EpiRes<false, false>, true, true>(lds, g, S, E);
        if (!(bid & 1)) sample_gemm<2, 11>(lds, (const bf16_t*)(ws + WS_H), DFF, (const bf16_t*)(ws + WS_WDOWN), 4, E, bid, G);
    }
    SEAM(5);
    if (IN(6)) {
        pg8::Gemm g{XB, (const bf16_t*)(ws + WS_WINB), DM, DM}; pg8::StaticOrder S; S.init(MP, NINB, G, bid);
        EpiInB E{ssq + 2 * M, (bf16_t*)(ws + WS_U), (bf16_t*)(ws + WS_GV), (bf16_t*)(ws + WS_XQ), P.in[22] + 64, ssq + 4 * M};
        pg8::gemm_phase<EpiInB, true, true>(lds, g, S, E);
        if (bid >= G / 2) { sample_gemm<4, 4>(lds, XBs, DM, (const bf16_t*)(ws + WS_WINB), 7, E, bid - G / 2, G - G / 2);
                            p0_prologue(P, lds, G - G / 2, bid - G / 2, 1); }
    }
    SEAM(6);
    if (IN(7)) {
        const int ns7 = (1024 + G - 1) / G;
        for (int j = 0; j < ns7; ++j) { const int jj = ((bid & 1) && ns7 == 4) ? (j + 3) % 4 : j; const int uidx = bid + jj * G; if (uidx >= 1024) continue;
            if (uidx < 256) unit_gmlp_prompt(P, lds, uidx >> 5, uidx & 31);
            else if (uidx < 768) { const int v = uidx - 256; unit_mem_prompt(P, lds, wsf, 1, v >> 6, (v >> 2) & 15, v & 3); }
            else { const int v = uidx - 768; unit_mem_sample(P, lds, wsf, 1, v >> 1, v & 1); }
        }
        gmlp_sample(P, G, bid);
    }
    SEAM(7);
    if (IN(8)) {
        pg8::Gemm g{(const bf16_t*)(ws + WS_O), (const bf16_t*)(ws + WS_WOUTB), DM, DM}; pg8::StaticOrder S; S.init(MP, DM, G, bid);
        EpiRes<false, false> E{nullptr, nullptr, nullptr, XB, ssq + 3 * M};
        if (bid & 1) sample_gemm<2, 4>(lds, (const bf16_t*)(ws + WS_O), DM, (const bf16_t*)(ws + WS_WOUTB), 4, E, bid, G);
        pg8::gemm_phase<EpiRes<false, false>, true, true>(lds, g, S, E);
        if (!(bid & 1)) sample_gemm<2, 4>(lds, (const bf16_t*)(ws + WS_O), DM, (const bf16_t*)(ws + WS_WOUTB), 4, E, bid, G);
    }
    SEAM(8);
    if (IN(9)) {
        pg8::Gemm g{XB, (const bf16_t*)(ws + WS_WFFN) + (size_t)NFF * DM, DM, DM}; pg8::StaticOrder S; S.init(MP, NFF, G, bid);
        EpiFfnConv E{ssq + 3 * M, (bf16_t*)(ws + WS_H), P.in[25] + 3 * DFF, P.in[26] + DFF, (float*)(ws + WS_SIDE), P.out + O_CONVP + (size_t)NBATCH * 2 * DFF, (LAS float*)(lds + RING_BYTES)};
        if (bid & 1) sample_ffn(P, lds, 1, ssq + 3 * M, bid, G);
        pg8::gemm_phase<EpiFfnConv, true, true>(lds, g, S, E);
        if (!(bid & 1)) sample_ffn(P, lds, 1, ssq + 3 * M, bid, G);
    }
    SEAM(9);
    if (IN(10)) {
        pg8::Gemm g{(const bf16_t*)(ws + WS_H), (const bf16_t*)(ws + WS_WDOWN) + (size_t)DM * DFF, DFF, DFF}; pg8::StaticOrder S; S.init(MP, DM, G, bid);
        ffn_fixup(P, 1, S);
        EpiRes<false, true> E{nullptr, nullptr, P.out + O_Y, XB, nullptr};
        if (bid & 1) sample_gemm<2, 11>(lds, (const bf16_t*)(ws + WS_H), DFF, (const bf16_t*)(ws + WS_WDOWN) + (size_t)DM * DFF, 4, E, bid, G);
        pg8::gemm_phase<EpiRes<false, true>, true, true>(lds, g, S, E);
        if (!(bid & 1)) sample_gemm<2, 11>(lds, (const bf16_t*)(ws + WS_H), DFF, (const bf16_t*)(ws + WS_WDOWN) + (size_t)DM * DFF, 4, E, bid, G);
    }
    if (TPROBE >= 0 && bid == 0) {
        __syncthreads();
        const unsigned long long tn = __builtin_amdgcn_s_memrealtime();
        if (TPROBE == 10) t_probe = tn - t_prev;
        if (TPROBE == 100) t_probe = tn - t_start;
        while (__builtin_amdgcn_s_memrealtime() - tn < t_probe) __builtin_amdgcn_s_sleep(8);
    }
#undef IN
#undef SEAM
}

extern "C" void kernel_launch(void* const* d_in, const int* in_sizes, int n_in, void* d_out, int out_size, void* d_ws, size_t ws_size, hipStream_t stream) {
    static int grid = 0;
    if (grid == 0) {
        if (n_in != 28 || (size_t)out_size != O_END || ws_size < WS_END) { fprintf(stderr, "kernel_launch: unexpected shapes: n_in %d out %d ws %zu (need %zu)\n", n_in, out_size, ws_size, (size_t)WS_END); grid = -1; return; }
        int dev = 0, cus = 0, per_cu = 0;
        hipGetDevice(&dev); hipDeviceGetAttribute(&cus, hipDeviceAttributeMultiprocessorCount, dev);
        if (hipFuncSetAttribute((const void*)mk_fwd, hipFuncAttributeMaxDynamicSharedMemorySize, LDS_BYTES) != hipSuccess) { fprintf(stderr, "kernel_launch: hipFuncSetAttribute failed\n"); grid = -1; return; }
        hipOccupancyMaxActiveBlocksPerMultiprocessor(&per_cu, (const void*)mk_fwd, 512, LDS_BYTES);
        (void)hipGetLastError();
        if (per_cu < 1) { fprintf(stderr, "kernel_launch: occupancy query says %d blocks per CU\n", per_cu); per_cu = 1; }
        grid = cus;
    }
    if (grid < 0) return;
    if (hipMemsetAsync((char*)d_ws + WS_CTL, 0, CTL_BYTES, stream) != hipSuccess) { fprintf(stderr, "kernel_launch: memset failed\n"); return; }
    Params p{};
    for (int i = 0; i < 28; ++i) p.in[i] = (const float*)d_in[i];
    p.out = (float*)d_out; p.ws = (unsigned char*)d_ws;
#if MK_N_LAUNCHES == 1
    p.ph_lo = 0; p.ph_hi = NPHASE;
    void* args[] = {&p};
    hipError_t e = hipLaunchCooperativeKernel((const void*)mk_fwd, dim3(grid), dim3(512), args, LDS_BYTES, stream);
    if (e != hipSuccess) fprintf(stderr, "cooperative launch failed: %s (grid %d)\n", hipGetErrorString(e), grid);
#else
    for (int ph = 0; ph < NPHASE; ++ph) {
        p.ph_lo = ph; p.ph_hi = ph + 1;
        hipLaunchKernelGGL(mk_fwd, dim3(grid), dim3(512), LDS_BYTES, stream, p);
    }
#endif
}
```

```cpp
#include <hip/hip_runtime.h>
#include <hip/hip_cooperative_groups.h>
#include <cstdio>
#include <cstdint>
namespace cg = cooperative_groups;

#ifndef MK_N_LAUNCHES
#define MK_N_LAUNCHES 1
#endif

#ifndef TPROBE
#define TPROBE -1
#endif
#ifndef DUP
#define DUP -1
#endif
#define LAS __attribute__((address_space(3)))
typedef unsigned short bf16_t;
typedef short bf16x8 __attribute__((ext_vector_type(8)));
typedef short s16x4 __attribute__((ext_vector_type(4)));
typedef float f32x4 __attribute__((ext_vector_type(4)));
typedef float f32x2 __attribute__((ext_vector_type(2)));
typedef float f32x16 __attribute__((ext_vector_type(16)));
typedef unsigned u32x4 __attribute__((ext_vector_type(4)));
typedef unsigned u32x2 __attribute__((ext_vector_type(2)));
typedef __bf16 bf16x2_t __attribute__((ext_vector_type(2)));

constexpr int DM = 1024, NBATCH = 8, SEQ = 4096, MP = NBATCH * SEQ, NDEC = 128, DSEQ = 4, MS = NDEC * DSEQ, M = MP + MS;
constexpr int NMEM = 256, MMEM = NBATCH * NMEM;
constexpr int DFF = 2816, NFF = 2 * DFF;
constexpr int NINA = 1536, NINB = 1792;
constexpr float EPS = 1e-6f;
constexpr float LOG2E = 1.4426950408889634f;
constexpr int NPHASE = 11;

constexpr size_t O_Y = 0, O_WKP = 34078720, O_WVP = 34340864, O_CVP = 34603008, O_MKP = 35389440, O_MVP = 36438016, O_CONVP = 37486592,
                 O_WKS = 37576704, O_WVS = 41771008, O_CVS = 45965312, O_CONVS = 46358528, O_END = 47800320;

constexpr size_t MiB = 1u << 20;
constexpr size_t WS_SSQ = 0, WS_GT = 1 * MiB, WS_CTL = 1 * MiB + 65536, CTL_BYTES = 32768;
constexpr size_t WS_WINA = 2 * MiB, WS_WOUTA = 5 * MiB, WS_WINB = 7 * MiB, WS_WOUTB = 11 * MiB, WS_WMKV = 13 * MiB, WS_WFFN = 15 * MiB,
                 WS_WDOWN = 37 * MiB, WS_WST = 48 * MiB;
constexpr size_t WS_MEMB = 50 * MiB, WS_MK = 54 * MiB, WS_MV = 56 * MiB;
constexpr size_t WS_XB = 58 * MiB;
constexpr size_t WS_H = 124 * MiB;
constexpr size_t WS_Q = WS_H, WS_K = WS_Q + (size_t)M * 768 * 2, WS_V = WS_K + (size_t)M * 256 * 2, WS_XQ = WS_V + (size_t)M * 256 * 2,
                 WS_O = WS_XQ + (size_t)M * 256 * 2, WS_U = WS_O + (size_t)M * 1024 * 2, WS_GV = WS_U + (size_t)M * 768 * 2;
constexpr size_t WS_SIDE = 384 * MiB, SIDE_N = (size_t)128 * 2 * DFF;
constexpr size_t WS_END = WS_SIDE + 3 * SIDE_N * 4;
static_assert(WS_GV + (size_t)M * 768 * 2 <= WS_SIDE && WS_H + (size_t)M * DFF * 2 <= WS_SIDE, "mixer buffers / hidden below the side buffers");
static_assert(WS_END <= 512 * MiB, "ws");

namespace pg8 {
constexpr int BM = 256, BK = 64, HALF = 128, HTB = HALF * BK * 2, STAGE_BYTES = 8 * HTB, NXCD = 8, WGM = 8;
__host__ __device__ __forceinline__ int lds_byte(int r, int c) { const int st = (r >> 4) * 2 + (c >> 5), rr = r & 15, cc = c & 31, ob = rr * 64 + cc * 2; return st * 1024 + (ob ^ (((ob >> 9) & 1) << 5)); }
__host__ __device__ __forceinline__ void stage_rc(int b, int& R, int& C) { const int st = b / 1024, sb = b % 1024, swz = sb ^ (((sb >> 9) & 1) << 5); R = (st >> 1) * 16 + swz / 64; C = (st & 1) * 32 + (swz % 64) / 2; }
__host__ __device__ __forceinline__ int perm32(int rho) { const int n = rho >> 4, i = rho & 15; return 8 * (i >> 2) + 4 * n + (i & 3); }

struct Unit { int pm, pn; };
struct Gemm { const bf16_t* A; const bf16_t* Bt; int lda, K; };

struct StaticOrder {
    int nM, nN, nwg, G, c;
    __device__ void init(int Mr, int N, int G_, int c_) { nM = Mr / BM; nN = N / BM; nwg = nM * nN; G = G_; c = c_; }
    __device__ bool next(int i, Unit& u) const {
        const long L = (long)i * G + c; if (L >= nwg) return false;
        int wgid = (int)L; { const int q = nwg / NXCD, r = nwg % NXCD, xcd = wgid % NXCD, off = wgid / NXCD; wgid = (xcd < r ? xcd * (q + 1) : r * (q + 1) + (xcd - r) * q) + off; }
        const int nig = WGM * nN, gid = wgid / nig, fm = gid * WGM, gsz = (nM - fm) < WGM ? (nM - fm) : WGM;
        u.pm = fm + ((wgid % nig) % gsz); u.pn = (wgid % nig) / gsz; return true;
    }
};

template <class Epi, bool ALIGN_EPI, bool SP2>
__device__ __forceinline__ void gemm_phase(LAS unsigned char* lds, const Gemm g, const StaticOrder& S, const Epi& E) {
    const int tid = threadIdx.x, wid = __builtin_amdgcn_readfirstlane(tid >> 6), lane = tid & 63, wr = wid >> 2, wc = wid & 3, fr = lane & 15, fq = lane >> 4;
    const int K = g.K, nt = K / BK, lda = g.lda;
    unsigned voffA[2], voffB[2];
#pragma unroll
    for (int i = 0; i < 2; ++i) { int R, C; stage_rc(tid * 16 + i * 8192, R, C); const int Rb = (R & ~31) + perm32(R & 31);
        voffA[i] = (unsigned)(R * lda + C) * 2u; voffB[i] = (unsigned)(Rb * K + C) * 2u; }
    const size_t kstep = (size_t)(BK * 2);
    const size_t hstepA = (size_t)HALF * lda * 2, hstepB = (size_t)HALF * K * 2;
    const size_t tstepA = 2 * hstepA, tstepB = 2 * hstepB;
    const unsigned ldsw = (unsigned)wid * 1024u;
    const int aoff = lds_byte(wr * 64 + fr, fq * 8), boff = lds_byte(wc * 32 + fr, fq * 8);
#define PG8_SA(b, h) (((b) * 2 + (h)) * HTB)
#define PG8_SB(b, h) ((4 + (b) * 2 + (h)) * HTB)
#define PG8_STAGE(bufoff, gbase, voff) do { _Pragma("unroll") for (int _i = 0; _i < 2; ++_i) \
        __builtin_amdgcn_global_load_lds((const unsigned*)((const char*)(gbase) + (voff)[_i]), (LAS unsigned*)(lds + (bufoff) + ldsw + _i * 8192), 16, 0, 0); } while (0)
#define PG8_LDA(dst, b, h) do { _Pragma("unroll") for (int m = 0; m < 4; ++m) _Pragma("unroll") for (int k = 0; k < 2; ++k) dst[m][k] = *(const LAS bf16x8*)(lds + PG8_SA(b, h) + aoff + m * 2048 + k * 1024); } while (0)
#define PG8_LDB(dst, b, h) do { _Pragma("unroll") for (int n = 0; n < 2; ++n) _Pragma("unroll") for (int k = 0; k < 2; ++k) dst[n][k] = *(const LAS bf16x8*)(lds + PG8_SB(b, h) + boff + n * 2048 + k * 1024); } while (0)
#define PG8_MMA(ai, bj, At, Bt) do { __builtin_amdgcn_s_setprio(1); _Pragma("unroll") for (int m = 0; m < 4; ++m) _Pragma("unroll") for (int n = 0; n < 2; ++n) _Pragma("unroll") for (int k = 0; k < 2; ++k) \
        acc[ai][bj][m][n] = __builtin_amdgcn_mfma_f32_16x16x32_bf16(Bt[n][k], At[m][k], acc[ai][bj][m][n], 0, 0, 0); __builtin_amdgcn_s_setprio(0); } while (0)
#define PG8_WAIT_V(n) asm volatile("s_waitcnt vmcnt(" #n ")" ::: "memory")
#define PG8_WAIT_L(n) asm volatile("s_waitcnt lgkmcnt(" #n ")" ::: "memory")
#define PG8_BAR __builtin_amdgcn_s_barrier()
#define PG8_SCHED __builtin_amdgcn_sched_barrier(0)
    Unit cur, nxt; int ui = 0;
    if (!S.next(0, cur)) return;
    f32x4 acc[2][2][4][2];
#pragma unroll
    for (int a = 0; a < 2; ++a)
#pragma unroll
        for (int b = 0; b < 2; ++b)
#pragma unroll
            for (int m = 0; m < 4; ++m)
#pragma unroll
                for (int n = 0; n < 2; ++n) acc[a][b][m][n] = (f32x4){0.f, 0.f, 0.f, 0.f};
    bf16x8 At[4][2], B0[2][2], B1[2][2];
    const char* cA = (const char*)g.A + (size_t)cur.pm * tstepA; const char* cB = (const char*)g.Bt + (size_t)cur.pn * tstepB;
    if constexpr (SP2) {
        PG8_STAGE(PG8_SB(0, 0), cB, voffB); PG8_STAGE(PG8_SB(0, 1), cB + hstepB, voffB); PG8_STAGE(PG8_SA(0, 0), cA, voffA); PG8_STAGE(PG8_SA(0, 1), cA + hstepA, voffA);
        if (wr == 1) PG8_BAR;
        PG8_WAIT_V(2); PG8_BAR;
        PG8_STAGE(PG8_SB(1, 0), cB + kstep, voffB); PG8_STAGE(PG8_SA(1, 0), cA + kstep, voffA); PG8_STAGE(PG8_SB(1, 1), cB + hstepB + kstep, voffB);
        PG8_WAIT_V(6); PG8_BAR;
    } else {
        PG8_STAGE(PG8_SB(0, 0), cB, voffB); PG8_STAGE(PG8_SA(0, 0), cA, voffA); PG8_STAGE(PG8_SB(0, 1), cB + hstepB, voffB); PG8_STAGE(PG8_SA(0, 1), cA + hstepA, voffA);
        if (wr == 1) PG8_BAR;
        PG8_WAIT_V(4); PG8_BAR;
        PG8_STAGE(PG8_SB(1, 0), cB + kstep, voffB); PG8_STAGE(PG8_SA(1, 0), cA + kstep, voffA); PG8_STAGE(PG8_SB(1, 1), cB + hstepB + kstep, voffB);
        PG8_WAIT_V(6); PG8_BAR;
    }
    for (;;) {
        const bool has_next = S.next(ui + 1, nxt);
        const char* nA = has_next ? (const char*)g.A + (size_t)nxt.pm * tstepA : cA; const char* nB = has_next ? (const char*)g.Bt + (size_t)nxt.pn * tstepB : cB;
        for (int t = 0; t < nt; t += 2) {
            const bool last = (t == nt - 2);
            const char* a1 = cA + (size_t)(t + 1) * kstep;
            const char* a2 = last ? nA : cA + (size_t)(t + 2) * kstep; const char* b2 = last ? nB : cB + (size_t)(t + 2) * kstep;
            const char* a3 = a2 + kstep; const char* b3 = b2 + kstep;
            if constexpr (SP2) {
            PG8_LDB(B0, 0, 0); PG8_LDB(B1, 0, 1); PG8_SCHED; PG8_LDA(At, 0, 0); PG8_STAGE(PG8_SA(1, 1), a1 + hstepA, voffA);
            PG8_WAIT_V(8); PG8_WAIT_L(0); PG8_BAR; PG8_MMA(0, 0, At, B0); PG8_MMA(0, 1, At, B1); PG8_BAR; PG8_SCHED;
            PG8_LDA(At, 0, 1); PG8_STAGE(PG8_SB(0, 0), b2, voffB); PG8_STAGE(PG8_SB(0, 1), b2 + hstepB, voffB); PG8_STAGE(PG8_SA(0, 0), a2, voffA);
            PG8_WAIT_V(8); PG8_WAIT_L(0); PG8_BAR; PG8_MMA(1, 0, At, B0); PG8_MMA(1, 1, At, B1); PG8_BAR; PG8_SCHED;
            PG8_LDB(B0, 1, 0); PG8_LDB(B1, 1, 1); PG8_SCHED; PG8_LDA(At, 1, 0); PG8_STAGE(PG8_SA(0, 1), a2 + hstepA, voffA);
            PG8_WAIT_V(8); PG8_WAIT_L(0); PG8_BAR; PG8_MMA(0, 0, At, B0); PG8_MMA(0, 1, At, B1); PG8_BAR; PG8_SCHED;
            PG8_LDA(At, 1, 1); PG8_STAGE(PG8_SB(1, 0), b3, voffB); PG8_STAGE(PG8_SB(1, 1), b3 + hstepB, voffB); PG8_STAGE(PG8_SA(1, 0), a3, voffA);
            PG8_WAIT_V(8); PG8_WAIT_L(0); PG8_BAR; PG8_MMA(1, 0, At, B0); PG8_MMA(1, 1, At, B1); PG8_BAR; PG8_SCHED;
            } else {
            PG8_LDB(B0, 0, 0); PG8_SCHED; PG8_LDA(At, 0, 0); PG8_STAGE(PG8_SA(1, 1), a1 + hstepA, voffA);
            PG8_WAIT_L(8); PG8_BAR; PG8_WAIT_L(0); PG8_MMA(0, 0, At, B0); PG8_BAR; PG8_SCHED;
            PG8_LDB(B1, 0, 1); PG8_STAGE(PG8_SB(0, 0), b2, voffB);
            PG8_BAR; PG8_WAIT_L(0); PG8_MMA(0, 1, At, B1); PG8_BAR;
            PG8_LDA(At, 0, 1); PG8_STAGE(PG8_SA(0, 0), a2, voffA);
            PG8_BAR; PG8_WAIT_L(0); PG8_MMA(1, 0, At, B0); PG8_BAR; PG8_SCHED;
            PG8_STAGE(PG8_SB(0, 1), b2 + hstepB, voffB);
            PG8_WAIT_V(6); PG8_BAR; PG8_MMA(1, 1, At, B1); PG8_BAR;
            PG8_LDB(B0, 1, 0); PG8_SCHED; PG8_LDA(At, 1, 0); PG8_STAGE(PG8_SA(0, 1), a2 + hstepA, voffA);
            PG8_WAIT_L(8); PG8_BAR; PG8_WAIT_L(0); PG8_MMA(0, 0, At, B0); PG8_BAR; PG8_SCHED;
            PG8_LDB(B1, 1, 1); PG8_STAGE(PG8_SB(1, 0), b3, voffB);
            PG8_BAR; PG8_WAIT_L(0); PG8_MMA(0, 1, At, B1); PG8_BAR;
            PG8_LDA(At, 1, 1); PG8_STAGE(PG8_SA(1, 0), a3, voffA);
            PG8_BAR; PG8_WAIT_L(0); PG8_MMA(1, 0, At, B0); PG8_BAR; PG8_SCHED;
            PG8_STAGE(PG8_SB(1, 1), b3 + hstepB, voffB);
            PG8_WAIT_V(6); PG8_BAR; PG8_MMA(1, 1, At, B1); PG8_BAR;
            }
        }
        if constexpr (ALIGN_EPI) { if (wr == 0) PG8_BAR; }
        E(acc, cur, wr, wc, fr, fq);
        if (!has_next) break;
#pragma unroll
        for (int a = 0; a < 2; ++a)
#pragma unroll
            for (int b = 0; b < 2; ++b)
#pragma unroll
                for (int m = 0; m < 4; ++m)
#pragma unroll
                    for (int n = 0; n < 2; ++n) acc[a][b][m][n] = (f32x4){0.f, 0.f, 0.f, 0.f};
        cur = nxt; cA = nA; cB = nB; ++ui;
        if constexpr (ALIGN_EPI) { if (wr == 1) PG8_BAR; }
    }
    PG8_WAIT_V(0);
    if constexpr (!ALIGN_EPI) { if (wr == 0) PG8_BAR; }
    PG8_BAR;
#undef PG8_SA
#undef PG8_SB
#undef PG8_STAGE
#undef PG8_LDA
#undef PG8_LDB
#undef PG8_MMA
#undef PG8_WAIT_V
#undef PG8_WAIT_L
#undef PG8_BAR
#undef PG8_SCHED
}
}
using pg8::Unit;

constexpr int RING_BYTES = 131072, WSF_OFF = RING_BYTES, OSTG2_OFF = RING_BYTES + 4096, BST_OFF = RING_BYTES + 16384, LDS_BYTES = BST_OFF + 256;
__device__ __forceinline__ unsigned cvtpk(float lo, float hi) { f32x2 v = {lo, hi}; bf16x2_t b = __builtin_convertvector(v, bf16x2_t); return __builtin_bit_cast(unsigned, b); }
__device__ __forceinline__ u32x4 pack8(const f32x4 a, const f32x4 b) { u32x4 w; w.x = cvtpk(a[0], a[1]); w.y = cvtpk(a[2], a[3]); w.z = cvtpk(b[0], b[1]); w.w = cvtpk(b[2], b[3]); return w; }
__device__ __forceinline__ float bf2f(unsigned short h) { return __uint_as_float((unsigned)h << 16); }
__device__ __forceinline__ float bflo(unsigned w) { return __uint_as_float(w << 16); }
__device__ __forceinline__ float bfhi(unsigned w) { return __uint_as_float(w & 0xffff0000u); }
__device__ __forceinline__ float wave_sum(float v) {
#pragma unroll
    for (int o = 1; o < 64; o <<= 1) v += __shfl_xor(v, o);
    return v;
}
__device__ __forceinline__ f32x2 gelu_pk(f32x2 v) {
    const f32x2 av = __builtin_elementwise_abs(v), d = av * 0.2316418882f + 1.0f;
    f32x2 t; t.x = __builtin_amdgcn_rcpf(d.x); t.y = __builtin_amdgcn_rcpf(d.y);
    f32x2 q = t * 0.5307027145f + (-0.7265760135f); q = q * t + 0.7107068705f; q = q * t + (-0.142248368f); q = q * t + 0.127414796f; q = q * t;
    const f32x2 s = (v * v) * (-0.72134752044f);
    f32x2 e; e.x = __builtin_amdgcn_exp2f(s.x); e.y = __builtin_amdgcn_exp2f(s.y);
    const f32x2 m = v * (q * e), r = v - m;
    f32x2 o; o.x = v.x < 0.f ? m.x : r.x; o.y = v.y < 0.f ? m.y : r.y; return o;
}
__device__ __forceinline__ f32x4 gelu4(f32x4 v) { const f32x2 a = gelu_pk((f32x2){v[0], v[1]}), b = gelu_pk((f32x2){v[2], v[3]}); return (f32x4){a.x, a.y, b.x, b.y}; }
__device__ __forceinline__ float dot4(f32x4 v) { return (v[0] * v[0] + v[1] * v[1]) + (v[2] * v[2] + v[3] * v[3]); }
__device__ __forceinline__ unsigned short f2bf_s(float f) { return (unsigned short)(cvtpk(f, 0.f) & 0xffffu); }
__device__ __forceinline__ float alibi_slope(int h) { return h < 8 ? exp2f(-(float)(h + 1)) : exp2f(-0.5f - (float)(h - 8)); }

struct Params {
    const float* in[28];
    float* out;
    unsigned char* ws;
    int ph_lo, ph_hi;
};

#define EPI_ARGS const f32x4 (&acc)[2][2][4][2], const Unit& u, int wr, int wc, int fr, int fq
#define FOR_AI_M _Pragma("unroll") for (int ai = 0; ai < 2; ++ai) _Pragma("unroll") for (int m = 0; m < 4; ++m)
#define BIG_ROWS(E) do { const int row0_ = u.pm * 256 + wr * 64 + fr; float rs_[2][4]; \
    FOR_AI_M rs_[ai][m] = (E).ssq[row0_ + ai * 128 + m * 16]; \
    FOR_AI_M { f32x4 v_[2][2]; \
    _Pragma("unroll") for (int bj = 0; bj < 2; ++bj) _Pragma("unroll") for (int n = 0; n < 2; ++n) v_[bj][n] = acc[ai][bj][m][n]; \
    (E).row(v_, rsqrtf(rs_[ai][m] * (1.f / 1024.f) + EPS), row0_ + ai * 128 + m * 16, u.pn, wc, fq); } } while (0)

__device__ __forceinline__ void head_norm(f32x4 (&v)[2][2], const float* gp, int fq) {
    float ss = (dot4(v[0][0]) + dot4(v[0][1])) + (dot4(v[1][0]) + dot4(v[1][1]));
    ss += __shfl_xor(ss, 16); ss += __shfl_xor(ss, 32);
    const float inv = rsqrtf(ss * (1.f / 64.f) + EPS);
#pragma unroll
    for (int bj = 0; bj < 2; ++bj)
#pragma unroll
        for (int n = 0; n < 2; ++n) { const f32x4 g = *(const f32x4*)(gp + 32 * bj + 8 * fq + 4 * n); v[bj][n] = v[bj][n] * inv * g; }
}

struct EpiInA {
    const float* ssq; bf16_t* Qb; const float* gt; float* out;
    __device__ __forceinline__ void row(f32x4 (&v)[2][2], float rs, int row, int pn, int wc, int fq) const {
        const int typ = pn < 3 ? 0 : pn - 2;
        const size_t doff = typ == 0 ? 0 : (size_t)M * 768 + (size_t)(typ - 1) * M * 256;
        const int ld = typ == 0 ? 768 : 256, cb = typ == 0 ? (pn * 4 + wc) * 64 : wc * 64;
#pragma unroll
        for (int bj = 0; bj < 2; ++bj)
#pragma unroll
            for (int n = 0; n < 2; ++n) v[bj][n] = v[bj][n] * rs;
        if (typ != 2) head_norm(v, gt + typ * 64, fq);
#pragma unroll
        for (int bj = 0; bj < 2; ++bj) *(u32x4*)(Qb + doff + (size_t)row * ld + cb + 32 * bj + 8 * fq) = pack8(v[bj][0], v[bj][1]);
        if (typ == 1 || typ == 2) {
            long wo = -1;
            if (row >= MP) { const int ns = row - MP; wo = (long)O_WKS + (long)(typ - 1) * (long)(O_WVS - O_WKS) + (long)((ns >> 2) * 128 + 124 + (ns & 3)) * 256; }
            else if ((row & 4095) >= 3968) { const int b = row >> 12, t = row & 4095; wo = (long)O_WKP + (long)(typ - 1) * (long)(O_WVP - O_WKP) + (long)(b * 128 + t - 3968) * 256; }
            if (wo >= 0) { float* wout = out + wo;
#pragma unroll
                for (int bj = 0; bj < 2; ++bj)
#pragma unroll
                    for (int n = 0; n < 2; ++n) *(f32x4*)(wout + wc * 64 + 32 * bj + 8 * fq + 4 * n) = v[bj][n];
            }
        }
    }
    __device__ __forceinline__ void operator()(EPI_ARGS) const { BIG_ROWS(*this); }
};

struct EpiMemKV {
    const float* ssq; const float* xk; float *outk, *outv; bf16_t *MK, *MV;
    __device__ __forceinline__ void row(f32x4 (&v)[2][2], float rs, int row, int pn, int wc, int fq) const {
        const int layer = pn >> 1; const bool isv = pn & 1;
        float* of = (isv ? outv : outk) + (size_t)layer * MMEM * 256; bf16_t* ob = (isv ? MV : MK) + (size_t)layer * MMEM * 256;
#pragma unroll
        for (int bj = 0; bj < 2; ++bj)
#pragma unroll
            for (int n = 0; n < 2; ++n) v[bj][n] = v[bj][n] * rs;
        if (!isv) head_norm(v, xk + layer * 64, fq);
#pragma unroll
        for (int bj = 0; bj < 2; ++bj) {
            const size_t o = (size_t)row * 256 + wc * 64 + 32 * bj + 8 * fq;
            *(u32x4*)(ob + o) = pack8(v[bj][0], v[bj][1]);
            *(f32x4*)(of + o) = v[bj][0]; *(f32x4*)(of + o + 4) = v[bj][1];
        }
    }
    __device__ __forceinline__ void operator()(EPI_ARGS) const { BIG_ROWS(*this); }
};

__device__ __forceinline__ void rowsum4_atomic(float s0, float s1, float s2, float s3, float* ssq_rbase_fr, int fq) {
    s0 += __shfl_xor(s0, 16); s1 += __shfl_xor(s1, 16); s2 += __shfl_xor(s2, 16); s3 += __shfl_xor(s3, 16);
    s0 += __shfl_xor(s0, 32); s1 += __shfl_xor(s1, 32); s2 += __shfl_xor(s2, 32); s3 += __shfl_xor(s3, 32);
    const float sel = fq == 0 ? s0 : fq == 1 ? s1 : fq == 2 ? s2 : s3;
    atomicAdd(ssq_rbase_fr + 16 * fq, sel);
}
template <bool IN32, bool OUT32>
struct EpiRes {
    const float* xin_p; const float* xin_s; float* xout; bf16_t* xb; float* ssq;
    __device__ __forceinline__ void finish(f32x4 x0, f32x4 x1, int row, int col, float& ss) const {
        if (OUT32) { float* o = xout + (size_t)row * DM + col; *(f32x4*)o = x0; *(f32x4*)(o + 4) = x1; }
        else { *(u32x4*)(xb + (size_t)row * DM + col) = pack8(x0, x1); ss += dot4(x0) + dot4(x1); }
    }
    __device__ __forceinline__ void rowsum(float ss, int row, int fq) const { if (!OUT32) { ss += __shfl_xor(ss, 16); ss += __shfl_xor(ss, 32); if (fq == 0) atomicAdd(ssq + row, ss); } }
    __device__ __forceinline__ void row(f32x4 (&v)[2][2], float, int row, int pn, int wc, int fq) const {
        const int col0 = pn * 256 + wc * 32 + 8 * fq; float ss = 0.f;
#pragma unroll
        for (int bj = 0; bj < 2; ++bj) {
            f32x4 x0, x1;
            if (IN32) { const float* src = (row < MP ? xin_p + (size_t)row * DM : xin_s + (size_t)(row - MP) * DM) + col0 + 128 * bj; x0 = *(const f32x4*)src; x1 = *(const f32x4*)(src + 4); }
            else { const u32x4 w = *(const u32x4*)(xb + (size_t)row * DM + col0 + 128 * bj); x0 = (f32x4){bflo(w.x), bfhi(w.x), bflo(w.y), bfhi(w.y)}; x1 = (f32x4){bflo(w.z), bfhi(w.z), bflo(w.w), bfhi(w.w)}; }
            finish(x0 + v[bj][0], x1 + v[bj][1], row, col0 + 128 * bj, ss);
        }
        rowsum(ss, row, fq);
    }
    __device__ __forceinline__ void operator()(EPI_ARGS) const {
        const int row0 = u.pm * 256 + wr * 64 + fr, col0 = u.pn * 256 + wc * 32 + 8 * fq;
        if (IN32) {
#pragma unroll
            for (int ai = 0; ai < 2; ++ai) {
                f32x4 r[4][2][2];
#pragma unroll
                for (int m = 0; m < 4; ++m)
#pragma unroll
                    for (int bj = 0; bj < 2; ++bj) { const float* src = xin_p + (size_t)(row0 + ai * 128 + m * 16) * DM + col0 + 128 * bj; r[m][bj][0] = *(const f32x4*)src; r[m][bj][1] = *(const f32x4*)(src + 4); }
                float ssm[4];
#pragma unroll
                for (int m = 0; m < 4; ++m) { const int row = row0 + ai * 128 + m * 16; ssm[m] = 0.f;
#pragma unroll
                    for (int bj = 0; bj < 2; ++bj) finish(r[m][bj][0] + acc[ai][bj][m][0], r[m][bj][1] + acc[ai][bj][m][1], row, col0 + 128 * bj, ssm[m]); }
                if (!OUT32) rowsum4_atomic(ssm[0], ssm[1], ssm[2], ssm[3], ssq + row0 + ai * 128, fq);
            }
        } else {
#pragma unroll
            for (int ai = 0; ai < 2; ++ai) {
                u32x4 r[4][2];
#pragma unroll
                for (int m = 0; m < 4; ++m)
#pragma unroll
                    for (int bj = 0; bj < 2; ++bj) r[m][bj] = *(const u32x4*)(xb + (size_t)(row0 + ai * 128 + m * 16) * DM + col0 + 128 * bj);
                float ssm[4];
#pragma unroll
                for (int m = 0; m < 4; ++m) { const int row = row0 + ai * 128 + m * 16; ssm[m] = 0.f;
#pragma unroll
                    for (int bj = 0; bj < 2; ++bj) { const u32x4 w = r[m][bj];
                        const f32x4 x0 = (f32x4){bflo(w.x), bfhi(w.x), bflo(w.y), bfhi(w.y)}, x1 = (f32x4){bflo(w.z), bfhi(w.z), bflo(w.w), bfhi(w.w)};
                        finish(x0 + acc[ai][bj][m][0], x1 + acc[ai][bj][m][1], row, col0 + 128 * bj, ssm[m]); } }
                if (!OUT32) rowsum4_atomic(ssm[0], ssm[1], ssm[2], ssm[3], ssq + row0 + ai * 128, fq);
                asm volatile("" ::: "memory");
            }
        }
    }
};

template <int CTRL> __device__ __forceinline__ float dpp_f(float x) { return __int_as_float(__builtin_amdgcn_update_dpp(0, __float_as_int(x), CTRL, 0xf, 0xf, false)); }
__device__ __forceinline__ float silu_f(float c) { return c * __builtin_amdgcn_rcpf(1.f + __builtin_amdgcn_exp2f(-c * LOG2E)); }

struct EpiFfnConv {
    const float* ssq; bf16_t* H; const float* cw; const float* cbp; float* side; float* convp; LAS float* xch;
    __device__ __forceinline__ void operator()(EPI_ARGS) const {
        const int pm = u.pm, ts = pm & 15, col0 = u.pn * 128 + wc * 32 + 8 * fq;
        const int rowbase = pm * 256 + wr * 64 + fr;
        float rsv[2][4];
        FOR_AI_M rsv[ai][m] = ssq[rowbase + ai * 128 + m * 16];
        float w0[8], w1[8], w2[8], cb[8];
#pragma unroll
        for (int e = 0; e < 8; e += 4) { const f32x4 a0 = *(const f32x4*)(cw + col0 + e), a1 = *(const f32x4*)(cw + DFF + col0 + e), a2 = *(const f32x4*)(cw + 2 * DFF + col0 + e), a3 = *(const f32x4*)(cbp + col0 + e);
#pragma unroll
            for (int j = 0; j < 4; ++j) { w0[e + j] = a0[j]; w1[e + j] = a1[j]; w2[e + j] = a2[j]; cb[e + j] = a3[j]; } }
        FOR_AI_M rsv[ai][m] = rsqrtf(rsv[ai][m] * (1.f / 1024.f) + EPS);
        if (fr >= 14) {
#pragma unroll
            for (int ai = 0; ai < 2; ++ai) {
                const float rs = rsv[ai][3];
                LAS float* x = xch + ((2 * ai + wr) * 2 + (fr - 14)) * 128 + wc * 32 + 8 * fq;
                *(LAS f32x4*)x = acc[ai][0][3][0] * rs; *(LAS f32x4*)(x + 4) = acc[ai][0][3][1] * rs;
            }
        }
        asm volatile("s_waitcnt lgkmcnt(0)" ::: "memory"); __builtin_amdgcn_s_barrier(); asm volatile("" ::: "memory");
#pragma unroll
        for (int ai = 0; ai < 2; ++ai) {
            const int blk = 2 * ai + wr;
            float prev[8];
            if (blk > 0) { const LAS float* x = xch + ((blk - 1) * 2 + (fr >= 14 ? fr - 14 : 0)) * 128 + wc * 32 + 8 * fq; const f32x4 p0 = *(const LAS f32x4*)x, p1 = *(const LAS f32x4*)(x + 4);
#pragma unroll
                for (int e = 0; e < 4; ++e) { prev[e] = p0[e]; prev[4 + e] = p1[e]; } }
            else {
#pragma unroll
                for (int e = 0; e < 8; ++e) prev[e] = 0.f; }
#pragma unroll
            for (int m = 0; m < 4; ++m) {
                const int row = rowbase + ai * 128 + m * 16;
                const float rs = rsv[ai][m];
                float a[8], c[8], h[8], up[8];
#pragma unroll
                for (int e = 0; e < 8; ++e) { a[e] = acc[ai][0][m][e >> 2][e & 3] * rs; up[e] = acc[ai][1][m][e >> 2][e & 3] * rs; }
#pragma unroll
                for (int e = 0; e < 8; ++e) {
                    const float s1 = fr == 15 ? prev[e] : a[e], s2 = fr >= 14 ? prev[e] : a[e];
                    const float p1 = dpp_f<0x121>(s1), p2 = dpp_f<0x122>(s2);
                    c[e] = cb[e] + w0[e] * p2 + w1[e] * p1 + w2[e] * a[e];
                    h[e] = silu_f(c[e]) * up[e];
                }
                u32x4 w; w.x = cvtpk(h[0], h[1]); w.y = cvtpk(h[2], h[3]); w.z = cvtpk(h[4], h[5]); w.w = cvtpk(h[6], h[7]);
                *(u32x4*)(H + (size_t)row * DFF + col0) = w;
                if (ai == 0 && m == 0) { if (wr == 0 && ts > 0 && fr < 2) { float* d = side + (size_t)(pm * 2 + fr) * DFF + col0;
                        *(f32x4*)d = (f32x4){c[0], c[1], c[2], c[3]}; *(f32x4*)(d + 4) = (f32x4){c[4], c[5], c[6], c[7]};
                        *(f32x4*)(d + SIDE_N) = (f32x4){up[0], up[1], up[2], up[3]}; *(f32x4*)(d + SIDE_N + 4) = (f32x4){up[4], up[5], up[6], up[7]}; } }
                if (ai == 1 && m == 3) { if (wr == 1 && fr >= 14) { float* d = ts < 15 ? side + 2 * SIDE_N + (size_t)(pm * 2 + fr - 14) * DFF + col0 : convp + (size_t)((pm >> 4) * 2 + fr - 14) * DFF + col0;
                        *(f32x4*)d = (f32x4){a[0], a[1], a[2], a[3]}; *(f32x4*)(d + 4) = (f32x4){a[4], a[5], a[6], a[7]}; } }
#pragma unroll
                for (int e = 0; e < 8; ++e) prev[e] = a[e];
            }
        }
    }
};
struct EpiFfnNull {
    const float* ssq; bf16_t* H;
    __device__ __forceinline__ void row(f32x4 (&v)[2][2], float rs, int row, int pn, int wc, int fq) const {
        *(u32x4*)(H + (size_t)row * DFF + pn * 128 + wc * 32 + 8 * fq) = pack8(v[0][0] * rs + v[1][0], v[0][1] * rs + v[1][1]);
    }
    __device__ __forceinline__ void operator()(EPI_ARGS) const { BIG_ROWS(*this); }
};
__device__ __forceinline__ void ffn_fixup(const Params& P, int layer, const pg8::StaticOrder& S) {
    bf16_t* H = (bf16_t*)(P.ws + WS_H); const float* side = (const float*)(P.ws + WS_SIDE); const float* cw = P.in[25] + (size_t)layer * 3 * DFF;
    Unit u; int last = -1;
    for (int i = 0; S.next(i, u); ++i) {
        const int pm = u.pm; if ((pm & 15) == 0 || pm == last) continue; last = pm;
        for (int c4 = threadIdx.x; c4 < DFF / 4; c4 += 512) { const int col = 4 * c4;
            const f32x4 cp0 = *(const f32x4*)(side + (size_t)(pm * 2) * DFF + col), cp1 = *(const f32x4*)(side + (size_t)(pm * 2 + 1) * DFF + col);
            const f32x4 u0 = *(const f32x4*)(side + SIDE_N + (size_t)(pm * 2) * DFF + col), u1 = *(const f32x4*)(side + SIDE_N + (size_t)(pm * 2 + 1) * DFF + col);
            const f32x4 am2 = *(const f32x4*)(side + 2 * SIDE_N + (size_t)((pm - 1) * 2) * DFF + col), am1 = *(const f32x4*)(side + 2 * SIDE_N + (size_t)((pm - 1) * 2 + 1) * DFF + col);
            const f32x4 w0 = *(const f32x4*)(cw + col), w1 = *(const f32x4*)(cw + DFF + col);
            const f32x4 c0 = cp0 + w0 * am2 + w1 * am1, c1 = cp1 + w0 * am1;
            u32x2 h0, h1;
            h0.x = cvtpk(silu_f(c0[0]) * u0[0], silu_f(c0[1]) * u0[1]); h0.y = cvtpk(silu_f(c0[2]) * u0[2], silu_f(c0[3]) * u0[3]);
            h1.x = cvtpk(silu_f(c1[0]) * u1[0], silu_f(c1[1]) * u1[1]); h1.y = cvtpk(silu_f(c1[2]) * u1[2], silu_f(c1[3]) * u1[3]);
            *(u32x2*)(H + (size_t)(pm * 256) * DFF + col) = h0; *(u32x2*)(H + (size_t)(pm * 256 + 1) * DFF + col) = h1; }
    }
    asm volatile("s_waitcnt vmcnt(0)" ::: "memory"); __syncthreads();
}

struct EpiInB {
    const float* ssq; bf16_t *U, *GV, *XQ; const float* xg; float* ssqv;
    __device__ __forceinline__ void row(f32x4 (&v)[2][2], float rs, int row, int pn, int wc, int fq) const {
        if (pn < 6) {
            bf16_t* dst = pn < 3 ? U : GV; const int col0 = (pn % 3) * 256 + wc * 32 + 8 * fq;
            float ss = 0.f;
#pragma unroll
            for (int bj = 0; bj < 2; ++bj) {
                const f32x4 v0 = gelu4(v[bj][0] * rs), v1 = gelu4(v[bj][1] * rs);
                *(u32x4*)(dst + (size_t)row * 768 + col0 + 128 * bj) = pack8(v0, v1);
                ss += dot4(v0) + dot4(v1);
            }
            if (pn >= 3) { ss += __shfl_xor(ss, 16); ss += __shfl_xor(ss, 32); if (fq == 0) atomicAdd(ssqv + row, ss); }
        } else {
#pragma unroll
            for (int bj = 0; bj < 2; ++bj)
#pragma unroll
                for (int n = 0; n < 2; ++n) v[bj][n] = v[bj][n] * rs;
            head_norm(v, xg, fq);
#pragma unroll
            for (int bj = 0; bj < 2; ++bj) *(u32x4*)(XQ + (size_t)row * 256 + wc * 64 + 32 * bj + 8 * fq) = pack8(v[bj][0], v[bj][1]);
        }
    }
    __device__ __forceinline__ void operator()(EPI_ARGS) const {
        if (u.pn < 3 || u.pn >= 6) { BIG_ROWS(*this); return; }
        const int row0 = u.pm * 256 + wr * 64 + fr, col0 = (u.pn - 3) * 256 + wc * 32 + 8 * fq;
        float rsv[2][4];
        FOR_AI_M rsv[ai][m] = ssq[row0 + ai * 128 + m * 16];
#pragma unroll
        for (int ai = 0; ai < 2; ++ai) {
            float ssm[4];
#pragma unroll
            for (int m = 0; m < 4; ++m) { const int row = row0 + ai * 128 + m * 16; const float rs = rsqrtf(rsv[ai][m] * (1.f / 1024.f) + EPS); ssm[m] = 0.f;
#pragma unroll
                for (int bj = 0; bj < 2; ++bj) {
                    const f32x4 v0 = gelu4(acc[ai][bj][m][0] * rs), v1 = gelu4(acc[ai][bj][m][1] * rs);
                    *(u32x4*)(GV + (size_t)row * 768 + col0 + 128 * bj) = pack8(v0, v1);
                    ssm[m] += dot4(v0) + dot4(v1);
                } }
            rowsum4_atomic(ssm[0], ssm[1], ssm[2], ssm[3], ssqv + row0 + ai * 128, fq);
        }
    }
};

template <int MB> struct WgFrags { bf16x8 af[4][MB], bf[4][2][2]; };
template <int MB, int NB>
__device__ __forceinline__ void wg_load(WgFrags<MB>& F, const bf16_t* A, int lda, int row0, const bf16_t* Bt, int K, int pn, int wc, int k0, int s0) {
    const int lane = threadIdx.x & 63, fr = lane & 15, fq = lane >> 4;
    const bf16_t* ap = A + (size_t)(row0 + fr) * lda + 8 * fq + k0 + s0 * 32;
#pragma unroll
    for (int j = 0; j < NB; ++j)
#pragma unroll
        for (int m = 0; m < MB; ++m) F.af[j][m] = *(const bf16x8*)(ap + (size_t)m * 16 * lda + j * 32);
#pragma unroll
    for (int bj = 0; bj < 2; ++bj)
#pragma unroll
        for (int n = 0; n < 2; ++n) { const bf16_t* bp = Bt + (size_t)(pn * 256 + 128 * bj + 32 * wc + pg8::perm32(16 * n + fr)) * K + 8 * fq + k0 + s0 * 32;
#pragma unroll
            for (int j = 0; j < NB; ++j) F.bf[j][bj][n] = *(const bf16x8*)(bp + j * 32); }
}
template <int MB, int NB>
__device__ __forceinline__ void wg_mma(const WgFrags<MB>& F, f32x4 (&acc)[MB][2][2]) {
#pragma unroll
    for (int j = 0; j < NB; ++j)
#pragma unroll
        for (int m = 0; m < MB; ++m)
#pragma unroll
            for (int bj = 0; bj < 2; ++bj)
#pragma unroll
                for (int n = 0; n < 2; ++n) acc[m][bj][n] = __builtin_amdgcn_mfma_f32_16x16x32_bf16(F.bf[j][bj][n], F.af[j][m], acc[m][bj][n], 0, 0, 0);
}
template <int MB>
__device__ __forceinline__ void sample_reduce_store(LAS unsigned char* lds, const f32x4 (&acc)[MB][2][2], int wave, int lane) {
    LAS f32x4* Pl = (LAS f32x4*)lds;
#pragma unroll
    for (int m = 0; m < MB; ++m)
#pragma unroll
        for (int bj = 0; bj < 2; ++bj)
#pragma unroll
            for (int n = 0; n < 2; ++n) Pl[((wave * MB + m) * 4 + bj * 2 + n) * 64 + lane] = acc[m][bj][n];
}
template <int MB>
__device__ __forceinline__ void sample_reduce_finish(LAS unsigned char* lds, int wave, int lane) {
    LAS f32x4* Pl = (LAS f32x4*)lds; LAS f32x4* Rl = (LAS f32x4*)(lds + RING_BYTES);
    __syncthreads();
#pragma unroll
    for (int i = 0; i < (MB * 4) / 8 + ((MB * 4) % 8 ? 1 : 0); ++i) { const int slot = wave + 8 * i;
        if (slot < MB * 4) { f32x4 sum = Pl[slot * 64 + lane];
#pragma unroll
            for (int w = 1; w < 8; ++w) sum += Pl[(w * MB * 4 + slot) * 64 + lane];
            Rl[slot * 64 + lane] = sum; } }
    __syncthreads();
}
template <int MB>
__device__ __forceinline__ void sample_reduce(LAS unsigned char* lds, const f32x4 (&acc)[MB][2][2], int wave, int lane) {
    sample_reduce_store<MB>(lds, acc, wave, lane); sample_reduce_finish<MB>(lds, wave, lane);
}
template <int MB>
__device__ __forceinline__ void sample_reduce_load(const LAS unsigned char* lds, f32x4 (&v)[2][2], int m, int lane) {
    const LAS f32x4* Rl = (const LAS f32x4*)(lds + RING_BYTES);
#pragma unroll
    for (int bj = 0; bj < 2; ++bj)
#pragma unroll
        for (int n = 0; n < 2; ++n) v[bj][n] = Rl[(m * 4 + bj * 2 + n) * 64 + lane];
}
template <int MB, int NS, class Epi>
__device__ __forceinline__ void sample_gemm(LAS unsigned char* lds, const bf16_t* A, int lda, const bf16_t* Bt, int ntiles, const Epi& E, int blk, int nblk, int rowbase = MP, int nrows = MS, int tbeg = 0, int tend = -1) {
    const int lane = threadIdx.x & 63, fr = lane & 15, fq = lane >> 4, wave = __builtin_amdgcn_readfirstlane(threadIdx.x >> 6);
    constexpr int K = 8 * NS * 32, NB0 = NS < 4 ? NS : 4;
    const int NRB = nrows / (16 * MB);
    const int ntask = (tend >= 0 && tend < NRB * ntiles * 4) ? tend : NRB * ntiles * 4;
    if (tbeg + blk >= ntask) return;
    WgFrags<MB> F;
    { const int t1 = tbeg + blk, rb = t1 % NRB, cw = t1 / NRB; wg_load<MB, NB0>(F, A, lda, rowbase + rb * 16 * MB, Bt, K, cw >> 2, cw & 3, wave * NS * 32, 0); }
    for (int t = tbeg + blk; t < ntask; t += nblk) {
        const int rb = t % NRB, cw = t / NRB, pn = cw >> 2, wc = cw & 3, row0 = rowbase + rb * 16 * MB;
        f32x4 acc[MB][2][2];
#pragma unroll
        for (int m = 0; m < MB; ++m)
#pragma unroll
            for (int bj = 0; bj < 2; ++bj)
#pragma unroll
                for (int n = 0; n < 2; ++n) acc[m][bj][n] = (f32x4){0.f, 0.f, 0.f, 0.f};
        wg_mma<MB, NB0>(F, acc);
#pragma unroll
        for (int s0 = 4; s0 < NS; s0 += 4) {
            if (NS - s0 >= 4) { wg_load<MB, 4>(F, A, lda, row0, Bt, K, pn, wc, wave * NS * 32, s0); wg_mma<MB, 4>(F, acc); }
            else { wg_load<MB, (NS % 4 ? NS % 4 : 4)>(F, A, lda, row0, Bt, K, pn, wc, wave * NS * 32, s0); wg_mma<MB, (NS % 4 ? NS % 4 : 4)>(F, acc); }
        }
        const int tn = t + nblk;
        if (tn < ntask) { const int rbn = tn % NRB, cwn = tn / NRB; wg_load<MB, NB0>(F, A, lda, rowbase + rbn * 16 * MB, Bt, K, cwn >> 2, cwn & 3, wave * NS * 32, 0); }
        const int row = row0 + 16 * (wave % MB) + fr; float rsq = 0.f;
        if (wave < MB && E.ssq) rsq = E.ssq[row];
        sample_reduce<MB>(lds, acc, wave, lane);
        if (wave < MB) { const float rs = E.ssq ? rsqrtf(rsq * (1.f / 1024.f) + EPS) : 1.f;
            f32x4 v[2][2]; sample_reduce_load<MB>(lds, v, wave, lane); E.row(v, rs, row, pn, wc, fq); }
    }
    __syncthreads();
}
__device__ __forceinline__ void sample_ffn(const Params& P, LAS unsigned char* lds, int layer, const float* ssq, int blk, int nblk, int rb0 = 0, int NRB = MS / 64) {
    const int lane = threadIdx.x & 63, fr = lane & 15, fq = lane >> 4, wave = __builtin_amdgcn_readfirstlane(threadIdx.x >> 6);
    const bf16_t* XB = (const bf16_t*)(P.ws + WS_XB); const bf16_t* Wt = (const bf16_t*)(P.ws + WS_WFFN) + (size_t)layer * NFF * DM; bf16_t* Hb = (bf16_t*)(P.ws + WS_H);
    const float* cw = P.in[25] + (size_t)layer * 3 * DFF; const float* cbp = P.in[26] + (size_t)layer * DFF; const float* st = P.in[6] + (size_t)layer * NDEC * 2 * DFF;
    float* convs = P.out + O_CONVS + (size_t)layer * NDEC * 2 * DFF;
    constexpr int MB = 4; const int NTASK = NRB * 22 * 4;
    if (blk >= NTASK) return;
    WgFrags<MB> F;
    { const int rb = rb0 + blk % NRB, cwi = blk / NRB; wg_load<MB, 4>(F, XB, DM, MP + rb * 64, Wt, DM, cwi >> 2, cwi & 3, wave * 128, 0); }
    for (int t = blk; t < NTASK; t += nblk) {
        const int rb = rb0 + t % NRB, cwi = t / NRB, pn = cwi >> 2, wc = cwi & 3;
        f32x4 acc[MB][2][2];
#pragma unroll
        for (int m = 0; m < MB; ++m)
#pragma unroll
            for (int bj = 0; bj < 2; ++bj)
#pragma unroll
                for (int n = 0; n < 2; ++n) acc[m][bj][n] = (f32x4){0.f, 0.f, 0.f, 0.f};
        wg_mma<MB, 4>(F, acc);
        const int tn = t + nblk;
        if (tn < NTASK) { const int rbn = rb0 + tn % NRB, cwn = tn / NRB; wg_load<MB, 4>(F, XB, DM, MP + rbn * 64, Wt, DM, cwn >> 2, cwn & 3, wave * 128, 0); }
        sample_reduce_store<MB>(lds, acc, wave, lane);
        const int col0 = pn * 128 + wc * 32 + 8 * fq, s = fr & 3;
        const int row = MP + rb * 64 + 16 * (wave & 3) + fr, nseq = (row - MP) >> 2;
        f32x4 q0[2], q1[2], k0[2], k1[2], k2[2], kb[2]; float rsq = 0.f;
        if (wave < MB) {
            rsq = ssq[row];
#pragma unroll
            for (int e = 0; e < 2; ++e) {
                q0[e] = *(const f32x4*)(st + (size_t)(nseq * 2 + 0) * DFF + col0 + 4 * e); q1[e] = *(const f32x4*)(st + (size_t)(nseq * 2 + 1) * DFF + col0 + 4 * e);
            }
        }
        sample_reduce_finish<MB>(lds, wave, lane);
        if (wave < MB) {
#pragma unroll
            for (int e = 0; e < 2; ++e) { k0[e] = *(const f32x4*)(cw + col0 + 4 * e); k1[e] = *(const f32x4*)(cw + DFF + col0 + 4 * e); k2[e] = *(const f32x4*)(cw + 2 * DFF + col0 + 4 * e); kb[e] = *(const f32x4*)(cbp + col0 + 4 * e); }
            f32x4 v[2][2]; sample_reduce_load<MB>(lds, v, wave, lane);
            const float rs = rsqrtf(rsq * (1.f / 1024.f) + EPS);
            float h[8]; f32x4 av[2];
#pragma unroll
            for (int e = 0; e < 8; ++e) {
                const float a = v[0][e >> 2][e & 3] * rs, up = v[1][e >> 2][e & 3] * rs;
                const float st0 = q0[e >> 2][e & 3], st1 = q1[e >> 2][e & 3];
                const float r1 = dpp_f<0x121>(a), r2 = dpp_f<0x122>(a);
                const float p1 = s >= 1 ? r1 : st1, p2 = s >= 2 ? r2 : (s == 1 ? st1 : st0);
                const float c = kb[e >> 2][e & 3] + k0[e >> 2][e & 3] * p2 + k1[e >> 2][e & 3] * p1 + k2[e >> 2][e & 3] * a;
                h[e] = silu_f(c) * up; av[e >> 2][e & 3] = a;
            }
            if (s >= 2) { float* d = convs + (size_t)(nseq * 2 + (s - 2)) * DFF + col0; *(f32x4*)d = av[0]; *(f32x4*)(d + 4) = av[1]; }
            u32x4 w; w.x = cvtpk(h[0], h[1]); w.y = cvtpk(h[2], h[3]); w.z = cvtpk(h[4], h[5]); w.w = cvtpk(h[6], h[7]);
            *(u32x4*)(Hb + (size_t)row * DFF + col0) = w;
        }
    }
    __syncthreads();
}

__device__ __forceinline__ void p0_transpose_item(const float* W, int K, int N, const float* gain, bf16_t* WT, int kb, int n0, int drow0, LAS float* scr, int lane) {
    const int k0 = 64 * kb;
    float wv[32];
#pragma unroll
    for (int i = 0; i < 32; ++i) wv[i] = W[(size_t)(k0 + 2 * i + (lane >> 5)) * N + n0 + (lane & 31)];
    if (gain) {
#pragma unroll
        for (int i = 0; i < 32; ++i) wv[i] *= gain[k0 + 2 * i + (lane >> 5)]; }
#pragma unroll
    for (int i = 0; i < 32; ++i) scr[(2 * i + (lane >> 5)) * 33 + (lane & 31)] = wv[i];
    asm volatile("s_waitcnt lgkmcnt(0)" ::: "memory");
    const int c = lane & 7;
#pragma unroll
    for (int j = 0; j < 4; ++j) { const int n = (lane >> 3) + 8 * j; const LAS float* s = scr + (8 * c) * 33 + n;
        u32x4 o; o.x = cvtpk(s[0 * 33], s[1 * 33]); o.y = cvtpk(s[2 * 33], s[3 * 33]); o.z = cvtpk(s[4 * 33], s[5 * 33]); o.w = cvtpk(s[6 * 33], s[7 * 33]);
        *(u32x4*)(WT + (size_t)(drow0 + n) * K + k0 + 8 * c) = o; }
    asm volatile("s_waitcnt lgkmcnt(0)" ::: "memory");
}
__device__ __forceinline__ int map_headperm(int nb) { const int p = (nb * 32) & 255, bj = p >> 7, wc = (p >> 5) & 3; return ((nb * 32) & ~255) + 64 * wc + 32 * bj; }
__device__ __forceinline__ int map_ffn(int nb) { const int tile = nb >> 3, p = (nb & 7) * 32; return p < 128 ? 128 * tile + p : DFF + 128 * tile + (p - 128); }

template <int NR>
__device__ __forceinline__ void rows_to_bf16(const float* xrow, bf16_t* orow, float* ssq, int lane) {
    f32x4 v[NR][4];
#pragma unroll
    for (int r = 0; r < NR; ++r)
#pragma unroll
        for (int j = 0; j < 4; ++j) v[r][j] = ((const f32x4*)(xrow + (size_t)r * DM))[lane + 64 * j];
#pragma unroll
    for (int r = 0; r < NR; ++r) {
        float s = 0.f;
#pragma unroll
        for (int j = 0; j < 4; ++j) s += dot4(v[r][j]);
        s = wave_sum(s);
        u32x2* o8 = (u32x2*)(orow + (size_t)r * DM) + lane;
#pragma unroll
        for (int j = 0; j < 4; ++j) { u32x2 w; w.x = cvtpk(v[r][j][0], v[r][j][1]); w.y = cvtpk(v[r][j][2], v[r][j][3]); o8[64 * j] = w; }
        if (lane == 0) ssq[r] = s;
    }
}

__device__ __forceinline__ void p0_prologue(const Params& P, LAS unsigned char* lds, int G, int bid, int part) {
    const int tid = threadIdx.x, lane = tid & 63, wave = __builtin_amdgcn_readfirstlane(tid >> 6);
    LAS float* scr = (LAS float*)(lds + wave * 16384);
    const int gw = bid * 8 + wave, NGW = G * 8;
    unsigned char* ws = P.ws;
    float* ssq = (float*)(ws + WS_SSQ);
    const int gt = bid * 512 + tid, NGT = G * 512;
    constexpr int I0 = 16 * 48, I1 = 16 * 32, I2 = 16 * 56, I3 = 16 * 32, I4 = 16 * 16, I6 = 16 * 176, I8 = 44 * 32;
    if (part == 1) {
        constexpr int NITEMS = I3 + I6 + I8;
        for (int it = gw; it < NITEMS; it += NGW) {
            int r = it;
            if (r < I3) { const int nb = r % 32, kb = r / 32; p0_transpose_item(P.in[20], 1024, 1024, nullptr, (bf16_t*)(ws + WS_WOUTB), kb, 32 * nb, 32 * nb, scr, lane); continue; } r -= I3;
            if (r < I6) { const int nb = r % 176, kb = r / 176;
                p0_transpose_item(P.in[24] + (size_t)1024 * NFF, 1024, NFF, P.in[9] + 1024, (bf16_t*)(ws + WS_WFFN) + (size_t)NFF * 1024, kb, map_ffn(nb), 32 * nb, scr, lane); continue; } r -= I6;
            { const int nb = r % 32, kb = r / 32;
                p0_transpose_item(P.in[27] + (size_t)DFF * 1024, DFF, 1024, nullptr, (bf16_t*)(ws + WS_WDOWN) + (size_t)1024 * DFF, kb, 32 * nb, 32 * nb, scr, lane); }
        }
        { const f32x4* ck = (const f32x4*)P.in[2]; const f32x4* cv = (const f32x4*)P.in[3]; f32x4* ok = (f32x4*)(P.out + O_WKS); f32x4* ov = (f32x4*)(P.out + O_WVS);
          for (int i = gt; i < NDEC * 124 * 64; i += NGT) { const int n = i / (124 * 64), r = i % (124 * 64); const size_t s = (size_t)n * 128 * 64 + 4 * 64 + r, d = (size_t)n * 128 * 64 + r; ok[d] = ck[s]; ov[d] = cv[s]; } }
        return;
    }
    constexpr int NITEMS = I0 + I1 + I2 + 2 * I4 + I6 + I8;
    for (int it = gw; it < NITEMS; it += NGW) {
        int r = it;
        if (r < I0) { const int nb = r % 48, kb = r / 48; p0_transpose_item(P.in[11], 1024, NINA, P.in[8], (bf16_t*)(ws + WS_WINA), kb, map_headperm(nb), 32 * nb, scr, lane); continue; } r -= I0;
        if (r < I1) { const int nb = r % 32, kb = r / 32; p0_transpose_item(P.in[15], 1024, 1024, nullptr, (bf16_t*)(ws + WS_WOUTA), kb, 32 * nb, 32 * nb, scr, lane); continue; } r -= I1;
        if (r < I2) { const int nb = r % 56, kb = r / 56; p0_transpose_item(P.in[16], 1024, NINB, P.in[8] + 1024, (bf16_t*)(ws + WS_WINB), kb, nb < 48 ? 32 * nb : map_headperm(nb), 32 * nb, scr, lane); continue; } r -= I2;
        if (r < 2 * I4) { const int l = r / I4; r -= l * I4; const int nb = r % 16, kb = r / 16;
            p0_transpose_item(P.in[21] + (size_t)l * 1024 * 512, 1024, 512, P.in[10] + l * 1024, (bf16_t*)(ws + WS_WMKV) + (size_t)l * 512 * 1024, kb, map_headperm(nb), 32 * nb, scr, lane); continue; } r -= 2 * I4;
        if (r < I6) { const int nb = r % 176, kb = r / 176;
            p0_transpose_item(P.in[24], 1024, NFF, P.in[9], (bf16_t*)(ws + WS_WFFN), kb, map_ffn(nb), 32 * nb, scr, lane); continue; } r -= I6;
        { const int nb = r % 32, kb = r / 32;
            p0_transpose_item(P.in[27], DFF, 1024, nullptr, (bf16_t*)(ws + WS_WDOWN), kb, 32 * nb, 32 * nb, scr, lane); }
    }
    bf16_t* XB = (bf16_t*)(ws + WS_XB); bf16_t* MEMB = (bf16_t*)(ws + WS_MEMB);
    for (int r4 = gw; r4 < (M + MMEM) / 4; r4 += NGW) { const int r = 4 * r4;
        if (r < MP) rows_to_bf16<4>(P.in[0] + (size_t)r * DM, XB + (size_t)r * DM, ssq + r, lane);
        else if (r < M) rows_to_bf16<4>(P.in[1] + (size_t)(r - MP) * DM, XB + (size_t)r * DM, ssq + r, lane);
        else rows_to_bf16<4>(P.in[7] + (size_t)(r - M) * DM, MEMB + (size_t)(r - M) * DM, ssq + 5 * M + (r - M), lane);
    }
    for (int i = gt; i < 4 * M; i += NGT) ssq[M + i] = 0.f;
    if (gt < 256) { float* GT = (float*)(ws + WS_GT); const int t4 = gt >> 6, d = gt & 63; GT[gt] = t4 == 0 ? P.in[12][d] : t4 == 1 ? P.in[13][d] : t4 == 2 ? 1.f : P.in[22][d]; }
    { bf16_t* WST = (bf16_t*)(ws + WS_WST); const float* wsb = P.in[18];
      for (int i = gt; i < 4 * 128 * 128; i += NGT) { const int ii = (i >> 7) & 127, jj = i & 127; const float w = jj <= ii ? wsb[i] : 0.f; WST[i] = (bf16_t)(cvtpk(w, 0.f) & 0xffffu); } }
}

__device__ __forceinline__ int crow(int r, int hi) { return (r & 3) + 8 * (r >> 2) + 4 * hi; }
__device__ __forceinline__ int kv_off(int row, int chunk) { return row * 128 + ((chunk ^ (row & 7)) << 4); }
__device__ __forceinline__ s16x4 vtr(const LAS unsigned char* p) { return __builtin_bit_cast(s16x4, __builtin_amdgcn_ds_read_tr16_b64_v4i16((LAS s16x4*)p)); }

struct AttnOfs { int k[4]; int v[2]; };
__device__ __forceinline__ AttnOfs attn_ofs() {
    const int lane = threadIdx.x & 63, r32 = lane & 31, hi = lane >> 5; AttnOfs a;
#pragma unroll
    for (int ks = 0; ks < 4; ++ks) a.k[ks] = r32 * 128 + (((2 * ks + hi) ^ (r32 & 7)) << 4);
    const int vkey = 4 * hi + ((lane & 15) >> 2), vcol = 16 * ((lane >> 4) & 1) + 4 * (lane & 3);
#pragma unroll
    for (int d0 = 0; d0 < 2; ++d0) a.v[d0] = vkey * 128 + (((4 * d0 + (vcol >> 3)) ^ vkey) << 4) + (vcol & 7) * 2;
    return a;
}
template <int CT, bool MASK, bool FIRST>
__device__ __forceinline__ void attn_chunk(const bf16x8 (&qf)[4], const AttnOfs& ao, const LAS unsigned char* Kb, const LAS unsigned char* Vb, int qpos, int kpos0, float slope2, LAS float* wsf, float& m, float& l, f32x16 (&o)[2]) {
    const int lane = threadIdx.x & 63, r32 = lane & 31, hi = lane >> 5;
    f32x16 s[CT];
#pragma unroll
    for (int t = 0; t < CT; ++t) {
#pragma unroll
        for (int r = 0; r < 16; ++r) s[t][r] = 0.f;
#pragma unroll
        for (int ks = 0; ks < 4; ++ks) { const bf16x8 kf = *(const LAS bf16x8*)(Kb + ao.k[ks] + t * 4096); s[t] = __builtin_amdgcn_mfma_f32_32x32x16_bf16(kf, qf[ks], s[t], 0, 0, 0); }
        if (CT > 2) __builtin_amdgcn_sched_barrier(0);
    }
    const float C2 = 0.125f * LOG2E;
    float mx = -1e30f;
    if (MASK) {
        int dbase = qpos - kpos0 - 4 * hi; asm volatile("" : "+v"(dbase));
        const float fdb = (float)dbase, lim = (float)(qpos < 127 ? qpos : 127), ns = -slope2;
#pragma unroll
        for (int t = 0; t < CT; ++t)
#pragma unroll
            for (int r = 0; r < 16; ++r) {
                const float fd = fdb - (float)(32 * t + (r & 3) + 8 * (r >> 2));
                float v = __builtin_fmaf(ns, fd, s[t][r] * C2);
                v = (fd >= 0.f && fd <= lim) ? v : -1e30f;
                s[t][r] = v; mx = fmaxf(mx, v);
            }
    } else {
#pragma unroll
        for (int t = 0; t < CT; ++t)
#pragma unroll
            for (int r = 0; r < 16; ++r) { const float v = s[t][r] * C2; s[t][r] = v; mx = fmaxf(mx, v); }
    }
    mx = fmaxf(mx, __shfl_xor(mx, 32));
    const float mn = fmaxf(m, mx), alpha = __builtin_amdgcn_exp2f(m - mn);
    m = mn;
    float sum = 0.f;
#pragma unroll
    for (int t = 0; t < CT; ++t)
#pragma unroll
        for (int r = 0; r < 16; ++r) { const float e = __builtin_amdgcn_exp2f(s[t][r] - mn); s[t][r] = e; sum += e; }
    l = l * alpha + sum;
    if (!FIRST) {
        if (hi == 0) wsf[r32] = alpha;
        asm volatile("s_waitcnt lgkmcnt(0)" ::: "memory");
#pragma unroll
        for (int r = 0; r < 16; ++r) { const float a = wsf[crow(r, hi)]; o[0][r] *= a; o[1][r] *= a; }
        asm volatile("s_waitcnt lgkmcnt(0)" ::: "memory");
    }
#pragma unroll
    for (int t = 0; t < CT; ++t)
#pragma unroll
        for (int k2 = 0; k2 < 2; ++k2) {
            u32x4 pw; pw.x = cvtpk(s[t][8 * k2 + 0], s[t][8 * k2 + 1]); pw.y = cvtpk(s[t][8 * k2 + 2], s[t][8 * k2 + 3]); pw.z = cvtpk(s[t][8 * k2 + 4], s[t][8 * k2 + 5]); pw.w = cvtpk(s[t][8 * k2 + 6], s[t][8 * k2 + 7]);
            const bf16x8 pa = __builtin_bit_cast(bf16x8, pw);
#pragma unroll
            for (int d0 = 0; d0 < 2; ++d0) {
                const LAS unsigned char* vp = Vb + ao.v[d0] + (32 * t + 16 * k2) * 128;
                const s16x4 lo = vtr(vp), hh = vtr(vp + 1024);
                const bf16x8 vf = (bf16x8){lo[0], lo[1], lo[2], lo[3], hh[0], hh[1], hh[2], hh[3]};
                o[d0] = __builtin_amdgcn_mfma_f32_32x32x16_bf16(pa, vf, o[d0], 0, 0, 0);
            }
        }
}
__device__ __forceinline__ void attn_init(bool mask, float sink2, float& m, float& l, f32x16 (&o)[2]) {
    const int hi = (threadIdx.x & 63) >> 5;
    m = mask ? sink2 : -1e30f; l = (mask && hi == 0) ? 1.f : 0.f;
#pragma unroll
    for (int r = 0; r < 16; ++r) { o[0][r] = 0.f; o[1][r] = 0.f; }
}
__device__ __forceinline__ void attn_finish(float l, LAS float* wsf, f32x16 (&o)[2], LAS unsigned short* stg) {
    const int lane = threadIdx.x & 63, r32 = lane & 31, hi = lane >> 5;
    l += __shfl_xor(l, 32);
    if (hi == 0) wsf[r32] = 1.0f / l;
    asm volatile("s_waitcnt lgkmcnt(0)" ::: "memory");
#pragma unroll
    for (int r = 0; r < 16; ++r) { const float li = wsf[crow(r, hi)]; const int q = crow(r, hi);
        stg[q * 64 + r32] = (unsigned short)(cvtpk(o[0][r] * li, 0.f) & 0xffffu); stg[q * 64 + 32 + r32] = (unsigned short)(cvtpk(o[1][r] * li, 0.f) & 0xffffu); }
    asm volatile("s_waitcnt lgkmcnt(0)" ::: "memory");
}
__device__ __forceinline__ void attn_swa(const bf16x8 (&qf)[4], const AttnOfs& ao, const LAS unsigned char* Kb, const LAS unsigned char* Vb, int qpos, int kpos0, float slope2, float sink2, LAS float* wsf, LAS unsigned short* stg) {
    float m, l; f32x16 o[2]; attn_init(true, sink2, m, l, o);
#pragma unroll 1
    for (int t = 0; t < 4; t += 2) attn_chunk<2, true, false>(qf, ao, Kb + t * 4096, Vb + t * 4096, qpos, kpos0 + 32 * t, slope2, wsf, m, l, o);
    attn_chunk<1, true, false>(qf, ao, Kb + 4 * 4096, Vb + 4 * 4096, qpos, kpos0 + 128, slope2, wsf, m, l, o);
    attn_finish(l, wsf, o, stg);
}
__device__ __forceinline__ void attn_mem(const bf16x8 (&qf)[4], const AttnOfs& ao, const LAS unsigned char* Kb, const LAS unsigned char* Vb, LAS float* wsf, LAS unsigned short* stg) {
    float m, l; f32x16 o[2]; attn_init(false, 0.f, m, l, o);
    attn_chunk<2, false, true>(qf, ao, Kb, Vb, 0, 0, 0.f, wsf, m, l, o);
#pragma unroll 1
    for (int c = 1; c < 4; ++c) attn_chunk<2, false, false>(qf, ao, Kb + c * 64 * 128, Vb + c * 64 * 128, 0, 0, 0.f, wsf, m, l, o);
    attn_finish(l, wsf, o, stg);
}
__device__ __forceinline__ void stage_out(const LAS unsigned short* stg, bf16_t* gdst, size_t ld) {
    const int lane = threadIdx.x & 63;
#pragma unroll
    for (int i = 0; i < 4; ++i) { const int row = i * 8 + (lane >> 3), ch = lane & 7; *(u32x4*)(gdst + (size_t)row * ld + ch * 8) = *(const LAS u32x4*)(stg + row * 64 + ch * 8); }
    asm volatile("s_waitcnt lgkmcnt(0)" ::: "memory");
}

__device__ __forceinline__ void unit_swa_prompt(const Params& P, LAS unsigned char* lds, LAS float* wsf, int b, int qb, int g) {
    const int tid = threadIdx.x, lane = tid & 63, wave = __builtin_amdgcn_readfirstlane(tid >> 6), r32 = lane & 31, hi = lane >> 5;
    const bf16_t* Qg = (const bf16_t*)(P.ws + WS_Q); const bf16_t* Kg = (const bf16_t*)(P.ws + WS_K); const bf16_t* Vg = (const bf16_t*)(P.ws + WS_V); bf16_t* Og = (bf16_t*)(P.ws + WS_O);
    LAS unsigned char* Kl = lds; LAS unsigned char* Vl = lds + 49152; LAS unsigned short* stg = (LAS unsigned short*)(lds + 98304 + wave * 4096);
    const int t0 = 256 * qb + 32 * wave;
    const bf16_t* qp = Qg + (size_t)(b * SEQ + t0 + r32) * 768 + (3 * g) * 64 + 8 * hi;
#pragma unroll 3
    for (int idx = tid; idx < 384 * 8; idx += 512) {
        const int row = idx >> 3, ch = idx & 7, t = 256 * qb - 128 + row;
        u32x4 kv = (u32x4){0u, 0u, 0u, 0u}, vv = kv;
        if (t >= 0) { const size_t o = (size_t)(b * SEQ + t) * 256 + g * 64 + ch * 8; kv = *(const u32x4*)(Kg + o); vv = *(const u32x4*)(Vg + o); }
        *(LAS u32x4*)(Kl + kv_off(row, ch)) = kv; *(LAS u32x4*)(Vl + kv_off(row, ch)) = vv;
    }
    __syncthreads();
    const AttnOfs ao = attn_ofs();
#pragma unroll 1
    for (int hh = 0; hh < 3; ++hh) {
        const int head = 3 * g + hh;
        bf16x8 qf[4];
#pragma unroll
        for (int ks = 0; ks < 4; ++ks) qf[ks] = *(const bf16x8*)(qp + hh * 64 + 16 * ks);
        attn_swa(qf, ao, Kl + 32 * wave * 128, Vl + 32 * wave * 128, t0 + r32, t0 - 128, alibi_slope(head) * LOG2E, P.in[14][head] * LOG2E, wsf, stg);
        stage_out(stg, Og + (size_t)(b * SEQ + t0) * DM + head * 64, DM);
    }
    __syncthreads();
}

__device__ __forceinline__ void unit_mem_prompt(const Params& P, LAS unsigned char* lds, LAS float* wsf, int layer, int b, int qb, int h) {
    const int tid = threadIdx.x, lane = tid & 63, wave = __builtin_amdgcn_readfirstlane(tid >> 6), r32 = lane & 31, hi = lane >> 5;
    const bf16_t* XQ = (const bf16_t*)(P.ws + WS_XQ); bf16_t* Og = (bf16_t*)(P.ws + WS_O);
    const bf16_t* MK = (const bf16_t*)(P.ws + WS_MK) + (size_t)layer * MMEM * 256; const bf16_t* MV = (const bf16_t*)(P.ws + WS_MV) + (size_t)layer * MMEM * 256;
    LAS unsigned char* Kl = lds; LAS unsigned char* Vl = lds + 32768; LAS unsigned short* stg = (LAS unsigned short*)(lds + 98304 + wave * 4096);
    const int t0 = 256 * qb + 32 * wave;
    bf16x8 qf[4];
#pragma unroll
    for (int ks = 0; ks < 4; ++ks) qf[ks] = *(const bf16x8*)(XQ + (size_t)(b * SEQ + t0 + r32) * 256 + h * 64 + 16 * ks + 8 * hi);
#pragma unroll
    for (int idx = tid; idx < 256 * 8; idx += 512) {
        const int row = idx >> 3, ch = idx & 7; const size_t o = (size_t)(b * NMEM + row) * 256 + h * 64 + ch * 8;
        *(LAS u32x4*)(Kl + kv_off(row, ch)) = *(const u32x4*)(MK + o); *(LAS u32x4*)(Vl + kv_off(row, ch)) = *(const u32x4*)(MV + o);
    }
    __syncthreads();
    const AttnOfs ao = attn_ofs();
    attn_mem(qf, ao, Kl, Vl, wsf, stg);
    stage_out(stg, Og + (size_t)(b * SEQ + t0) * DM + 768 + h * 64, DM);
    __syncthreads();
}

__device__ __forceinline__ u32x4 ld8f_pack(const float* p) { const f32x4 a = *(const f32x4*)p, b = *(const f32x4*)(p + 4); return pack8(a, b); }

__device__ __forceinline__ void unit_swa_sample(const Params& P, LAS unsigned char* lds, LAS float* wsf, int n, int gp) {
    const int tid = threadIdx.x, lane = tid & 63, wave = __builtin_amdgcn_readfirstlane(tid >> 6), r32 = lane & 31, hi = lane >> 5;
    const bf16_t* Qg = (const bf16_t*)(P.ws + WS_Q); const bf16_t* Kg = (const bf16_t*)(P.ws + WS_K); const bf16_t* Vg = (const bf16_t*)(P.ws + WS_V); bf16_t* Og = (bf16_t*)(P.ws + WS_O);
#pragma unroll 2
    for (int idx = tid; idx < 2 * 160 * 8; idx += 512) {
        const int gi = idx / 1280, rem = idx % 1280, row = rem >> 3, ch = rem & 7, g = 2 * gp + gi;
        LAS unsigned char* Kl = lds + gi * 40960; LAS unsigned char* Vl = Kl + 20480;
        u32x4 kv = (u32x4){0u, 0u, 0u, 0u}, vv = kv;
        if (row < 128) { const size_t o = ((size_t)(n * 128 + row) * 4 + g) * 64 + ch * 8; kv = ld8f_pack(P.in[2] + o); vv = ld8f_pack(P.in[3] + o); }
        else if (row < 132) { const size_t o = (size_t)(MP + 4 * n + row - 128) * 256 + g * 64 + ch * 8; kv = *(const u32x4*)(Kg + o); vv = *(const u32x4*)(Vg + o); }
        *(LAS u32x4*)(Kl + kv_off(row, ch)) = kv; *(LAS u32x4*)(Vl + kv_off(row, ch)) = vv;
    }
    __syncthreads();
    if (wave < 2) {
        LAS unsigned short* stg = (LAS unsigned short*)(lds + 98304 + wave * 4096);
        const AttnOfs ao = attn_ofs();
        const int g = 2 * gp + wave; const bool qv = r32 < 12; const int hh = qv ? (r32 >> 2) : 0, sidx = r32 & 3, head = 3 * g + hh;
        bf16x8 qf[4];
#pragma unroll
        for (int ks = 0; ks < 4; ++ks) { qf[ks] = *(const bf16x8*)(Qg + (size_t)(MP + 4 * n + sidx) * 768 + head * 64 + 16 * ks + 8 * hi); if (!qv) qf[ks] = (bf16x8){0, 0, 0, 0, 0, 0, 0, 0}; }
        const LAS unsigned char* Kl = lds + wave * 40960;
        attn_swa(qf, ao, Kl, Kl + 20480, 128 + sidx, 0, alibi_slope(head) * LOG2E, P.in[14][head] * LOG2E, wsf, stg);
        for (int i = lane; i < 96; i += 64) { const int q = i >> 3, ch = i & 7;
            *(u32x4*)(Og + (size_t)(MP + 4 * n + (q & 3)) * DM + (3 * g + (q >> 2)) * 64 + ch * 8) = *(const LAS u32x4*)(stg + q * 64 + ch * 8); }
        asm volatile("s_waitcnt lgkmcnt(0)" ::: "memory");
    }
    __syncthreads();
}

__device__ __forceinline__ void unit_mem_sample(const Params& P, LAS unsigned char* lds, LAS float* wsf, int layer, int n, int hp) {
    const int tid = threadIdx.x, lane = tid & 63, wave = __builtin_amdgcn_readfirstlane(tid >> 6), r32 = lane & 31, hi = lane >> 5;
    const bf16_t* XQ = (const bf16_t*)(P.ws + WS_XQ); bf16_t* Og = (bf16_t*)(P.ws + WS_O);
    const float* ck = P.in[4] + (size_t)(layer * NDEC + n) * NMEM * 256; const float* cv = P.in[5] + (size_t)(layer * NDEC + n) * NMEM * 256;
#pragma unroll 2
    for (int idx = tid; idx < 256 * 16; idx += 512) {
        const int row = idx >> 4, hsel = (idx >> 3) & 1, ch = idx & 7; const size_t o = (size_t)row * 256 + (2 * hp + hsel) * 64 + ch * 8;
        LAS unsigned char* Kl = lds + hsel * 65536;
        *(LAS u32x4*)(Kl + kv_off(row, ch)) = ld8f_pack(ck + o); *(LAS u32x4*)(Kl + 32768 + kv_off(row, ch)) = ld8f_pack(cv + o);
    }
    __syncthreads();
    if (wave < 2) {
        LAS unsigned short* stg = (LAS unsigned short*)(lds + OSTG2_OFF + wave * 4096);
        const AttnOfs ao = attn_ofs();
        const int h = 2 * hp + wave; const bool qv = r32 < 4;
        bf16x8 qf[4];
#pragma unroll
        for (int ks = 0; ks < 4; ++ks) { qf[ks] = *(const bf16x8*)(XQ + (size_t)(MP + 4 * n + (r32 & 3)) * 256 + h * 64 + 16 * ks + 8 * hi); if (!qv) qf[ks] = (bf16x8){0, 0, 0, 0, 0, 0, 0, 0}; }
        const LAS unsigned char* Kl = lds + wave * 65536;
        attn_mem(qf, ao, Kl, Kl + 32768, wsf, stg);
        if (lane < 32) { const int q = lane >> 3, ch = lane & 7;
            *(u32x4*)(Og + (size_t)(MP + 4 * n + q) * DM + 768 + h * 64 + ch * 8) = *(const LAS u32x4*)(stg + q * 64 + ch * 8); }
        asm volatile("s_waitcnt lgkmcnt(0)" ::: "memory");
    }
    __syncthreads();
}

__device__ __forceinline__ void unit_gmlp_prompt(const Params& P, LAS unsigned char* lds, int b, int c) {
    const int tid = threadIdx.x, lane = tid & 63, wave = __builtin_amdgcn_readfirstlane(tid >> 6), r32 = lane & 31, hi = lane >> 5;
    const bf16_t* U = (const bf16_t*)(P.ws + WS_U); const bf16_t* GV = (const bf16_t*)(P.ws + WS_GV); bf16_t* Og = (bf16_t*)(P.ws + WS_O);
    const bf16_t* WST = (const bf16_t*)(P.ws + WS_WST); const float* ssqv = (const float*)(P.ws + WS_SSQ) + 4 * M;
    const float* vg = P.in[17]; const float* bs = P.in[19]; float* cvp = P.out + O_CVP;
    const int rowb = b * SEQ + c * 128;
    const int ib = wave & 3, cb0 = 3 * (wave >> 2);
#pragma unroll 1
    for (int g = 0; g < 4; ++g) {
        for (int idx = tid; idx < 128 * 24; idx += 512) {
            const int j = idx / 24, ch = idx % 24; const int row = rowb + j, col = g * 192 + ch * 8;
            const float rv = rsqrtf(ssqv[row] * (1.f / 768.f) + EPS);
            const u32x4 w = *(const u32x4*)(GV + (size_t)row * 768 + col);
            const f32x4 g0 = *(const f32x4*)(vg + col), g1 = *(const f32x4*)(vg + col + 4);
            f32x4 v0 = (f32x4){bflo(w.x), bfhi(w.x), bflo(w.y), bfhi(w.y)}, v1 = (f32x4){bflo(w.z), bfhi(w.z), bflo(w.w), bfhi(w.w)};
            v0 = v0 * rv * g0; v1 = v1 * rv * g1;
            *(LAS u32x4*)(lds + j * 384 + ch * 16) = pack8(v0, v1);
            if (c == 31) { float* o = cvp + (size_t)(b * 128 + j) * 768 + col; *(f32x4*)o = v0; *(f32x4*)(o + 4) = v1; }
        }
        __syncthreads();
        f32x16 acc[3];
#pragma unroll
        for (int i = 0; i < 3; ++i)
#pragma unroll
            for (int r = 0; r < 16; ++r) acc[i][r] = 0.f;
        const int nks = 2 * (ib + 1);
#pragma unroll 1
        for (int ks = 0; ks < nks; ++ks) {
            const bf16x8 af = *(const bf16x8*)(WST + (size_t)(g * 128 + 32 * ib + r32) * 128 + 16 * ks + 8 * hi);
            const int j0 = 16 * ks + 8 * hi + ((lane & 15) >> 2);
#pragma unroll
            for (int i = 0; i < 3; ++i) {
                const int col = 32 * (cb0 + i) + 16 * ((lane >> 4) & 1) + 4 * (lane & 3);
                const s16x4 lo = vtr(lds + j0 * 384 + col * 2), hh = vtr(lds + (j0 + 4) * 384 + col * 2);
                const bf16x8 vf = (bf16x8){lo[0], lo[1], lo[2], lo[3], hh[0], hh[1], hh[2], hh[3]};
                acc[i] = __builtin_amdgcn_mfma_f32_32x32x16_bf16(af, vf, acc[i], 0, 0, 0);
            }
        }
        LAS float* stg = (LAS float*)(lds + 49152 + wave * 4096);
#pragma unroll 1
        for (int i = 0; i < 3; ++i) {
            const f32x16 a = i == 0 ? acc[0] : i == 1 ? acc[1] : acc[2];
#pragma unroll
            for (int r = 0; r < 16; ++r) { const int q = crow(r, hi); stg[q * 32 + r32] = a[r] + bs[g * 128 + 32 * ib + q]; }
            asm volatile("s_waitcnt lgkmcnt(0)" ::: "memory");
            const int q = lane >> 1, hf = lane & 1; const size_t ro = (size_t)(rowb + 32 * ib + q); const int col = g * 192 + 32 * (cb0 + i) + 16 * hf;
            const u32x4 u0 = *(const u32x4*)(U + ro * 768 + col), u1 = *(const u32x4*)(U + ro * 768 + col + 8);
            const LAS f32x4* sp = (const LAS f32x4*)(stg + q * 32 + 16 * hf);
            const f32x4 m0 = sp[0], m1 = sp[1], m2 = sp[2], m3 = sp[3];
            u32x4 o0, o1;
            o0.x = cvtpk(bflo(u0.x) * m0[0], bfhi(u0.x) * m0[1]); o0.y = cvtpk(bflo(u0.y) * m0[2], bfhi(u0.y) * m0[3]); o0.z = cvtpk(bflo(u0.z) * m1[0], bfhi(u0.z) * m1[1]); o0.w = cvtpk(bflo(u0.w) * m1[2], bfhi(u0.w) * m1[3]);
            o1.x = cvtpk(bflo(u1.x) * m2[0], bfhi(u1.x) * m2[1]); o1.y = cvtpk(bflo(u1.y) * m2[2], bfhi(u1.y) * m2[3]); o1.z = cvtpk(bflo(u1.z) * m3[0], bfhi(u1.z) * m3[1]); o1.w = cvtpk(bflo(u1.w) * m3[2], bfhi(u1.w) * m3[3]);
            *(u32x4*)(Og + ro * DM + col) = o0; *(u32x4*)(Og + ro * DM + col + 8) = o1;
            asm volatile("s_waitcnt lgkmcnt(0)" ::: "memory");
        }
        __syncthreads();
    }
}

__device__ __forceinline__ void gmlp_sample(const Params& P, int G, int bid, int n0 = 0, int nn = NDEC) {
    const bf16_t* U = (const bf16_t*)(P.ws + WS_U); const bf16_t* GV = (const bf16_t*)(P.ws + WS_GV); bf16_t* Og = (bf16_t*)(P.ws + WS_O);
    const float* ssqv = (const float*)(P.ws + WS_SSQ) + 4 * M; const float* vg = P.in[17]; const float* wsb = P.in[18]; const float* bs = P.in[19]; float* cvs = P.out + O_CVS;
    for (int i = bid * 512 + threadIdx.x; i < nn * 768; i += G * 512) {
        const int n = n0 + i / 768, col = i % 768, g = col / 192; float vn[4];
#pragma unroll
        for (int s = 0; s < 4; ++s) { const int row = MP + 4 * n + s; vn[s] = bf2f(GV[(size_t)row * 768 + col]) * rsqrtf(ssqv[row] * (1.f / 768.f) + EPS) * vg[col]; cvs[(size_t)(4 * n + s) * 768 + col] = vn[s]; }
#pragma unroll
        for (int s = 0; s < 4; ++s) { float mx = bs[g * 128 + s];
#pragma unroll
            for (int j = 0; j < 4; ++j) if (j <= s) mx += wsb[(size_t)(g * 128 + s) * 128 + j] * vn[j];
            const int row = MP + 4 * n + s; Og[(size_t)row * DM + col] = f2bf_s(bf2f(U[(size_t)row * 768 + col]) * mx); }
    }
}

#define XB_TMO      128
#define XB_XCNT(j)  (256  + 64 * (j))
#define XB_XSUB(j)  (1280 + 64 * (j))
#define XB_XGEN(j)  (2304 + 64 * (j))
#define XB_TOP      3328
#define XB_TOPGEN   3392
#define XCD_BAR_WORDS 3456
#define XB_SPIN_CAP (1u << 22)
__device__ __forceinline__ unsigned xb_ld(unsigned* p)              { return __hip_atomic_load(p, __ATOMIC_RELAXED, __HIP_MEMORY_SCOPE_AGENT); }
__device__ __forceinline__ unsigned xb_add(unsigned* p, unsigned v) { return __hip_atomic_fetch_add(p, v, __ATOMIC_RELAXED, __HIP_MEMORY_SCOPE_AGENT); }
__device__ __forceinline__ unsigned xb_xcc_id() { return (unsigned)__builtin_amdgcn_s_getreg((3 << 11) | 20) & 0xFu; }
#define XB_SPIN(cond, bar) do { unsigned _sp = 0; while (cond) { __builtin_amdgcn_s_sleep(1); \
    if ((++_sp & 255u) == 0u) { if (xb_ld(&(bar)[XB_TMO])) break; if (_sp > XB_SPIN_CAP) { atomicAdd(&(bar)[XB_TMO], 1u); break; } } } } while (0)
struct XcdBarrier { unsigned* bar; unsigned x; volatile LAS unsigned* st; };
__device__ __forceinline__ XcdBarrier xcd_barrier_post(unsigned* bar, volatile LAS unsigned* st) {
    XcdBarrier b; b.bar = bar; b.x = xb_xcc_id(); b.st = st;
    if (threadIdx.x == 0) (void)xb_add(&bar[XB_XCNT(b.x)], 1u);
    return b;
}
__device__ __forceinline__ void xcd_barrier_complete(unsigned* bar, unsigned x, unsigned& nloc, unsigned& nx) {
    const unsigned G = gridDim.x * gridDim.y * gridDim.z;
    unsigned sum, cnt, mine, sp = 0u;
    for (;;) {
        sum = 0u; cnt = 0u; mine = 0u;
#pragma unroll
        for (unsigned j = 0; j < 16; ++j) { const unsigned c = xb_ld(&bar[XB_XCNT(j)]); sum += c; cnt += (c > 0u) ? 1u : 0u; mine = (j == x) ? c : mine; }
        if (sum == G) break;
        __builtin_amdgcn_s_sleep(1);
        if ((++sp & 255u) == 0u) { if (xb_ld(&bar[XB_TMO])) break; if (sp > XB_SPIN_CAP) { atomicAdd(&bar[XB_TMO], 1u); break; } }
    }
    nloc = mine > 0u ? mine : 1u; nx = cnt > 0u ? cnt : 1u;
}
__device__ __forceinline__ void xcd_barrier(const XcdBarrier& b) {
    asm volatile("s_waitcnt vmcnt(0)" ::: "memory");
    __syncthreads();
    if (threadIdx.x == 0) {
        unsigned* bar = b.bar;
        __builtin_amdgcn_s_waitcnt(0);
        unsigned nloc = b.st[0], nx = b.st[1];
        if (nloc == 0u) { xcd_barrier_complete(bar, b.x, nloc, nx); b.st[0] = nloc; b.st[1] = nx; }
        const unsigned old = xb_add(&bar[XB_XSUB(b.x)], 1u);
        const unsigned gen = old / nloc;
        if (old + 1u == (gen + 1u) * nloc) {
            __builtin_amdgcn_fence(__ATOMIC_RELEASE, "agent");
            asm volatile("s_waitcnt vmcnt(0)" ::: "memory");
            const unsigned og = xb_add(&bar[XB_TOP], 1u);
            const unsigned tg = og / nx;
            if (og + 1u == (tg + 1u) * nx) xb_add(&bar[XB_TOPGEN], 1u);
            else XB_SPIN(xb_ld(&bar[XB_TOPGEN]) == tg, bar);
            __builtin_amdgcn_fence(__ATOMIC_ACQUIRE, "agent");
            xb_add(&bar[XB_XGEN(b.x)], 1u);
            asm volatile("s_waitcnt vmcnt(0)" ::: "memory");
        } else {
            XB_SPIN(xb_ld(&bar[XB_XGEN(b.x)]) == gen, bar);
            __builtin_amdgcn_fence(__ATOMIC_ACQUIRE, "agent");
            asm volatile("s_waitcnt vmcnt(0)" ::: "memory");
        }
    }
    __syncthreads();
}

#define GB_CNT(g) (3584 + 128 * (g))
#define GB_GEN(g) (3648 + 128 * (g))
static_assert((3648 + 128 * 7 + 1) * 4 <= 32768, "group barrier words inside the control region");
#define GB_XMAX(g) (4608 + 64 * (g))
#define GB_XMIN(g) (5120 + 64 * (g))
__device__ __forceinline__ void group_barrier(unsigned* bar, int grp, unsigned nblk, unsigned& epoch, bool coloc) {
    asm volatile("s_waitcnt vmcnt(0)" ::: "memory");
    __syncthreads();
    if (threadIdx.x == 0) {
        if (!coloc) { __builtin_amdgcn_fence(__ATOMIC_RELEASE, "agent"); asm volatile("s_waitcnt vmcnt(0)" ::: "memory"); }
        const unsigned old = xb_add(&bar[GB_CNT(grp)], 1u);
        if (old + 1u == (epoch + 1u) * nblk) xb_add(&bar[GB_GEN(grp)], 1u);
        else XB_SPIN(xb_ld(&bar[GB_GEN(grp)]) == epoch, bar);
        __builtin_amdgcn_fence(__ATOMIC_ACQUIRE, "agent");
        asm volatile("s_waitcnt vmcnt(0)" ::: "memory");
    }
    ++epoch;
    __syncthreads();
}


__global__ void __launch_bounds__(512, 2) mk_fwd(Params P) {
    extern __shared__ __attribute__((aligned(16))) unsigned char lds_raw[];
    LAS unsigned char* lds = (LAS unsigned char*)lds_raw;
    const int tid = threadIdx.x, wave = __builtin_amdgcn_readfirstlane(tid >> 6);
    const int G = gridDim.x, bid = blockIdx.x;
    LAS float* wsf = (LAS float*)(lds + WSF_OFF) + wave * 64;
    unsigned char* ws = P.ws;
    float* ssq = (float*)(ws + WS_SSQ);
    bf16_t* XB = (bf16_t*)(ws + WS_XB);
    cg::grid_group grid = cg::this_grid();
    const int lo = P.ph_lo, hi = P.ph_hi;
#ifndef PH_MASK
#define PH_MASK 0x1fff
#endif
#define IN(k) (((PH_MASK >> (k)) & 1) && lo <= (k) && (k) < hi)
#ifndef USE_XCD_BAR
#define USE_XCD_BAR 1
#endif
    volatile LAS unsigned* bst = (volatile LAS unsigned*)(lds + BST_OFF);
    if (tid < 2) bst[tid] = 0u;
    __syncthreads();
    XcdBarrier xbar = xcd_barrier_post((unsigned*)(ws + WS_CTL), bst);
    if (tid == 0 && (G % 8) == 0) { unsigned* cb = (unsigned*)(ws + WS_CTL); const unsigned xc = xb_xcc_id();
        __hip_atomic_fetch_max(&cb[GB_XMAX(bid % 8)], xc + 1u, __ATOMIC_RELAXED, __HIP_MEMORY_SCOPE_AGENT); __hip_atomic_fetch_max(&cb[GB_XMIN(bid % 8)], 16u - xc, __ATOMIC_RELAXED, __HIP_MEMORY_SCOPE_AGENT); }
    unsigned long long t_prev = 0ull, t_probe = 0ull;
    if (TPROBE == 200 && bid == 0) { const unsigned long long t0 = __builtin_amdgcn_s_memrealtime(); while (__builtin_amdgcn_s_memrealtime() - t0 < 20000ull) __builtin_amdgcn_s_sleep(8); }
    if (TPROBE >= 0) t_prev = __builtin_amdgcn_s_memrealtime();
    const unsigned long long t_start = t_prev;
#ifndef GROUP_BAR
#define GROUP_BAR 1
#endif
    unsigned gepoch = 0u;
    const int ng_ = (G % 8 == 0) ? 8 : 1;
    bool coloc = false;
#define SEAM(k) do { if (IN(k) && IN((k) + 1)) { if (!USE_XCD_BAR) grid.sync(); else if (GROUP_BAR && ng_ == 8 && (k) != 0 && (k) != 7) group_barrier((unsigned*)(ws + WS_CTL), bid % 8, (unsigned)(G / 8), gepoch, coloc); else xcd_barrier(xbar); \
        if ((k) == 0 && ng_ == 8) { unsigned* cb = (unsigned*)(ws + WS_CTL); const unsigned a = xb_ld(&cb[GB_XMAX(bid % 8)]), b2 = xb_ld(&cb[GB_XMIN(bid % 8)]); coloc = (a != 0u) && (a - 1u == 16u - b2); } } \
    if (TPROBE >= 0) { const unsigned long long tn = __builtin_amdgcn_s_memrealtime(); if (TPROBE == (k)) t_probe = tn - t_prev; t_prev = tn; } } while (0)

    const int ng = (G % 8 == 0) ? 8 : 1, grp = bid % ng, lb = bid / ng, LB = G / ng;
    const bool early = (lb & 1) != 0;
    const int srow = MP + (MS / ng) * grp, snrow = MS / ng;
    if (IN(0)) { p0_prologue(P, lds, G, bid, 0); }
    SEAM(0);
    const int gwave = bid * 8 + wave, NW = G * 8;
    const bf16_t* XBs = XB;
    if (IN(1)) {
        EpiInA E{ssq, (bf16_t*)(ws + WS_Q), (const float*)(ws + WS_GT), P.out};
        EpiMemKV E2{ssq + 5 * M, P.in[23], P.out + O_MKP, P.out + O_MVP, (bf16_t*)(ws + WS_MK), (bf16_t*)(ws + WS_MV)};
        const int mrow = (MMEM / ng) * grp, mnrow = MMEM / ng, mtask = (mnrow / 64) * 16, msplit = mtask * 5 / 16;
        if (early) { sample_gemm<4, 4>(lds, XBs, DM, (const bf16_t*)(ws + WS_WINA), 6, E, lb >> 1, LB >> 1, srow, snrow);
                     sample_gemm<4, 4>(lds, (const bf16_t*)(ws + WS_MEMB), DM, (const bf16_t*)(ws + WS_WMKV), 4, E2, lb >> 1, LB >> 1, mrow, mnrow, 0, msplit); }
        { pg8::Gemm g{XB, (const bf16_t*)(ws + WS_WINA), DM, DM}; pg8::StaticOrder S; S.init(MP, NINA, G, bid);
          pg8::gemm_phase<EpiInA, true, true>(lds, g, S, E); }
        if (!early) sample_gemm<4, 4>(lds, (const bf16_t*)(ws + WS_MEMB), DM, (const bf16_t*)(ws + WS_WMKV), 4, E2, lb >> 1, (LB + 1) >> 1, mrow, mnrow, msplit, mtask);
    }
    SEAM(1);
    if (IN(2)) {
        const int nA = 512 / ng, nB = 512 / ng, nD = 256 / ng, nU = nA + nB + 2 * nD, ns2 = (nU + LB - 1) / LB;
        for (int j = 0; j < ns2; ++j) { const int jj = (early && ns2 == 6) ? (j + 4) % 6 : j; const int u = lb + jj * LB; if (u >= nU) continue;
            if (u < nA) { const int v = u; unit_swa_prompt(P, lds, wsf, grp * (8 / ng) + (v >> 6), (v >> 2) & 15, v & 3); }
            else if (u < nA + nB) { const int v = u - nA; unit_mem_prompt(P, lds, wsf, 0, grp * (8 / ng) + (v >> 6), (v >> 2) & 15, v & 3); }
            else if (u < nA + nB + nD) { const int v = u - nA - nB; unit_mem_sample(P, lds, wsf, 0, grp * (NDEC / ng) + (v >> 1), v & 1); }
            else { const int v = u - nA - nB - nD; unit_swa_sample(P, lds, wsf, grp * (NDEC / ng) + (v >> 1), v & 1); }
        }
    }
    SEAM(2);
    if (IN(3)) {
        pg8::Gemm g{(const bf16_t*)(ws + WS_O), (const bf16_t*)(ws + WS_WOUTA), DM, DM}; pg8::StaticOrder S; S.init(MP, DM, G, bid);
        EpiRes<false, false> E{nullptr, nullptr, nullptr, XB, ssq + M};
        if (early) sample_gemm<2, 4>(lds, (const bf16_t*)(ws + WS_O), DM, (const bf16_t*)(ws + WS_WOUTA), 4, E, lb, LB, srow, snrow);
        pg8::gemm_phase<EpiRes<false, false>, true, true>(lds, g, S, E);
        if (!early) sample_gemm<2, 4>(lds, (const bf16_t*)(ws + WS_O), DM, (const bf16_t*)(ws + WS_WOUTA), 4, E, lb, LB, srow, snrow);
    }
    SEAM(3);
    if (IN(4)) {
        pg8::Gemm g{XB, (const bf16_t*)(ws + WS_WFFN), DM, DM}; pg8::StaticOrder S; S.init(MP, NFF, G, bid);
        EpiFfnConv E{ssq + M, (bf16_t*)(ws + WS_H), P.in[25], P.in[26], (float*)(ws + WS_SIDE), P.out + O_CONVP, (LAS float*)(lds + RING_BYTES)};
        if (early) sample_ffn(P, lds, 0, ssq + M, lb, LB, (snrow / 64) * grp, snrow / 64);
        pg8::gemm_phase<EpiFfnConv, true, true>(lds, g, S, E);
        if (!early) sample_ffn(P, lds, 0, ssq + M, lb, LB, (snrow / 64) * grp, snrow / 64);
    }
    SEAM(4);
    if (IN(5)) {
        pg8::Gemm g{(const bf16_t*)(ws + WS_H), (const bf16_t*)(ws + WS_WDOWN), DFF, DFF}; pg8::StaticOrder S; S.init(MP, DM, G, bid);
        ffn_fixup(P, 0, S);
        EpiRes<false, false> E{nullptr, nullptr, nullptr, XB, ssq + 2 * M};
        if (early) sample_gemm<2, 11>(lds, (const bf16_t*)(ws + WS_H), DFF, (const bf16_t*)(ws + WS_WDOWN), 4, E, lb, LB, srow, snrow);
        pg8::gemm_phase<EpiRes<false, false>, true, true>(lds, g, S, E);
        if (!early) sample_gemm<2, 11>(lds, (const bf16_t*)(ws + WS_H), DFF, (const bf16_t*)(ws + WS_WDOWN), 4, E, lb, LB, srow, snrow);
    }
    SEAM(5);
    if (IN(6)) {
        pg8::Gemm g{XB, (const bf16_t*)(ws + WS_WINB), DM, DM}; pg8::StaticOrder S; S.init(MP, NINB, G, bid);
        EpiInB E{ssq + 2 * M, (bf16_t*)(ws + WS_U), (bf16_t*)(ws + WS_GV), (bf16_t*)(ws + WS_XQ), P.in[22] + 64, ssq + 4 * M};
        pg8::gemm_phase<EpiInB, true, true>(lds, g, S, E);
        if (lb >= LB / 2) { sample_gemm<4, 4>(lds, XBs, DM, (const bf16_t*)(ws + WS_WINB), 7, E, lb - LB / 2, LB - LB / 2, srow, snrow);
                            p0_prologue(P, lds, (LB - LB / 2) * ng, (lb - LB / 2) * ng + grp, 1); }
    }
    SEAM(6);
    if (IN(7)) {
        const int nG = 256 / ng, nB = 512 / ng, nD = 256 / ng, nU = nG + nB + nD, ns7 = (nU + LB - 1) / LB;
        for (int j = 0; j < ns7; ++j) { const int jj = (early && ns7 == 4) ? (j + 3) % 4 : j; const int u = lb + jj * LB; if (u >= nU) continue;
            if (u < nG) { const int v = u; unit_gmlp_prompt(P, lds, grp * (8 / ng) + (v >> 5), v & 31); }
            else if (u < nG + nB) { const int v = u - nG; unit_mem_prompt(P, lds, wsf, 1, grp * (8 / ng) + (v >> 6), (v >> 2) & 15, v & 3); }
            else { const int v = u - nG - nB; unit_mem_sample(P, lds, wsf, 1, grp * (NDEC / ng) + (v >> 1), v & 1); }
        }
        gmlp_sample(P, LB, lb, grp * (NDEC / ng), NDEC / ng);
    }
    SEAM(7);
    if (IN(8)) {
        pg8::Gemm g{(const bf16_t*)(ws + WS_O), (const bf16_t*)(ws + WS_WOUTB), DM, DM}; pg8::StaticOrder S; S.init(MP, DM, G, bid);
        EpiRes<false, false> E{nullptr, nullptr, nullptr, XB, ssq + 3 * M};
        if (early) sample_gemm<2, 4>(lds, (const bf16_t*)(ws + WS_O), DM, (const bf16_t*)(ws + WS_WOUTB), 4, E, lb, LB, srow, snrow);
        pg8::gemm_phase<EpiRes<false, false>, true, true>(lds, g, S, E);
        if (!early) sample_gemm<2, 4>(lds, (const bf16_t*)(ws + WS_O), DM, (const bf16_t*)(ws + WS_WOUTB), 4, E, lb, LB, srow, snrow);
    }
    SEAM(8);
    if (IN(9)) {
        pg8::Gemm g{XB, (const bf16_t*)(ws + WS_WFFN) + (size_t)NFF * DM, DM, DM}; pg8::StaticOrder S; S.init(MP, NFF, G, bid);
        EpiFfnConv E{ssq + 3 * M, (bf16_t*)(ws + WS_H), P.in[25] + 3 * DFF, P.in[26] + DFF, (float*)(ws + WS_SIDE), P.out + O_CONVP + (size_t)NBATCH * 2 * DFF, (LAS float*)(lds + RING_BYTES)};
        if (early) sample_ffn(P, lds, 1, ssq + 3 * M, lb, LB, (snrow / 64) * grp, snrow / 64);
        pg8::gemm_phase<EpiFfnConv, true, true>(lds, g, S, E);
        if (!early) sample_ffn(P, lds, 1, ssq + 3 * M, lb, LB, (snrow / 64) * grp, snrow / 64);
    }
    SEAM(9);
    if (IN(10)) {
        pg8::Gemm g{(const bf16_t*)(ws + WS_H), (const bf16_t*)(ws + WS_WDOWN) + (size_t)DM * DFF, DFF, DFF}; pg8::StaticOrder S; S.init(MP, DM, G, bid);
        ffn_fixup(P, 1, S);
        EpiRes<false, true> E{nullptr, nullptr, P.out + O_Y, XB, nullptr};
        if (early) sample_gemm<2, 11>(lds, (const bf16_t*)(ws + WS_H), DFF, (const bf16_t*)(ws + WS_WDOWN) + (size_t)DM * DFF, 4, E, lb, LB, srow, snrow);
        pg8::gemm_phase<EpiRes<false, true>, true, true>(lds, g, S, E);
        if (!early) sample_gemm<2, 11>(lds, (const bf16_t*)(ws + WS_H), DFF, (const bf16_t*)(ws + WS_WDOWN) + (size_t)DM * DFF, 4, E, lb, LB, srow, snrow);
    }
    if ((TPROBE >= 0) && bid == 0) {
        __syncthreads();
        const unsigned long long tn = __builtin_amdgcn_s_memrealtime();
        if (TPROBE == 10) t_probe = tn - t_prev;
        if (TPROBE == 100) t_probe = tn - t_start;
        while (__builtin_amdgcn_s_memrealtime() - tn < t_probe) __builtin_amdgcn_s_sleep(8);
    }
#undef IN
#undef SEAM
}

extern "C" void kernel_launch(void* const* d_in, const int* in_sizes, int n_in, void* d_out, int out_size, void* d_ws, size_t ws_size, hipStream_t stream) {
    static int grid = 0;
    if (grid == 0) {
        if (n_in != 28 || (size_t)out_size != O_END || ws_size < WS_END) { fprintf(stderr, "kernel_launch: unexpected shapes: n_in %d out %d ws %zu (need %zu)\n", n_in, out_size, ws_size, (size_t)WS_END); grid = -1; return; }
        int dev = 0, cus = 0, per_cu = 0;
        hipGetDevice(&dev); hipDeviceGetAttribute(&cus, hipDeviceAttributeMultiprocessorCount, dev);
        if (hipFuncSetAttribute((const void*)mk_fwd, hipFuncAttributeMaxDynamicSharedMemorySize, LDS_BYTES) != hipSuccess) { fprintf(stderr, "kernel_launch: hipFuncSetAttribute failed\n"); grid = -1; return; }
        hipOccupancyMaxActiveBlocksPerMultiprocessor(&per_cu, (const void*)mk_fwd, 512, LDS_BYTES);
        (void)hipGetLastError();
        if (per_cu < 1) { fprintf(stderr, "kernel_launch: occupancy query says %d blocks per CU\n", per_cu); per_cu = 1; }
        grid = cus;
    }
    if (grid < 0) return;
    if (hipMemsetAsync((char*)d_ws + WS_CTL, 0, CTL_BYTES, stream) != hipSuccess) { fprintf(stderr, "kernel_launch: memset failed\n"); return; }
    Params p{};
    for (int i = 0; i < 28; ++i) p.in[i] = (const float*)d_in[i];
    p.out = (float*)d_out; p.ws = (unsigned char*)d_ws;
#if MK_N_LAUNCHES == 1
    p.ph_lo = 0; p.ph_hi = NPHASE;
    void* args[] = {&p};
    hipError_t e = hipLaunchCooperativeKernel((const void*)mk_fwd, dim3(grid), dim3(512), args, LDS_BYTES, stream);
    if (e != hipSuccess) fprintf(stderr, "cooperative launch failed: %s (grid %d)\n", hipGetErrorString(e), grid);
#else
    for (int ph = 0; ph < NPHASE; ++ph) {
        p.ph_lo = ph; p.ph_hi = ph + 1;
        hipLaunchKernelGGL(mk_fwd, dim3(grid), dim3(512), LDS_BYTES, stream, p);
    }
#endif
}
```

```cpp
#include <hip/hip_runtime.h>
#include <hip/hip_cooperative_groups.h>
#include <cstdio>
#include <cstdint>
namespace cg = cooperative_groups;

#ifndef MK_N_LAUNCHES
#define MK_N_LAUNCHES 1
#endif

#ifndef TPROBE
#define TPROBE -1
#endif
#ifndef STAGGER_NS
#define STAGGER_NS 0
#endif
#ifndef DUP
#define DUP -1
#endif
#define LAS __attribute__((address_space(3)))
typedef unsigned short bf16_t;
typedef short bf16x8 __attribute__((ext_vector_type(8)));
typedef short s16x4 __attribute__((ext_vector_type(4)));
typedef float f32x4 __attribute__((ext_vector_type(4)));
typedef float f32x2 __attribute__((ext_vector_type(2)));
typedef float f32x16 __attribute__((ext_vector_type(16)));
typedef unsigned u32x4 __attribute__((ext_vector_type(4)));
typedef unsigned u32x2 __attribute__((ext_vector_type(2)));
typedef __bf16 bf16x2_t __attribute__((ext_vector_type(2)));

constexpr int DM = 1024, NBATCH = 8, SEQ = 4096, MP = NBATCH * SEQ, NDEC = 128, DSEQ = 4, MS = NDEC * DSEQ, M = MP + MS;
constexpr int NMEM = 256, MMEM = NBATCH * NMEM;
constexpr int DFF = 2816, NFF = 2 * DFF;
constexpr int NINA = 1536, NINB = 1792;
constexpr float EPS = 1e-6f;
constexpr float LOG2E = 1.4426950408889634f;
constexpr int NPHASE = 11;

constexpr size_t O_Y = 0, O_WKP = 34078720, O_WVP = 34340864, O_CVP = 34603008, O_MKP = 35389440, O_MVP = 36438016, O_CONVP = 37486592,
                 O_WKS = 37576704, O_WVS = 41771008, O_CVS = 45965312, O_CONVS = 46358528, O_END = 47800320;

constexpr size_t MiB = 1u << 20;
constexpr size_t WS_SSQ = 0, WS_GT = 1 * MiB, WS_CTL = 1 * MiB + 65536, CTL_BYTES = 32768;
constexpr size_t WS_WINA = 2 * MiB, WS_WOUTA = 5 * MiB, WS_WINB = 7 * MiB, WS_WOUTB = 11 * MiB, WS_WMKV = 13 * MiB, WS_WFFN = 15 * MiB,
                 WS_WDOWN = 37 * MiB, WS_WST = 48 * MiB;
constexpr size_t WS_MEMB = 50 * MiB, WS_MK = 54 * MiB, WS_MV = 56 * MiB;
constexpr size_t WS_XB = 58 * MiB;
constexpr size_t WS_H = 124 * MiB;
constexpr size_t WS_Q = WS_H, WS_K = WS_Q + (size_t)M * 768 * 2, WS_V = WS_K + (size_t)M * 256 * 2, WS_XQ = WS_V + (size_t)M * 256 * 2,
                 WS_O = WS_XQ + (size_t)M * 256 * 2, WS_U = WS_O + (size_t)M * 1024 * 2, WS_GV = WS_U + (size_t)M * 768 * 2;
constexpr size_t WS_SIDE = 384 * MiB, SIDE_N = (size_t)128 * 2 * DFF;
constexpr size_t WS_END = WS_SIDE + 3 * SIDE_N * 4;
static_assert(WS_GV + (size_t)M * 768 * 2 <= WS_SIDE && WS_H + (size_t)M * DFF * 2 <= WS_SIDE, "mixer buffers / hidden below the side buffers");
static_assert(WS_END <= 512 * MiB, "ws");

namespace pg8 {
constexpr int BM = 256, BK = 64, HALF = 128, HTB = HALF * BK * 2, STAGE_BYTES = 8 * HTB, NXCD = 8, WGM = 8;
__host__ __device__ __forceinline__ int lds_byte(int r, int c) { const int st = (r >> 4) * 2 + (c >> 5), rr = r & 15, cc = c & 31, ob = rr * 64 + cc * 2; return st * 1024 + (ob ^ (((ob >> 9) & 1) << 5)); }
__host__ __device__ __forceinline__ void stage_rc(int b, int& R, int& C) { const int st = b / 1024, sb = b % 1024, swz = sb ^ (((sb >> 9) & 1) << 5); R = (st >> 1) * 16 + swz / 64; C = (st & 1) * 32 + (swz % 64) / 2; }
__host__ __device__ __forceinline__ int perm32(int rho) { const int n = rho >> 4, i = rho & 15; return 8 * (i >> 2) + 4 * n + (i & 3); }

struct Unit { int pm, pn; };
struct Gemm { const bf16_t* A; const bf16_t* Bt; int lda, K; };

struct StaticOrder {
    int nM, nN, nwg, G, c;
    __device__ void init(int Mr, int N, int G_, int c_) { nM = Mr / BM; nN = N / BM; nwg = nM * nN; G = G_; c = c_; }
    __device__ bool next(int i, Unit& u) const {
        const long L = (long)i * G + c; if (L >= nwg) return false;
        int wgid = (int)L; { const int q = nwg / NXCD, r = nwg % NXCD, xcd = wgid % NXCD, off = wgid / NXCD; wgid = (xcd < r ? xcd * (q + 1) : r * (q + 1) + (xcd - r) * q) + off; }
        const int nig = WGM * nN, gid = wgid / nig, fm = gid * WGM, gsz = (nM - fm) < WGM ? (nM - fm) : WGM;
        u.pm = fm + ((wgid % nig) % gsz); u.pn = (wgid % nig) / gsz; return true;
    }
};

template <class Epi, bool ALIGN_EPI, bool SP2>
__device__ __forceinline__ void gemm_phase(LAS unsigned char* lds, const Gemm g, const StaticOrder& S, const Epi& E) {
    const int tid = threadIdx.x, wid = __builtin_amdgcn_readfirstlane(tid >> 6), lane = tid & 63, wr = wid >> 2, wc = wid & 3, fr = lane & 15, fq = lane >> 4;
    const int K = g.K, nt = K / BK, lda = g.lda;
    unsigned voffA[2], voffB[2];
#pragma unroll
    for (int i = 0; i < 2; ++i) { int R, C; stage_rc(tid * 16 + i * 8192, R, C); const int Rb = (R & ~31) + perm32(R & 31);
        voffA[i] = (unsigned)(R * lda + C) * 2u; voffB[i] = (unsigned)(Rb * K + C) * 2u; }
    const size_t kstep = (size_t)(BK * 2);
    const size_t hstepA = (size_t)HALF * lda * 2, hstepB = (size_t)HALF * K * 2;
    const size_t tstepA = 2 * hstepA, tstepB = 2 * hstepB;
    const unsigned ldsw = (unsigned)wid * 1024u;
    const int aoff = lds_byte(wr * 64 + fr, fq * 8), boff = lds_byte(wc * 32 + fr, fq * 8);
#define PG8_SA(b, h) (((b) * 2 + (h)) * HTB)
#define PG8_SB(b, h) ((4 + (b) * 2 + (h)) * HTB)
#define PG8_STAGE(bufoff, gbase, voff) do { _Pragma("unroll") for (int _i = 0; _i < 2; ++_i) \
        __builtin_amdgcn_global_load_lds((const unsigned*)((const char*)(gbase) + (voff)[_i]), (LAS unsigned*)(lds + (bufoff) + ldsw + _i * 8192), 16, 0, 0); } while (0)
#define PG8_LDA(dst, b, h) do { _Pragma("unroll") for (int m = 0; m < 4; ++m) _Pragma("unroll") for (int k = 0; k < 2; ++k) dst[m][k] = *(const LAS bf16x8*)(lds + PG8_SA(b, h) + aoff + m * 2048 + k * 1024); } while (0)
#define PG8_LDB(dst, b, h) do { _Pragma("unroll") for (int n = 0; n < 2; ++n) _Pragma("unroll") for (int k = 0; k < 2; ++k) dst[n][k] = *(const LAS bf16x8*)(lds + PG8_SB(b, h) + boff + n * 2048 + k * 1024); } while (0)
#define PG8_MMA(ai, bj, At, Bt) do { __builtin_amdgcn_s_setprio(1); _Pragma("unroll") for (int m = 0; m < 4; ++m) _Pragma("unroll") for (int n = 0; n < 2; ++n) _Pragma("unroll") for (int k = 0; k < 2; ++k) \
        acc[ai][bj][m][n] = __builtin_amdgcn_mfma_f32_16x16x32_bf16(Bt[n][k], At[m][k], acc[ai][bj][m][n], 0, 0, 0); __builtin_amdgcn_s_setprio(0); } while (0)
#define PG8_WAIT_V(n) asm volatile("s_waitcnt vmcnt(" #n ")" ::: "memory")
#define PG8_WAIT_L(n) asm volatile("s_waitcnt lgkmcnt(" #n ")" ::: "memory")
#define PG8_BAR __builtin_amdgcn_s_barrier()
#define PG8_SCHED __builtin_amdgcn_sched_barrier(0)
    Unit cur, nxt; int ui = 0;
    if (!S.next(0, cur)) return;
    f32x4 acc[2][2][4][2];
#pragma unroll
    for (int a = 0; a < 2; ++a)
#pragma unroll
        for (int b = 0; b < 2; ++b)
#pragma unroll
            for (int m = 0; m < 4; ++m)
#pragma unroll
                for (int n = 0; n < 2; ++n) acc[a][b][m][n] = (f32x4){0.f, 0.f, 0.f, 0.f};
    bf16x8 At[4][2], B0[2][2], B1[2][2];
    const char* cA = (const char*)g.A + (size_t)cur.pm * tstepA; const char* cB = (const char*)g.Bt + (size_t)cur.pn * tstepB;
    if constexpr (SP2) {
        PG8_STAGE(PG8_SB(0, 0), cB, voffB); PG8_STAGE(PG8_SB(0, 1), cB + hstepB, voffB); PG8_STAGE(PG8_SA(0, 0), cA, voffA); PG8_STAGE(PG8_SA(0, 1), cA + hstepA, voffA);
        if (wr == 1) PG8_BAR;
        PG8_WAIT_V(2); PG8_BAR;
        PG8_STAGE(PG8_SB(1, 0), cB + kstep, voffB); PG8_STAGE(PG8_SA(1, 0), cA + kstep, voffA); PG8_STAGE(PG8_SB(1, 1), cB + hstepB + kstep, voffB);
        PG8_WAIT_V(6); PG8_BAR;
    } else {
        PG8_STAGE(PG8_SB(0, 0), cB, voffB); PG8_STAGE(PG8_SA(0, 0), cA, voffA); PG8_STAGE(PG8_SB(0, 1), cB + hstepB, voffB); PG8_STAGE(PG8_SA(0, 1), cA + hstepA, voffA);
        if (wr == 1) PG8_BAR;
        PG8_WAIT_V(4); PG8_BAR;
        PG8_STAGE(PG8_SB(1, 0), cB + kstep, voffB); PG8_STAGE(PG8_SA(1, 0), cA + kstep, voffA); PG8_STAGE(PG8_SB(1, 1), cB + hstepB + kstep, voffB);
        PG8_WAIT_V(6); PG8_BAR;
    }
    for (;;) {
        const bool has_next = S.next(ui + 1, nxt);
        const char* nA = has_next ? (const char*)g.A + (size_t)nxt.pm * tstepA : cA; const char* nB = has_next ? (const char*)g.Bt + (size_t)nxt.pn * tstepB : cB;
        for (int t = 0; t < nt; t += 2) {
            const bool last = (t == nt - 2);
            const char* a1 = cA + (size_t)(t + 1) * kstep;
            const char* a2 = last ? nA : cA + (size_t)(t + 2) * kstep; const char* b2 = last ? nB : cB + (size_t)(t + 2) * kstep;
            const char* a3 = a2 + kstep; const char* b3 = b2 + kstep;
            if constexpr (SP2) {
            PG8_LDB(B0, 0, 0); PG8_LDB(B1, 0, 1); PG8_SCHED; PG8_LDA(At, 0, 0); PG8_STAGE(PG8_SA(1, 1), a1 + hstepA, voffA);
            PG8_WAIT_V(8); PG8_WAIT_L(0); PG8_BAR; PG8_MMA(0, 0, At, B0); PG8_MMA(0, 1, At, B1); PG8_BAR; PG8_SCHED;
            PG8_LDA(At, 0, 1); PG8_STAGE(PG8_SB(0, 0), b2, voffB); PG8_STAGE(PG8_SB(0, 1), b2 + hstepB, voffB); PG8_STAGE(PG8_SA(0, 0), a2, voffA);
            PG8_WAIT_V(8); PG8_WAIT_L(0); PG8_BAR; PG8_MMA(1, 0, At, B0); PG8_MMA(1, 1, At, B1); PG8_BAR; PG8_SCHED;
            PG8_LDB(B0, 1, 0); PG8_LDB(B1, 1, 1); PG8_SCHED; PG8_LDA(At, 1, 0); PG8_STAGE(PG8_SA(0, 1), a2 + hstepA, voffA);
            PG8_WAIT_V(8); PG8_WAIT_L(0); PG8_BAR; PG8_MMA(0, 0, At, B0); PG8_MMA(0, 1, At, B1); PG8_BAR; PG8_SCHED;
            PG8_LDA(At, 1, 1); PG8_STAGE(PG8_SB(1, 0), b3, voffB); PG8_STAGE(PG8_SB(1, 1), b3 + hstepB, voffB); PG8_STAGE(PG8_SA(1, 0), a3, voffA);
            PG8_WAIT_V(8); PG8_WAIT_L(0); PG8_BAR; PG8_MMA(1, 0, At, B0); PG8_MMA(1, 1, At, B1); PG8_BAR; PG8_SCHED;
            } else {
            PG8_LDB(B0, 0, 0); PG8_SCHED; PG8_LDA(At, 0, 0); PG8_STAGE(PG8_SA(1, 1), a1 + hstepA, voffA);
            PG8_WAIT_L(8); PG8_BAR; PG8_WAIT_L(0); PG8_MMA(0, 0, At, B0); PG8_BAR; PG8_SCHED;
            PG8_LDB(B1, 0, 1); PG8_STAGE(PG8_SB(0, 0), b2, voffB);
            PG8_BAR; PG8_WAIT_L(0); PG8_MMA(0, 1, At, B1); PG8_BAR;
            PG8_LDA(At, 0, 1); PG8_STAGE(PG8_SA(0, 0), a2, voffA);
            PG8_BAR; PG8_WAIT_L(0); PG8_MMA(1, 0, At, B0); PG8_BAR; PG8_SCHED;
            PG8_STAGE(PG8_SB(0, 1), b2 + hstepB, voffB);
            PG8_WAIT_V(6); PG8_BAR; PG8_MMA(1, 1, At, B1); PG8_BAR;
            PG8_LDB(B0, 1, 0); PG8_SCHED; PG8_LDA(At, 1, 0); PG8_STAGE(PG8_SA(0, 1), a2 + hstepA, voffA);
            PG8_WAIT_L(8); PG8_BAR; PG8_WAIT_L(0); PG8_MMA(0, 0, At, B0); PG8_BAR; PG8_SCHED;
            PG8_LDB(B1, 1, 1); PG8_STAGE(PG8_SB(1, 0), b3, voffB);
            PG8_BAR; PG8_WAIT_L(0); PG8_MMA(0, 1, At, B1); PG8_BAR;
            PG8_LDA(At, 1, 1); PG8_STAGE(PG8_SA(1, 0), a3, voffA);
            PG8_BAR; PG8_WAIT_L(0); PG8_MMA(1, 0, At, B0); PG8_BAR; PG8_SCHED;
            PG8_STAGE(PG8_SB(1, 1), b3 + hstepB, voffB);
            PG8_WAIT_V(6); PG8_BAR; PG8_MMA(1, 1, At, B1); PG8_BAR;
            }
        }
        if constexpr (ALIGN_EPI) { if (wr == 0) PG8_BAR; }
        E(acc, cur, wr, wc, fr, fq);
        if (!has_next) break;
#pragma unroll
        for (int a = 0; a < 2; ++a)
#pragma unroll
            for (int b = 0; b < 2; ++b)
#pragma unroll
                for (int m = 0; m < 4; ++m)
#pragma unroll
                    for (int n = 0; n < 2; ++n) acc[a][b][m][n] = (f32x4){0.f, 0.f, 0.f, 0.f};
        cur = nxt; cA = nA; cB = nB; ++ui;
        if constexpr (ALIGN_EPI) { if (wr == 1) PG8_BAR; }
    }
    PG8_WAIT_V(0);
    if constexpr (!ALIGN_EPI) { if (wr == 0) PG8_BAR; }
    PG8_BAR;
#undef PG8_SA
#undef PG8_SB
#undef PG8_STAGE
#undef PG8_LDA
#undef PG8_LDB
#undef PG8_MMA
#undef PG8_WAIT_V
#undef PG8_WAIT_L
#undef PG8_BAR
#undef PG8_SCHED
}
}
using pg8::Unit;

constexpr int RING_BYTES = 131072, WSF_OFF = RING_BYTES, OSTG2_OFF = RING_BYTES + 4096, BST_OFF = RING_BYTES + 16384, LDS_BYTES = BST_OFF + 256;
__device__ __forceinline__ unsigned cvtpk(float lo, float hi) { f32x2 v = {lo, hi}; bf16x2_t b = __builtin_convertvector(v, bf16x2_t); return __builtin_bit_cast(unsigned, b); }
__device__ __forceinline__ u32x4 pack8(const f32x4 a, const f32x4 b) { u32x4 w; w.x = cvtpk(a[0], a[1]); w.y = cvtpk(a[2], a[3]); w.z = cvtpk(b[0], b[1]); w.w = cvtpk(b[2], b[3]); return w; }
__device__ __forceinline__ float bf2f(unsigned short h) { return __uint_as_float((unsigned)h << 16); }
__device__ __forceinline__ float bflo(unsigned w) { return __uint_as_float(w << 16); }
__device__ __forceinline__ float bfhi(unsigned w) { return __uint_as_float(w & 0xffff0000u); }
__device__ __forceinline__ float wave_sum(float v) {
#pragma unroll
    for (int o = 1; o < 64; o <<= 1) v += __shfl_xor(v, o);
    return v;
}
__device__ __forceinline__ f32x2 gelu_pk(f32x2 v) {
    const f32x2 av = __builtin_elementwise_abs(v), d = av * 0.2316418882f + 1.0f;
    f32x2 t; t.x = __builtin_amdgcn_rcpf(d.x); t.y = __builtin_amdgcn_rcpf(d.y);
    f32x2 q = t * 0.5307027145f + (-0.7265760135f); q = q * t + 0.7107068705f; q = q * t + (-0.142248368f); q = q * t + 0.127414796f; q = q * t;
    const f32x2 s = (v * v) * (-0.72134752044f);
    f32x2 e; e.x = __builtin_amdgcn_exp2f(s.x); e.y = __builtin_amdgcn_exp2f(s.y);
    const f32x2 m = v * (q * e), r = v - m;
    f32x2 o; o.x = v.x < 0.f ? m.x : r.x; o.y = v.y < 0.f ? m.y : r.y; return o;
}
__device__ __forceinline__ f32x4 gelu4(f32x4 v) { const f32x2 a = gelu_pk((f32x2){v[0], v[1]}), b = gelu_pk((f32x2){v[2], v[3]}); return (f32x4){a.x, a.y, b.x, b.y}; }
__device__ __forceinline__ float dot4(f32x4 v) { return (v[0] * v[0] + v[1] * v[1]) + (v[2] * v[2] + v[3] * v[3]); }
__device__ __forceinline__ unsigned short f2bf_s(float f) { return (unsigned short)(cvtpk(f, 0.f) & 0xffffu); }
__device__ __forceinline__ float alibi_slope(int h) { return h < 8 ? exp2f(-(float)(h + 1)) : exp2f(-0.5f - (float)(h - 8)); }

struct Params {
    const float* in[28];
    float* out;
    unsigned char* ws;
    int ph_lo, ph_hi;
};

#define EPI_ARGS const f32x4 (&acc)[2][2][4][2], const Unit& u, int wr, int wc, int fr, int fq
#define FOR_AI_M _Pragma("unroll") for (int ai = 0; ai < 2; ++ai) _Pragma("unroll") for (int m = 0; m < 4; ++m)
#define BIG_ROWS(E) do { const int row0_ = u.pm * 256 + wr * 64 + fr; float rs_[2][4]; \
    FOR_AI_M rs_[ai][m] = (E).ssq[row0_ + ai * 128 + m * 16]; \
    FOR_AI_M { f32x4 v_[2][2]; \
    _Pragma("unroll") for (int bj = 0; bj < 2; ++bj) _Pragma("unroll") for (int n = 0; n < 2; ++n) v_[bj][n] = acc[ai][bj][m][n]; \
    (E).row(v_, rsqrtf(rs_[ai][m] * (1.f / 1024.f) + EPS), row0_ + ai * 128 + m * 16, u.pn, wc, fq); } } while (0)

__device__ __forceinline__ void head_norm(f32x4 (&v)[2][2], const float* gp, int fq) {
    float ss = (dot4(v[0][0]) + dot4(v[0][1])) + (dot4(v[1][0]) + dot4(v[1][1]));
    ss += __shfl_xor(ss, 16); ss += __shfl_xor(ss, 32);
    const float inv = rsqrtf(ss * (1.f / 64.f) + EPS);
#pragma unroll
    for (int bj = 0; bj < 2; ++bj)
#pragma unroll
        for (int n = 0; n < 2; ++n) { const f32x4 g = *(const f32x4*)(gp + 32 * bj + 8 * fq + 4 * n); v[bj][n] = v[bj][n] * inv * g; }
}

struct EpiInA {
    const float* ssq; bf16_t* Qb; const float* gt; float* out;
    __device__ __forceinline__ void row(f32x4 (&v)[2][2], float rs, int row, int pn, int wc, int fq) const {
        const int typ = pn < 3 ? 0 : pn - 2;
        const size_t doff = typ == 0 ? 0 : (size_t)M * 768 + (size_t)(typ - 1) * M * 256;
        const int ld = typ == 0 ? 768 : 256, cb = typ == 0 ? (pn * 4 + wc) * 64 : wc * 64;
#pragma unroll
        for (int bj = 0; bj < 2; ++bj)
#pragma unroll
            for (int n = 0; n < 2; ++n) v[bj][n] = v[bj][n] * rs;
        if (typ != 2) head_norm(v, gt + typ * 64, fq);
#pragma unroll
        for (int bj = 0; bj < 2; ++bj) *(u32x4*)(Qb + doff + (size_t)row * ld + cb + 32 * bj + 8 * fq) = pack8(v[bj][0], v[bj][1]);
        if (typ == 1 || typ == 2) {
            long wo = -1;
            if (row >= MP) { const int ns = row - MP; wo = (long)O_WKS + (long)(typ - 1) * (long)(O_WVS - O_WKS) + (long)((ns >> 2) * 128 + 124 + (ns & 3)) * 256; }
            else if ((row & 4095) >= 3968) { const int b = row >> 12, t = row & 4095; wo = (long)O_WKP + (long)(typ - 1) * (long)(O_WVP - O_WKP) + (long)(b * 128 + t - 3968) * 256; }
            if (wo >= 0) { float* wout = out + wo;
#pragma unroll
                for (int bj = 0; bj < 2; ++bj)
#pragma unroll
                    for (int n = 0; n < 2; ++n) *(f32x4*)(wout + wc * 64 + 32 * bj + 8 * fq + 4 * n) = v[bj][n];
            }
        }
    }
    __device__ __forceinline__ void operator()(EPI_ARGS) const { BIG_ROWS(*this); }
};

struct EpiMemKV {
    const float* ssq; const float* xk; float *outk, *outv; bf16_t *MK, *MV;
    __device__ __forceinline__ void row(f32x4 (&v)[2][2], float rs, int row, int pn, int wc, int fq) const {
        const int layer = pn >> 1; const bool isv = pn & 1;
        float* of = (isv ? outv : outk) + (size_t)layer * MMEM * 256; bf16_t* ob = (isv ? MV : MK) + (size_t)layer * MMEM * 256;
#pragma unroll
        for (int bj = 0; bj < 2; ++bj)
#pragma unroll
            for (int n = 0; n < 2; ++n) v[bj][n] = v[bj][n] * rs;
        if (!isv) head_norm(v, xk + layer * 64, fq);
#pragma unroll
        for (int bj = 0; bj < 2; ++bj) {
            const size_t o = (size_t)row * 256 + wc * 64 + 32 * bj + 8 * fq;
            *(u32x4*)(ob + o) = pack8(v[bj][0], v[bj][1]);
            *(f32x4*)(of + o) = v[bj][0]; *(f32x4*)(of + o + 4) = v[bj][1];
        }
    }
    __device__ __forceinline__ void operator()(EPI_ARGS) const { BIG_ROWS(*this); }
};

__device__ __forceinline__ void rowsum4_atomic(float s0, float s1, float s2, float s3, float* ssq_rbase_fr, int fq) {
    s0 += __shfl_xor(s0, 16); s1 += __shfl_xor(s1, 16); s2 += __shfl_xor(s2, 16); s3 += __shfl_xor(s3, 16);
    s0 += __shfl_xor(s0, 32); s1 += __shfl_xor(s1, 32); s2 += __shfl_xor(s2, 32); s3 += __shfl_xor(s3, 32);
    const float sel = fq == 0 ? s0 : fq == 1 ? s1 : fq == 2 ? s2 : s3;
    atomicAdd(ssq_rbase_fr + 16 * fq, sel);
}
template <bool IN32, bool OUT32>
struct EpiRes {
    const float* xin_p; const float* xin_s; float* xout; bf16_t* xb; float* ssq;
    __device__ __forceinline__ void finish(f32x4 x0, f32x4 x1, int row, int col, float& ss) const {
        if (OUT32) { float* o = xout + (size_t)row * DM + col; *(f32x4*)o = x0; *(f32x4*)(o + 4) = x1; }
        else { *(u32x4*)(xb + (size_t)row * DM + col) = pack8(x0, x1); ss += dot4(x0) + dot4(x1); }
    }
    __device__ __forceinline__ void rowsum(float ss, int row, int fq) const { if (!OUT32) { ss += __shfl_xor(ss, 16); ss += __shfl_xor(ss, 32); if (fq == 0) atomicAdd(ssq + row, ss); } }
    __device__ __forceinline__ void row(f32x4 (&v)[2][2], float, int row, int pn, int wc, int fq) const {
        const int col0 = pn * 256 + wc * 32 + 8 * fq; float ss = 0.f;
#pragma unroll
        for (int bj = 0; bj < 2; ++bj) {
            f32x4 x0, x1;
            if (IN32) { const float* src = (row < MP ? xin_p + (size_t)row * DM : xin_s + (size_t)(row - MP) * DM) + col0 + 128 * bj; x0 = *(const f32x4*)src; x1 = *(const f32x4*)(src + 4); }
            else { const u32x4 w = *(const u32x4*)(xb + (size_t)row * DM + col0 + 128 * bj); x0 = (f32x4){bflo(w.x), bfhi(w.x), bflo(w.y), bfhi(w.y)}; x1 = (f32x4){bflo(w.z), bfhi(w.z), bflo(w.w), bfhi(w.w)}; }
            finish(x0 + v[bj][0], x1 + v[bj][1], row, col0 + 128 * bj, ss);
        }
        rowsum(ss, row, fq);
    }
    __device__ __forceinline__ void operator()(EPI_ARGS) const {
        const int row0 = u.pm * 256 + wr * 64 + fr, col0 = u.pn * 256 + wc * 32 + 8 * fq;
        if (IN32) {
#pragma unroll
            for (int ai = 0; ai < 2; ++ai) {
                f32x4 r[4][2][2];
#pragma unroll
                for (int m = 0; m < 4; ++m)
#pragma unroll
                    for (int bj = 0; bj < 2; ++bj) { const float* src = xin_p + (size_t)(row0 + ai * 128 + m * 16) * DM + col0 + 128 * bj; r[m][bj][0] = *(const f32x4*)src; r[m][bj][1] = *(const f32x4*)(src + 4); }
                float ssm[4];
#pragma unroll
                for (int m = 0; m < 4; ++m) { const int row = row0 + ai * 128 + m * 16; ssm[m] = 0.f;
#pragma unroll
                    for (int bj = 0; bj < 2; ++bj) finish(r[m][bj][0] + acc[ai][bj][m][0], r[m][bj][1] + acc[ai][bj][m][1], row, col0 + 128 * bj, ssm[m]); }
                if (!OUT32) rowsum4_atomic(ssm[0], ssm[1], ssm[2], ssm[3], ssq + row0 + ai * 128, fq);
            }
        } else {
#pragma unroll
            for (int ai = 0; ai < 2; ++ai) {
                u32x4 r[4][2];
#pragma unroll
                for (int m = 0; m < 4; ++m)
#pragma unroll
                    for (int bj = 0; bj < 2; ++bj) r[m][bj] = *(const u32x4*)(xb + (size_t)(row0 + ai * 128 + m * 16) * DM + col0 + 128 * bj);
                float ssm[4];
#pragma unroll
                for (int m = 0; m < 4; ++m) { const int row = row0 + ai * 128 + m * 16; ssm[m] = 0.f;
#pragma unroll
                    for (int bj = 0; bj < 2; ++bj) { const u32x4 w = r[m][bj];
                        const f32x4 x0 = (f32x4){bflo(w.x), bfhi(w.x), bflo(w.y), bfhi(w.y)}, x1 = (f32x4){bflo(w.z), bfhi(w.z), bflo(w.w), bfhi(w.w)};
                        finish(x0 + acc[ai][bj][m][0], x1 + acc[ai][bj][m][1], row, col0 + 128 * bj, ssm[m]); } }
                if (!OUT32) rowsum4_atomic(ssm[0], ssm[1], ssm[2], ssm[3], ssq + row0 + ai * 128, fq);
                asm volatile("" ::: "memory");
            }
        }
    }
};

template <int CTRL> __device__ __forceinline__ float dpp_f(float x) { return __int_as_float(__builtin_amdgcn_update_dpp(0, __float_as_int(x), CTRL, 0xf, 0xf, false)); }
__device__ __forceinline__ float silu_f(float c) { return c * __builtin_amdgcn_rcpf(1.f + __builtin_amdgcn_exp2f(-c * LOG2E)); }

struct EpiFfnConv {
    const float* ssq; bf16_t* H; const float* cw; const float* cbp; float* side; float* convp; LAS float* xch;
    __device__ __forceinline__ void operator()(EPI_ARGS) const {
        const int pm = u.pm, ts = pm & 15, col0 = u.pn * 128 + wc * 32 + 8 * fq;
        const int rowbase = pm * 256 + wr * 64 + fr;
        float rsv[2][4];
        FOR_AI_M rsv[ai][m] = ssq[rowbase + ai * 128 + m * 16];
        float w0[8], w1[8], w2[8], cb[8];
#pragma unroll
        for (int e = 0; e < 8; e += 4) { const f32x4 a0 = *(const f32x4*)(cw + col0 + e), a1 = *(const f32x4*)(cw + DFF + col0 + e), a2 = *(const f32x4*)(cw + 2 * DFF + col0 + e), a3 = *(const f32x4*)(cbp + col0 + e);
#pragma unroll
            for (int j = 0; j < 4; ++j) { w0[e + j] = a0[j]; w1[e + j] = a1[j]; w2[e + j] = a2[j]; cb[e + j] = a3[j]; } }
        FOR_AI_M rsv[ai][m] = rsqrtf(rsv[ai][m] * (1.f / 1024.f) + EPS);
        if (fr >= 14) {
#pragma unroll
            for (int ai = 0; ai < 2; ++ai) {
                const float rs = rsv[ai][3];
                LAS float* x = xch + ((2 * ai + wr) * 2 + (fr - 14)) * 128 + wc * 32 + 8 * fq;
                *(LAS f32x4*)x = acc[ai][0][3][0] * rs; *(LAS f32x4*)(x + 4) = acc[ai][0][3][1] * rs;
            }
        }
        asm volatile("s_waitcnt lgkmcnt(0)" ::: "memory"); __builtin_amdgcn_s_barrier(); asm volatile("" ::: "memory");
#pragma unroll
        for (int ai = 0; ai < 2; ++ai) {
            const int blk = 2 * ai + wr;
            float prev[8];
            if (blk > 0) { const LAS float* x = xch + ((blk - 1) * 2 + (fr >= 14 ? fr - 14 : 0)) * 128 + wc * 32 + 8 * fq; const f32x4 p0 = *(const LAS f32x4*)x, p1 = *(const LAS f32x4*)(x + 4);
#pragma unroll
                for (int e = 0; e < 4; ++e) { prev[e] = p0[e]; prev[4 + e] = p1[e]; } }
            else {
#pragma unroll
                for (int e = 0; e < 8; ++e) prev[e] = 0.f; }
#pragma unroll
            for (int m = 0; m < 4; ++m) {
                const int row = rowbase + ai * 128 + m * 16;
                const float rs = rsv[ai][m];
                float a[8], c[8], h[8], up[8];
#pragma unroll
                for (int e = 0; e < 8; ++e) { a[e] = acc[ai][0][m][e >> 2][e & 3] * rs; up[e] = acc[ai][1][m][e >> 2][e & 3] * rs; }
#pragma unroll
                for (int e = 0; e < 8; ++e) {
                    const float s1 = fr == 15 ? prev[e] : a[e], s2 = fr >= 14 ? prev[e] : a[e];
                    const float p1 = dpp_f<0x121>(s1), p2 = dpp_f<0x122>(s2);
                    c[e] = cb[e] + w0[e] * p2 + w1[e] * p1 + w2[e] * a[e];
                    h[e] = silu_f(c[e]) * up[e];
                }
                u32x4 w; w.x = cvtpk(h[0], h[1]); w.y = cvtpk(h[2], h[3]); w.z = cvtpk(h[4], h[5]); w.w = cvtpk(h[6], h[7]);
                *(u32x4*)(H + (size_t)row * DFF + col0) = w;
                if (ai == 0 && m == 0) { if (wr == 0 && ts > 0 && fr < 2) { float* d = side + (size_t)(pm * 2 + fr) * DFF + col0;
                        *(f32x4*)d = (f32x4){c[0], c[1], c[2], c[3]}; *(f32x4*)(d + 4) = (f32x4){c[4], c[5], c[6], c[7]};
                        *(f32x4*)(d + SIDE_N) = (f32x4){up[0], up[1], up[2], up[3]}; *(f32x4*)(d + SIDE_N + 4) = (f32x4){up[4], up[5], up[6], up[7]}; } }
                if (ai == 1 && m == 3) { if (wr == 1 && fr >= 14) { float* d = ts < 15 ? side + 2 * SIDE_N + (size_t)(pm * 2 + fr - 14) * DFF + col0 : convp + (size_t)((pm >> 4) * 2 + fr - 14) * DFF + col0;
                        *(f32x4*)d = (f32x4){a[0], a[1], a[2], a[3]}; *(f32x4*)(d + 4) = (f32x4){a[4], a[5], a[6], a[7]}; } }
#pragma unroll
                for (int e = 0; e < 8; ++e) prev[e] = a[e];
            }
        }
    }
};
struct EpiFfnNull {
    const float* ssq; bf16_t* H;
    __device__ __forceinline__ void row(f32x4 (&v)[2][2], float rs, int row, int pn, int wc, int fq) const {
        *(u32x4*)(H + (size_t)row * DFF + pn * 128 + wc * 32 + 8 * fq) = pack8(v[0][0] * rs + v[1][0], v[0][1] * rs + v[1][1]);
    }
    __device__ __forceinline__ void operator()(EPI_ARGS) const { BIG_ROWS(*this); }
};
__device__ __forceinline__ void ffn_fixup(const Params& P, int layer, const pg8::StaticOrder& S) {
    bf16_t* H = (bf16_t*)(P.ws + WS_H); const float* side = (const float*)(P.ws + WS_SIDE); const float* cw = P.in[25] + (size_t)layer * 3 * DFF;
    Unit u; int last = -1;
    for (int i = 0; S.next(i, u); ++i) {
        const int pm = u.pm; if ((pm & 15) == 0 || pm == last) continue; last = pm;
        for (int c4 = threadIdx.x; c4 < DFF / 4; c4 += 512) { const int col = 4 * c4;
            const f32x4 cp0 = *(const f32x4*)(side + (size_t)(pm * 2) * DFF + col), cp1 = *(const f32x4*)(side + (size_t)(pm * 2 + 1) * DFF + col);
            const f32x4 u0 = *(const f32x4*)(side + SIDE_N + (size_t)(pm * 2) * DFF + col), u1 = *(const f32x4*)(side + SIDE_N + (size_t)(pm * 2 + 1) * DFF + col);
            const f32x4 am2 = *(const f32x4*)(side + 2 * SIDE_N + (size_t)((pm - 1) * 2) * DFF + col), am1 = *(const f32x4*)(side + 2 * SIDE_N + (size_t)((pm - 1) * 2 + 1) * DFF + col);
            const f32x4 w0 = *(const f32x4*)(cw + col), w1 = *(const f32x4*)(cw + DFF + col);
            const f32x4 c0 = cp0 + w0 * am2 + w1 * am1, c1 = cp1 + w0 * am1;
            u32x2 h0, h1;
            h0.x = cvtpk(silu_f(c0[0]) * u0[0], silu_f(c0[1]) * u0[1]); h0.y = cvtpk(silu_f(c0[2]) * u0[2], silu_f(c0[3]) * u0[3]);
            h1.x = cvtpk(silu_f(c1[0]) * u1[0], silu_f(c1[1]) * u1[1]); h1.y = cvtpk(silu_f(c1[2]) * u1[2], silu_f(c1[3]) * u1[3]);
            *(u32x2*)(H + (size_t)(pm * 256) * DFF + col) = h0; *(u32x2*)(H + (size_t)(pm * 256 + 1) * DFF + col) = h1; }
    }
    asm volatile("s_waitcnt vmcnt(0)" ::: "memory"); __syncthreads();
}

struct EpiInB {
    const float* ssq; bf16_t *U, *GV, *XQ; const float* xg; float* ssqv;
    __device__ __forceinline__ void row(f32x4 (&v)[2][2], float rs, int row, int pn, int wc, int fq) const {
        if (pn < 6) {
            bf16_t* dst = pn < 3 ? U : GV; const int col0 = (pn % 3) * 256 + wc * 32 + 8 * fq;
            float ss = 0.f;
#pragma unroll
            for (int bj = 0; bj < 2; ++bj) {
                const f32x4 v0 = gelu4(v[bj][0] * rs), v1 = gelu4(v[bj][1] * rs);
                *(u32x4*)(dst + (size_t)row * 768 + col0 + 128 * bj) = pack8(v0, v1);
                ss += dot4(v0) + dot4(v1);
            }
            if (pn >= 3) { ss += __shfl_xor(ss, 16); ss += __shfl_xor(ss, 32); if (fq == 0) atomicAdd(ssqv + row, ss); }
        } else {
#pragma unroll
            for (int bj = 0; bj < 2; ++bj)
#pragma unroll
                for (int n = 0; n < 2; ++n) v[bj][n] = v[bj][n] * rs;
            head_norm(v, xg, fq);
#pragma unroll
            for (int bj = 0; bj < 2; ++bj) *(u32x4*)(XQ + (size_t)row * 256 + wc * 64 + 32 * bj + 8 * fq) = pack8(v[bj][0], v[bj][1]);
        }
    }
    __device__ __forceinline__ void operator()(EPI_ARGS) const {
        if (u.pn < 3 || u.pn >= 6) { BIG_ROWS(*this); return; }
        const int row0 = u.pm * 256 + wr * 64 + fr, col0 = (u.pn - 3) * 256 + wc * 32 + 8 * fq;
        float rsv[2][4];
        FOR_AI_M rsv[ai][m] = ssq[row0 + ai * 128 + m * 16];
#pragma unroll
        for (int ai = 0; ai < 2; ++ai) {
            float ssm[4];
#pragma unroll
            for (int m = 0; m < 4; ++m) { const int row = row0 + ai * 128 + m * 16; const float rs = rsqrtf(rsv[ai][m] * (1.f / 1024.f) + EPS); ssm[m] = 0.f;
#pragma unroll
                for (int bj = 0; bj < 2; ++bj) {
                    const f32x4 v0 = gelu4(acc[ai][bj][m][0] * rs), v1 = gelu4(acc[ai][bj][m][1] * rs);
                    *(u32x4*)(GV + (size_t)row * 768 + col0 + 128 * bj) = pack8(v0, v1);
                    ssm[m] += dot4(v0) + dot4(v1);
                } }
            rowsum4_atomic(ssm[0], ssm[1], ssm[2], ssm[3], ssqv + row0 + ai * 128, fq);
        }
    }
};

template <int MB> struct WgFrags { bf16x8 af[4][MB], bf[4][2][2]; };
template <int MB, int NB>
__device__ __forceinline__ void wg_load(WgFrags<MB>& F, const bf16_t* A, int lda, int row0, const bf16_t* Bt, int K, int pn, int wc, int k0, int s0) {
    const int lane = threadIdx.x & 63, fr = lane & 15, fq = lane >> 4;
    const bf16_t* ap = A + (size_t)(row0 + fr) * lda + 8 * fq + k0 + s0 * 32;
#pragma unroll
    for (int j = 0; j < NB; ++j)
#pragma unroll
        for (int m = 0; m < MB; ++m) F.af[j][m] = *(const bf16x8*)(ap + (size_t)m * 16 * lda + j * 32);
#pragma unroll
    for (int bj = 0; bj < 2; ++bj)
#pragma unroll
        for (int n = 0; n < 2; ++n) { const bf16_t* bp = Bt + (size_t)(pn * 256 + 128 * bj + 32 * wc + pg8::perm32(16 * n + fr)) * K + 8 * fq + k0 + s0 * 32;
#pragma unroll
            for (int j = 0; j < NB; ++j) F.bf[j][bj][n] = *(const bf16x8*)(bp + j * 32); }
}
template <int MB, int NB>
__device__ __forceinline__ void wg_mma(const WgFrags<MB>& F, f32x4 (&acc)[MB][2][2]) {
#pragma unroll
    for (int j = 0; j < NB; ++j)
#pragma unroll
        for (int m = 0; m < MB; ++m)
#pragma unroll
            for (int bj = 0; bj < 2; ++bj)
#pragma unroll
                for (int n = 0; n < 2; ++n) acc[m][bj][n] = __builtin_amdgcn_mfma_f32_16x16x32_bf16(F.bf[j][bj][n], F.af[j][m], acc[m][bj][n], 0, 0, 0);
}
template <int MB>
__device__ __forceinline__ void sample_reduce_store(LAS unsigned char* lds, const f32x4 (&acc)[MB][2][2], int wave, int lane) {
    LAS f32x4* Pl = (LAS f32x4*)lds;
#pragma unroll
    for (int m = 0; m < MB; ++m)
#pragma unroll
        for (int bj = 0; bj < 2; ++bj)
#pragma unroll
            for (int n = 0; n < 2; ++n) Pl[((wave * MB + m) * 4 + bj * 2 + n) * 64 + lane] = acc[m][bj][n];
}
template <int MB>
__device__ __forceinline__ void sample_reduce_finish(LAS unsigned char* lds, int wave, int lane) {
    LAS f32x4* Pl = (LAS f32x4*)lds; LAS f32x4* Rl = (LAS f32x4*)(lds + RING_BYTES);
    __syncthreads();
#pragma unroll
    for (int i = 0; i < (MB * 4) / 8 + ((MB * 4) % 8 ? 1 : 0); ++i) { const int slot = wave + 8 * i;
        if (slot < MB * 4) { f32x4 sum = Pl[slot * 64 + lane];
#pragma unroll
            for (int w = 1; w < 8; ++w) sum += Pl[(w * MB * 4 + slot) * 64 + lane];
            Rl[slot * 64 + lane] = sum; } }
    __syncthreads();
}
template <int MB>
__device__ __forceinline__ void sample_reduce(LAS unsigned char* lds, const f32x4 (&acc)[MB][2][2], int wave, int lane) {
    sample_reduce_store<MB>(lds, acc, wave, lane); sample_reduce_finish<MB>(lds, wave, lane);
}
template <int MB>
__device__ __forceinline__ void sample_reduce_load(const LAS unsigned char* lds, f32x4 (&v)[2][2], int m, int lane) {
    const LAS f32x4* Rl = (const LAS f32x4*)(lds + RING_BYTES);
#pragma unroll
    for (int bj = 0; bj < 2; ++bj)
#pragma unroll
        for (int n = 0; n < 2; ++n) v[bj][n] = Rl[(m * 4 + bj * 2 + n) * 64 + lane];
}
template <int MB, int NS, class Epi>
__device__ __forceinline__ void sample_gemm(LAS unsigned char* lds, const bf16_t* A, int lda, const bf16_t* Bt, int ntiles, const Epi& E, int blk, int nblk, int rowbase = MP, int nrows = MS, int tbeg = 0, int tend = -1) {
    const int lane = threadIdx.x & 63, fr = lane & 15, fq = lane >> 4, wave = __builtin_amdgcn_readfirstlane(threadIdx.x >> 6);
    constexpr int K = 8 * NS * 32, NB0 = NS < 4 ? NS : 4;
    const int NRB = nrows / (16 * MB);
    const int ntask = (tend >= 0 && tend < NRB * ntiles * 4) ? tend : NRB * ntiles * 4;
    if (tbeg + blk >= ntask) return;
    WgFrags<MB> F;
    { const int t1 = tbeg + blk, rb = t1 % NRB, cw = t1 / NRB; wg_load<MB, NB0>(F, A, lda, rowbase + rb * 16 * MB, Bt, K, cw >> 2, cw & 3, wave * NS * 32, 0); }
    for (int t = tbeg + blk; t < ntask; t += nblk) {
        const int rb = t % NRB, cw = t / NRB, pn = cw >> 2, wc = cw & 3, row0 = rowbase + rb * 16 * MB;
        f32x4 acc[MB][2][2];
#pragma unroll
        for (int m = 0; m < MB; ++m)
#pragma unroll
            for (int bj = 0; bj < 2; ++bj)
#pragma unroll
                for (int n = 0; n < 2; ++n) acc[m][bj][n] = (f32x4){0.f, 0.f, 0.f, 0.f};
        wg_mma<MB, NB0>(F, acc);
#pragma unroll
        for (int s0 = 4; s0 < NS; s0 += 4) {
            if (NS - s0 >= 4) { wg_load<MB, 4>(F, A, lda, row0, Bt, K, pn, wc, wave * NS * 32, s0); wg_mma<MB, 4>(F, acc); }
            else { wg_load<MB, (NS % 4 ? NS % 4 : 4)>(F, A, lda, row0, Bt, K, pn, wc, wave * NS * 32, s0); wg_mma<MB, (NS % 4 ? NS % 4 : 4)>(F, acc); }
        }
        const int tn = t + nblk;
        if (tn < ntask) { const int rbn = tn % NRB, cwn = tn / NRB; wg_load<MB, NB0>(F, A, lda, rowbase + rbn * 16 * MB, Bt, K, cwn >> 2, cwn & 3, wave * NS * 32, 0); }
        const int row = row0 + 16 * (wave % MB) + fr; float rsq = 0.f;
        if (wave < MB && E.ssq) rsq = E.ssq[row];
        sample_reduce<MB>(lds, acc, wave, lane);
        if (wave < MB) { const float rs = E.ssq ? rsqrtf(rsq * (1.f / 1024.f) + EPS) : 1.f;
            f32x4 v[2][2]; sample_reduce_load<MB>(lds, v, wave, lane); E.row(v, rs, row, pn, wc, fq); }
    }
    __syncthreads();
}
__device__ __forceinline__ void sample_ffn(const Params& P, LAS unsigned char* lds, int layer, const float* ssq, int blk, int nblk, int rb0 = 0, int NRB = MS / 64) {
    const int lane = threadIdx.x & 63, fr = lane & 15, fq = lane >> 4, wave = __builtin_amdgcn_readfirstlane(threadIdx.x >> 6);
    const bf16_t* XB = (const bf16_t*)(P.ws + WS_XB); const bf16_t* Wt = (const bf16_t*)(P.ws + WS_WFFN) + (size_t)layer * NFF * DM; bf16_t* Hb = (bf16_t*)(P.ws + WS_H);
    const float* cw = P.in[25] + (size_t)layer * 3 * DFF; const float* cbp = P.in[26] + (size_t)layer * DFF; const float* st = P.in[6] + (size_t)layer * NDEC * 2 * DFF;
    float* convs = P.out + O_CONVS + (size_t)layer * NDEC * 2 * DFF;
    constexpr int MB = 4; const int NTASK = NRB * 22 * 4;
    if (blk >= NTASK) return;
    WgFrags<MB> F;
    { const int rb = rb0 + blk % NRB, cwi = blk / NRB; wg_load<MB, 4>(F, XB, DM, MP + rb * 64, Wt, DM, cwi >> 2, cwi & 3, wave * 128, 0); }
    for (int t = blk; t < NTASK; t += nblk) {
        const int rb = rb0 + t % NRB, cwi = t / NRB, pn = cwi >> 2, wc = cwi & 3;
        f32x4 acc[MB][2][2];
#pragma unroll
        for (int m = 0; m < MB; ++m)
#pragma unroll
            for (int bj = 0; bj < 2; ++bj)
#pragma unroll
                for (int n = 0; n < 2; ++n) acc[m][bj][n] = (f32x4){0.f, 0.f, 0.f, 0.f};
        wg_mma<MB, 4>(F, acc);
        const int tn = t + nblk;
        if (tn < NTASK) { const int rbn = rb0 + tn % NRB, cwn = tn / NRB; wg_load<MB, 4>(F, XB, DM, MP + rbn * 64, Wt, DM, cwn >> 2, cwn & 3, wave * 128, 0); }
        sample_reduce_store<MB>(lds, acc, wave, lane);
        const int col0 = pn * 128 + wc * 32 + 8 * fq, s = fr & 3;
        const int row = MP + rb * 64 + 16 * (wave & 3) + fr, nseq = (row - MP) >> 2;
        f32x4 q0[2], q1[2], k0[2], k1[2], k2[2], kb[2]; float rsq = 0.f;
        if (wave < MB) {
            rsq = ssq[row];
#pragma unroll
            for (int e = 0; e < 2; ++e) {
                q0[e] = *(const f32x4*)(st + (size_t)(nseq * 2 + 0) * DFF + col0 + 4 * e); q1[e] = *(const f32x4*)(st + (size_t)(nseq * 2 + 1) * DFF + col0 + 4 * e);
            }
        }
        sample_reduce_finish<MB>(lds, wave, lane);
        if (wave < MB) {
#pragma unroll
            for (int e = 0; e < 2; ++e) { k0[e] = *(const f32x4*)(cw + col0 + 4 * e); k1[e] = *(const f32x4*)(cw + DFF + col0 + 4 * e); k2[e] = *(const f32x4*)(cw + 2 * DFF + col0 + 4 * e); kb[e] = *(const f32x4*)(cbp + col0 + 4 * e); }
            f32x4 v[2][2]; sample_reduce_load<MB>(lds, v, wave, lane);
            const float rs = rsqrtf(rsq * (1.f / 1024.f) + EPS);
            float h[8]; f32x4 av[2];
#pragma unroll
            for (int e = 0; e < 8; ++e) {
                const float a = v[0][e >> 2][e & 3] * rs, up = v[1][e >> 2][e & 3] * rs;
                const float st0 = q0[e >> 2][e & 3], st1 = q1[e >> 2][e & 3];
                const float r1 = dpp_f<0x121>(a), r2 = dpp_f<0x122>(a);
                const float p1 = s >= 1 ? r1 : st1, p2 = s >= 2 ? r2 : (s == 1 ? st1 : st0);
                const float c = kb[e >> 2][e & 3] + k0[e >> 2][e & 3] * p2 + k1[e >> 2][e & 3] * p1 + k2[e >> 2][e & 3] * a;
                h[e] = silu_f(c) * up; av[e >> 2][e & 3] = a;
            }
            if (s >= 2) { float* d = convs + (size_t)(nseq * 2 + (s - 2)) * DFF + col0; *(f32x4*)d = av[0]; *(f32x4*)(d + 4) = av[1]; }
            u32x4 w; w.x = cvtpk(h[0], h[1]); w.y = cvtpk(h[2], h[3]); w.z = cvtpk(h[4], h[5]); w.w = cvtpk(h[6], h[7]);
            *(u32x4*)(Hb + (size_t)row * DFF + col0) = w;
        }
    }
    __syncthreads();
}

__device__ __forceinline__ void p0_transpose_item(const float* W, int K, int N, const float* gain, bf16_t* WT, int kb, int n0, int drow0, LAS float* scr, int lane) {
    const int k0 = 64 * kb;
    float wv[32];
#pragma unroll
    for (int i = 0; i < 32; ++i) wv[i] = W[(size_t)(k0 + 2 * i + (lane >> 5)) * N + n0 + (lane & 31)];
    if (gain) {
#pragma unroll
        for (int i = 0; i < 32; ++i) wv[i] *= gain[k0 + 2 * i + (lane >> 5)]; }
#pragma unroll
    for (int i = 0; i < 32; ++i) scr[(2 * i + (lane >> 5)) * 33 + (lane & 31)] = wv[i];
    asm volatile("s_waitcnt lgkmcnt(0)" ::: "memory");
    const int c = lane & 7;
#pragma unroll
    for (int j = 0; j < 4; ++j) { const int n = (lane >> 3) + 8 * j; const LAS float* s = scr + (8 * c) * 33 + n;
        u32x4 o; o.x = cvtpk(s[0 * 33], s[1 * 33]); o.y = cvtpk(s[2 * 33], s[3 * 33]); o.z = cvtpk(s[4 * 33], s[5 * 33]); o.w = cvtpk(s[6 * 33], s[7 * 33]);
        *(u32x4*)(WT + (size_t)(drow0 + n) * K + k0 + 8 * c) = o; }
    asm volatile("s_waitcnt lgkmcnt(0)" ::: "memory");
}
__device__ __forceinline__ int map_headperm(int nb) { const int p = (nb * 32) & 255, bj = p >> 7, wc = (p >> 5) & 3; return ((nb * 32) & ~255) + 64 * wc + 32 * bj; }
__device__ __forceinline__ int map_ffn(int nb) { const int tile = nb >> 3, p = (nb & 7) * 32; return p < 128 ? 128 * tile + p : DFF + 128 * tile + (p - 128); }

template <int NR>
__device__ __forceinline__ void rows_to_bf16(const float* xrow, bf16_t* orow, float* ssq, int lane) {
    f32x4 v[NR][4];
#pragma unroll
    for (int r = 0; r < NR; ++r)
#pragma unroll
        for (int j = 0; j < 4; ++j) v[r][j] = ((const f32x4*)(xrow + (size_t)r * DM))[lane + 64 * j];
#pragma unroll
    for (int r = 0; r < NR; ++r) {
        float s = 0.f;
#pragma unroll
        for (int j = 0; j < 4; ++j) s += dot4(v[r][j]);
        s = wave_sum(s);
        u32x2* o8 = (u32x2*)(orow + (size_t)r * DM) + lane;
#pragma unroll
        for (int j = 0; j < 4; ++j) { u32x2 w; w.x = cvtpk(v[r][j][0], v[r][j][1]); w.y = cvtpk(v[r][j][2], v[r][j][3]); o8[64 * j] = w; }
        if (lane == 0) ssq[r] = s;
    }
}

__device__ __forceinline__ void p0_prologue(const Params& P, LAS unsigned char* lds, int G, int bid, int part) {
    const int tid = threadIdx.x, lane = tid & 63, wave = __builtin_amdgcn_readfirstlane(tid >> 6);
    LAS float* scr = (LAS float*)(lds + wave * 16384);
    const int gw = bid * 8 + wave, NGW = G * 8;
    unsigned char* ws = P.ws;
    float* ssq = (float*)(ws + WS_SSQ);
    const int gt = bid * 512 + tid, NGT = G * 512;
    constexpr int I0 = 16 * 48, I1 = 16 * 32, I2 = 16 * 56, I3 = 16 * 32, I4 = 16 * 16, I6 = 16 * 176, I8 = 44 * 32;
    if (part == 1) {
        constexpr int NITEMS = I3 + I6 + I8;
        for (int it = gw; it < NITEMS; it += NGW) {
            int r = it;
            if (r < I3) { const int nb = r % 32, kb = r / 32; p0_transpose_item(P.in[20], 1024, 1024, nullptr, (bf16_t*)(ws + WS_WOUTB), kb, 32 * nb, 32 * nb, scr, lane); continue; } r -= I3;
            if (r < I6) { const int nb = r % 176, kb = r / 176;
                p0_transpose_item(P.in[24] + (size_t)1024 * NFF, 1024, NFF, P.in[9] + 1024, (bf16_t*)(ws + WS_WFFN) + (size_t)NFF * 1024, kb, map_ffn(nb), 32 * nb, scr, lane); continue; } r -= I6;
            { const int nb = r % 32, kb = r / 32;
                p0_transpose_item(P.in[27] + (size_t)DFF * 1024, DFF, 1024, nullptr, (bf16_t*)(ws + WS_WDOWN) + (size_t)1024 * DFF, kb, 32 * nb, 32 * nb, scr, lane); }
        }
        { const f32x4* ck = (const f32x4*)P.in[2]; const f32x4* cv = (const f32x4*)P.in[3]; f32x4* ok = (f32x4*)(P.out + O_WKS); f32x4* ov = (f32x4*)(P.out + O_WVS);
          for (int i = gt; i < NDEC * 124 * 64; i += NGT) { const int n = i / (124 * 64), r = i % (124 * 64); const size_t s = (size_t)n * 128 * 64 + 4 * 64 + r, d = (size_t)n * 128 * 64 + r; ok[d] = ck[s]; ov[d] = cv[s]; } }
        return;
    }
    constexpr int NITEMS = I0 + I1 + I2 + 2 * I4 + I6 + I8;
    for (int it = gw; it < NITEMS; it += NGW) {
        int r = it;
        if (r < I0) { const int nb = r % 48, kb = r / 48; p0_transpose_item(P.in[11], 1024, NINA, P.in[8], (bf16_t*)(ws + WS_WINA), kb, map_headperm(nb), 32 * nb, scr, lane); continue; } r -= I0;
        if (r < I1) { const int nb = r % 32, kb = r / 32; p0_transpose_item(P.in[15], 1024, 1024, nullptr, (bf16_t*)(ws + WS_WOUTA), kb, 32 * nb, 32 * nb, scr, lane); continue; } r -= I1;
        if (r < I2) { const int nb = r % 56, kb = r / 56; p0_transpose_item(P.in[16], 1024, NINB, P.in[8] + 1024, (bf16_t*)(ws + WS_WINB), kb, nb < 48 ? 32 * nb : map_headperm(nb), 32 * nb, scr, lane); continue; } r -= I2;
        if (r < 2 * I4) { const int l = r / I4; r -= l * I4; const int nb = r % 16, kb = r / 16;
            p0_transpose_item(P.in[21] + (size_t)l * 1024 * 512, 1024, 512, P.in[10] + l * 1024, (bf16_t*)(ws + WS_WMKV) + (size_t)l * 512 * 1024, kb, map_headperm(nb), 32 * nb, scr, lane); continue; } r -= 2 * I4;
        if (r < I6) { const int nb = r % 176, kb = r / 176;
            p0_transpose_item(P.in[24], 1024, NFF, P.in[9], (bf16_t*)(ws + WS_WFFN), kb, map_ffn(nb), 32 * nb, scr, lane); continue; } r -= I6;
        { const int nb = r % 32, kb = r / 32;
            p0_transpose_item(P.in[27], DFF, 1024, nullptr, (bf16_t*)(ws + WS_WDOWN), kb, 32 * nb, 32 * nb, scr, lane); }
    }
    bf16_t* XB = (bf16_t*)(ws + WS_XB); bf16_t* MEMB = (bf16_t*)(ws + WS_MEMB);
    for (int r4 = gw; r4 < (M + MMEM) / 4; r4 += NGW) { const int r = 4 * r4;
        if (r < MP) rows_to_bf16<4>(P.in[0] + (size_t)r * DM, XB + (size_t)r * DM, ssq + r, lane);
        else if (r < M) rows_to_bf16<4>(P.in[1] + (size_t)(r - MP) * DM, XB + (size_t)r * DM, ssq + r, lane);
        else rows_to_bf16<4>(P.in[7] + (size_t)(r - M) * DM, MEMB + (size_t)(r - M) * DM, ssq + 5 * M + (r - M), lane);
    }
    for (int i = gt; i < 4 * M; i += NGT) ssq[M + i] = 0.f;
    if (gt < 256) { float* GT = (float*)(ws + WS_GT); const int t4 = gt >> 6, d = gt & 63; GT[gt] = t4 == 0 ? P.in[12][d] : t4 == 1 ? P.in[13][d] : t4 == 2 ? 1.f : P.in[22][d]; }
    { bf16_t* WST = (bf16_t*)(ws + WS_WST); const float* wsb = P.in[18];
      for (int i = gt; i < 4 * 128 * 128; i += NGT) { const int ii = (i >> 7) & 127, jj = i & 127; const float w = jj <= ii ? wsb[i] : 0.f; WST[i] = (bf16_t)(cvtpk(w, 0.f) & 0xffffu); } }
}

__device__ __forceinline__ int crow(int r, int hi) { return (r & 3) + 8 * (r >> 2) + 4 * hi; }
__device__ __forceinline__ int kv_off(int row, int chunk) { return row * 128 + ((chunk ^ (row & 7)) << 4); }
__device__ __forceinline__ s16x4 vtr(const LAS unsigned char* p) { return __builtin_bit_cast(s16x4, __builtin_amdgcn_ds_read_tr16_b64_v4i16((LAS s16x4*)p)); }

struct AttnOfs { int k[4]; int v[2]; };
__device__ __forceinline__ AttnOfs attn_ofs() {
    const int lane = threadIdx.x & 63, r32 = lane & 31, hi = lane >> 5; AttnOfs a;
#pragma unroll
    for (int ks = 0; ks < 4; ++ks) a.k[ks] = r32 * 128 + (((2 * ks + hi) ^ (r32 & 7)) << 4);
    const int vkey = 4 * hi + ((lane & 15) >> 2), vcol = 16 * ((lane >> 4) & 1) + 4 * (lane & 3);
#pragma unroll
    for (int d0 = 0; d0 < 2; ++d0) a.v[d0] = vkey * 128 + (((4 * d0 + (vcol >> 3)) ^ vkey) << 4) + (vcol & 7) * 2;
    return a;
}
template <int CT, bool MASK, bool FIRST>
__device__ __forceinline__ void attn_chunk(const bf16x8 (&qf)[4], const AttnOfs& ao, const LAS unsigned char* Kb, const LAS unsigned char* Vb, int qpos, int kpos0, float slope2, LAS float* wsf, float& m, float& l, f32x16 (&o)[2]) {
    const int lane = threadIdx.x & 63, r32 = lane & 31, hi = lane >> 5;
    f32x16 s[CT];
#pragma unroll
    for (int t = 0; t < CT; ++t) {
#pragma unroll
        for (int r = 0; r < 16; ++r) s[t][r] = 0.f;
#pragma unroll
        for (int ks = 0; ks < 4; ++ks) { const bf16x8 kf = *(const LAS bf16x8*)(Kb + ao.k[ks] + t * 4096); s[t] = __builtin_amdgcn_mfma_f32_32x32x16_bf16(kf, qf[ks], s[t], 0, 0, 0); }
        if (CT > 2) __builtin_amdgcn_sched_barrier(0);
    }
    const float C2 = 0.125f * LOG2E;
    float mx = -1e30f;
    if (MASK) {
        int dbase = qpos - kpos0 - 4 * hi; asm volatile("" : "+v"(dbase));
        const float fdb = (float)dbase, lim = (float)(qpos < 127 ? qpos : 127), ns = -slope2;
#pragma unroll
        for (int t = 0; t < CT; ++t)
#pragma unroll
            for (int r = 0; r < 16; ++r) {
                const float fd = fdb - (float)(32 * t + (r & 3) + 8 * (r >> 2));
                float v = __builtin_fmaf(ns, fd, s[t][r] * C2);
                v = (fd >= 0.f && fd <= lim) ? v : -1e30f;
                s[t][r] = v; mx = fmaxf(mx, v);
            }
    } else {
#pragma unroll
        for (int t = 0; t < CT; ++t)
#pragma unroll
            for (int r = 0; r < 16; ++r) { const float v = s[t][r] * C2; s[t][r] = v; mx = fmaxf(mx, v); }
    }
    mx = fmaxf(mx, __shfl_xor(mx, 32));
    const float mn = fmaxf(m, mx), alpha = __builtin_amdgcn_exp2f(m - mn);
    m = mn;
    float sum = 0.f;
#pragma unroll
    for (int t = 0; t < CT; ++t)
#pragma unroll
        for (int r = 0; r < 16; ++r) { const float e = __builtin_amdgcn_exp2f(s[t][r] - mn); s[t][r] = e; sum += e; }
    l = l * alpha + sum;
    if (!FIRST) {
        if (hi == 0) wsf[r32] = alpha;
        asm volatile("s_waitcnt lgkmcnt(0)" ::: "memory");
#pragma unroll
        for (int r = 0; r < 16; ++r) { const float a = wsf[crow(r, hi)]; o[0][r] *= a; o[1][r] *= a; }
        asm volatile("s_waitcnt lgkmcnt(0)" ::: "memory");
    }
#pragma unroll
    for (int t = 0; t < CT; ++t)
#pragma unroll
        for (int k2 = 0; k2 < 2; ++k2) {
            u32x4 pw; pw.x = cvtpk(s[t][8 * k2 + 0], s[t][8 * k2 + 1]); pw.y = cvtpk(s[t][8 * k2 + 2], s[t][8 * k2 + 3]); pw.z = cvtpk(s[t][8 * k2 + 4], s[t][8 * k2 + 5]); pw.w = cvtpk(s[t][8 * k2 + 6], s[t][8 * k2 + 7]);
            const bf16x8 pa = __builtin_bit_cast(bf16x8, pw);
#pragma unroll
            for (int d0 = 0; d0 < 2; ++d0) {
                const LAS unsigned char* vp = Vb + ao.v[d0] + (32 * t + 16 * k2) * 128;
                const s16x4 lo = vtr(vp), hh = vtr(vp + 1024);
                const bf16x8 vf = (bf16x8){lo[0], lo[1], lo[2], lo[3], hh[0], hh[1], hh[2], hh[3]};
                o[d0] = __builtin_amdgcn_mfma_f32_32x32x16_bf16(pa, vf, o[d0], 0, 0, 0);
            }
        }
}
__device__ __forceinline__ void attn_init(bool mask, float sink2, float& m, float& l, f32x16 (&o)[2]) {
    const int hi = (threadIdx.x & 63) >> 5;
    m = mask ? sink2 : -1e30f; l = (mask && hi == 0) ? 1.f : 0.f;
#pragma unroll
    for (int r = 0; r < 16; ++r) { o[0][r] = 0.f; o[1][r] = 0.f; }
}
__device__ __forceinline__ void attn_finish(float l, LAS float* wsf, f32x16 (&o)[2], LAS unsigned short* stg) {
    const int lane = threadIdx.x & 63, r32 = lane & 31, hi = lane >> 5;
    l += __shfl_xor(l, 32);
    if (hi == 0) wsf[r32] = 1.0f / l;
    asm volatile("s_waitcnt lgkmcnt(0)" ::: "memory");
#pragma unroll
    for (int r = 0; r < 16; ++r) { const float li = wsf[crow(r, hi)]; const int q = crow(r, hi);
        stg[q * 64 + r32] = (unsigned short)(cvtpk(o[0][r] * li, 0.f) & 0xffffu); stg[q * 64 + 32 + r32] = (unsigned short)(cvtpk(o[1][r] * li, 0.f) & 0xffffu); }
    asm volatile("s_waitcnt lgkmcnt(0)" ::: "memory");
}
__device__ __forceinline__ void attn_swa(const bf16x8 (&qf)[4], const AttnOfs& ao, const LAS unsigned char* Kb, const LAS unsigned char* Vb, int qpos, int kpos0, float slope2, float sink2, LAS float* wsf, LAS unsigned short* stg) {
    float m, l; f32x16 o[2]; attn_init(true, sink2, m, l, o);
#pragma unroll 1
    for (int t = 0; t < 4; t += 2) attn_chunk<2, true, false>(qf, ao, Kb + t * 4096, Vb + t * 4096, qpos, kpos0 + 32 * t, slope2, wsf, m, l, o);
    attn_chunk<1, true, false>(qf, ao, Kb + 4 * 4096, Vb + 4 * 4096, qpos, kpos0 + 128, slope2, wsf, m, l, o);
    attn_finish(l, wsf, o, stg);
}
__device__ __forceinline__ void attn_mem(const bf16x8 (&qf)[4], const AttnOfs& ao, const LAS unsigned char* Kb, const LAS unsigned char* Vb, LAS float* wsf, LAS unsigned short* stg) {
    float m, l; f32x16 o[2]; attn_init(false, 0.f, m, l, o);
    attn_chunk<2, false, true>(qf, ao, Kb, Vb, 0, 0, 0.f, wsf, m, l, o);
#pragma unroll 1
    for (int c = 1; c < 4; ++c) attn_chunk<2, false, false>(qf, ao, Kb + c * 64 * 128, Vb + c * 64 * 128, 0, 0, 0.f, wsf, m, l, o);
    attn_finish(l, wsf, o, stg);
}
__device__ __forceinline__ void stage_out(const LAS unsigned short* stg, bf16_t* gdst, size_t ld) {
    const int lane = threadIdx.x & 63;
#pragma unroll
    for (int i = 0; i < 4; ++i) { const int row = i * 8 + (lane >> 3), ch = lane & 7; *(u32x4*)(gdst + (size_t)row * ld + ch * 8) = *(const LAS u32x4*)(stg + row * 64 + ch * 8); }
    asm volatile("s_waitcnt lgkmcnt(0)" ::: "memory");
}

__device__ __forceinline__ void unit_swa_prompt(const Params& P, LAS unsigned char* lds, LAS float* wsf, int b, int qb, int g) {
    const int tid = threadIdx.x, lane = tid & 63, wave = __builtin_amdgcn_readfirstlane(tid >> 6), r32 = lane & 31, hi = lane >> 5;
    const bf16_t* Qg = (const bf16_t*)(P.ws + WS_Q); const bf16_t* Kg = (const bf16_t*)(P.ws + WS_K); const bf16_t* Vg = (const bf16_t*)(P.ws + WS_V); bf16_t* Og = (bf16_t*)(P.ws + WS_O);
    LAS unsigned char* Kl = lds; LAS unsigned char* Vl = lds + 49152; LAS unsigned short* stg = (LAS unsigned short*)(lds + 98304 + wave * 4096);
    const int t0 = 256 * qb + 32 * wave;
    const bf16_t* qp = Qg + (size_t)(b * SEQ + t0 + r32) * 768 + (3 * g) * 64 + 8 * hi;
#pragma unroll 3
    for (int idx = tid; idx < 384 * 8; idx += 512) {
        const int row = idx >> 3, ch = idx & 7, t = 256 * qb - 128 + row;
        u32x4 kv = (u32x4){0u, 0u, 0u, 0u}, vv = kv;
        if (t >= 0) { const size_t o = (size_t)(b * SEQ + t) * 256 + g * 64 + ch * 8; kv = *(const u32x4*)(Kg + o); vv = *(const u32x4*)(Vg + o); }
        *(LAS u32x4*)(Kl + kv_off(row, ch)) = kv; *(LAS u32x4*)(Vl + kv_off(row, ch)) = vv;
    }
    __syncthreads();
    const AttnOfs ao = attn_ofs();
#pragma unroll 1
    for (int hh = 0; hh < 3; ++hh) {
        const int head = 3 * g + hh;
        bf16x8 qf[4];
#pragma unroll
        for (int ks = 0; ks < 4; ++ks) qf[ks] = *(const bf16x8*)(qp + hh * 64 + 16 * ks);
        attn_swa(qf, ao, Kl + 32 * wave * 128, Vl + 32 * wave * 128, t0 + r32, t0 - 128, alibi_slope(head) * LOG2E, P.in[14][head] * LOG2E, wsf, stg);
        stage_out(stg, Og + (size_t)(b * SEQ + t0) * DM + head * 64, DM);
    }
    __syncthreads();
}

__device__ __forceinline__ void unit_mem_prompt(const Params& P, LAS unsigned char* lds, LAS float* wsf, int layer, int b, int qb, int h) {
    const int tid = threadIdx.x, lane = tid & 63, wave = __builtin_amdgcn_readfirstlane(tid >> 6), r32 = lane & 31, hi = lane >> 5;
    const bf16_t* XQ = (const bf16_t*)(P.ws + WS_XQ); bf16_t* Og = (bf16_t*)(P.ws + WS_O);
    const bf16_t* MK = (const bf16_t*)(P.ws + WS_MK) + (size_t)layer * MMEM * 256; const bf16_t* MV = (const bf16_t*)(P.ws + WS_MV) + (size_t)layer * MMEM * 256;
    LAS unsigned char* Kl = lds; LAS unsigned char* Vl = lds + 32768; LAS unsigned short* stg = (LAS unsigned short*)(lds + 98304 + wave * 4096);
    const int t0 = 256 * qb + 32 * wave;
    bf16x8 qf[4];
#pragma unroll
    for (int ks = 0; ks < 4; ++ks) qf[ks] = *(const bf16x8*)(XQ + (size_t)(b * SEQ + t0 + r32) * 256 + h * 64 + 16 * ks + 8 * hi);
#pragma unroll
    for (int idx = tid; idx < 256 * 8; idx += 512) {
        const int row = idx >> 3, ch = idx & 7; const size_t o = (size_t)(b * NMEM + row) * 256 + h * 64 + ch * 8;
        *(LAS u32x4*)(Kl + kv_off(row, ch)) = *(const u32x4*)(MK + o); *(LAS u32x4*)(Vl + kv_off(row, ch)) = *(const u32x4*)(MV + o);
    }
    __syncthreads();
    const AttnOfs ao = attn_ofs();
    attn_mem(qf, ao, Kl, Vl, wsf, stg);
    stage_out(stg, Og + (size_t)(b * SEQ + t0) * DM + 768 + h * 64, DM);
    __syncthreads();
}

__device__ __forceinline__ u32x4 ld8f_pack(const float* p) { const f32x4 a = *(const f32x4*)p, b = *(const f32x4*)(p + 4); return pack8(a, b); }

__device__ __forceinline__ void unit_swa_sample(const Params& P, LAS unsigned char* lds, LAS float* wsf, int n, int gp) {
    const int tid = threadIdx.x, lane = tid & 63, wave = __builtin_amdgcn_readfirstlane(tid >> 6), r32 = lane & 31, hi = lane >> 5;
    const bf16_t* Qg = (const bf16_t*)(P.ws + WS_Q); const bf16_t* Kg = (const bf16_t*)(P.ws + WS_K); const bf16_t* Vg = (const bf16_t*)(P.ws + WS_V); bf16_t* Og = (bf16_t*)(P.ws + WS_O);
#pragma unroll 2
    for (int idx = tid; idx < 2 * 160 * 8; idx += 512) {
        const int gi = idx / 1280, rem = idx % 1280, row = rem >> 3, ch = rem & 7, g = 2 * gp + gi;
        LAS unsigned char* Kl = lds + gi * 40960; LAS unsigned char* Vl = Kl + 20480;
        u32x4 kv = (u32x4){0u, 0u, 0u, 0u}, vv = kv;
        if (row < 128) { const size_t o = ((size_t)(n * 128 + row) * 4 + g) * 64 + ch * 8; kv = ld8f_pack(P.in[2] + o); vv = ld8f_pack(P.in[3] + o); }
        else if (row < 132) { const size_t o = (size_t)(MP + 4 * n + row - 128) * 256 + g * 64 + ch * 8; kv = *(const u32x4*)(Kg + o); vv = *(const u32x4*)(Vg + o); }
        *(LAS u32x4*)(Kl + kv_off(row, ch)) = kv; *(LAS u32x4*)(Vl + kv_off(row, ch)) = vv;
    }
    __syncthreads();
    if (wave < 2) {
        LAS unsigned short* stg = (LAS unsigned short*)(lds + 98304 + wave * 4096);
        const AttnOfs ao = attn_ofs();
        const int g = 2 * gp + wave; const bool qv = r32 < 12; const int hh = qv ? (r32 >> 2) : 0, sidx = r32 & 3, head = 3 * g + hh;
        bf16x8 qf[4];
#pragma unroll
        for (int ks = 0; ks < 4; ++ks) { qf[ks] = *(const bf16x8*)(Qg + (size_t)(MP + 4 * n + sidx) * 768 + head * 64 + 16 * ks + 8 * hi); if (!qv) qf[ks] = (bf16x8){0, 0, 0, 0, 0, 0, 0, 0}; }
        const LAS unsigned char* Kl = lds + wave * 40960;
        attn_swa(qf, ao, Kl, Kl + 20480, 128 + sidx, 0, alibi_slope(head) * LOG2E, P.in[14][head] * LOG2E, wsf, stg);
        for (int i = lane; i < 96; i += 64) { const int q = i >> 3, ch = i & 7;
            *(u32x4*)(Og + (size_t)(MP + 4 * n + (q & 3)) * DM + (3 * g + (q >> 2)) * 64 + ch * 8) = *(const LAS u32x4*)(stg + q * 64 + ch * 8); }
        asm volatile("s_waitcnt lgkmcnt(0)" ::: "memory");
    }
    __syncthreads();
}

__device__ __forceinline__ void unit_mem_sample(const Params& P, LAS unsigned char* lds, LAS float* wsf, int layer, int n, int hp) {
    const int tid = threadIdx.x, lane = tid & 63, wave = __builtin_amdgcn_readfirstlane(tid >> 6), r32 = lane & 31, hi = lane >> 5;
    const bf16_t* XQ = (const bf16_t*)(P.ws + WS_XQ); bf16_t* Og = (bf16_t*)(P.ws + WS_O);
    const float* ck = P.in[4] + (size_t)(layer * NDEC + n) * NMEM * 256; const float* cv = P.in[5] + (size_t)(layer * NDEC + n) * NMEM * 256;
#pragma unroll 2
    for (int idx = tid; idx < 256 * 16; idx += 512) {
        const int row = idx >> 4, hsel = (idx >> 3) & 1, ch = idx & 7; const size_t o = (size_t)row * 256 + (2 * hp + hsel) * 64 + ch * 8;
        LAS unsigned char* Kl = lds + hsel * 65536;
        *(LAS u32x4*)(Kl + kv_off(row, ch)) = ld8f_pack(ck + o); *(LAS u32x4*)(Kl + 32768 + kv_off(row, ch)) = ld8f_pack(cv + o);
    }
    __syncthreads();
    if (wave < 2) {
        LAS unsigned short* stg = (LAS unsigned short*)(lds + OSTG2_OFF + wave * 4096);
        const AttnOfs ao = attn_ofs();
        const int h = 2 * hp + wave; const bool qv = r32 < 4;
        bf16x8 qf[4];
#pragma unroll
        for (int ks = 0; ks < 4; ++ks) { qf[ks] = *(const bf16x8*)(XQ + (size_t)(MP + 4 * n + (r32 & 3)) * 256 + h * 64 + 16 * ks + 8 * hi); if (!qv) qf[ks] = (bf16x8){0, 0, 0, 0, 0, 0, 0, 0}; }
        const LAS unsigned char* Kl = lds + wave * 65536;
        attn_mem(qf, ao, Kl, Kl + 32768, wsf, stg);
        if (lane < 32) { const int q = lane >> 3, ch = lane & 7;
            *(u32x4*)(Og + (size_t)(MP + 4 * n + q) * DM + 768 + h * 64 + ch * 8) = *(const LAS u32x4*)(stg + q * 64 + ch * 8); }
        asm volatile("s_waitcnt lgkmcnt(0)" ::: "memory");
    }
    __syncthreads();
}

__device__ __forceinline__ void unit_gmlp_prompt(const Params& P, LAS unsigned char* lds, int b, int c) {
    const int tid = threadIdx.x, lane = tid & 63, wave = __builtin_amdgcn_readfirstlane(tid >> 6), r32 = lane & 31, hi = lane >> 5;
    const bf16_t* U = (const bf16_t*)(P.ws + WS_U); const bf16_t* GV = (const bf16_t*)(P.ws + WS_GV); bf16_t* Og = (bf16_t*)(P.ws + WS_O);
    const bf16_t* WST = (const bf16_t*)(P.ws + WS_WST); const float* ssqv = (const float*)(P.ws + WS_SSQ) + 4 * M;
    const float* vg = P.in[17]; const float* bs = P.in[19]; float* cvp = P.out + O_CVP;
    const int rowb = b * SEQ + c * 128;
    const int ib = wave & 3, cb0 = 3 * (wave >> 2);
#pragma unroll 1
    for (int g = 0; g < 4; ++g) {
        for (int idx = tid; idx < 128 * 24; idx += 512) {
            const int j = idx / 24, ch = idx % 24; const int row = rowb + j, col = g * 192 + ch * 8;
            const float rv = rsqrtf(ssqv[row] * (1.f / 768.f) + EPS);
            const u32x4 w = *(const u32x4*)(GV + (size_t)row * 768 + col);
            const f32x4 g0 = *(const f32x4*)(vg + col), g1 = *(const f32x4*)(vg + col + 4);
            f32x4 v0 = (f32x4){bflo(w.x), bfhi(w.x), bflo(w.y), bfhi(w.y)}, v1 = (f32x4){bflo(w.z), bfhi(w.z), bflo(w.w), bfhi(w.w)};
            v0 = v0 * rv * g0; v1 = v1 * rv * g1;
            *(LAS u32x4*)(lds + j * 384 + ch * 16) = pack8(v0, v1);
            if (c == 31) { float* o = cvp + (size_t)(b * 128 + j) * 768 + col; *(f32x4*)o = v0; *(f32x4*)(o + 4) = v1; }
        }
        __syncthreads();
        f32x16 acc[3];
#pragma unroll
        for (int i = 0; i < 3; ++i)
#pragma unroll
            for (int r = 0; r < 16; ++r) acc[i][r] = 0.f;
        const int nks = 2 * (ib + 1);
#pragma unroll 1
        for (int ks = 0; ks < nks; ++ks) {
            const bf16x8 af = *(const bf16x8*)(WST + (size_t)(g * 128 + 32 * ib + r32) * 128 + 16 * ks + 8 * hi);
            const int j0 = 16 * ks + 8 * hi + ((lane & 15) >> 2);
#pragma unroll
            for (int i = 0; i < 3; ++i) {
                const int col = 32 * (cb0 + i) + 16 * ((lane >> 4) & 1) + 4 * (lane & 3);
                const s16x4 lo = vtr(lds + j0 * 384 + col * 2), hh = vtr(lds + (j0 + 4) * 384 + col * 2);
                const bf16x8 vf = (bf16x8){lo[0], lo[1], lo[2], lo[3], hh[0], hh[1], hh[2], hh[3]};
                acc[i] = __builtin_amdgcn_mfma_f32_32x32x16_bf16(af, vf, acc[i], 0, 0, 0);
            }
        }
        LAS float* stg = (LAS float*)(lds + 49152 + wave * 4096);
#pragma unroll 1
        for (int i = 0; i < 3; ++i) {
            const f32x16 a = i == 0 ? acc[0] : i == 1 ? acc[1] : acc[2];
#pragma unroll
            for (int r = 0; r < 16; ++r) { const int q = crow(r, hi); stg[q * 32 + r32] = a[r] + bs[g * 128 + 32 * ib + q]; }
            asm volatile("s_waitcnt lgkmcnt(0)" ::: "memory");
            const int q = lane >> 1, hf = lane & 1; const size_t ro = (size_t)(rowb + 32 * ib + q); const int col = g * 192 + 32 * (cb0 + i) + 16 * hf;
            const u32x4 u0 = *(const u32x4*)(U + ro * 768 + col), u1 = *(const u32x4*)(U + ro * 768 + col + 8);
            const LAS f32x4* sp = (const LAS f32x4*)(stg + q * 32 + 16 * hf);
            const f32x4 m0 = sp[0], m1 = sp[1], m2 = sp[2], m3 = sp[3];
            u32x4 o0, o1;
            o0.x = cvtpk(bflo(u0.x) * m0[0], bfhi(u0.x) * m0[1]); o0.y = cvtpk(bflo(u0.y) * m0[2], bfhi(u0.y) * m0[3]); o0.z = cvtpk(bflo(u0.z) * m1[0], bfhi(u0.z) * m1[1]); o0.w = cvtpk(bflo(u0.w) * m1[2], bfhi(u0.w) * m1[3]);
            o1.x = cvtpk(bflo(u1.x) * m2[0], bfhi(u1.x) * m2[1]); o1.y = cvtpk(bflo(u1.y) * m2[2], bfhi(u1.y) * m2[3]); o1.z = cvtpk(bflo(u1.z) * m3[0], bfhi(u1.z) * m3[1]); o1.w = cvtpk(bflo(u1.w) * m3[2], bfhi(u1.w) * m3[3]);
            *(u32x4*)(Og + ro * DM + col) = o0; *(u32x4*)(Og + ro * DM + col + 8) = o1;
            asm volatile("s_waitcnt lgkmcnt(0)" ::: "memory");
        }
        __syncthreads();
    }
}

__device__ __forceinline__ void gmlp_sample(const Params& P, int G, int bid, int n0 = 0, int nn = NDEC) {
    const bf16_t* U = (const bf16_t*)(P.ws + WS_U); const bf16_t* GV = (const bf16_t*)(P.ws + WS_GV); bf16_t* Og = (bf16_t*)(P.ws + WS_O);
    const float* ssqv = (const float*)(P.ws + WS_SSQ) + 4 * M; const float* vg = P.in[17]; const float* wsb = P.in[18]; const float* bs = P.in[19]; float* cvs = P.out + O_CVS;
    for (int i = bid * 512 + threadIdx.x; i < nn * 768; i += G * 512) {
        const int n = n0 + i / 768, col = i % 768, g = col / 192; float vn[4];
#pragma unroll
        for (int s = 0; s < 4; ++s) { const int row = MP + 4 * n + s; vn[s] = bf2f(GV[(size_t)row * 768 + col]) * rsqrtf(ssqv[row] * (1.f / 768.f) + EPS) * vg[col]; cvs[(size_t)(4 * n + s) * 768 + col] = vn[s]; }
#pragma unroll
        for (int s = 0; s < 4; ++s) { float mx = bs[g * 128 + s];
#pragma unroll
            for (int j = 0; j < 4; ++j) if (j <= s) mx += wsb[(size_t)(g * 128 + s) * 128 + j] * vn[j];
            const int row = MP + 4 * n + s; Og[(size_t)row * DM + col] = f2bf_s(bf2f(U[(size_t)row * 768 + col]) * mx); }
    }
}

#define XB_TMO      128
#define XB_XCNT(j)  (256  + 64 * (j))
#define XB_XSUB(j)  (1280 + 64 * (j))
#define XB_XGEN(j)  (2304 + 64 * (j))
#define XB_TOP      3328
#define XB_TOPGEN   3392
#define XCD_BAR_WORDS 3456
#define XB_SPIN_CAP (1u << 22)
__device__ __forceinline__ unsigned xb_ld(unsigned* p)              { return __hip_atomic_load(p, __ATOMIC_RELAXED, __HIP_MEMORY_SCOPE_AGENT); }
__device__ __forceinline__ unsigned xb_add(unsigned* p, unsigned v) { return __hip_atomic_fetch_add(p, v, __ATOMIC_RELAXED, __HIP_MEMORY_SCOPE_AGENT); }
__device__ __forceinline__ unsigned xb_xcc_id() { return (unsigned)__builtin_amdgcn_s_getreg((3 << 11) | 20) & 0xFu; }
#define XB_SPIN(cond, bar) do { unsigned _sp = 0; while (cond) { __builtin_amdgcn_s_sleep(1); \
    if ((++_sp & 255u) == 0u) { if (xb_ld(&(bar)[XB_TMO])) break; if (_sp > XB_SPIN_CAP) { atomicAdd(&(bar)[XB_TMO], 1u); break; } } } } while (0)
struct XcdBarrier { unsigned* bar; unsigned x; volatile LAS unsigned* st; };
__device__ __forceinline__ XcdBarrier xcd_barrier_post(unsigned* bar, volatile LAS unsigned* st) {
    XcdBarrier b; b.bar = bar; b.x = xb_xcc_id(); b.st = st;
    if (threadIdx.x == 0) (void)xb_add(&bar[XB_XCNT(b.x)], 1u);
    return b;
}
__device__ __forceinline__ void xcd_barrier_complete(unsigned* bar, unsigned x, unsigned& nloc, unsigned& nx) {
    const unsigned G = gridDim.x * gridDim.y * gridDim.z;
    unsigned sum, cnt, mine, sp = 0u;
    for (;;) {
        sum = 0u; cnt = 0u; mine = 0u;
#pragma unroll
        for (unsigned j = 0; j < 16; ++j) { const unsigned c = xb_ld(&bar[XB_XCNT(j)]); sum += c; cnt += (c > 0u) ? 1u : 0u; mine = (j == x) ? c : mine; }
        if (sum == G) break;
        __builtin_amdgcn_s_sleep(1);
        if ((++sp & 255u) == 0u) { if (xb_ld(&bar[XB_TMO])) break; if (sp > XB_SPIN_CAP) { atomicAdd(&bar[XB_TMO], 1u); break; } }
    }
    nloc = mine > 0u ? mine : 1u; nx = cnt > 0u ? cnt : 1u;
}
__device__ __forceinline__ void xcd_barrier(const XcdBarrier& b) {
    asm volatile("s_waitcnt vmcnt(0)" ::: "memory");
    __syncthreads();
    if (threadIdx.x == 0) {
        unsigned* bar = b.bar;
        __builtin_amdgcn_s_waitcnt(0);
        unsigned nloc = b.st[0], nx = b.st[1];
        if (nloc == 0u) { xcd_barrier_complete(bar, b.x, nloc, nx); b.st[0] = nloc; b.st[1] = nx; }
        const unsigned old = xb_add(&bar[XB_XSUB(b.x)], 1u);
        const unsigned gen = old / nloc;
        if (old + 1u == (gen + 1u) * nloc) {
            __builtin_amdgcn_fence(__ATOMIC_RELEASE, "agent");
            asm volatile("s_waitcnt vmcnt(0)" ::: "memory");
            const unsigned og = xb_add(&bar[XB_TOP], 1u);
            const unsigned tg = og / nx;
            if (og + 1u == (tg + 1u) * nx) xb_add(&bar[XB_TOPGEN], 1u);
            else XB_SPIN(xb_ld(&bar[XB_TOPGEN]) == tg, bar);
            __builtin_amdgcn_fence(__ATOMIC_ACQUIRE, "agent");
            xb_add(&bar[XB_XGEN(b.x)], 1u);
            asm volatile("s_waitcnt vmcnt(0)" ::: "memory");
        } else {
            XB_SPIN(xb_ld(&bar[XB_XGEN(b.x)]) == gen, bar);
            __builtin_amdgcn_fence(__ATOMIC_ACQUIRE, "agent");
            asm volatile("s_waitcnt vmcnt(0)" ::: "memory");
        }
    }
    __syncthreads();
}

#define GB_CNT(g) (3584 + 128 * (g))
#define GB_GEN(g) (3648 + 128 * (g))
static_assert((3648 + 128 * 7 + 1) * 4 <= 32768, "group barrier words inside the control region");
#define GB_DEF 6144
#define GB_XMAX(g) (4608 + 64 * (g))
#define GB_XMIN(g) (5120 + 64 * (g))
__device__ __forceinline__ void group_barrier(unsigned* bar, int grp, unsigned nblk, unsigned& epoch, bool coloc) {
    asm volatile("s_waitcnt vmcnt(0)" ::: "memory");
    __syncthreads();
    if (threadIdx.x == 0) {
        if (!coloc) { __builtin_amdgcn_fence(__ATOMIC_RELEASE, "agent"); asm volatile("s_waitcnt vmcnt(0)" ::: "memory"); }
        const unsigned old = xb_add(&bar[GB_CNT(grp)], 1u);
        if (old + 1u == (epoch + 1u) * nblk) xb_add(&bar[GB_GEN(grp)], 1u);
        else XB_SPIN(xb_ld(&bar[GB_GEN(grp)]) == epoch, bar);
        __builtin_amdgcn_fence(__ATOMIC_ACQUIRE, "agent");
        asm volatile("s_waitcnt vmcnt(0)" ::: "memory");
    }
    ++epoch;
    __syncthreads();
}


__global__ void __launch_bounds__(512, 2) mk_fwd(Params P) {
    extern __shared__ __attribute__((aligned(16))) unsigned char lds_raw[];
    LAS unsigned char* lds = (LAS unsigned char*)lds_raw;
    const int tid = threadIdx.x, wave = __builtin_amdgcn_readfirstlane(tid >> 6);
    const int G = gridDim.x, bid = blockIdx.x;
    LAS float* wsf = (LAS float*)(lds + WSF_OFF) + wave * 64;
    unsigned char* ws = P.ws;
    float* ssq = (float*)(ws + WS_SSQ);
    bf16_t* XB = (bf16_t*)(ws + WS_XB);
    cg::grid_group grid = cg::this_grid();
    const int lo = P.ph_lo, hi = P.ph_hi;
#ifndef PH_MASK
#define PH_MASK 0x1fff
#endif
#define IN(k) (((PH_MASK >> (k)) & 1) && lo <= (k) && (k) < hi)
#ifndef USE_XCD_BAR
#define USE_XCD_BAR 1
#endif
    volatile LAS unsigned* bst = (volatile LAS unsigned*)(lds + BST_OFF);
    if (tid < 2) bst[tid] = 0u;
    __syncthreads();
    XcdBarrier xbar = xcd_barrier_post((unsigned*)(ws + WS_CTL), bst);
    if (tid == 0 && (G % 8) == 0) { unsigned* cb = (unsigned*)(ws + WS_CTL); const unsigned xc = xb_xcc_id();
        __hip_atomic_fetch_max(&cb[GB_XMAX(bid % 8)], xc + 1u, __ATOMIC_RELAXED, __HIP_MEMORY_SCOPE_AGENT); __hip_atomic_fetch_max(&cb[GB_XMIN(bid % 8)], 16u - xc, __ATOMIC_RELAXED, __HIP_MEMORY_SCOPE_AGENT); }
    unsigned long long t_prev = 0ull, t_probe = 0ull;
    if (TPROBE == 200 && bid == 0) { const unsigned long long t0 = __builtin_amdgcn_s_memrealtime(); while (__builtin_amdgcn_s_memrealtime() - t0 < 20000ull) __builtin_amdgcn_s_sleep(8); }
    if (TPROBE >= 0) t_prev = __builtin_amdgcn_s_memrealtime();
    const unsigned long long t_start = t_prev;
#ifndef GROUP_BAR
#define GROUP_BAR 1
#endif
    unsigned gepoch = 0u;
    const int ng_ = (G % 8 == 0) ? 8 : 1;
    bool coloc = false;
#define SEAM(k) do { if (IN(k) && IN((k) + 1)) { if (!USE_XCD_BAR) grid.sync(); else if (GROUP_BAR && ng_ == 8 && (k) != 0) group_barrier((unsigned*)(ws + WS_CTL), bid % 8, (unsigned)(G / 8), gepoch, coloc); else xcd_barrier(xbar); \
        if (STAGGER_NS > 0 && ng_ == 8 && (k) == 0) { const unsigned long long t0_ = __builtin_amdgcn_s_memrealtime(); const unsigned long long w_ = (unsigned long long)(bid % 8) * STAGGER_NS / 10ull; while (__builtin_amdgcn_s_memrealtime() - t0_ < w_) __builtin_amdgcn_s_sleep(2); } \
        if ((k) == 0 && ng_ == 8) { unsigned* cb = (unsigned*)(ws + WS_CTL); const unsigned a = xb_ld(&cb[GB_XMAX(bid % 8)]), b2 = xb_ld(&cb[GB_XMIN(bid % 8)]); coloc = (a != 0u) && (a - 1u == 16u - b2); } } \
    if (TPROBE >= 0) { const unsigned long long tn = __builtin_amdgcn_s_memrealtime(); if (TPROBE == (k)) t_probe = tn - t_prev; t_prev = tn; } } while (0)

    const int ng = (G % 8 == 0) ? 8 : 1, grp = bid % ng, lb = bid / ng, LB = G / ng;
    const bool early = (lb & 1) != 0;
    const int srow = MP + (MS / ng) * grp, snrow = MS / ng;
    if (IN(0)) { p0_prologue(P, lds, G, bid, 0); }
    SEAM(0);
    const int gwave = bid * 8 + wave, NW = G * 8;
    const bf16_t* XBs = XB;
    if (IN(1)) {
        EpiInA E{ssq, (bf16_t*)(ws + WS_Q), (const float*)(ws + WS_GT), P.out};
        EpiMemKV E2{ssq + 5 * M, P.in[23], P.out + O_MKP, P.out + O_MVP, (bf16_t*)(ws + WS_MK), (bf16_t*)(ws + WS_MV)};
        const int mrow = (MMEM / ng) * grp, mnrow = MMEM / ng, mtask = (mnrow / 64) * 16, msplit = mtask * 5 / 16;
        if (early) { sample_gemm<4, 4>(lds, XBs, DM, (const bf16_t*)(ws + WS_WINA), 6, E, lb >> 1, LB >> 1, srow, snrow);
                     sample_gemm<4, 4>(lds, (const bf16_t*)(ws + WS_MEMB), DM, (const bf16_t*)(ws + WS_WMKV), 4, E2, lb >> 1, LB >> 1, mrow, mnrow, 0, msplit); }
        { pg8::Gemm g{XB, (const bf16_t*)(ws + WS_WINA), DM, DM}; pg8::StaticOrder S; S.init(MP, NINA, G, bid);
          pg8::gemm_phase<EpiInA, true, true>(lds, g, S, E); }
        if (!early) sample_gemm<4, 4>(lds, (const bf16_t*)(ws + WS_MEMB), DM, (const bf16_t*)(ws + WS_WMKV), 4, E2, lb >> 1, (LB + 1) >> 1, mrow, mnrow, msplit, mtask);
    }
    SEAM(1);
    if (IN(2)) {
        const int nA = 512 / ng, nB = 512 / ng, nD = 256 / ng, nU = nA + nB + 2 * nD, ns2 = (nU + LB - 1) / LB;
        for (int j = 0; j < ns2; ++j) { const int jj = (early && ns2 == 6) ? (j + 4) % 6 : j; const int u = lb + jj * LB; if (u >= nU) continue;
            if (u < nA) { const int v = u; unit_swa_prompt(P, lds, wsf, grp * (8 / ng) + (v >> 6), (v >> 2) & 15, v & 3); }
            else if (u < nA + nB) { const int v = u - nA; unit_mem_prompt(P, lds, wsf, 0, grp * (8 / ng) + (v >> 6), (v >> 2) & 15, v & 3); }
            else if (u < nA + nB + nD) { const int v = u - nA - nB; unit_mem_sample(P, lds, wsf, 0, grp * (NDEC / ng) + (v >> 1), v & 1); }
            else { const int v = u - nA - nB - nD; unit_swa_sample(P, lds, wsf, grp * (NDEC / ng) + (v >> 1), v & 1); }
        }
    }
    SEAM(2);
    if (IN(3)) {
        pg8::Gemm g{(const bf16_t*)(ws + WS_O), (const bf16_t*)(ws + WS_WOUTA), DM, DM}; pg8::StaticOrder S; S.init(MP, DM, G, bid);
        EpiRes<false, false> E{nullptr, nullptr, nullptr, XB, ssq + M};
        if (early) sample_gemm<2, 4>(lds, (const bf16_t*)(ws + WS_O), DM, (const bf16_t*)(ws + WS_WOUTA), 4, E, lb, LB, srow, snrow);
        pg8::gemm_phase<EpiRes<false, false>, true, true>(lds, g, S, E);
        if (!early) sample_gemm<2, 4>(lds, (const bf16_t*)(ws + WS_O), DM, (const bf16_t*)(ws + WS_WOUTA), 4, E, lb, LB, srow, snrow);
    }
    SEAM(3);
    if (IN(4)) {
        pg8::Gemm g{XB, (const bf16_t*)(ws + WS_WFFN), DM, DM}; pg8::StaticOrder S; S.init(MP, NFF, G, bid);
        EpiFfnConv E{ssq + M, (bf16_t*)(ws + WS_H), P.in[25], P.in[26], (float*)(ws + WS_SIDE), P.out + O_CONVP, (LAS float*)(lds + RING_BYTES)};
        if (early) sample_ffn(P, lds, 0, ssq + M, lb, LB, (snrow / 64) * grp, snrow / 64);
        pg8::gemm_phase<EpiFfnConv, true, true>(lds, g, S, E);
        if (!early) sample_ffn(P, lds, 0, ssq + M, lb, LB, (snrow / 64) * grp, snrow / 64);
    }
    SEAM(4);
    if (IN(5)) {
        pg8::Gemm g{(const bf16_t*)(ws + WS_H), (const bf16_t*)(ws + WS_WDOWN), DFF, DFF}; pg8::StaticOrder S; S.init(MP, DM, G, bid);
        ffn_fixup(P, 0, S);
        EpiRes<false, false> E{nullptr, nullptr, nullptr, XB, ssq + 2 * M};
        if (early) sample_gemm<2, 11>(lds, (const bf16_t*)(ws + WS_H), DFF, (const bf16_t*)(ws + WS_WDOWN), 4, E, lb, LB, srow, snrow);
        pg8::gemm_phase<EpiRes<false, false>, true, true>(lds, g, S, E);
        if (!early) sample_gemm<2, 11>(lds, (const bf16_t*)(ws + WS_H), DFF, (const bf16_t*)(ws + WS_WDOWN), 4, E, lb, LB, srow, snrow);
    }
    SEAM(5);
    if (IN(6)) {
        pg8::Gemm g{XB, (const bf16_t*)(ws + WS_WINB), DM, DM}; pg8::StaticOrder S; S.init(MP, NINB, G, bid);
        EpiInB E{ssq + 2 * M, (bf16_t*)(ws + WS_U), (bf16_t*)(ws + WS_GV), (bf16_t*)(ws + WS_XQ), P.in[22] + 64, ssq + 4 * M};
        pg8::gemm_phase<EpiInB, true, true>(lds, g, S, E);
        if (lb >= LB / 2) { sample_gemm<4, 4>(lds, XBs, DM, (const bf16_t*)(ws + WS_WINB), 7, E, lb - LB / 2, LB - LB / 2, srow, snrow);
                            p0_prologue(P, lds, (LB - LB / 2) * ng, (lb - LB / 2) * ng + grp, 1);
                            asm volatile("s_waitcnt vmcnt(0)" ::: "memory"); __syncthreads();
                            if (tid == 0) { __builtin_amdgcn_fence(__ATOMIC_RELEASE, "agent"); asm volatile("s_waitcnt vmcnt(0)" ::: "memory"); xb_add((unsigned*)(ws + WS_CTL) + GB_DEF, 1u); } }
    }
    SEAM(6);
    if (IN(7)) {
        const int nG = 256 / ng, nB = 512 / ng, nD = 256 / ng, nU = nG + nB + nD, ns7 = (nU + LB - 1) / LB;
        for (int j = 0; j < ns7; ++j) { const int jj = (early && ns7 == 4) ? (j + 3) % 4 : j; const int u = lb + jj * LB; if (u >= nU) continue;
            if (u < nG) { const int v = u; unit_gmlp_prompt(P, lds, grp * (8 / ng) + (v >> 5), v & 31); }
            else if (u < nG + nB) { const int v = u - nG; unit_mem_prompt(P, lds, wsf, 1, grp * (8 / ng) + (v >> 6), (v >> 2) & 15, v & 3); }
            else { const int v = u - nG - nB; unit_mem_sample(P, lds, wsf, 1, grp * (NDEC / ng) + (v >> 1), v & 1); }
        }
        gmlp_sample(P, LB, lb, grp * (NDEC / ng), NDEC / ng);
    }
    SEAM(7);
    if (IN(8)) {
        if (IN(6)) {
            if (tid == 0) { unsigned* cb = (unsigned*)(ws + WS_CTL); const unsigned need = (unsigned)((LB - LB / 2) * ng);
                XB_SPIN(xb_ld(&cb[GB_DEF]) < need, cb);
                __builtin_amdgcn_fence(__ATOMIC_ACQUIRE, "agent"); asm volatile("s_waitcnt vmcnt(0)" ::: "memory"); }
            __syncthreads();
        }
        pg8::Gemm g{(const bf16_t*)(ws + WS_O), (const bf16_t*)(ws + WS_WOUTB), DM, DM}; pg8::StaticOrder S; S.init(MP, DM, G, bid);
        EpiRes<false, false> E{nullptr, nullptr, nullptr, XB, ssq + 3 * M};
        if (early) sample_gemm<2, 4>(lds, (const bf16_t*)(ws + WS_O), DM, (const bf16_t*)(ws + WS_WOUTB), 4, E, lb, LB, srow, snrow);
        pg8::gemm_phase<EpiRes<false, false>, true, true>(lds, g, S, E);
        if (!early) sample_gemm<2, 4>(lds, (const bf16_t*)(ws + WS_O), DM, (const bf16_t*)(ws + WS_WOUTB), 4, E, lb, LB, srow, snrow);
    }
    SEAM(8);
    if (IN(9)) {
        pg8::Gemm g{XB, (const bf16_t*)(ws + WS_WFFN) + (size_t)NFF * DM, DM, DM}; pg8::StaticOrder S; S.init(MP, NFF, G, bid);
        EpiFfnConv E{ssq + 3 * M, (bf16_t*)(ws + WS_H), P.in[25] + 3 * DFF, P.in[26] + DFF, (float*)(ws + WS_SIDE), P.out + O_CONVP + (size_t)NBATCH * 2 * DFF, (LAS float*)(lds + RING_BYTES)};
        if (early) sample_ffn(P, lds, 1, ssq + 3 * M, lb, LB, (snrow / 64) * grp, snrow / 64);
        pg8::gemm_phase<EpiFfnConv, true, true>(lds, g, S, E);
        if (!early) sample_ffn(P, lds, 1, ssq + 3 * M, lb, LB, (snrow / 64) * grp, snrow / 64);
    }
    SEAM(9);
    if (IN(10)) {
        pg8::Gemm g{(const bf16_t*)(ws + WS_H), (const bf16_t*)(ws + WS_WDOWN) + (size_t)DM * DFF, DFF, DFF}; pg8::StaticOrder S; S.init(MP, DM, G, bid);
        ffn_fixup(P, 1, S);
        EpiRes<false, true> E{nullptr, nullptr, P.out + O_Y, XB, nullptr};
        if (early) sample_gemm<2, 11>(lds, (const bf16_t*)(ws + WS_H), DFF, (const bf16_t*)(ws + WS_WDOWN) + (size_t)DM * DFF, 4, E, lb, LB, srow, snrow);
        pg8::gemm_phase<EpiRes<false, true>, true, true>(lds, g, S, E);
        if (!early) sample_gemm<2, 11>(lds, (const bf16_t*)(ws + WS_H), DFF, (const bf16_t*)(ws + WS_WDOWN) + (size_t)DM * DFF, 4, E, lb, LB, srow, snrow);
    }
    if ((TPROBE >= 0) && bid == 0) {
        __syncthreads();
        const unsigned long long tn = __builtin_amdgcn_s_memrealtime();
        if (TPROBE == 10) t_probe = tn - t_prev;
        if (TPROBE == 100) t_probe = tn - t_start;
        while (__builtin_amdgcn_s_memrealtime() - tn < t_probe) __builtin_amdgcn_s_sleep(8);
    }
#undef IN
#undef SEAM
}

extern "C" void kernel_launch(void* const* d_in, const int* in_sizes, int n_in, void* d_out, int out_size, void* d_ws, size_t ws_size, hipStream_t stream) {
    static int grid = 0;
    if (grid == 0) {
        if (n_in != 28 || (size_t)out_size != O_END || ws_size < WS_END) { fprintf(stderr, "kernel_launch: unexpected shapes: n_in %d out %d ws %zu (need %zu)\n", n_in, out_size, ws_size, (size_t)WS_END); grid = -1; return; }
        int dev = 0, cus = 0, per_cu = 0;
        hipGetDevice(&dev); hipDeviceGetAttribute(&cus, hipDeviceAttributeMultiprocessorCount, dev);
        if (hipFuncSetAttribute((const void*)mk_fwd, hipFuncAttributeMaxDynamicSharedMemorySize, LDS_BYTES) != hipSuccess) { fprintf(stderr, "kernel_launch: hipFuncSetAttribute failed\n"); grid = -1; return; }
        hipOccupancyMaxActiveBlocksPerMultiprocessor(&per_cu, (const void*)mk_fwd, 512, LDS_BYTES);
        (void)hipGetLastError();
        if (per_cu < 1) { fprintf(stderr, "kernel_launch: occupancy query says %d blocks per CU\n", per_cu); per_cu = 1; }
        grid = cus;
    }
    if (grid < 0) return;
    if (hipMemsetAsync((char*)d_ws + WS_CTL, 0, CTL_BYTES, stream) != hipSuccess) { fprintf(stderr, "kernel_launch: memset failed\n"); return; }
    Params p{};
    for (int i = 0; i < 28; ++i) p.in[i] = (const float*)d_in[i];
    p.out = (float*)d_out; p.ws = (unsigned char*)d_ws;
#if MK_N_LAUNCHES == 1
    p.ph_lo = 0; p.ph_hi = NPHASE;
    void* args[] = {&p};
    hipError_t e = hipLaunchCooperativeKernel((const void*)mk_fwd, dim3(grid), dim3(512), args, LDS_BYTES, stream);
    if (e != hipSuccess) fprintf(stderr, "cooperative launch failed: %s (grid %d)\n", hipGetErrorString(e), grid);
#else
    for (int ph = 0; ph < NPHASE; ++ph) {
        p.ph_lo = ph; p.ph_hi = ph + 1;
        hipLaunchKernelGGL(mk_fwd, dim3(grid), dim3(512), LDS_BYTES, stream, p);
    }
#endif
}
```

```cpp
#include <hip/hip_runtime.h>
#include <hip/hip_cooperative_groups.h>
#include <cstdio>
#include <cstdint>
namespace cg = cooperative_groups;

#ifndef MK_N_LAUNCHES
#define MK_N_LAUNCHES 1
#endif

#ifndef TPROBE
#define TPROBE -1
#endif
#ifndef STAGGER_NS
#define STAGGER_NS 0
#endif
#ifndef DUP
#define DUP -1
#endif
#define LAS __attribute__((address_space(3)))
typedef unsigned short bf16_t;
typedef short bf16x8 __attribute__((ext_vector_type(8)));
typedef short s16x4 __attribute__((ext_vector_type(4)));
typedef float f32x4 __attribute__((ext_vector_type(4)));
typedef float f32x2 __attribute__((ext_vector_type(2)));
typedef float f32x16 __attribute__((ext_vector_type(16)));
typedef unsigned u32x4 __attribute__((ext_vector_type(4)));
typedef unsigned u32x2 __attribute__((ext_vector_type(2)));
typedef __bf16 bf16x2_t __attribute__((ext_vector_type(2)));

constexpr int DM = 1024, NBATCH = 8, SEQ = 4096, MP = NBATCH * SEQ, NDEC = 128, DSEQ = 4, MS = NDEC * DSEQ, M = MP + MS;
constexpr int NMEM = 256, MMEM = NBATCH * NMEM;
constexpr int DFF = 2816, NFF = 2 * DFF;
constexpr int NINA = 1536, NINB = 1792;
constexpr float EPS = 1e-6f;
constexpr float LOG2E = 1.4426950408889634f;
constexpr int NPHASE = 11;

constexpr size_t O_Y = 0, O_WKP = 34078720, O_WVP = 34340864, O_CVP = 34603008, O_MKP = 35389440, O_MVP = 36438016, O_CONVP = 37486592,
                 O_WKS = 37576704, O_WVS = 41771008, O_CVS = 45965312, O_CONVS = 46358528, O_END = 47800320;

constexpr size_t MiB = 1u << 20;
constexpr size_t WS_SSQ = 0, WS_GT = 1 * MiB, WS_CTL = 1 * MiB + 65536, CTL_BYTES = 32768;
constexpr size_t WS_WINA = 2 * MiB, WS_WOUTA = 5 * MiB, WS_WINB = 7 * MiB, WS_WOUTB = 11 * MiB, WS_WMKV = 13 * MiB, WS_WFFN = 15 * MiB,
                 WS_WDOWN = 37 * MiB, WS_WST = 48 * MiB;
constexpr size_t WS_MEMB = 50 * MiB, WS_MK = 54 * MiB, WS_MV = 56 * MiB;
constexpr size_t WS_XB = 58 * MiB;
constexpr size_t WS_H = 124 * MiB;
constexpr size_t WS_A = 304 * MiB, WS_B = 353 * MiB, WS_OB = 402 * MiB, WS_X1 = 467 * MiB;
constexpr size_t WS_SIDE = 484 * MiB, SIDE_N = (size_t)128 * 2 * DFF;
constexpr size_t WS_END = WS_SIDE + 3 * SIDE_N * 4;
static_assert(WS_H + (size_t)M * DFF * 2 <= WS_A && WS_A + (size_t)M * 768 * 2 <= WS_B && WS_B + (size_t)M * 768 * 2 <= WS_OB && WS_OB + (size_t)M * 1024 * 2 <= WS_X1 && WS_X1 + (size_t)M * 256 * 2 <= WS_SIDE, "workspace map");
static_assert(WS_END <= 512 * MiB, "ws");

namespace pg8 {
constexpr int BM = 256, BK = 64, HALF = 128, HTB = HALF * BK * 2, STAGE_BYTES = 8 * HTB, NXCD = 8, WGM = 8;
__host__ __device__ __forceinline__ int lds_byte(int r, int c) { const int st = (r >> 4) * 2 + (c >> 5), rr = r & 15, cc = c & 31, ob = rr * 64 + cc * 2; return st * 1024 + (ob ^ (((ob >> 9) & 1) << 5)); }
__host__ __device__ __forceinline__ void stage_rc(int b, int& R, int& C) { const int st = b / 1024, sb = b % 1024, swz = sb ^ (((sb >> 9) & 1) << 5); R = (st >> 1) * 16 + swz / 64; C = (st & 1) * 32 + (swz % 64) / 2; }
__host__ __device__ __forceinline__ int perm32(int rho) { const int n = rho >> 4, i = rho & 15; return 8 * (i >> 2) + 4 * n + (i & 3); }

struct Unit { int pm, pn; };
struct Gemm { const bf16_t* A; const bf16_t* Bt; int lda, K; };

struct StaticOrder {
    int nM, nN, nwg, G, c;
    __device__ void init(int Mr, int N, int G_, int c_) { nM = Mr / BM; nN = N / BM; nwg = nM * nN; G = G_; c = c_; }
    __device__ bool next(int i, Unit& u) const {
        const long L = (long)i * G + c; if (L >= nwg) return false;
        int wgid = (int)L; { const int q = nwg / NXCD, r = nwg % NXCD, xcd = wgid % NXCD, off = wgid / NXCD; wgid = (xcd < r ? xcd * (q + 1) : r * (q + 1) + (xcd - r) * q) + off; }
        const int nig = WGM * nN, gid = wgid / nig, fm = gid * WGM, gsz = (nM - fm) < WGM ? (nM - fm) : WGM;
        u.pm = fm + ((wgid % nig) % gsz); u.pn = (wgid % nig) / gsz; return true;
    }
};

template <class Epi, bool ALIGN_EPI, bool SP2>
__device__ __forceinline__ void gemm_phase(LAS unsigned char* lds, const Gemm g, const StaticOrder& S, const Epi& E) {
    const int tid = threadIdx.x, wid = __builtin_amdgcn_readfirstlane(tid >> 6), lane = tid & 63, wr = wid >> 2, wc = wid & 3, fr = lane & 15, fq = lane >> 4;
    const int K = g.K, nt = K / BK, lda = g.lda;
    unsigned voffA[2], voffB[2];
#pragma unroll
    for (int i = 0; i < 2; ++i) { int R, C; stage_rc(tid * 16 + i * 8192, R, C); const int Rb = (R & ~31) + perm32(R & 31);
        voffA[i] = (unsigned)(R * lda + C) * 2u; voffB[i] = (unsigned)(Rb * K + C) * 2u; }
    const size_t kstep = (size_t)(BK * 2);
    const size_t hstepA = (size_t)HALF * lda * 2, hstepB = (size_t)HALF * K * 2;
    const size_t tstepA = 2 * hstepA, tstepB = 2 * hstepB;
    const unsigned ldsw = (unsigned)wid * 1024u;
    const int aoff = lds_byte(wr * 64 + fr, fq * 8), boff = lds_byte(wc * 32 + fr, fq * 8);
#define PG8_SA(b, h) (((b) * 2 + (h)) * HTB)
#define PG8_SB(b, h) ((4 + (b) * 2 + (h)) * HTB)
#define PG8_STAGE(bufoff, gbase, voff) do { _Pragma("unroll") for (int _i = 0; _i < 2; ++_i) \
        __builtin_amdgcn_global_load_lds((const unsigned*)((const char*)(gbase) + (voff)[_i]), (LAS unsigned*)(lds + (bufoff) + ldsw + _i * 8192), 16, 0, 0); } while (0)
#define PG8_LDA(dst, b, h) do { _Pragma("unroll") for (int m = 0; m < 4; ++m) _Pragma("unroll") for (int k = 0; k < 2; ++k) dst[m][k] = *(const LAS bf16x8*)(lds + PG8_SA(b, h) + aoff + m * 2048 + k * 1024); } while (0)
#define PG8_LDB(dst, b, h) do { _Pragma("unroll") for (int n = 0; n < 2; ++n) _Pragma("unroll") for (int k = 0; k < 2; ++k) dst[n][k] = *(const LAS bf16x8*)(lds + PG8_SB(b, h) + boff + n * 2048 + k * 1024); } while (0)
#define PG8_MMA(ai, bj, At, Bt) do { __builtin_amdgcn_s_setprio(1); _Pragma("unroll") for (int m = 0; m < 4; ++m) _Pragma("unroll") for (int n = 0; n < 2; ++n) _Pragma("unroll") for (int k = 0; k < 2; ++k) \
        acc[ai][bj][m][n] = __builtin_amdgcn_mfma_f32_16x16x32_bf16(Bt[n][k], At[m][k], acc[ai][bj][m][n], 0, 0, 0); __builtin_amdgcn_s_setprio(0); } while (0)
#define PG8_WAIT_V(n) asm volatile("s_waitcnt vmcnt(" #n ")" ::: "memory")
#define PG8_WAIT_L(n) asm volatile("s_waitcnt lgkmcnt(" #n ")" ::: "memory")
#define PG8_BAR __builtin_amdgcn_s_barrier()
#define PG8_SCHED __builtin_amdgcn_sched_barrier(0)
    Unit cur, nxt; int ui = 0;
    if (!S.next(0, cur)) return;
    f32x4 acc[2][2][4][2];
#pragma unroll
    for (int a = 0; a < 2; ++a)
#pragma unroll
        for (int b = 0; b < 2; ++b)
#pragma unroll
            for (int m = 0; m < 4; ++m)
#pragma unroll
                for (int n = 0; n < 2; ++n) acc[a][b][m][n] = (f32x4){0.f, 0.f, 0.f, 0.f};
    bf16x8 At[4][2], B0[2][2], B1[2][2];
    const char* cA = (const char*)g.A + (size_t)cur.pm * tstepA; const char* cB = (const char*)g.Bt + (size_t)cur.pn * tstepB;
    if constexpr (SP2) {
        PG8_STAGE(PG8_SB(0, 0), cB, voffB); PG8_STAGE(PG8_SB(0, 1), cB + hstepB, voffB); PG8_STAGE(PG8_SA(0, 0), cA, voffA); PG8_STAGE(PG8_SA(0, 1), cA + hstepA, voffA);
        if (wr == 1) PG8_BAR;
        PG8_WAIT_V(2); PG8_BAR;
        PG8_STAGE(PG8_SB(1, 0), cB + kstep, voffB); PG8_STAGE(PG8_SA(1, 0), cA + kstep, voffA); PG8_STAGE(PG8_SB(1, 1), cB + hstepB + kstep, voffB);
        PG8_WAIT_V(6); PG8_BAR;
    } else {
        PG8_STAGE(PG8_SB(0, 0), cB, voffB); PG8_STAGE(PG8_SA(0, 0), cA, voffA); PG8_STAGE(PG8_SB(0, 1), cB + hstepB, voffB); PG8_STAGE(PG8_SA(0, 1), cA + hstepA, voffA);
        if (wr == 1) PG8_BAR;
        PG8_WAIT_V(4); PG8_BAR;
        PG8_STAGE(PG8_SB(1, 0), cB + kstep, voffB); PG8_STAGE(PG8_SA(1, 0), cA + kstep, voffA); PG8_STAGE(PG8_SB(1, 1), cB + hstepB + kstep, voffB);
        PG8_WAIT_V(6); PG8_BAR;
    }
    for (;;) {
        const bool has_next = S.next(ui + 1, nxt);
        const char* nA = has_next ? (const char*)g.A + (size_t)nxt.pm * tstepA : cA; const char* nB = has_next ? (const char*)g.Bt + (size_t)nxt.pn * tstepB : cB;
        for (int t = 0; t < nt; t += 2) {
            const bool last = (t == nt - 2);
            const char* a1 = cA + (size_t)(t + 1) * kstep;
            const char* a2 = last ? nA : cA + (size_t)(t + 2) * kstep; const char* b2 = last ? nB : cB + (size_t)(t + 2) * kstep;
            const char* a3 = a2 + kstep; const char* b3 = b2 + kstep;
            if constexpr (SP2) {
            PG8_LDB(B0, 0, 0); PG8_LDB(B1, 0, 1); PG8_SCHED; PG8_LDA(At, 0, 0); PG8_STAGE(PG8_SA(1, 1), a1 + hstepA, voffA);
            PG8_WAIT_V(8); PG8_WAIT_L(0); PG8_BAR; PG8_MMA(0, 0, At, B0); PG8_MMA(0, 1, At, B1); PG8_BAR; PG8_SCHED;
            PG8_LDA(At, 0, 1); PG8_STAGE(PG8_SB(0, 0), b2, voffB); PG8_STAGE(PG8_SB(0, 1), b2 + hstepB, voffB); PG8_STAGE(PG8_SA(0, 0), a2, voffA);
            PG8_WAIT_V(8); PG8_WAIT_L(0); PG8_BAR; PG8_MMA(1, 0, At, B0); PG8_MMA(1, 1, At, B1); PG8_BAR; PG8_SCHED;
            PG8_LDB(B0, 1, 0); PG8_LDB(B1, 1, 1); PG8_SCHED; PG8_LDA(At, 1, 0); PG8_STAGE(PG8_SA(0, 1), a2 + hstepA, voffA);
            PG8_WAIT_V(8); PG8_WAIT_L(0); PG8_BAR; PG8_MMA(0, 0, At, B0); PG8_MMA(0, 1, At, B1); PG8_BAR; PG8_SCHED;
            PG8_LDA(At, 1, 1); PG8_STAGE(PG8_SB(1, 0), b3, voffB); PG8_STAGE(PG8_SB(1, 1), b3 + hstepB, voffB); PG8_STAGE(PG8_SA(1, 0), a3, voffA);
            PG8_WAIT_V(8); PG8_WAIT_L(0); PG8_BAR; PG8_MMA(1, 0, At, B0); PG8_MMA(1, 1, At, B1); PG8_BAR; PG8_SCHED;
            } else {
            PG8_LDB(B0, 0, 0); PG8_SCHED; PG8_LDA(At, 0, 0); PG8_STAGE(PG8_SA(1, 1), a1 + hstepA, voffA);
            PG8_WAIT_L(8); PG8_BAR; PG8_WAIT_L(0); PG8_MMA(0, 0, At, B0); PG8_BAR; PG8_SCHED;
            PG8_LDB(B1, 0, 1); PG8_STAGE(PG8_SB(0, 0), b2, voffB);
            PG8_BAR; PG8_WAIT_L(0); PG8_MMA(0, 1, At, B1); PG8_BAR;
            PG8_LDA(At, 0, 1); PG8_STAGE(PG8_SA(0, 0), a2, voffA);
            PG8_BAR; PG8_WAIT_L(0); PG8_MMA(1, 0, At, B0); PG8_BAR; PG8_SCHED;
            PG8_STAGE(PG8_SB(0, 1), b2 + hstepB, voffB);
            PG8_WAIT_V(6); PG8_BAR; PG8_MMA(1, 1, At, B1); PG8_BAR;
            PG8_LDB(B0, 1, 0); PG8_SCHED; PG8_LDA(At, 1, 0); PG8_STAGE(PG8_SA(0, 1), a2 + hstepA, voffA);
            PG8_WAIT_L(8); PG8_BAR; PG8_WAIT_L(0); PG8_MMA(0, 0, At, B0); PG8_BAR; PG8_SCHED;
            PG8_LDB(B1, 1, 1); PG8_STAGE(PG8_SB(1, 0), b3, voffB);
            PG8_BAR; PG8_WAIT_L(0); PG8_MMA(0, 1, At, B1); PG8_BAR;
            PG8_LDA(At, 1, 1); PG8_STAGE(PG8_SA(1, 0), a3, voffA);
            PG8_BAR; PG8_WAIT_L(0); PG8_MMA(1, 0, At, B0); PG8_BAR; PG8_SCHED;
            PG8_STAGE(PG8_SB(1, 1), b3 + hstepB, voffB);
            PG8_WAIT_V(6); PG8_BAR; PG8_MMA(1, 1, At, B1); PG8_BAR;
            }
        }
        if constexpr (ALIGN_EPI) { if (wr == 0) PG8_BAR; }
        E(acc, cur, wr, wc, fr, fq);
        if (!has_next) break;
#pragma unroll
        for (int a = 0; a < 2; ++a)
#pragma unroll
            for (int b = 0; b < 2; ++b)
#pragma unroll
                for (int m = 0; m < 4; ++m)
#pragma unroll
                    for (int n = 0; n < 2; ++n) acc[a][b][m][n] = (f32x4){0.f, 0.f, 0.f, 0.f};
        cur = nxt; cA = nA; cB = nB; ++ui;
        if constexpr (ALIGN_EPI) { if (wr == 1) PG8_BAR; }
    }
    PG8_WAIT_V(0);
    if constexpr (!ALIGN_EPI) { if (wr == 0) PG8_BAR; }
    PG8_BAR;
#undef PG8_SA
#undef PG8_SB
#undef PG8_STAGE
#undef PG8_LDA
#undef PG8_LDB
#undef PG8_MMA
#undef PG8_WAIT_V
#undef PG8_WAIT_L
#undef PG8_BAR
#undef PG8_SCHED
}
}
using pg8::Unit;

constexpr int RING_BYTES = 131072, WSF_OFF = RING_BYTES, OSTG2_OFF = RING_BYTES + 4096, BST_OFF = RING_BYTES + 16384, LDS_BYTES = BST_OFF + 256;
__device__ __forceinline__ unsigned cvtpk(float lo, float hi) { f32x2 v = {lo, hi}; bf16x2_t b = __builtin_convertvector(v, bf16x2_t); return __builtin_bit_cast(unsigned, b); }
__device__ __forceinline__ u32x4 pack8(const f32x4 a, const f32x4 b) { u32x4 w; w.x = cvtpk(a[0], a[1]); w.y = cvtpk(a[2], a[3]); w.z = cvtpk(b[0], b[1]); w.w = cvtpk(b[2], b[3]); return w; }
__device__ __forceinline__ float bf2f(unsigned short h) { return __uint_as_float((unsigned)h << 16); }
__device__ __forceinline__ float bflo(unsigned w) { return __uint_as_float(w << 16); }
__device__ __forceinline__ float bfhi(unsigned w) { return __uint_as_float(w & 0xffff0000u); }
__device__ __forceinline__ float wave_sum(float v) {
#pragma unroll
    for (int o = 1; o < 64; o <<= 1) v += __shfl_xor(v, o);
    return v;
}
__device__ __forceinline__ f32x2 gelu_pk(f32x2 v) {
    const f32x2 av = __builtin_elementwise_abs(v), d = av * 0.2316418882f + 1.0f;
    f32x2 t; t.x = __builtin_amdgcn_rcpf(d.x); t.y = __builtin_amdgcn_rcpf(d.y);
    f32x2 q = t * 0.5307027145f + (-0.7265760135f); q = q * t + 0.7107068705f; q = q * t + (-0.142248368f); q = q * t + 0.127414796f; q = q * t;
    const f32x2 s = (v * v) * (-0.72134752044f);
    f32x2 e; e.x = __builtin_amdgcn_exp2f(s.x); e.y = __builtin_amdgcn_exp2f(s.y);
    const f32x2 m = v * (q * e), r = v - m;
    f32x2 o; o.x = v.x < 0.f ? m.x : r.x; o.y = v.y < 0.f ? m.y : r.y; return o;
}
__device__ __forceinline__ f32x4 gelu4(f32x4 v) { const f32x2 a = gelu_pk((f32x2){v[0], v[1]}), b = gelu_pk((f32x2){v[2], v[3]}); return (f32x4){a.x, a.y, b.x, b.y}; }
__device__ __forceinline__ float dot4(f32x4 v) { return (v[0] * v[0] + v[1] * v[1]) + (v[2] * v[2] + v[3] * v[3]); }
__device__ __forceinline__ unsigned short f2bf_s(float f) { return (unsigned short)(cvtpk(f, 0.f) & 0xffffu); }
__device__ __forceinline__ float alibi_slope(int h) { return h < 8 ? exp2f(-(float)(h + 1)) : exp2f(-0.5f - (float)(h - 8)); }

struct Params {
    const float* in[28];
    float* out;
    unsigned char* ws;
    int ph_lo, ph_hi;
};

#define EPI_ARGS const f32x4 (&acc)[2][2][4][2], const Unit& u, int wr, int wc, int fr, int fq
#define FOR_AI_M _Pragma("unroll") for (int ai = 0; ai < 2; ++ai) _Pragma("unroll") for (int m = 0; m < 4; ++m)
#define BIG_ROWS(E) do { const int row0_ = u.pm * 256 + wr * 64 + fr; float rs_[2][4]; \
    FOR_AI_M rs_[ai][m] = (E).ssq[row0_ + ai * 128 + m * 16]; \
    FOR_AI_M { f32x4 v_[2][2]; \
    _Pragma("unroll") for (int bj = 0; bj < 2; ++bj) _Pragma("unroll") for (int n = 0; n < 2; ++n) v_[bj][n] = acc[ai][bj][m][n]; \
    (E).row(v_, rsqrtf(rs_[ai][m] * (1.f / 1024.f) + EPS), row0_ + ai * 128 + m * 16, u.pn, wc, fq); } } while (0)

__device__ __forceinline__ void head_norm(f32x4 (&v)[2][2], const float* gp, int fq) {
    float ss = (dot4(v[0][0]) + dot4(v[0][1])) + (dot4(v[1][0]) + dot4(v[1][1]));
    ss += __shfl_xor(ss, 16); ss += __shfl_xor(ss, 32);
    const float inv = rsqrtf(ss * (1.f / 64.f) + EPS);
#pragma unroll
    for (int bj = 0; bj < 2; ++bj)
#pragma unroll
        for (int n = 0; n < 2; ++n) { const f32x4 g = *(const f32x4*)(gp + 32 * bj + 8 * fq + 4 * n); v[bj][n] = v[bj][n] * inv * g; }
}

__device__ __forceinline__ void head_norm_g(f32x4 (&v)[2][2], const f32x4 (&g)[2][2]) {
    float ss = (dot4(v[0][0]) + dot4(v[0][1])) + (dot4(v[1][0]) + dot4(v[1][1]));
    ss += __shfl_xor(ss, 16); ss += __shfl_xor(ss, 32);
    const float inv = rsqrtf(ss * (1.f / 64.f) + EPS);
#pragma unroll
    for (int bj = 0; bj < 2; ++bj)
#pragma unroll
        for (int n = 0; n < 2; ++n) v[bj][n] = v[bj][n] * inv * g[bj][n];
}
#define BIG_ROWS_G(E, GP) do { const int row0_ = u.pm * 256 + wr * 64 + fr; float rs_[2][4]; f32x4 g_[2][2]; \
    FOR_AI_M rs_[ai][m] = (E).ssq[row0_ + ai * 128 + m * 16]; \
    _Pragma("unroll") for (int bj = 0; bj < 2; ++bj) _Pragma("unroll") for (int n = 0; n < 2; ++n) g_[bj][n] = *(const f32x4*)((GP) + 32 * bj + 8 * fq + 4 * n); \
    FOR_AI_M { f32x4 v_[2][2]; \
    _Pragma("unroll") for (int bj = 0; bj < 2; ++bj) _Pragma("unroll") for (int n = 0; n < 2; ++n) v_[bj][n] = acc[ai][bj][m][n]; \
    (E).rowg(v_, rsqrtf(rs_[ai][m] * (1.f / 1024.f) + EPS), row0_ + ai * 128 + m * 16, u.pn, wc, fq, g_); } } while (0)

struct EpiInA {
    const float* ssq; bf16_t* Qb; const float* gt; float* out;
    struct Pre {}; __device__ __forceinline__ void pre(Pre&, int, int, int, int) const {}
    __device__ __forceinline__ void row(f32x4 (&v)[2][2], float rs, int row_, int pn, int wc, int fq, const Pre&) const { row(v, rs, row_, pn, wc, fq); }
    __device__ __forceinline__ void row(f32x4 (&v)[2][2], float rs, int row, int pn, int wc, int fq) const {
        const int typ = pn < 3 ? 0 : pn - 2; f32x4 g[2][2];
#pragma unroll
        for (int bj = 0; bj < 2; ++bj)
#pragma unroll
            for (int n = 0; n < 2; ++n) g[bj][n] = *(const f32x4*)(gt + typ * 64 + 32 * bj + 8 * fq + 4 * n);
        rowg(v, rs, row, pn, wc, fq, g);
    }
    __device__ __forceinline__ void rowg(f32x4 (&v)[2][2], float rs, int row, int pn, int wc, int fq, const f32x4 (&g)[2][2]) const {
        const int typ = pn < 3 ? 0 : pn - 2;
        const size_t doff = typ == 0 ? 0 : (WS_B - WS_A) / 2;
        const int ld = 768, cb = typ == 0 ? (pn * 4 + wc) * 64 : (typ - 1) * 256 + wc * 64;
#pragma unroll
        for (int bj = 0; bj < 2; ++bj)
#pragma unroll
            for (int n = 0; n < 2; ++n) v[bj][n] = v[bj][n] * rs;
        if (typ != 2) head_norm_g(v, g);
#pragma unroll
        for (int bj = 0; bj < 2; ++bj) *(u32x4*)(Qb + doff + (size_t)row * ld + cb + 32 * bj + 8 * fq) = pack8(v[bj][0], v[bj][1]);
        if (typ == 1 || typ == 2) {
            long wo = -1;
            if (row >= MP) { const int ns = row - MP; wo = (long)O_WKS + (long)(typ - 1) * (long)(O_WVS - O_WKS) + (long)((ns >> 2) * 128 + 124 + (ns & 3)) * 256; }
            else if ((row & 4095) >= 3968) { const int b = row >> 12, t = row & 4095; wo = (long)O_WKP + (long)(typ - 1) * (long)(O_WVP - O_WKP) + (long)(b * 128 + t - 3968) * 256; }
            if (wo >= 0) { float* wout = out + wo;
#pragma unroll
                for (int bj = 0; bj < 2; ++bj)
#pragma unroll
                    for (int n = 0; n < 2; ++n) *(f32x4*)(wout + wc * 64 + 32 * bj + 8 * fq + 4 * n) = v[bj][n];
            }
        }
    }
    __device__ __forceinline__ void operator()(EPI_ARGS) const { const int typ_ = u.pn < 3 ? 0 : u.pn - 2; BIG_ROWS_G(*this, gt + typ_ * 64); }
};

struct EpiMemKV {
    const float* ssq; const float* xk; float *outk, *outv; bf16_t *MK, *MV;
    struct Pre {}; __device__ __forceinline__ void pre(Pre&, int, int, int, int) const {}
    __device__ __forceinline__ void row(f32x4 (&v)[2][2], float rs, int row_, int pn, int wc, int fq, const Pre&) const { row(v, rs, row_, pn, wc, fq); }
    __device__ __forceinline__ void row(f32x4 (&v)[2][2], float rs, int row, int pn, int wc, int fq) const {
        const int layer = pn >> 1; const bool isv = pn & 1;
        float* of = (isv ? outv : outk) + (size_t)layer * MMEM * 256; bf16_t* ob = (isv ? MV : MK) + (size_t)layer * MMEM * 256;
#pragma unroll
        for (int bj = 0; bj < 2; ++bj)
#pragma unroll
            for (int n = 0; n < 2; ++n) v[bj][n] = v[bj][n] * rs;
        if (!isv) head_norm(v, xk + layer * 64, fq);
#pragma unroll
        for (int bj = 0; bj < 2; ++bj) {
            const size_t o = (size_t)row * 256 + wc * 64 + 32 * bj + 8 * fq;
            *(u32x4*)(ob + o) = pack8(v[bj][0], v[bj][1]);
            *(f32x4*)(of + o) = v[bj][0]; *(f32x4*)(of + o + 4) = v[bj][1];
        }
    }
    __device__ __forceinline__ void operator()(EPI_ARGS) const { BIG_ROWS(*this); }
};

__device__ __forceinline__ void rowsum4_atomic(float s0, float s1, float s2, float s3, float* ssq_rbase_fr, int fq) {
    s0 += __shfl_xor(s0, 16); s1 += __shfl_xor(s1, 16); s2 += __shfl_xor(s2, 16); s3 += __shfl_xor(s3, 16);
    s0 += __shfl_xor(s0, 32); s1 += __shfl_xor(s1, 32); s2 += __shfl_xor(s2, 32); s3 += __shfl_xor(s3, 32);
    const float sel = fq == 0 ? s0 : fq == 1 ? s1 : fq == 2 ? s2 : s3;
    atomicAdd(ssq_rbase_fr + 16 * fq, sel);
}
template <bool IN32, bool OUT32>
struct EpiRes {
    const float* xin_p; const float* xin_s; float* xout; bf16_t* xb; float* ssq;
    __device__ __forceinline__ void finish(f32x4 x0, f32x4 x1, int row, int col, float& ss) const {
        if (OUT32) { float* o = xout + (size_t)row * DM + col; *(f32x4*)o = x0; *(f32x4*)(o + 4) = x1; }
        else { *(u32x4*)(xb + (size_t)row * DM + col) = pack8(x0, x1); ss += dot4(x0) + dot4(x1); }
    }
    __device__ __forceinline__ void rowsum(float ss, int row, int fq) const { if (!OUT32) { ss += __shfl_xor(ss, 16); ss += __shfl_xor(ss, 32); if (fq == 0) atomicAdd(ssq + row, ss); } }
    struct Pre { u32x4 w[2]; };
    __device__ __forceinline__ void pre(Pre& p, int row, int pn, int wc, int fq) const {
        if (!IN32) { const int col0 = pn * 256 + wc * 32 + 8 * fq; p.w[0] = *(const u32x4*)(xb + (size_t)row * DM + col0); p.w[1] = *(const u32x4*)(xb + (size_t)row * DM + col0 + 128); } }
    __device__ __forceinline__ void row(f32x4 (&v)[2][2], float rs, int row_, int pn, int wc, int fq, const Pre& p) const {
        if (IN32) { row(v, rs, row_, pn, wc, fq); return; }
        const int col0 = pn * 256 + wc * 32 + 8 * fq; float ss = 0.f;
#pragma unroll
        for (int bj = 0; bj < 2; ++bj) { const u32x4 w = p.w[bj];
            const f32x4 x0 = (f32x4){bflo(w.x), bfhi(w.x), bflo(w.y), bfhi(w.y)}, x1 = (f32x4){bflo(w.z), bfhi(w.z), bflo(w.w), bfhi(w.w)};
            finish(x0 + v[bj][0], x1 + v[bj][1], row_, col0 + 128 * bj, ss); }
        rowsum(ss, row_, fq);
    }
    __device__ __forceinline__ void row(f32x4 (&v)[2][2], float, int row, int pn, int wc, int fq) const {
        const int col0 = pn * 256 + wc * 32 + 8 * fq; float ss = 0.f;
#pragma unroll
        for (int bj = 0; bj < 2; ++bj) {
            f32x4 x0, x1;
            if (IN32) { const float* src = (row < MP ? xin_p + (size_t)row * DM : xin_s + (size_t)(row - MP) * DM) + col0 + 128 * bj; x0 = *(const f32x4*)src; x1 = *(const f32x4*)(src + 4); }
            else { const u32x4 w = *(const u32x4*)(xb + (size_t)row * DM + col0 + 128 * bj); x0 = (f32x4){bflo(w.x), bfhi(w.x), bflo(w.y), bfhi(w.y)}; x1 = (f32x4){bflo(w.z), bfhi(w.z), bflo(w.w), bfhi(w.w)}; }
            finish(x0 + v[bj][0], x1 + v[bj][1], row, col0 + 128 * bj, ss);
        }
        rowsum(ss, row, fq);
    }
    __device__ __forceinline__ void operator()(EPI_ARGS) const {
        const int row0 = u.pm * 256 + wr * 64 + fr, col0 = u.pn * 256 + wc * 32 + 8 * fq;
        if (IN32) {
#pragma unroll
            for (int ai = 0; ai < 2; ++ai) {
                f32x4 r[4][2][2];
#pragma unroll
                for (int m = 0; m < 4; ++m)
#pragma unroll
                    for (int bj = 0; bj < 2; ++bj) { const float* src = xin_p + (size_t)(row0 + ai * 128 + m * 16) * DM + col0 + 128 * bj; r[m][bj][0] = *(const f32x4*)src; r[m][bj][1] = *(const f32x4*)(src + 4); }
                float ssm[4];
#pragma unroll
                for (int m = 0; m < 4; ++m) { const int row = row0 + ai * 128 + m * 16; ssm[m] = 0.f;
#pragma unroll
                    for (int bj = 0; bj < 2; ++bj) finish(r[m][bj][0] + acc[ai][bj][m][0], r[m][bj][1] + acc[ai][bj][m][1], row, col0 + 128 * bj, ssm[m]); }
                if (!OUT32) rowsum4_atomic(ssm[0], ssm[1], ssm[2], ssm[3], ssq + row0 + ai * 128, fq);
            }
        } else {
#pragma unroll
            for (int ai = 0; ai < 2; ++ai) {
                u32x4 r[4][2];
#pragma unroll
                for (int m = 0; m < 4; ++m)
#pragma unroll
                    for (int bj = 0; bj < 2; ++bj) r[m][bj] = *(const u32x4*)(xb + (size_t)(row0 + ai * 128 + m * 16) * DM + col0 + 128 * bj);
                float ssm[4];
#pragma unroll
                for (int m = 0; m < 4; ++m) { const int row = row0 + ai * 128 + m * 16; ssm[m] = 0.f;
#pragma unroll
                    for (int bj = 0; bj < 2; ++bj) { const u32x4 w = r[m][bj];
                        const f32x4 x0 = (f32x4){bflo(w.x), bfhi(w.x), bflo(w.y), bfhi(w.y)}, x1 = (f32x4){bflo(w.z), bfhi(w.z), bflo(w.w), bfhi(w.w)};
                        finish(x0 + acc[ai][bj][m][0], x1 + acc[ai][bj][m][1], row, col0 + 128 * bj, ssm[m]); } }
                if (!OUT32) rowsum4_atomic(ssm[0], ssm[1], ssm[2], ssm[3], ssq + row0 + ai * 128, fq);
                asm volatile("" ::: "memory");
            }
        }
    }
};

template <int CTRL> __device__ __forceinline__ float dppz_f(float x) { return __int_as_float(__builtin_amdgcn_update_dpp(0, __float_as_int(x), CTRL, 0xf, 0xf, true)); }
template <int CTRL> __device__ __forceinline__ float dpp_f(float x) { return __int_as_float(__builtin_amdgcn_update_dpp(0, __float_as_int(x), CTRL, 0xf, 0xf, false)); }
__device__ __forceinline__ float silu_f(float c) { return c * __builtin_amdgcn_rcpf(1.f + __builtin_amdgcn_exp2f(-c * LOG2E)); }

struct EpiFfnConv {
    const float* ssq; bf16_t* H; const float* cw; const float* cbp; float* side; float* convp; LAS float* xch;
    __device__ __forceinline__ void operator()(EPI_ARGS) const {
        const int pm = u.pm, ts = pm & 15, col0 = u.pn * 128 + wc * 32 + 8 * fq;
        const int rowbase = pm * 256 + wr * 64 + fr;
        float rsv[2][4];
        FOR_AI_M rsv[ai][m] = ssq[rowbase + ai * 128 + m * 16];
        float w0[8], w1[8], w2[8], cb[8];
#pragma unroll
        for (int e = 0; e < 8; e += 4) { const f32x4 a0 = *(const f32x4*)(cw + col0 + e), a1 = *(const f32x4*)(cw + DFF + col0 + e), a2 = *(const f32x4*)(cw + 2 * DFF + col0 + e), a3 = *(const f32x4*)(cbp + col0 + e);
#pragma unroll
            for (int j = 0; j < 4; ++j) { w0[e + j] = a0[j] * -LOG2E; w1[e + j] = a1[j] * -LOG2E; w2[e + j] = a2[j] * -LOG2E; cb[e + j] = a3[j] * -LOG2E; } }
        FOR_AI_M rsv[ai][m] = rsqrtf(rsv[ai][m] * (1.f / 1024.f) + EPS);
        if (fr >= 14) {
#pragma unroll
            for (int ai = 0; ai < 2; ++ai) {
                const float rs = rsv[ai][3];
                LAS float* x = xch + ((2 * ai + wr) * 2 + (fr - 14)) * 128 + wc * 32 + 8 * fq;
                *(LAS f32x4*)x = acc[ai][0][3][0] * rs; *(LAS f32x4*)(x + 4) = acc[ai][0][3][1] * rs;
            }
        }
        asm volatile("s_waitcnt lgkmcnt(0)" ::: "memory"); __builtin_amdgcn_s_barrier(); asm volatile("" ::: "memory");
#pragma unroll
        for (int ai = 0; ai < 2; ++ai) {
            const int blk = 2 * ai + wr;
            float prev[8];
            if (blk > 0) { const LAS float* x = xch + ((blk - 1) * 2 + (fr >= 14 ? fr - 14 : 0)) * 128 + wc * 32 + 8 * fq; const f32x4 p0 = *(const LAS f32x4*)x, p1 = *(const LAS f32x4*)(x + 4);
#pragma unroll
                for (int e = 0; e < 4; ++e) { prev[e] = p0[e]; prev[4 + e] = p1[e]; } }
            else {
#pragma unroll
                for (int e = 0; e < 8; ++e) prev[e] = 0.f; }
#pragma unroll
            for (int m = 0; m < 4; ++m) {
                const int row = rowbase + ai * 128 + m * 16;
                const float rs = rsv[ai][m], rsu = rs * -0.69314718056f;
                float a[8], c[8], h[8], up[8];
#pragma unroll
                for (int p = 0; p < 4; ++p) {
                    const f32x4 av = acc[ai][0][m][p >> 1], uv = acc[ai][1][m][p >> 1];
                    const f32x2 a2 = (f32x2){av[2 * (p & 1)], av[2 * (p & 1) + 1]} * rs, u2 = (f32x2){uv[2 * (p & 1)], uv[2 * (p & 1) + 1]} * rsu;
                    const f32x2 c2 = __builtin_elementwise_fma((f32x2){w2[2 * p], w2[2 * p + 1]}, a2, (f32x2){cb[2 * p], cb[2 * p + 1]});
                    a[2 * p] = a2.x; a[2 * p + 1] = a2.y; up[2 * p] = u2.x; up[2 * p + 1] = u2.y; c[2 * p] = c2.x; c[2 * p + 1] = c2.y;
                }
#pragma unroll
                for (int e = 0; e < 8; e += 4)
                    asm("s_nop 1\n\t"
                        "v_fmac_f32_dpp %0, %4, %12 row_shr:1 row_mask:0xf bank_mask:0xf bound_ctrl:1\n\t" "v_fmac_f32_dpp %1, %5, %13 row_shr:1 row_mask:0xf bank_mask:0xf bound_ctrl:1\n\t"
                        "v_fmac_f32_dpp %2, %6, %14 row_shr:1 row_mask:0xf bank_mask:0xf bound_ctrl:1\n\t" "v_fmac_f32_dpp %3, %7, %15 row_shr:1 row_mask:0xf bank_mask:0xf bound_ctrl:1\n\t"
                        "v_fmac_f32_dpp %0, %4, %16 row_shr:2 row_mask:0xf bank_mask:0xf bound_ctrl:1\n\t" "v_fmac_f32_dpp %1, %5, %17 row_shr:2 row_mask:0xf bank_mask:0xf bound_ctrl:1\n\t"
                        "v_fmac_f32_dpp %2, %6, %18 row_shr:2 row_mask:0xf bank_mask:0xf bound_ctrl:1\n\t" "v_fmac_f32_dpp %3, %7, %19 row_shr:2 row_mask:0xf bank_mask:0xf bound_ctrl:1\n\t"
                        "v_fmac_f32_dpp %0, %8, %12 row_shl:15 row_mask:0xf bank_mask:0xf bound_ctrl:1\n\t" "v_fmac_f32_dpp %1, %9, %13 row_shl:15 row_mask:0xf bank_mask:0xf bound_ctrl:1\n\t"
                        "v_fmac_f32_dpp %2, %10, %14 row_shl:15 row_mask:0xf bank_mask:0xf bound_ctrl:1\n\t" "v_fmac_f32_dpp %3, %11, %15 row_shl:15 row_mask:0xf bank_mask:0xf bound_ctrl:1\n\t"
                        "v_fmac_f32_dpp %0, %8, %16 row_shl:14 row_mask:0xf bank_mask:0xf bound_ctrl:1\n\t" "v_fmac_f32_dpp %1, %9, %17 row_shl:14 row_mask:0xf bank_mask:0xf bound_ctrl:1\n\t"
                        "v_fmac_f32_dpp %2, %10, %18 row_shl:14 row_mask:0xf bank_mask:0xf bound_ctrl:1\n\t" "v_fmac_f32_dpp %3, %11, %19 row_shl:14 row_mask:0xf bank_mask:0xf bound_ctrl:1"
                        : "+v"(c[e]), "+v"(c[e + 1]), "+v"(c[e + 2]), "+v"(c[e + 3])
                        : "v"(a[e]), "v"(a[e + 1]), "v"(a[e + 2]), "v"(a[e + 3]), "v"(prev[e]), "v"(prev[e + 1]), "v"(prev[e + 2]), "v"(prev[e + 3]),
                          "v"(w1[e]), "v"(w1[e + 1]), "v"(w1[e + 2]), "v"(w1[e + 3]), "v"(w0[e]), "v"(w0[e + 1]), "v"(w0[e + 2]), "v"(w0[e + 3]));
#pragma unroll
                for (int p = 0; p < 4; ++p) {
                    const f32x2 c2 = (f32x2){c[2 * p], c[2 * p + 1]}, den = (f32x2){__builtin_amdgcn_exp2f(c2.x), __builtin_amdgcn_exp2f(c2.y)} + 1.0f;
                    const f32x2 h2 = (c2 * (f32x2){up[2 * p], up[2 * p + 1]}) * (f32x2){__builtin_amdgcn_rcpf(den.x), __builtin_amdgcn_rcpf(den.y)};
                    h[2 * p] = h2.x; h[2 * p + 1] = h2.y;
                }
                u32x4 w; w.x = cvtpk(h[0], h[1]); w.y = cvtpk(h[2], h[3]); w.z = cvtpk(h[4], h[5]); w.w = cvtpk(h[6], h[7]);
                *(u32x4*)(H + (size_t)row * DFF + col0) = w;
                if (ai == 0 && m == 0) { if (wr == 0 && ts > 0 && fr < 2) { float* d = side + (size_t)(pm * 2 + fr) * DFF + col0; const float kc = -0.69314718056f, ku = -LOG2E;
                        *(f32x4*)d = (f32x4){c[0] * kc, c[1] * kc, c[2] * kc, c[3] * kc}; *(f32x4*)(d + 4) = (f32x4){c[4] * kc, c[5] * kc, c[6] * kc, c[7] * kc};
                        *(f32x4*)(d + SIDE_N) = (f32x4){up[0] * ku, up[1] * ku, up[2] * ku, up[3] * ku}; *(f32x4*)(d + SIDE_N + 4) = (f32x4){up[4] * ku, up[5] * ku, up[6] * ku, up[7] * ku}; } }
                if (ai == 1 && m == 3) { if (wr == 1 && fr >= 14) { float* d = ts < 15 ? side + 2 * SIDE_N + (size_t)(pm * 2 + fr - 14) * DFF + col0 : convp + (size_t)((pm >> 4) * 2 + fr - 14) * DFF + col0;
                        *(f32x4*)d = (f32x4){a[0], a[1], a[2], a[3]}; *(f32x4*)(d + 4) = (f32x4){a[4], a[5], a[6], a[7]}; } }
#pragma unroll
                for (int e = 0; e < 8; ++e) prev[e] = a[e];
            }
        }
    }
};
struct EpiFfnNull {
    const float* ssq; bf16_t* H;
    __device__ __forceinline__ void row(f32x4 (&v)[2][2], float rs, int row, int pn, int wc, int fq) const {
        *(u32x4*)(H + (size_t)row * DFF + pn * 128 + wc * 32 + 8 * fq) = pack8(v[0][0] * rs + v[1][0], v[0][1] * rs + v[1][1]);
    }
    __device__ __forceinline__ void operator()(EPI_ARGS) const { BIG_ROWS(*this); }
};
__device__ __forceinline__ void ffn_fixup(const Params& P, int layer, const pg8::StaticOrder& S) {
    bf16_t* H = (bf16_t*)(P.ws + WS_H); const float* side = (const float*)(P.ws + WS_SIDE); const float* cw = P.in[25] + (size_t)layer * 3 * DFF;
    Unit u; int last = -1;
    for (int i = 0; S.next(i, u); ++i) {
        const int pm = u.pm; if ((pm & 15) == 0 || pm == last) continue; last = pm;
        for (int c4 = threadIdx.x; c4 < DFF / 4; c4 += 512) { const int col = 4 * c4;
            const f32x4 cp0 = *(const f32x4*)(side + (size_t)(pm * 2) * DFF + col), cp1 = *(const f32x4*)(side + (size_t)(pm * 2 + 1) * DFF + col);
            const f32x4 u0 = *(const f32x4*)(side + SIDE_N + (size_t)(pm * 2) * DFF + col), u1 = *(const f32x4*)(side + SIDE_N + (size_t)(pm * 2 + 1) * DFF + col);
            const f32x4 am2 = *(const f32x4*)(side + 2 * SIDE_N + (size_t)((pm - 1) * 2) * DFF + col), am1 = *(const f32x4*)(side + 2 * SIDE_N + (size_t)((pm - 1) * 2 + 1) * DFF + col);
            const f32x4 w0 = *(const f32x4*)(cw + col), w1 = *(const f32x4*)(cw + DFF + col);
            const f32x4 c0 = cp0 + w0 * am2 + w1 * am1, c1 = cp1 + w0 * am1;
            u32x2 h0, h1;
            h0.x = cvtpk(silu_f(c0[0]) * u0[0], silu_f(c0[1]) * u0[1]); h0.y = cvtpk(silu_f(c0[2]) * u0[2], silu_f(c0[3]) * u0[3]);
            h1.x = cvtpk(silu_f(c1[0]) * u1[0], silu_f(c1[1]) * u1[1]); h1.y = cvtpk(silu_f(c1[2]) * u1[2], silu_f(c1[3]) * u1[3]);
            *(u32x2*)(H + (size_t)(pm * 256) * DFF + col) = h0; *(u32x2*)(H + (size_t)(pm * 256 + 1) * DFF + col) = h1; }
    }
    asm volatile("s_waitcnt vmcnt(0)" ::: "memory"); __syncthreads();
}

struct EpiInB {
    const float* ssq; bf16_t *U, *GV, *XQ; const float* xg; float* ssqv;
    struct Pre {}; __device__ __forceinline__ void pre(Pre&, int, int, int, int) const {}
    __device__ __forceinline__ void row(f32x4 (&v)[2][2], float rs, int row_, int pn, int wc, int fq, const Pre&) const { row(v, rs, row_, pn, wc, fq); }
    __device__ __forceinline__ void row(f32x4 (&v)[2][2], float rs, int row, int pn, int wc, int fq) const {
        if (pn < 6) {
            bf16_t* dst = pn < 3 ? U : GV; const int col0 = (pn % 3) * 256 + wc * 32 + 8 * fq;
            float ss = 0.f;
#pragma unroll
            for (int bj = 0; bj < 2; ++bj) {
                const f32x4 v0 = gelu4(v[bj][0] * rs), v1 = gelu4(v[bj][1] * rs);
                *(u32x4*)(dst + (size_t)row * 768 + col0 + 128 * bj) = pack8(v0, v1);
                ss += dot4(v0) + dot4(v1);
            }
            if (pn >= 3) { ss += __shfl_xor(ss, 16); ss += __shfl_xor(ss, 32); if (fq == 0) atomicAdd(ssqv + row, ss); }
        } else {
            f32x4 g[2][2];
#pragma unroll
            for (int bj = 0; bj < 2; ++bj)
#pragma unroll
                for (int n = 0; n < 2; ++n) g[bj][n] = *(const f32x4*)(xg + 32 * bj + 8 * fq + 4 * n);
            rowg(v, rs, row, pn, wc, fq, g);
        }
    }
    __device__ __forceinline__ void rowg(f32x4 (&v)[2][2], float rs, int row, int pn, int wc, int fq, const f32x4 (&g)[2][2]) const {
#pragma unroll
        for (int bj = 0; bj < 2; ++bj)
#pragma unroll
            for (int n = 0; n < 2; ++n) v[bj][n] = v[bj][n] * rs;
        head_norm_g(v, g);
#pragma unroll
        for (int bj = 0; bj < 2; ++bj) *(u32x4*)(XQ + (size_t)row * 256 + wc * 64 + 32 * bj + 8 * fq) = pack8(v[bj][0], v[bj][1]);
    }
    __device__ __forceinline__ void operator()(EPI_ARGS) const {
        if (u.pn >= 6) { BIG_ROWS_G(*this, xg); return; }
        if (u.pn < 3) { BIG_ROWS(*this); return; }
        const int row0 = u.pm * 256 + wr * 64 + fr, col0 = (u.pn - 3) * 256 + wc * 32 + 8 * fq;
        float rsv[2][4];
        FOR_AI_M rsv[ai][m] = ssq[row0 + ai * 128 + m * 16];
#pragma unroll
        for (int ai = 0; ai < 2; ++ai) {
            float ssm[4];
#pragma unroll
            for (int m = 0; m < 4; ++m) { const int row = row0 + ai * 128 + m * 16; const float rs = rsqrtf(rsv[ai][m] * (1.f / 1024.f) + EPS); ssm[m] = 0.f;
#pragma unroll
                for (int bj = 0; bj < 2; ++bj) {
                    const f32x4 v0 = gelu4(acc[ai][bj][m][0] * rs), v1 = gelu4(acc[ai][bj][m][1] * rs);
                    *(u32x4*)(GV + (size_t)row * 768 + col0 + 128 * bj) = pack8(v0, v1);
                    ssm[m] += dot4(v0) + dot4(v1);
                } }
            rowsum4_atomic(ssm[0], ssm[1], ssm[2], ssm[3], ssqv + row0 + ai * 128, fq);
        }
    }
};

template <int MB> struct WgFrags { bf16x8 af[4][MB], bf[4][2][2]; };
template <int MB, int NB>
__device__ __forceinline__ void wg_load(WgFrags<MB>& F, const bf16_t* A, int lda, int row0, const bf16_t* Bt, int K, int pn, int wc, int k0, int s0, bool load_a = true) {
    const int lane = threadIdx.x & 63, fr = lane & 15, fq = lane >> 4;
    const bf16_t* ap = A + (size_t)(row0 + fr) * lda + 8 * fq + k0 + s0 * 32;
    if (load_a) {
#pragma unroll
        for (int j = 0; j < NB; ++j)
#pragma unroll
            for (int m = 0; m < MB; ++m) F.af[j][m] = *(const bf16x8*)(ap + (size_t)m * 16 * lda + j * 32);
    }
#pragma unroll
    for (int bj = 0; bj < 2; ++bj)
#pragma unroll
        for (int n = 0; n < 2; ++n) { const bf16_t* bp = Bt + (size_t)(pn * 256 + 128 * bj + 32 * wc + pg8::perm32(16 * n + fr)) * K + 8 * fq + k0 + s0 * 32;
#pragma unroll
            for (int j = 0; j < NB; ++j) F.bf[j][bj][n] = *(const bf16x8*)(bp + j * 32); }
}
template <int MB, int NB>
__device__ __forceinline__ void wg_mma(const WgFrags<MB>& F, f32x4 (&acc)[MB][2][2]) {
#pragma unroll
    for (int j = 0; j < NB; ++j)
#pragma unroll
        for (int m = 0; m < MB; ++m)
#pragma unroll
            for (int bj = 0; bj < 2; ++bj)
#pragma unroll
                for (int n = 0; n < 2; ++n) acc[m][bj][n] = __builtin_amdgcn_mfma_f32_16x16x32_bf16(F.bf[j][bj][n], F.af[j][m], acc[m][bj][n], 0, 0, 0);
}
template <int MB>
__device__ __forceinline__ void sample_reduce_store(LAS unsigned char* lds, const f32x4 (&acc)[MB][2][2], int wave, int lane) {
    LAS f32x4* Pl = (LAS f32x4*)lds;
#pragma unroll
    for (int m = 0; m < MB; ++m)
#pragma unroll
        for (int bj = 0; bj < 2; ++bj)
#pragma unroll
            for (int n = 0; n < 2; ++n) Pl[((wave * MB + m) * 4 + bj * 2 + n) * 64 + lane] = acc[m][bj][n];
}
template <int MB>
__device__ __forceinline__ void sample_reduce_finish(LAS unsigned char* lds, int wave, int lane) {
    LAS f32x4* Pl = (LAS f32x4*)lds; LAS f32x4* Rl = (LAS f32x4*)(lds + RING_BYTES);
    __syncthreads();
#pragma unroll
    for (int i = 0; i < (MB * 4) / 8 + ((MB * 4) % 8 ? 1 : 0); ++i) { const int slot = wave + 8 * i;
        if (slot < MB * 4) { f32x4 sum = Pl[slot * 64 + lane];
#pragma unroll
            for (int w = 1; w < 8; ++w) sum += Pl[(w * MB * 4 + slot) * 64 + lane];
            Rl[slot * 64 + lane] = sum; } }
    __syncthreads();
}
template <int MB>
__device__ __forceinline__ void sample_reduce(LAS unsigned char* lds, const f32x4 (&acc)[MB][2][2], int wave, int lane) {
    sample_reduce_store<MB>(lds, acc, wave, lane); sample_reduce_finish<MB>(lds, wave, lane);
}
template <int MB>
__device__ __forceinline__ void sample_reduce_load(const LAS unsigned char* lds, f32x4 (&v)[2][2], int m, int lane) {
    const LAS f32x4* Rl = (const LAS f32x4*)(lds + RING_BYTES);
#pragma unroll
    for (int bj = 0; bj < 2; ++bj)
#pragma unroll
        for (int n = 0; n < 2; ++n) v[bj][n] = Rl[(m * 4 + bj * 2 + n) * 64 + lane];
}
template <int MB, int NS, class Epi>
__device__ __forceinline__ void sample_gemm(LAS unsigned char* lds, const bf16_t* A, int lda, const bf16_t* Bt, int ntiles, const Epi& E, int blk, int nblk, int rowbase = MP, int nrows = MS, int tbeg = 0, int tend = -1) {
    const int lane = threadIdx.x & 63, fr = lane & 15, fq = lane >> 4, wave = __builtin_amdgcn_readfirstlane(threadIdx.x >> 6);
    constexpr int K = 8 * NS * 32, NB0 = NS < 4 ? NS : 4;
    const int NRB = nrows / (16 * MB);
    const int ntask = (tend >= 0 && tend < NRB * ntiles * 4) ? tend : NRB * ntiles * 4;
    if (tbeg + blk >= ntask) return;
    WgFrags<MB> F;
    { const int t1 = tbeg + blk, rb = t1 % NRB, cw = t1 / NRB; wg_load<MB, NB0>(F, A, lda, rowbase + rb * 16 * MB, Bt, K, cw >> 2, cw & 3, wave * NS * 32, 0); }
    for (int t = tbeg + blk; t < ntask; t += nblk) {
        const int rb = t % NRB, cw = t / NRB, pn = cw >> 2, wc = cw & 3, row0 = rowbase + rb * 16 * MB;
        f32x4 acc[MB][2][2];
#pragma unroll
        for (int m = 0; m < MB; ++m)
#pragma unroll
            for (int bj = 0; bj < 2; ++bj)
#pragma unroll
                for (int n = 0; n < 2; ++n) acc[m][bj][n] = (f32x4){0.f, 0.f, 0.f, 0.f};
        wg_mma<MB, NB0>(F, acc);
#pragma unroll
        for (int s0 = 4; s0 < NS; s0 += 4) {
            if (NS - s0 >= 4) { wg_load<MB, 4>(F, A, lda, row0, Bt, K, pn, wc, wave * NS * 32, s0); wg_mma<MB, 4>(F, acc); }
            else { wg_load<MB, (NS % 4 ? NS % 4 : 4)>(F, A, lda, row0, Bt, K, pn, wc, wave * NS * 32, s0); wg_mma<MB, (NS % 4 ? NS % 4 : 4)>(F, acc); }
        }
        const int tn = t + nblk;
        if (tn < ntask) { const int rbn = tn % NRB, cwn = tn / NRB; wg_load<MB, NB0>(F, A, lda, rowbase + rbn * 16 * MB, Bt, K, cwn >> 2, cwn & 3, wave * NS * 32, 0, NS > 4 || rbn != rb); }
        const int row = row0 + 16 * (wave % MB) + fr; float rsq = 0.f;
        if (wave < MB && E.ssq) rsq = E.ssq[row];
        typename Epi::Pre epre; if (wave < MB) E.pre(epre, row, pn, wc, fq);
        sample_reduce<MB>(lds, acc, wave, lane);
        if (wave < MB) { const float rs = E.ssq ? rsqrtf(rsq * (1.f / 1024.f) + EPS) : 1.f;
            f32x4 v[2][2]; sample_reduce_load<MB>(lds, v, wave, lane); E.row(v, rs, row, pn, wc, fq, epre); }
    }
    __syncthreads();
}
__device__ __forceinline__ void sample_ffn(const Params& P, LAS unsigned char* lds, int layer, const float* ssq, int blk, int nblk, int rb0 = 0, int NRB = MS / 64) {
    const int lane = threadIdx.x & 63, fr = lane & 15, fq = lane >> 4, wave = __builtin_amdgcn_readfirstlane(threadIdx.x >> 6);
    const bf16_t* XB = (const bf16_t*)(P.ws + WS_XB); const bf16_t* Wt = (const bf16_t*)(P.ws + WS_WFFN) + (size_t)layer * NFF * DM; bf16_t* Hb = (bf16_t*)(P.ws + WS_H);
    const float* cw = P.in[25] + (size_t)layer * 3 * DFF; const float* cbp = P.in[26] + (size_t)layer * DFF; const float* st = P.in[6] + (size_t)layer * NDEC * 2 * DFF;
    float* convs = P.out + O_CONVS + (size_t)layer * NDEC * 2 * DFF;
    constexpr int MB = 4; const int NTASK = NRB * 22 * 4;
    if (blk >= NTASK) return;
    WgFrags<MB> F;
    { const int rb = rb0 + blk % NRB, cwi = blk / NRB; wg_load<MB, 4>(F, XB, DM, MP + rb * 64, Wt, DM, cwi >> 2, cwi & 3, wave * 128, 0); }
    for (int t = blk; t < NTASK; t += nblk) {
        const int rb = rb0 + t % NRB, cwi = t / NRB, pn = cwi >> 2, wc = cwi & 3;
        f32x4 acc[MB][2][2];
#pragma unroll
        for (int m = 0; m < MB; ++m)
#pragma unroll
            for (int bj = 0; bj < 2; ++bj)
#pragma unroll
                for (int n = 0; n < 2; ++n) acc[m][bj][n] = (f32x4){0.f, 0.f, 0.f, 0.f};
        wg_mma<MB, 4>(F, acc);
        const int tn = t + nblk;
        if (tn < NTASK) { const int rbn = rb0 + tn % NRB, cwn = tn / NRB; wg_load<MB, 4>(F, XB, DM, MP + rbn * 64, Wt, DM, cwn >> 2, cwn & 3, wave * 128, 0, rbn != rb); }
        sample_reduce_store<MB>(lds, acc, wave, lane);
        const int col0 = pn * 128 + wc * 32 + 8 * fq, s = fr & 3;
        const int row = MP + rb * 64 + 16 * (wave & 3) + fr, nseq = (row - MP) >> 2;
        f32x4 q0[2], q1[2], k0[2], k1[2], k2[2], kb[2]; float rsq = 0.f;
        if (wave < MB) {
            rsq = ssq[row];
#pragma unroll
            for (int e = 0; e < 2; ++e) {
                q0[e] = *(const f32x4*)(st + (size_t)(nseq * 2 + 0) * DFF + col0 + 4 * e); q1[e] = *(const f32x4*)(st + (size_t)(nseq * 2 + 1) * DFF + col0 + 4 * e);
            }
        }
        sample_reduce_finish<MB>(lds, wave, lane);
        if (wave < MB) {
#pragma unroll
            for (int e = 0; e < 2; ++e) { k0[e] = *(const f32x4*)(cw + col0 + 4 * e); k1[e] = *(const f32x4*)(cw + DFF + col0 + 4 * e); k2[e] = *(const f32x4*)(cw + 2 * DFF + col0 + 4 * e); kb[e] = *(const f32x4*)(cbp + col0 + 4 * e); }
            f32x4 v[2][2]; sample_reduce_load<MB>(lds, v, wave, lane);
            const float rs = rsqrtf(rsq * (1.f / 1024.f) + EPS);
            float h[8]; f32x4 av[2];
#pragma unroll
            for (int e = 0; e < 8; ++e) {
                const float a = v[0][e >> 2][e & 3] * rs, up = v[1][e >> 2][e & 3] * rs;
                const float st0 = q0[e >> 2][e & 3], st1 = q1[e >> 2][e & 3];
                const float r1 = dpp_f<0x121>(a), r2 = dpp_f<0x122>(a);
                const float p1 = s >= 1 ? r1 : st1, p2 = s >= 2 ? r2 : (s == 1 ? st1 : st0);
                const float c = kb[e >> 2][e & 3] + k0[e >> 2][e & 3] * p2 + k1[e >> 2][e & 3] * p1 + k2[e >> 2][e & 3] * a;
                h[e] = silu_f(c) * up; av[e >> 2][e & 3] = a;
            }
            if (s >= 2) { float* d = convs + (size_t)(nseq * 2 + (s - 2)) * DFF + col0; *(f32x4*)d = av[0]; *(f32x4*)(d + 4) = av[1]; }
            u32x4 w; w.x = cvtpk(h[0], h[1]); w.y = cvtpk(h[2], h[3]); w.z = cvtpk(h[4], h[5]); w.w = cvtpk(h[6], h[7]);
            *(u32x4*)(Hb + (size_t)row * DFF + col0) = w;
        }
    }
    __syncthreads();
}

__device__ __forceinline__ void p0_transpose_item(const float* W, int K, int N, const float* gain, bf16_t* WT, int kb, int n0, int drow0, LAS float* scr, int lane) {
    const int k0 = 64 * kb;
    float wv[32];
#pragma unroll
    for (int i = 0; i < 32; ++i) wv[i] = W[(size_t)(k0 + 2 * i + (lane >> 5)) * N + n0 + (lane & 31)];
    if (gain) {
#pragma unroll
        for (int i = 0; i < 32; ++i) wv[i] *= gain[k0 + 2 * i + (lane >> 5)]; }
#pragma unroll
    for (int i = 0; i < 32; ++i) scr[(2 * i + (lane >> 5)) * 33 + (lane & 31)] = wv[i];
    asm volatile("s_waitcnt lgkmcnt(0)" ::: "memory");
    const int c = lane & 7;
#pragma unroll
    for (int j = 0; j < 4; ++j) { const int n = (lane >> 3) + 8 * j; const LAS float* s = scr + (8 * c) * 33 + n;
        u32x4 o; o.x = cvtpk(s[0 * 33], s[1 * 33]); o.y = cvtpk(s[2 * 33], s[3 * 33]); o.z = cvtpk(s[4 * 33], s[5 * 33]); o.w = cvtpk(s[6 * 33], s[7 * 33]);
        *(u32x4*)(WT + (size_t)(drow0 + n) * K + k0 + 8 * c) = o; }
    asm volatile("s_waitcnt lgkmcnt(0)" ::: "memory");
}
__device__ __forceinline__ int map_headperm(int nb) { const int p = (nb * 32) & 255, bj = p >> 7, wc = (p >> 5) & 3; return ((nb * 32) & ~255) + 64 * wc + 32 * bj; }
__device__ __forceinline__ int map_ffn(int nb) { const int tile = nb >> 3, p = (nb & 7) * 32; return p < 128 ? 128 * tile + p : DFF + 128 * tile + (p - 128); }

template <int NR>
__device__ __forceinline__ void rows_to_bf16(const float* xrow, bf16_t* orow, float* ssq, int lane) {
    f32x4 v[NR][4];
#pragma unroll
    for (int r = 0; r < NR; ++r)
#pragma unroll
        for (int j = 0; j < 4; ++j) v[r][j] = ((const f32x4*)(xrow + (size_t)r * DM))[lane + 64 * j];
#pragma unroll
    for (int r = 0; r < NR; ++r) {
        float s = 0.f;
#pragma unroll
        for (int j = 0; j < 4; ++j) s += dot4(v[r][j]);
        s = wave_sum(s);
        u32x2* o8 = (u32x2*)(orow + (size_t)r * DM) + lane;
#pragma unroll
        for (int j = 0; j < 4; ++j) { u32x2 w; w.x = cvtpk(v[r][j][0], v[r][j][1]); w.y = cvtpk(v[r][j][2], v[r][j][3]); o8[64 * j] = w; }
        if (lane == 0) ssq[r] = s;
    }
}

__device__ __forceinline__ void p0_prologue(const Params& P, LAS unsigned char* lds, int G, int bid, int part) {
    const int tid = threadIdx.x, lane = tid & 63, wave = __builtin_amdgcn_readfirstlane(tid >> 6);
    LAS float* scr = (LAS float*)(lds + wave * 16384);
    const int gw = bid * 8 + wave, NGW = G * 8;
    unsigned char* ws = P.ws;
    float* ssq = (float*)(ws + WS_SSQ);
    const int gt = bid * 512 + tid, NGT = G * 512;
    constexpr int I0 = 16 * 48, I1 = 16 * 32, I2 = 16 * 56, I3 = 16 * 32, I4 = 16 * 16, I6 = 16 * 176, I8 = 44 * 32;
    if (part == 1) {
        constexpr int NITEMS = I3 + I6 + I8;
        for (int it = gw; it < NITEMS; it += NGW) {
            int r = it;
            if (r < I3) { const int nb = r % 32, kb = r / 32; p0_transpose_item(P.in[20], 1024, 1024, nullptr, (bf16_t*)(ws + WS_WOUTB), kb, 32 * nb, 32 * nb, scr, lane); continue; } r -= I3;
            if (r < I6) { const int nb = r % 176, kb = r / 176;
                p0_transpose_item(P.in[24] + (size_t)1024 * NFF, 1024, NFF, P.in[9] + 1024, (bf16_t*)(ws + WS_WFFN) + (size_t)NFF * 1024, kb, map_ffn(nb), 32 * nb, scr, lane); continue; } r -= I6;
            { const int nb = r % 32, kb = r / 32;
                p0_transpose_item(P.in[27] + (size_t)DFF * 1024, DFF, 1024, nullptr, (bf16_t*)(ws + WS_WDOWN) + (size_t)1024 * DFF, kb, 32 * nb, 32 * nb, scr, lane); }
        }
        { const f32x4* ck = (const f32x4*)P.in[2]; const f32x4* cv = (const f32x4*)P.in[3]; f32x4* ok = (f32x4*)(P.out + O_WKS); f32x4* ov = (f32x4*)(P.out + O_WVS);
          constexpr int NEL = NDEC * 124 * 64;
          for (int i0 = gt; i0 < NEL; i0 += 4 * NGT) {
              f32x4 a[4], b[4];
#pragma unroll
              for (int q = 0; q < 4; ++q) { const int i = i0 + q * NGT; if (i < NEL) { const int n = i / (124 * 64), r = i % (124 * 64); const size_t s = (size_t)n * 128 * 64 + 4 * 64 + r; a[q] = ck[s]; b[q] = cv[s]; } }
#pragma unroll
              for (int q = 0; q < 4; ++q) { const int i = i0 + q * NGT; if (i < NEL) { const int n = i / (124 * 64), r = i % (124 * 64); const size_t d = (size_t)n * 128 * 64 + r; ok[d] = a[q]; ov[d] = b[q]; } }
          } }
        return;
    }
    constexpr int NITEMS = I0 + I1 + I2 + 2 * I4 + I6 + I8;
    for (int it = gw; it < NITEMS; it += NGW) {
        int r = it;
        if (r < I0) { const int nb = r % 48, kb = r / 48; p0_transpose_item(P.in[11], 1024, NINA, P.in[8], (bf16_t*)(ws + WS_WINA), kb, map_headperm(nb), 32 * nb, scr, lane); continue; } r -= I0;
        if (r < I1) { const int nb = r % 32, kb = r / 32; p0_transpose_item(P.in[15], 1024, 1024, nullptr, (bf16_t*)(ws + WS_WOUTA), kb, 32 * nb, 32 * nb, scr, lane); continue; } r -= I1;
        if (r < I2) { const int nb = r % 56, kb = r / 56; p0_transpose_item(P.in[16], 1024, NINB, P.in[8] + 1024, (bf16_t*)(ws + WS_WINB), kb, nb < 48 ? 32 * nb : map_headperm(nb), 32 * nb, scr, lane); continue; } r -= I2;
        if (r < 2 * I4) { const int l = r / I4; r -= l * I4; const int nb = r % 16, kb = r / 16;
            p0_transpose_item(P.in[21] + (size_t)l * 1024 * 512, 1024, 512, P.in[10] + l * 1024, (bf16_t*)(ws + WS_WMKV) + (size_t)l * 512 * 1024, kb, map_headperm(nb), 32 * nb, scr, lane); continue; } r -= 2 * I4;
        if (r < I6) { const int nb = r % 176, kb = r / 176;
            p0_transpose_item(P.in[24], 1024, NFF, P.in[9], (bf16_t*)(ws + WS_WFFN), kb, map_ffn(nb), 32 * nb, scr, lane); continue; } r -= I6;
        { const int nb = r % 32, kb = r / 32;
            p0_transpose_item(P.in[27], DFF, 1024, nullptr, (bf16_t*)(ws + WS_WDOWN), kb, 32 * nb, 32 * nb, scr, lane); }
    }
    bf16_t* XB = (bf16_t*)(ws + WS_XB); bf16_t* MEMB = (bf16_t*)(ws + WS_MEMB);
    for (int r4 = gw; r4 < (M + MMEM) / 4; r4 += NGW) { const int r = 4 * r4;
        if (r < MP) rows_to_bf16<4>(P.in[0] + (size_t)r * DM, XB + (size_t)r * DM, ssq + r, lane);
        else if (r < M) rows_to_bf16<4>(P.in[1] + (size_t)(r - MP) * DM, XB + (size_t)r * DM, ssq + r, lane);
        else rows_to_bf16<4>(P.in[7] + (size_t)(r - M) * DM, MEMB + (size_t)(r - M) * DM, ssq + 5 * M + (r - M), lane);
    }
    for (int i = gt; i < 4 * M; i += NGT) ssq[M + i] = 0.f;
    if (gt < 320) { float* GT = (float*)(ws + WS_GT); const int t4 = gt >> 6, d = gt & 63; const float c = 0.125f * LOG2E; GT[gt] = t4 == 0 ? P.in[12][d] * c : t4 == 1 ? P.in[13][d] : t4 == 2 ? 1.f : t4 == 3 ? P.in[22][d] * c : P.in[22][64 + d] * c; }
    { bf16_t* WST = (bf16_t*)(ws + WS_WST); const float* wsb = P.in[18];
      for (int i = gt; i < 4 * 128 * 128; i += NGT) { const int ii = (i >> 7) & 127, jj = i & 127; const float w = jj <= ii ? wsb[i] : 0.f; WST[i] = (bf16_t)(cvtpk(w, 0.f) & 0xffffu); } }
}

__device__ __forceinline__ int crow(int r, int hi) { return (r & 3) + 8 * (r >> 2) + 4 * hi; }
__device__ __forceinline__ int kv_off(int row, int chunk) { return row * 128 + ((chunk ^ (row & 7)) << 4); }
__device__ __forceinline__ s16x4 vtr(const LAS unsigned char* p) { return __builtin_bit_cast(s16x4, __builtin_amdgcn_ds_read_tr16_b64_v4i16((LAS s16x4*)p)); }

struct AttnOfs { int k[4]; int v[2]; };
__device__ __forceinline__ AttnOfs attn_ofs() {
    int lane_ = threadIdx.x & 63; asm volatile("" : "+v"(lane_)); const int lane = lane_, r32 = lane & 31, hi = lane >> 5; AttnOfs a;
#pragma unroll
    for (int ks = 0; ks < 4; ++ks) a.k[ks] = r32 * 128 + (((2 * ks + hi) ^ (r32 & 7)) << 4);
    const int vkey = 4 * hi + ((lane & 15) >> 2), vcol = 16 * ((lane >> 4) & 1) + 4 * (lane & 3);
#pragma unroll
    for (int d0 = 0; d0 < 2; ++d0) a.v[d0] = vkey * 128 + (((4 * d0 + (vcol >> 3)) ^ vkey) << 4) + (vcol & 7) * 2;
    return a;
}
template <int CT, int MODE0, int MODE1, bool FIRST, int MODEL = MODE1>
__device__ __forceinline__ void attn_chunk(const bf16x8 (&qf)[4], const AttnOfs& ao, const LAS unsigned char* Kb, const LAS unsigned char* Vb, int idb, int lim, float bias0, float slope2, LAS float* wsf, float& m, float& l, f32x16 (&o)[2]) {
    const int lane = threadIdx.x & 63, r32 = lane & 31, hi = lane >> 5;
    f32x16 s[CT];
#pragma unroll
    for (int t = 0; t < CT; ++t) {
        const int MODE = t == 0 ? MODE0 : (t == CT - 1 ? MODEL : MODE1);
#pragma unroll
        for (int r = 0; r < 16; ++r) s[t][r] = MODE == 0 ? 0.f : __builtin_fmaf(slope2, (float)(32 * t + (r & 3) + 8 * (r >> 2)), bias0);
#pragma unroll
        for (int ks = 0; ks < 4; ++ks) { const bf16x8 kf = *(const LAS bf16x8*)(Kb + ao.k[ks] + t * 4096); s[t] = __builtin_amdgcn_mfma_f32_32x32x16_bf16(kf, qf[ks], s[t], 0, 0, 0); }
        if (CT > 2) __builtin_amdgcn_sched_barrier(0);
    }
    float mx = -1e30f;
    if (MODE0 >= 2 || MODE1 >= 2 || MODEL >= 2) {
        int hi_ = idb; asm volatile("" : "+v"(hi_));
        const int lo127 = hi_ - 127, lolim = hi_ - lim;
#pragma unroll
        for (int t = 0; t < CT; ++t) {
            const int MODE = t == 0 ? MODE0 : (t == CT - 1 ? MODEL : MODE1);
#pragma unroll
            for (int r = 0; r < 16; ++r) {
                const int cr = 32 * t + (r & 3) + 8 * (r >> 2);
                float v = s[t][r];
                if (MODE == 2) v = cr >= lo127 ? v : -1e30f;
                if (MODE == 3) v = cr <= hi_ ? v : -1e30f;
                if (MODE == 4) v = (cr <= hi_ && cr >= lolim) ? v : -1e30f;
                s[t][r] = v; mx = fmaxf(mx, v);
            }
        }
    } else {
#pragma unroll
        for (int t = 0; t < CT; ++t)
#pragma unroll
            for (int r = 0; r < 16; ++r) mx = fmaxf(mx, s[t][r]);
    }
    mx = fmaxf(mx, __shfl_xor(mx, 32));
    const float mn = fmaxf(m, mx), alpha = __builtin_amdgcn_exp2f(m - mn);
    m = mn;
    float sum = 0.f;
#pragma unroll
    for (int t = 0; t < CT; ++t)
#pragma unroll
        for (int r = 0; r < 16; ++r) { const float e = __builtin_amdgcn_exp2f(s[t][r] - mn); s[t][r] = e; sum += e; }
    l = l * alpha + sum;
    if (!FIRST) {
        if (hi == 0) wsf[r32] = alpha;
        asm volatile("s_waitcnt lgkmcnt(0)" ::: "memory");
#pragma unroll
        for (int r = 0; r < 16; ++r) { const float a = wsf[crow(r, hi)]; o[0][r] *= a; o[1][r] *= a; }
        asm volatile("s_waitcnt lgkmcnt(0)" ::: "memory");
    }
#pragma unroll
    for (int t = 0; t < CT; ++t)
#pragma unroll
        for (int k2 = 0; k2 < 2; ++k2) {
            u32x4 pw; pw.x = cvtpk(s[t][8 * k2 + 0], s[t][8 * k2 + 1]); pw.y = cvtpk(s[t][8 * k2 + 2], s[t][8 * k2 + 3]); pw.z = cvtpk(s[t][8 * k2 + 4], s[t][8 * k2 + 5]); pw.w = cvtpk(s[t][8 * k2 + 6], s[t][8 * k2 + 7]);
            const bf16x8 pa = __builtin_bit_cast(bf16x8, pw);
#pragma unroll
            for (int d0 = 0; d0 < 2; ++d0) {
                const LAS unsigned char* vp = Vb + ao.v[d0] + (32 * t + 16 * k2) * 128;
                const s16x4 lo = vtr(vp), hh = vtr(vp + 1024);
                const bf16x8 vf = (bf16x8){lo[0], lo[1], lo[2], lo[3], hh[0], hh[1], hh[2], hh[3]};
                o[d0] = __builtin_amdgcn_mfma_f32_32x32x16_bf16(pa, vf, o[d0], 0, 0, 0);
            }
        }
}
__device__ __forceinline__ void attn_init(bool mask, float sink2, float& m, float& l, f32x16 (&o)[2]) {
    const int hi = (threadIdx.x & 63) >> 5;
    m = mask ? sink2 : -1e30f; l = (mask && hi == 0) ? 1.f : 0.f;
#pragma unroll
    for (int r = 0; r < 16; ++r) { o[0][r] = 0.f; o[1][r] = 0.f; }
}
__device__ __forceinline__ void attn_finish(float l, LAS float* wsf, f32x16 (&o)[2], LAS unsigned short* stg) {
    const int lane = threadIdx.x & 63, r32 = lane & 31, hi = lane >> 5;
    l += __shfl_xor(l, 32);
    if (hi == 0) wsf[r32] = 1.0f / l;
    asm volatile("s_waitcnt lgkmcnt(0)" ::: "memory");
#pragma unroll
    for (int r = 0; r < 16; ++r) { const float li = wsf[crow(r, hi)]; const int q = crow(r, hi);
        stg[q * 64 + r32] = (unsigned short)(cvtpk(o[0][r] * li, 0.f) & 0xffffu); stg[q * 64 + 32 + r32] = (unsigned short)(cvtpk(o[1][r] * li, 0.f) & 0xffffu); }
    asm volatile("s_waitcnt lgkmcnt(0)" ::: "memory");
}
template <bool EDGE>
__device__ __forceinline__ void attn_swa(const bf16x8 (&qf)[4], const AttnOfs& ao, const LAS unsigned char* Kb, const LAS unsigned char* Vb, int qpos, int kpos0, float slope2, float sink2, LAS float* wsf, LAS unsigned short* stg) {
    const int hi = (threadIdx.x & 63) >> 5;
    float m, l; f32x16 o[2]; attn_init(true, __builtin_fmaf(slope2, (float)(qpos - kpos0), sink2), m, l, o);
    const int idb = qpos - kpos0 - 4 * hi; const float b0 = slope2 * (float)(4 * hi);
    if (!EDGE) {
        attn_chunk<5, 2, 1, true, 3>(qf, ao, Kb, Vb, idb, 0, b0, slope2, wsf, m, l, o);
    } else {
        const int lim = qpos < 127 ? qpos : 127;
        attn_chunk<5, 4, 4, true, 4>(qf, ao, Kb, Vb, idb, lim, b0, slope2, wsf, m, l, o);
    }
    attn_finish(l, wsf, o, stg);
}
__device__ __forceinline__ void attn_mem(const bf16x8 (&qf)[4], const AttnOfs& ao, const LAS unsigned char* Kb, const LAS unsigned char* Vb, LAS float* wsf, LAS unsigned short* stg) {
    float m, l; f32x16 o[2]; attn_init(false, 0.f, m, l, o);
    attn_chunk<4, 0, 0, true>(qf, ao, Kb, Vb, 0, 0, 0.f, 0.f, wsf, m, l, o);
    attn_chunk<4, 0, 0, false>(qf, ao, Kb + 128 * 128, Vb + 128 * 128, 0, 0, 0.f, 0.f, wsf, m, l, o);
    attn_finish(l, wsf, o, stg);
}
__device__ __forceinline__ void stage_out(const LAS unsigned short* stg, bf16_t* gdst, size_t ld) {
    const int lane = threadIdx.x & 63;
#pragma unroll
    for (int i = 0; i < 4; ++i) { const int row = i * 8 + (lane >> 3), ch = lane & 7; *(u32x4*)(gdst + (size_t)row * ld + ch * 8) = *(const LAS u32x4*)(stg + row * 64 + ch * 8); }
    asm volatile("s_waitcnt lgkmcnt(0)" ::: "memory");
}

__device__ __forceinline__ void unit_swa_prompt(const Params& P, LAS unsigned char* lds, LAS float* wsf, int b, int qb, int g) {
    int tid_ = threadIdx.x; asm volatile("" : "+v"(tid_));
    const int tid = tid_, lane = tid & 63, wave = __builtin_amdgcn_readfirstlane(tid >> 6), r32 = lane & 31, hi = lane >> 5;
    const bf16_t* Qg = (const bf16_t*)(P.ws + WS_A); const bf16_t* Kg = (const bf16_t*)(P.ws + WS_B); const bf16_t* Vg = Kg + 256; bf16_t* Og = (bf16_t*)(P.ws + WS_OB);
    LAS unsigned char* Kl = lds; LAS unsigned char* Vl = lds + 49152; LAS unsigned short* stg = (LAS unsigned short*)(lds + 98304 + wave * 4096);
    const int t0 = 256 * qb + 32 * wave;
    const bf16_t* qp = Qg + (size_t)(b * SEQ + t0 + r32) * 768 + (3 * g) * 64 + 8 * hi;
    bf16x8 qn[4];
#pragma unroll
    for (int ks = 0; ks < 4; ++ks) qn[ks] = *(const bf16x8*)(qp + 16 * ks);
#pragma unroll
    for (int idx = tid; idx < 384 * 8; idx += 512) {
        const int row = idx >> 3, ch = idx & 7, t = 256 * qb - 128 + row;
        u32x4 kv = (u32x4){0u, 0u, 0u, 0u}, vv = kv;
        if (t >= 0) { const size_t o = (size_t)(b * SEQ + t) * 768 + g * 64 + ch * 8; kv = *(const u32x4*)(Kg + o); vv = *(const u32x4*)(Vg + o); }
        *(LAS u32x4*)(Kl + kv_off(row, ch)) = kv; *(LAS u32x4*)(Vl + kv_off(row, ch)) = vv;
    }
    __syncthreads();
    const AttnOfs ao = attn_ofs();
#pragma unroll 1
    for (int hh = 0; hh < 3; ++hh) {
        const int head = 3 * g + hh;
        bf16x8 qf[4];
#pragma unroll
        for (int ks = 0; ks < 4; ++ks) qf[ks] = qn[ks];
        if (hh < 2) {
#pragma unroll
            for (int ks = 0; ks < 4; ++ks) qn[ks] = *(const bf16x8*)(qp + (hh + 1) * 64 + 16 * ks); }
        if (t0 >= 128) attn_swa<false>(qf, ao, Kl + 32 * wave * 128, Vl + 32 * wave * 128, t0 + r32, t0 - 128, alibi_slope(head) * LOG2E, P.in[14][head] * LOG2E, wsf, stg);
        else attn_swa<true>(qf, ao, Kl + 32 * wave * 128, Vl + 32 * wave * 128, t0 + r32, t0 - 128, alibi_slope(head) * LOG2E, P.in[14][head] * LOG2E, wsf, stg);
        stage_out(stg, Og + (size_t)(b * SEQ + t0) * DM + head * 64, DM);
    }
    __syncthreads();
}

__device__ __forceinline__ void unit_mem_prompt(const Params& P, LAS unsigned char* lds, LAS float* wsf, int layer, int b, int qb, int h, bool reuse, int qb2 = -1) {

    int tid_ = threadIdx.x; asm volatile("" : "+v"(tid_));
    const int tid = tid_, lane = tid & 63, wave = __builtin_amdgcn_readfirstlane(tid >> 6), r32 = lane & 31, hi = lane >> 5;
    const bf16_t* XQ = layer ? (const bf16_t*)(P.ws + WS_X1) : (const bf16_t*)(P.ws + WS_B) + 512; const int xld = layer ? 256 : 768; bf16_t* Og = (bf16_t*)(P.ws + WS_OB);
    const bf16_t* MK = (const bf16_t*)(P.ws + WS_MK) + (size_t)layer * MMEM * 256; const bf16_t* MV = (const bf16_t*)(P.ws + WS_MV) + (size_t)layer * MMEM * 256;
    LAS unsigned char* Kl = lds; LAS unsigned char* Vl = lds + 32768; LAS unsigned short* stg = (LAS unsigned short*)(lds + 98304 + wave * 4096);
    const int t0 = 256 * qb + 32 * wave;
    bf16x8 qf[4];
#pragma unroll
    for (int ks = 0; ks < 4; ++ks) qf[ks] = *(const bf16x8*)(XQ + (size_t)(b * SEQ + t0 + r32) * xld + h * 64 + 16 * ks + 8 * hi);
    if (!reuse) {
#pragma unroll
        for (int idx = tid; idx < 256 * 8; idx += 512) {
            const int row = idx >> 3, ch = idx & 7; const size_t o = (size_t)(b * NMEM + row) * 256 + h * 64 + ch * 8;
            *(LAS u32x4*)(Kl + kv_off(row, ch)) = *(const u32x4*)(MK + o); *(LAS u32x4*)(Vl + kv_off(row, ch)) = *(const u32x4*)(MV + o);
        }
        __syncthreads();
    }
    const AttnOfs ao = attn_ofs();
    if (qb2 >= 0) {
        const int t1 = 256 * qb2 + 32 * wave;
        bf16x8 qg[4];
#pragma unroll
        for (int ks = 0; ks < 4; ++ks) qg[ks] = *(const bf16x8*)(XQ + (size_t)(b * SEQ + t1 + r32) * xld + h * 64 + 16 * ks + 8 * hi);
        attn_mem(qf, ao, Kl, Vl, wsf, stg);
        stage_out(stg, Og + (size_t)(b * SEQ + t0) * DM + 768 + h * 64, DM);
        attn_mem(qg, ao, Kl, Vl, wsf, stg);
        stage_out(stg, Og + (size_t)(b * SEQ + t1) * DM + 768 + h * 64, DM);
        __syncthreads();
        return;
    }
    attn_mem(qf, ao, Kl, Vl, wsf, stg);
    stage_out(stg, Og + (size_t)(b * SEQ + t0) * DM + 768 + h * 64, DM);
    __syncthreads();
}

__device__ __forceinline__ u32x4 ld8f_pack(const float* p) { const f32x4 a = *(const f32x4*)p, b = *(const f32x4*)(p + 4); return pack8(a, b); }

__device__ __forceinline__ void unit_swa_sample(const Params& P, LAS unsigned char* lds, LAS float* wsf, int n, int gp) {
    int tid_ = threadIdx.x; asm volatile("" : "+v"(tid_));
    const int tid = tid_, lane = tid & 63, wave = __builtin_amdgcn_readfirstlane(tid >> 6), r32 = lane & 31, hi = lane >> 5;
    const bf16_t* Qg = (const bf16_t*)(P.ws + WS_A); const bf16_t* Kg = (const bf16_t*)(P.ws + WS_B); const bf16_t* Vg = Kg + 256; bf16_t* Og = (bf16_t*)(P.ws + WS_OB);
#pragma unroll
    for (int idx = tid; idx < 2 * 128 * 8; idx += 512) {
        const int gi = idx >> 10, rem = idx & 1023, row = rem >> 3, ch = rem & 7, g = 2 * gp + gi;
        LAS unsigned char* Kl = lds + gi * 40960; LAS unsigned char* Vl = Kl + 20480;
        const size_t o = ((size_t)(n * 128 + row) * 4 + g) * 64 + ch * 8;
        const u32x4 kv = ld8f_pack(P.in[2] + o), vv = ld8f_pack(P.in[3] + o);
        *(LAS u32x4*)(Kl + kv_off(row, ch)) = kv; *(LAS u32x4*)(Vl + kv_off(row, ch)) = vv;
    }
    { const int gi = tid >> 8, rem = tid & 255, row = 128 + (rem >> 3), ch = rem & 7, g = 2 * gp + gi;
        LAS unsigned char* Kl = lds + gi * 40960; LAS unsigned char* Vl = Kl + 20480;
        u32x4 kv = (u32x4){0u, 0u, 0u, 0u}, vv = kv;
        if (row < 132) { const size_t o = (size_t)(MP + 4 * n + row - 128) * 768 + g * 64 + ch * 8; kv = *(const u32x4*)(Kg + o); vv = *(const u32x4*)(Vg + o); }
        *(LAS u32x4*)(Kl + kv_off(row, ch)) = kv; *(LAS u32x4*)(Vl + kv_off(row, ch)) = vv;
    }
    __syncthreads();
    if (wave < 2) {
        LAS unsigned short* stg = (LAS unsigned short*)(lds + 98304 + wave * 4096);
        const AttnOfs ao = attn_ofs();
        const int g = 2 * gp + wave; const bool qv = r32 < 12; const int hh = qv ? (r32 >> 2) : 0, sidx = r32 & 3, head = 3 * g + hh;
        bf16x8 qf[4];
#pragma unroll
        for (int ks = 0; ks < 4; ++ks) { qf[ks] = *(const bf16x8*)(Qg + (size_t)(MP + 4 * n + sidx) * 768 + head * 64 + 16 * ks + 8 * hi); if (!qv) qf[ks] = (bf16x8){0, 0, 0, 0, 0, 0, 0, 0}; }
        const LAS unsigned char* Kl = lds + wave * 40960;
        attn_swa<true>(qf, ao, Kl, Kl + 20480, 128 + sidx, 0, alibi_slope(head) * LOG2E, P.in[14][head] * LOG2E, wsf, stg);
        for (int i = lane; i < 96; i += 64) { const int q = i >> 3, ch = i & 7;
            *(u32x4*)(Og + (size_t)(MP + 4 * n + (q & 3)) * DM + (3 * g + (q >> 2)) * 64 + ch * 8) = *(const LAS u32x4*)(stg + q * 64 + ch * 8); }
        asm volatile("s_waitcnt lgkmcnt(0)" ::: "memory");
    }
    __syncthreads();
}

__device__ __forceinline__ void unit_mem_sample(const Params& P, LAS unsigned char* lds, LAS float* wsf, int layer, int n, int hp) {
    int tid_ = threadIdx.x; asm volatile("" : "+v"(tid_));
    const int tid = tid_, lane = tid & 63, wave = __builtin_amdgcn_readfirstlane(tid >> 6), r32 = lane & 31, hi = lane >> 5;
    const bf16_t* XQ = layer ? (const bf16_t*)(P.ws + WS_X1) : (const bf16_t*)(P.ws + WS_B) + 512; const int xld = layer ? 256 : 768; bf16_t* Og = (bf16_t*)(P.ws + WS_OB);
    const float* ck = P.in[4] + (size_t)(layer * NDEC + n) * NMEM * 256; const float* cv = P.in[5] + (size_t)(layer * NDEC + n) * NMEM * 256;
#pragma unroll
    for (int idx = tid; idx < 256 * 16; idx += 512) {
        const int row = idx >> 4, hsel = (idx >> 3) & 1, ch = idx & 7; const size_t o = (size_t)row * 256 + (2 * hp + hsel) * 64 + ch * 8;
        LAS unsigned char* Kl = lds + hsel * 65536;
        *(LAS u32x4*)(Kl + kv_off(row, ch)) = ld8f_pack(ck + o); *(LAS u32x4*)(Kl + 32768 + kv_off(row, ch)) = ld8f_pack(cv + o);
    }
    __syncthreads();
    if (wave < 2) {
        LAS unsigned short* stg = (LAS unsigned short*)(lds + OSTG2_OFF + wave * 4096);
        const AttnOfs ao = attn_ofs();
        const int h = 2 * hp + wave; const bool qv = r32 < 4;
        bf16x8 qf[4];
#pragma unroll
        for (int ks = 0; ks < 4; ++ks) { qf[ks] = *(const bf16x8*)(XQ + (size_t)(MP + 4 * n + (r32 & 3)) * xld + h * 64 + 16 * ks + 8 * hi); if (!qv) qf[ks] = (bf16x8){0, 0, 0, 0, 0, 0, 0, 0}; }
        const LAS unsigned char* Kl = lds + wave * 65536;
        attn_mem(qf, ao, Kl, Kl + 32768, wsf, stg);
        if (lane < 32) { const int q = lane >> 3, ch = lane & 7;
            *(u32x4*)(Og + (size_t)(MP + 4 * n + q) * DM + 768 + h * 64 + ch * 8) = *(const LAS u32x4*)(stg + q * 64 + ch * 8); }
        asm volatile("s_waitcnt lgkmcnt(0)" ::: "memory");
    }
    __syncthreads();
}

__device__ __forceinline__ void unit_gmlp_prompt(const Params& P, LAS unsigned char* lds, int b, int c) {
    int tid_ = threadIdx.x; asm volatile("" : "+v"(tid_));
    const int tid = tid_, lane = tid & 63, wave = __builtin_amdgcn_readfirstlane(tid >> 6), r32 = lane & 31, hi = lane >> 5;
    const bf16_t* U = (const bf16_t*)(P.ws + WS_A); const bf16_t* GV = (const bf16_t*)(P.ws + WS_B); bf16_t* Og = (bf16_t*)(P.ws + WS_OB);
    const bf16_t* WST = (const bf16_t*)(P.ws + WS_WST); const float* ssqv = (const float*)(P.ws + WS_SSQ) + 4 * M;
    const float* vg = P.in[17]; const float* bs = P.in[19]; float* cvp = P.out + O_CVP;
    const int rowb = b * SEQ + c * 128;
    const int ib = wave & 3, cb0 = 3 * (wave >> 2);
    LAS unsigned char* wl = lds + 81920;
    u32x4 gvr[6]; float rvv[6];
#define GMLP_LOADS(gg) do { _Pragma("unroll") for (int i = 0; i < 6; ++i) { const int idx = tid + 512 * i, j = idx / 24, ch = idx % 24; \
            gvr[i] = *(const u32x4*)(GV + (size_t)(rowb + j) * 768 + (gg) * 192 + ch * 8); } } while (0)
    GMLP_LOADS(0);
#pragma unroll
    for (int i = 0; i < 6; ++i) rvv[i] = rsqrtf(ssqv[rowb + (tid + 512 * i) / 24] * (1.f / 768.f) + EPS);
#pragma unroll 1
    for (int g = 0; g < 4; ++g) {
        u32x4 wv[4];
#pragma unroll
        for (int i = 0; i < 4; ++i) { const int idx = tid + 512 * i; wv[i] = *(const u32x4*)(WST + (size_t)(g * 128 + (idx >> 4)) * 128 + (idx & 15) * 8); }
        const int eq = lane >> 1, hf = lane & 1; const size_t ro = (size_t)(rowb + 32 * ib + eq);
        u32x4 uu[3][2]; float gcol[3]; const float bq = bs[g * 128 + 32 * ib + eq];
#pragma unroll
        for (int i = 0; i < 3; ++i) { const int col = g * 192 + 32 * (cb0 + i) + 16 * hf; uu[i][0] = *(const u32x4*)(U + ro * 768 + col); uu[i][1] = *(const u32x4*)(U + ro * 768 + col + 8);
            gcol[i] = vg[g * 192 + 32 * (cb0 + i) + r32]; }
#pragma unroll
        for (int i = 0; i < 6; ++i) { const int idx = tid + 512 * i, j = idx / 24, ch = idx % 24;
            const float rv = rvv[i]; const u32x4 w = gvr[i];
            const f32x4 v0 = (f32x4){bflo(w.x), bfhi(w.x), bflo(w.y), bfhi(w.y)} * rv, v1 = (f32x4){bflo(w.z), bfhi(w.z), bflo(w.w), bfhi(w.w)} * rv;
            *(LAS u32x4*)(lds + j * 384 + ch * 16) = pack8(v0, v1);
            if (c == 31) { const int col = g * 192 + ch * 8; const f32x4 g0 = *(const f32x4*)(vg + col), g1 = *(const f32x4*)(vg + col + 4);
                float* o = cvp + (size_t)(b * 128 + j) * 768 + col; *(f32x4*)o = v0 * g0; *(f32x4*)(o + 4) = v1 * g1; }
        }
#pragma unroll
        for (int i = 0; i < 4; ++i) { const int idx = tid + 512 * i; *(LAS u32x4*)(wl + (idx >> 4) * 272 + (idx & 15) * 16) = wv[i]; }
        __syncthreads();
        { const int gn = g < 3 ? g + 1 : 3; GMLP_LOADS(gn); }
        f32x16 acc[3];
#pragma unroll
        for (int i = 0; i < 3; ++i)
#pragma unroll
            for (int r = 0; r < 16; ++r) acc[i][r] = 0.f;
        const int nks = 2 * (ib + 1);
#pragma unroll 1
        for (int ks = 0; ks < nks; ++ks) {
            const bf16x8 af = *(const LAS bf16x8*)(wl + (32 * ib + r32) * 272 + 32 * ks + 16 * hi);
            const int j0 = 16 * ks + 8 * hi + ((lane & 15) >> 2);
#pragma unroll
            for (int i = 0; i < 3; ++i) {
                const int col = 32 * (cb0 + i) + 16 * ((lane >> 4) & 1) + 4 * (lane & 3);
                const s16x4 lo = vtr(lds + j0 * 384 + col * 2), hh = vtr(lds + (j0 + 4) * 384 + col * 2);
                const bf16x8 vf = (bf16x8){lo[0], lo[1], lo[2], lo[3], hh[0], hh[1], hh[2], hh[3]};
                acc[i] = __builtin_amdgcn_mfma_f32_32x32x16_bf16(af, vf, acc[i], 0, 0, 0);
            }
        }
        LAS float* stg = (LAS float*)(lds + 49152 + wave * 4096);
#pragma unroll
        for (int i = 0; i < 3; ++i) {
#pragma unroll
            for (int r = 0; r < 16; ++r) { const int q = crow(r, hi); stg[q * 32 + r32] = acc[i][r] * gcol[i]; }
            asm volatile("s_waitcnt lgkmcnt(0)" ::: "memory");
            const int col = g * 192 + 32 * (cb0 + i) + 16 * hf;
            const u32x4 u0 = uu[i][0], u1 = uu[i][1];
            const LAS f32x4* sp = (const LAS f32x4*)(stg + eq * 32 + 16 * hf);
            const f32x4 m0 = sp[0] + bq, m1 = sp[1] + bq, m2 = sp[2] + bq, m3 = sp[3] + bq;
            u32x4 o0, o1;
            o0.x = cvtpk(bflo(u0.x) * m0[0], bfhi(u0.x) * m0[1]); o0.y = cvtpk(bflo(u0.y) * m0[2], bfhi(u0.y) * m0[3]); o0.z = cvtpk(bflo(u0.z) * m1[0], bfhi(u0.z) * m1[1]); o0.w = cvtpk(bflo(u0.w) * m1[2], bfhi(u0.w) * m1[3]);
            o1.x = cvtpk(bflo(u1.x) * m2[0], bfhi(u1.x) * m2[1]); o1.y = cvtpk(bflo(u1.y) * m2[2], bfhi(u1.y) * m2[3]); o1.z = cvtpk(bflo(u1.z) * m3[0], bfhi(u1.z) * m3[1]); o1.w = cvtpk(bflo(u1.w) * m3[2], bfhi(u1.w) * m3[3]);
            *(u32x4*)(Og + ro * DM + col) = o0; *(u32x4*)(Og + ro * DM + col + 8) = o1;
            asm volatile("s_waitcnt lgkmcnt(0)" ::: "memory");
        }
        __syncthreads();
    }
#undef GMLP_LOADS
}

__device__ __forceinline__ void gmlp_sample(const Params& P, int G, int bid, int n0 = 0, int nn = NDEC) {
    const bf16_t* U = (const bf16_t*)(P.ws + WS_A); const bf16_t* GV = (const bf16_t*)(P.ws + WS_B); bf16_t* Og = (bf16_t*)(P.ws + WS_OB);
    const float* ssqv = (const float*)(P.ws + WS_SSQ) + 4 * M; const float* vg = P.in[17]; const float* wsb = P.in[18]; const float* bs = P.in[19]; float* cvs = P.out + O_CVS;
    for (int i = bid * 512 + threadIdx.x; i < nn * 768; i += G * 512) {
        const int n = n0 + i / 768, col = i % 768, g = col / 192; float vn[4], uv[4], wm[4][4], bv[4];
#pragma unroll
        for (int s = 0; s < 4; ++s) { const int row = MP + 4 * n + s; vn[s] = bf2f(GV[(size_t)row * 768 + col]) * rsqrtf(ssqv[row] * (1.f / 768.f) + EPS) * vg[col]; uv[s] = bf2f(U[(size_t)row * 768 + col]); bv[s] = bs[g * 128 + s];
#pragma unroll
            for (int j = 0; j < 4; ++j) wm[s][j] = j <= s ? wsb[(size_t)(g * 128 + s) * 128 + j] : 0.f; }
#pragma unroll
        for (int s = 0; s < 4; ++s) cvs[(size_t)(4 * n + s) * 768 + col] = vn[s];
#pragma unroll
        for (int s = 0; s < 4; ++s) { float mx = bv[s];
#pragma unroll
            for (int j = 0; j < 4; ++j) if (j <= s) mx += wm[s][j] * vn[j];
            const int row = MP + 4 * n + s; Og[(size_t)row * DM + col] = f2bf_s(uv[s] * mx); }
    }
}

#define XB_TMO      128
#define XB_XCNT(j)  (256  + 64 * (j))
#define XB_XSUB(j)  (1280 + 64 * (j))
#define XB_XGEN(j)  (2304 + 64 * (j))
#define XB_TOP      3328
#define XB_TOPGEN   3392
#define XCD_BAR_WORDS 3456
#define XB_SPIN_CAP (1u << 22)
__device__ __forceinline__ unsigned xb_ld(unsigned* p)              { return __hip_atomic_load(p, __ATOMIC_RELAXED, __HIP_MEMORY_SCOPE_AGENT); }
__device__ __forceinline__ unsigned xb_add(unsigned* p, unsigned v) { return __hip_atomic_fetch_add(p, v, __ATOMIC_RELAXED, __HIP_MEMORY_SCOPE_AGENT); }
__device__ __forceinline__ unsigned xb_xcc_id() { return (unsigned)__builtin_amdgcn_s_getreg((3 << 11) | 20) & 0xFu; }
#define XB_SPIN(cond, bar) do { unsigned _sp = 0; while (cond) { __builtin_amdgcn_s_sleep(1); \
    if ((++_sp & 255u) == 0u) { if (xb_ld(&(bar)[XB_TMO])) break; if (_sp > XB_SPIN_CAP) { atomicAdd(&(bar)[XB_TMO], 1u); break; } } } } while (0)
struct XcdBarrier { unsigned* bar; unsigned x; volatile LAS unsigned* st; };
__device__ __forceinline__ XcdBarrier xcd_barrier_post(unsigned* bar, volatile LAS unsigned* st) {
    XcdBarrier b; b.bar = bar; b.x = xb_xcc_id(); b.st = st;
    if (threadIdx.x == 0) (void)xb_add(&bar[XB_XCNT(b.x)], 1u);
    return b;
}
__device__ __forceinline__ void xcd_barrier_complete(unsigned* bar, unsigned x, unsigned& nloc, unsigned& nx) {
    const unsigned G = gridDim.x * gridDim.y * gridDim.z;
    unsigned sum, cnt, mine, sp = 0u;
    for (;;) {
        sum = 0u; cnt = 0u; mine = 0u;
#pragma unroll
        for (unsigned j = 0; j < 16; ++j) { const unsigned c = xb_ld(&bar[XB_XCNT(j)]); sum += c; cnt += (c > 0u) ? 1u : 0u; mine = (j == x) ? c : mine; }
        if (sum == G) break;
        __builtin_amdgcn_s_sleep(1);
        if ((++sp & 255u) == 0u) { if (xb_ld(&bar[XB_TMO])) break; if (sp > XB_SPIN_CAP) { atomicAdd(&bar[XB_TMO], 1u); break; } }
    }
    nloc = mine > 0u ? mine : 1u; nx = cnt > 0u ? cnt : 1u;
}
__device__ __forceinline__ void xcd_barrier(const XcdBarrier& b) {
    asm volatile("s_waitcnt vmcnt(0)" ::: "memory");
    __syncthreads();
    if (threadIdx.x == 0) {
        unsigned* bar = b.bar;
        __builtin_amdgcn_s_waitcnt(0);
        unsigned nloc = b.st[0], nx = b.st[1];
        if (nloc == 0u) { xcd_barrier_complete(bar, b.x, nloc, nx); b.st[0] = nloc; b.st[1] = nx; }
        const unsigned old = xb_add(&bar[XB_XSUB(b.x)], 1u);
        const unsigned gen = old / nloc;
        if (old + 1u == (gen + 1u) * nloc) {
            __builtin_amdgcn_fence(__ATOMIC_RELEASE, "agent");
            asm volatile("s_waitcnt vmcnt(0)" ::: "memory");
            const unsigned og = xb_add(&bar[XB_TOP], 1u);
            const unsigned tg = og / nx;
            if (og + 1u == (tg + 1u) * nx) xb_add(&bar[XB_TOPGEN], 1u);
            else XB_SPIN(xb_ld(&bar[XB_TOPGEN]) == tg, bar);
            __builtin_amdgcn_fence(__ATOMIC_ACQUIRE, "agent");
            xb_add(&bar[XB_XGEN(b.x)], 1u);
            asm volatile("s_waitcnt vmcnt(0)" ::: "memory");
        } else {
            XB_SPIN(xb_ld(&bar[XB_XGEN(b.x)]) == gen, bar);
            __builtin_amdgcn_fence(__ATOMIC_ACQUIRE, "agent");
            asm volatile("s_waitcnt vmcnt(0)" ::: "memory");
        }
    }
    __syncthreads();
}

#define GB_CNT(g) (3584 + 128 * (g))
#define GB_GEN(g) (3648 + 128 * (g))
static_assert((3648 + 128 * 7 + 1) * 4 <= 32768, "group barrier words inside the control region");
#define GB_DEF 6144
#define GB_XMAX(g) (4608 + 64 * (g))
#define GB_XMIN(g) (5120 + 64 * (g))
__device__ __forceinline__ void group_barrier(unsigned* bar, int grp, unsigned nblk, unsigned& epoch, bool coloc) {
    asm volatile("s_waitcnt vmcnt(0)" ::: "memory");
    __syncthreads();
    if (threadIdx.x == 0) {
        if (!coloc) { __builtin_amdgcn_fence(__ATOMIC_RELEASE, "agent"); asm volatile("s_waitcnt vmcnt(0)" ::: "memory"); }
        const unsigned old = xb_add(&bar[GB_CNT(grp)], 1u);
        if (old + 1u == (epoch + 1u) * nblk) xb_add(&bar[GB_GEN(grp)], 1u);
        else XB_SPIN(xb_ld(&bar[GB_GEN(grp)]) == epoch, bar);
        __builtin_amdgcn_fence(__ATOMIC_ACQUIRE, "agent");
        asm volatile("s_waitcnt vmcnt(0)" ::: "memory");
    }
    ++epoch;
    __syncthreads();
}


__global__ void __launch_bounds__(512, 2) mk_fwd(Params P) {
    extern __shared__ __attribute__((aligned(16))) unsigned char lds_raw[];
    LAS unsigned char* lds = (LAS unsigned char*)lds_raw;
    const int tid = threadIdx.x, wave = __builtin_amdgcn_readfirstlane(tid >> 6);
    const int G = gridDim.x, bid = blockIdx.x;
    LAS float* wsf = (LAS float*)(lds + WSF_OFF) + wave * 64;
    unsigned char* ws = P.ws;
    float* ssq = (float*)(ws + WS_SSQ);
    bf16_t* XB = (bf16_t*)(ws + WS_XB);
    cg::grid_group grid = cg::this_grid();
    const int lo = P.ph_lo, hi = P.ph_hi;
#ifndef PH_MASK
#define PH_MASK 0x1fff
#endif
#define IN(k) (((PH_MASK >> (k)) & 1) && lo <= (k) && (k) < hi)
#ifndef USE_XCD_BAR
#define USE_XCD_BAR 1
#endif
    volatile LAS unsigned* bst = (volatile LAS unsigned*)(lds + BST_OFF);
    if (tid < 2) bst[tid] = 0u;
    __syncthreads();
    XcdBarrier xbar = xcd_barrier_post((unsigned*)(ws + WS_CTL), bst);
    if (tid == 0 && (G % 8) == 0) { unsigned* cb = (unsigned*)(ws + WS_CTL); const unsigned xc = xb_xcc_id();
        __hip_atomic_fetch_max(&cb[GB_XMAX(bid % 8)], xc + 1u, __ATOMIC_RELAXED, __HIP_MEMORY_SCOPE_AGENT); __hip_atomic_fetch_max(&cb[GB_XMIN(bid % 8)], 16u - xc, __ATOMIC_RELAXED, __HIP_MEMORY_SCOPE_AGENT); }
    unsigned long long t_prev = 0ull, t_probe = 0ull;
    if (TPROBE == 200 && bid == 0) { const unsigned long long t0 = __builtin_amdgcn_s_memrealtime(); while (__builtin_amdgcn_s_memrealtime() - t0 < 20000ull) __builtin_amdgcn_s_sleep(8); }
    if (TPROBE >= 0) t_prev = __builtin_amdgcn_s_memrealtime();
    const unsigned long long t_start = t_prev;
#ifndef GROUP_BAR
#define GROUP_BAR 1
#endif
    unsigned gepoch = 0u;
    const int ng_ = (G % 8 == 0) ? 8 : 1;
    bool coloc = false;
#define SEAM(k) do { if (IN(k) && IN((k) + 1)) { if (!USE_XCD_BAR) grid.sync(); else if (GROUP_BAR && ng_ == 8 && (k) != 0) group_barrier((unsigned*)(ws + WS_CTL), bid % 8, (unsigned)(G / 8), gepoch, coloc); else xcd_barrier(xbar); \
        if (STAGGER_NS > 0 && ng_ == 8 && (k) == 0) { const unsigned long long t0_ = __builtin_amdgcn_s_memrealtime(); const unsigned long long w_ = (unsigned long long)(bid % 8) * STAGGER_NS / 10ull; while (__builtin_amdgcn_s_memrealtime() - t0_ < w_) __builtin_amdgcn_s_sleep(2); } \
        if ((k) == 0 && ng_ == 8) { unsigned* cb = (unsigned*)(ws + WS_CTL); const unsigned a = xb_ld(&cb[GB_XMAX(bid % 8)]), b2 = xb_ld(&cb[GB_XMIN(bid % 8)]); coloc = (a != 0u) && (a - 1u == 16u - b2); } } \
    if (TPROBE >= 0) { const unsigned long long tn = __builtin_amdgcn_s_memrealtime(); if (TPROBE == (k)) t_probe = tn - t_prev; t_prev = tn; } } while (0)

    const int ng = (G % 8 == 0) ? 8 : 1, grp = bid % ng, lb = bid / ng, LB = G / ng;
    const bool early = (lb & 1) != 0;
    const int srow = MP + (MS / ng) * grp, snrow = MS / ng;
    if (IN(0)) { p0_prologue(P, lds, G, bid, 0); }
    SEAM(0);
    const int gwave = bid * 8 + wave, NW = G * 8;
    const bf16_t* XBs = XB;
    if (IN(1)) {
        EpiInA E{ssq, (bf16_t*)(ws + WS_A), (const float*)(ws + WS_GT), P.out};
        EpiMemKV E2{ssq + 5 * M, P.in[23], P.out + O_MKP, P.out + O_MVP, (bf16_t*)(ws + WS_MK), (bf16_t*)(ws + WS_MV)};
        const int mrow = (MMEM / ng) * grp, mnrow = MMEM / ng, mtask = (mnrow / 64) * 16, msplit = mtask * 5 / 16;
        if (early) { sample_gemm<4, 4>(lds, XBs, DM, (const bf16_t*)(ws + WS_WINA), 6, E, lb >> 1, LB >> 1, srow, snrow);
                     sample_gemm<4, 4>(lds, (const bf16_t*)(ws + WS_MEMB), DM, (const bf16_t*)(ws + WS_WMKV), 4, E2, lb >> 1, LB >> 1, mrow, mnrow, 0, msplit); }
        { pg8::Gemm g{XB, (const bf16_t*)(ws + WS_WINA), DM, DM}; pg8::StaticOrder S; S.init(MP, NINA, G, bid);
          pg8::gemm_phase<EpiInA, true, true>(lds, g, S, E); }
        if (!early) sample_gemm<4, 4>(lds, (const bf16_t*)(ws + WS_MEMB), DM, (const bf16_t*)(ws + WS_WMKV), 4, E2, lb >> 1, (LB + 1) >> 1, mrow, mnrow, msplit, mtask);
    }
    SEAM(1);
    if (IN(2)) {
        const int nA = 512 / ng, nB = 512 / ng, nD = 256 / ng, nU = nA + nB + 2 * nD, ns2 = (nU + LB - 1) / LB;
        int uskip = -1; int kvkey = -1;
        for (int j = 0; j < ns2; ++j) { const int jj = (early && ns2 == 6) ? (j + 4) % 6 : j; const int u = lb + jj * LB; if (u >= nU) continue;
            if (u >= nA && u < nA + nB) { const int v = u - nA, bb = grp * (8 / ng) + (v >> 6), key = bb * 4 + (v & 3);
                if (u == uskip) continue;
                const int v2 = v + LB; const bool pair = (j + 1 < ns2) && (v2 < nB) && ((v2 >> 6) == (v >> 6)) && ((v2 & 3) == (v & 3));
                if (pair) uskip = u + LB;
                unit_mem_prompt(P, lds, wsf, 0, bb, (v >> 2) & 15, v & 3, key == kvkey, pair ? ((v2 >> 2) & 15) : -1); kvkey = key; continue; }
            kvkey = -1;
            if (u < nA) { const int v = u; unit_swa_prompt(P, lds, wsf, grp * (8 / ng) + (v >> 6), (v >> 2) & 15, v & 3); }
            else if (u < nA + nB + nD) { const int v = u - nA - nB; unit_mem_sample(P, lds, wsf, 0, grp * (NDEC / ng) + (v >> 1), v & 1); }
            else { const int v = u - nA - nB - nD; unit_swa_sample(P, lds, wsf, grp * (NDEC / ng) + (v >> 1), v & 1); }
        }
    }
    SEAM(2);
    if (IN(3)) {
        pg8::Gemm g{(const bf16_t*)(ws + WS_OB), (const bf16_t*)(ws + WS_WOUTA), DM, DM}; pg8::StaticOrder S; S.init(MP, DM, G, bid);
        EpiRes<false, false> E{nullptr, nullptr, nullptr, XB, ssq + M};
        if (early) sample_gemm<2, 4>(lds, (const bf16_t*)(ws + WS_OB), DM, (const bf16_t*)(ws + WS_WOUTA), 4, E, lb, LB, srow, snrow);
        pg8::gemm_phase<EpiRes<false, false>, true, true>(lds, g, S, E);
        if (!early) sample_gemm<2, 4>(lds, (const bf16_t*)(ws + WS_OB), DM, (const bf16_t*)(ws + WS_WOUTA), 4, E, lb, LB, srow, snrow);
    }
    SEAM(3);
    if (IN(4)) {
        pg8::Gemm g{XB, (const bf16_t*)(ws + WS_WFFN), DM, DM}; pg8::StaticOrder S; S.init(MP, NFF, G, bid);
        EpiFfnConv E{ssq + M, (bf16_t*)(ws + WS_H), P.in[25], P.in[26], (float*)(ws + WS_SIDE), P.out + O_CONVP, (LAS float*)(lds + RING_BYTES)};
        if (early) sample_ffn(P, lds, 0, ssq + M, lb, LB, (snrow / 64) * grp, snrow / 64);
        pg8::gemm_phase<EpiFfnConv, true, true>(lds, g, S, E);
        if (!early) sample_ffn(P, lds, 0, ssq + M, lb, LB, (snrow / 64) * grp, snrow / 64);
    }
    SEAM(4);
    if (IN(5)) {
        pg8::Gemm g{(const bf16_t*)(ws + WS_H), (const bf16_t*)(ws + WS_WDOWN), DFF, DFF}; pg8::StaticOrder S; S.init(MP, DM, G, bid);
        ffn_fixup(P, 0, S);
        EpiRes<false, false> E{nullptr, nullptr, nullptr, XB, ssq + 2 * M};
        if (early) sample_gemm<2, 11>(lds, (const bf16_t*)(ws + WS_H), DFF, (const bf16_t*)(ws + WS_WDOWN), 4, E, lb, LB, srow, snrow);
        pg8::gemm_phase<EpiRes<false, false>, true, true>(lds, g, S, E);
        if (!early) sample_gemm<2, 11>(lds, (const bf16_t*)(ws + WS_H), DFF, (const bf16_t*)(ws + WS_WDOWN), 4, E, lb, LB, srow, snrow);
    }
    SEAM(5);
    if (IN(6)) {
        pg8::Gemm g{XB, (const bf16_t*)(ws + WS_WINB), DM, DM}; pg8::StaticOrder S; S.init(MP, NINB, G, bid);
        EpiInB E{ssq + 2 * M, (bf16_t*)(ws + WS_A), (bf16_t*)(ws + WS_B), (bf16_t*)(ws + WS_X1), (const float*)(ws + WS_GT) + 256, ssq + 4 * M};
        if (early) sample_gemm<4, 4>(lds, XBs, DM, (const bf16_t*)(ws + WS_WINB), 7, E, lb, LB, srow, snrow);
        pg8::gemm_phase<EpiInB, true, true>(lds, g, S, E);
        if (!early) sample_gemm<4, 4>(lds, XBs, DM, (const bf16_t*)(ws + WS_WINB), 7, E, lb, LB, srow, snrow);
        if (lb >= LB / 2) { p0_prologue(P, lds, (LB - LB / 2) * ng, (lb - LB / 2) * ng + grp, 1);
                            asm volatile("s_waitcnt vmcnt(0)" ::: "memory"); __syncthreads();
                            if (tid == 0) { __builtin_amdgcn_fence(__ATOMIC_RELEASE, "agent"); asm volatile("s_waitcnt vmcnt(0)" ::: "memory"); xb_add((unsigned*)(ws + WS_CTL) + GB_DEF, 1u); } }
    }
    SEAM(6);
    if (IN(7)) {
        const int nG = 256 / ng, nB = 512 / ng, nD = 256 / ng, nU = nG + nB + nD, ns7 = (nU + LB - 1) / LB;
        int uskip = -1; int kvkey = -1;
        for (int j = 0; j < ns7; ++j) { const int jj = (early && ns7 == 4) ? (j + 3) % 4 : j; const int u = lb + jj * LB; if (u >= nU) continue;
            if (u >= nG && u < nG + nB) { const int v = u - nG, bb = grp * (8 / ng) + (v >> 6), key = bb * 4 + (v & 3);
                if (u == uskip) continue;
                const int v2 = v + LB; const bool pair = (j + 1 < ns7) && (v2 < nB) && ((v2 >> 6) == (v >> 6)) && ((v2 & 3) == (v & 3));
                if (pair) uskip = u + LB;
                unit_mem_prompt(P, lds, wsf, 1, bb, (v >> 2) & 15, v & 3, key == kvkey, pair ? ((v2 >> 2) & 15) : -1); kvkey = key; continue; }
            kvkey = -1;
            if (u < nG) { const int v = u; unit_gmlp_prompt(P, lds, grp * (8 / ng) + (v >> 5), v & 31); }
            else { const int v = u - nG - nB; unit_mem_sample(P, lds, wsf, 1, grp * (NDEC / ng) + (v >> 1), v & 1); }
        }
        gmlp_sample(P, LB, lb, grp * (NDEC / ng), NDEC / ng);
    }
    SEAM(7);
    if (IN(8)) {
        if (IN(6)) {
            if (tid == 0) { unsigned* cb = (unsigned*)(ws + WS_CTL); const unsigned need = (unsigned)((LB - LB / 2) * ng);
                XB_SPIN(xb_ld(&cb[GB_DEF]) < need, cb);
                __builtin_amdgcn_fence(__ATOMIC_ACQUIRE, "agent"); asm volatile("s_waitcnt vmcnt(0)" ::: "memory"); }
            __syncthreads();
        }
        pg8::Gemm g{(const bf16_t*)(ws + WS_OB), (const bf16_t*)(ws + WS_WOUTB), DM, DM}; pg8::StaticOrder S; S.init(MP, DM, G, bid);
        EpiRes<false, false> E{nullptr, nullptr, nullptr, XB, ssq + 3 * M};
        if (early) sample_gemm<2, 4>(lds, (const bf16_t*)(ws + WS_OB), DM, (const bf16_t*)(ws + WS_WOUTB), 4, E, lb, LB, srow, snrow);
        pg8::gemm_phase<EpiRes<false, false>, true, true>(lds, g, S, E);
        if (!early) sample_gemm<2, 4>(lds, (const bf16_t*)(ws + WS_OB), DM, (const bf16_t*)(ws + WS_WOUTB), 4, E, lb, LB, srow, snrow);
    }
    SEAM(8);
    if (IN(9)) {
        pg8::Gemm g{XB, (const bf16_t*)(ws + WS_WFFN) + (size_t)NFF * DM, DM, DM}; pg8::StaticOrder S; S.init(MP, NFF, G, bid);
        EpiFfnConv E{ssq + 3 * M, (bf16_t*)(ws + WS_H), P.in[25] + 3 * DFF, P.in[26] + DFF, (float*)(ws + WS_SIDE), P.out + O_CONVP + (size_t)NBATCH * 2 * DFF, (LAS float*)(lds + RING_BYTES)};
        if (early) sample_ffn(P, lds, 1, ssq + 3 * M, lb, LB, (snrow / 64) * grp, snrow / 64);
        pg8::gemm_phase<EpiFfnConv, true, true>(lds, g, S, E);
        if (!early) sample_ffn(P, lds, 1, ssq + 3 * M, lb, LB, (snrow / 64) * grp, snrow / 64);
    }
    SEAM(9);
    if (IN(10)) {
        pg8::Gemm g{(const bf16_t*)(ws + WS_H), (const bf16_t*)(ws + WS_WDOWN) + (size_t)DM * DFF, DFF, DFF}; pg8::StaticOrder S; S.init(MP, DM, G, bid);
        ffn_fixup(P, 1, S);
        EpiRes<false, true> E{nullptr, nullptr, P.out + O_Y, XB, nullptr};
        if (early) sample_gemm<2, 11>(lds, (const bf16_t*)(ws + WS_H), DFF, (const bf16_t*)(ws + WS_WDOWN) + (size_t)DM * DFF, 4, E, lb, LB, srow, snrow);
        pg8::gemm_phase<EpiRes<false, true>, true, true>(lds, g, S, E);
        if (!early) sample_gemm<2, 11>(lds, (const bf16_t*)(ws + WS_H), DFF, (const bf16_t*)(ws + WS_WDOWN) + (size_t)DM * DFF, 4, E, lb, LB, srow, snrow);
    }
    if ((TPROBE >= 0) && bid == 0) {
        __syncthreads();
        const unsigned long long tn = __builtin_amdgcn_s_memrealtime();
        if (TPROBE == 10) t_probe = tn - t_prev;
        if (TPROBE == 100) t_probe = tn - t_start;
        while (__builtin_amdgcn_s_memrealtime() - tn < t_probe) __builtin_amdgcn_s_sleep(8);
    }
#undef IN
#undef SEAM
}

extern "C" void kernel_launch(void* const* d_in, const int* in_sizes, int n_in, void* d_out, int out_size, void* d_ws, size_t ws_size, hipStream_t stream) {
    static int grid = 0;
    if (grid == 0) {
        if (n_in != 28 || (size_t)out_size != O_END || ws_size < WS_END) { fprintf(stderr, "kernel_launch: unexpected shapes: n_in %d out %d ws %zu (need %zu)\n", n_in, out_size, ws_size, (size_t)WS_END); grid = -1; return; }
        int dev = 0, cus = 0, per_cu = 0;
        hipGetDevice(&dev); hipDeviceGetAttribute(&cus, hipDeviceAttributeMultiprocessorCount, dev);
        if (hipFuncSetAttribute((const void*)mk_fwd, hipFuncAttributeMaxDynamicSharedMemorySize, LDS_BYTES) != hipSuccess) { fprintf(stderr, "kernel_launch: hipFuncSetAttribute failed\n"); grid = -1; return; }
        hipOccupancyMaxActiveBlocksPerMultiprocessor(&per_cu, (const void*)mk_fwd, 512, LDS_BYTES);
        (void)hipGetLastError();
        if (per_cu < 1) { fprintf(stderr, "kernel_launch: occupancy query says %d blocks per CU\n", per_cu); per_cu = 1; }
        grid = cus;
    }
    if (grid < 0) return;
    if (hipMemsetAsync((char*)d_ws + WS_CTL, 0, CTL_BYTES, stream) != hipSuccess) { fprintf(stderr, "kernel_launch: memset failed\n"); return; }
    Params p{};
    for (int i = 0; i < 28; ++i) p.in[i] = (const float*)d_in[i];
    p.out = (float*)d_out; p.ws = (unsigned char*)d_ws;
#if MK_N_LAUNCHES == 1
    p.ph_lo = 0; p.ph_hi = NPHASE;
    void* args[] = {&p};
    hipError_t e = hipLaunchCooperativeKernel((const void*)mk_fwd, dim3(grid), dim3(512), args, LDS_BYTES, stream);
    if (e != hipSuccess) fprintf(stderr, "cooperative launch failed: %s (grid %d)\n", hipGetErrorString(e), grid);
#else
    for (int ph = 0; ph < NPHASE; ++ph) {
        p.ph_lo = ph; p.ph_hi = ph + 1;
        hipLaunchKernelGGL(mk_fwd, dim3(grid), dim3(512), LDS_BYTES, stream, p);
    }
#endif
}
```
